# Optimizing an MI355X kernel written in HIP

```python
import math
import jax, jax.numpy as jnp
from jax import lax
import numpy as np

D_MODEL = 1024
BATCH = 8
SEQ = 2048
DEPTH = 1

MEM_LEN = 256
RMS_EPS = 1e-6

SB_HEADS = 16
SB_HEAD_DIM = 64
SB_WIDTH = SB_HEADS * SB_HEAD_DIM
SB_BLOCK = 128

CONV_WIDTH = D_MODEL
CONV_K = 3

IN_COLS = 3 * SB_WIDTH + 3 * CONV_WIDTH + 2 * D_MODEL
IN_SPLITS = (SB_WIDTH, 2 * SB_WIDTH, 3 * SB_WIDTH,
             3 * SB_WIDTH + CONV_WIDTH, 3 * SB_WIDTH + 2 * CONV_WIDTH, 3 * SB_WIDTH + 3 * CONV_WIDTH,
             3 * SB_WIDTH + 3 * CONV_WIDTH + D_MODEL)

XATTN_HEADS = 4
XATTN_HEAD_DIM = D_MODEL // XATTN_HEADS

PEER_HEADS = 8
PEER_N_KEYS = 128
PEER_N_EXPERTS = PEER_N_KEYS * PEER_N_KEYS
PEER_KEY_DIM = 256
PEER_HALF = PEER_KEY_DIM // 2
PEER_TOPK = 16
PEER_TOKEN_CHUNK = 128

kernel_name = "hybrid_sb_shortconv_xmem_peer"


def rmsnorm(x, g):
    xf = x.astype(jnp.float32)
    y = xf * lax.rsqrt(jnp.mean(xf * xf, axis=-1, keepdims=True) + RMS_EPS) * g.astype(jnp.float32)
    return y.astype(x.dtype)


def stick_breaking_attention(q, k, v):
    s = q.shape[2]
    scale = 1.0 / math.sqrt(q.shape[-1])
    outs = []
    for blk in range(s // SB_BLOCK):
        start = blk * SB_BLOCK
        end = start + SB_BLOCK
        z = jnp.einsum('bhqd,bhkd->bhqk', q[:, :, start:end], k[:, :, :end]).astype(jnp.float32) * scale
        t_idx = start + jnp.arange(SB_BLOCK)[:, None]
        s_idx = jnp.arange(end)[None, :]
        causal = s_idx < t_idx
        log_stay = jnp.where(causal, jax.nn.log_sigmoid(-z), 0.0)
        log_after = lax.cumsum(log_stay, axis=3, reverse=True) - log_stay
        w = jnp.where(causal, jnp.exp(jax.nn.log_sigmoid(z) + log_after), 0.0)
        outs.append(jnp.einsum('bhqk,bhkd->bhqd', w.astype(v.dtype), v[:, :, :end]))
    return jnp.concatenate(outs, axis=2)


def causal_short_conv(u, w):
    s = u.shape[1]
    padded = jnp.pad(u, ((0, 0), (CONV_K - 1, 0), (0, 0)))
    y = padded[:, 0:s] * w[0]
    for i in range(1, CONV_K):
        y = y + padded[:, i:i + s] * w[i]
    return y


def memory_cross_attention(xn, memn, wq, wk, wv, wo):
    b, s, _ = xn.shape
    m = memn.shape[1]
    q = (xn @ wq).reshape(b, s, XATTN_HEADS, XATTN_HEAD_DIM)
    k = (memn @ wk).reshape(b, m, XATTN_HEADS, XATTN_HEAD_DIM)
    v = (memn @ wv).reshape(b, m, XATTN_HEADS, XATTN_HEAD_DIM)
    scores = jnp.einsum('bshd,bmhd->bhsm', q, k).astype(jnp.float32) / math.sqrt(XATTN_HEAD_DIM)
    p = jax.nn.softmax(scores, axis=-1).astype(v.dtype)
    o = jnp.einsum('bhsm,bmhd->bshd', p, v).reshape(b, s, XATTN_HEADS * XATTN_HEAD_DIM)
    return o @ wo


def peer_ffn(xn, w_query, sub_keys, expert_u, expert_v):
    b, s, d = xn.shape
    q = (xn @ w_query).reshape(b, s, PEER_HEADS, 2, PEER_HALF).astype(jnp.float32)
    sc = jnp.einsum('bshcd,hcnd->bshcn', q, sub_keys.astype(jnp.float32))
    top_s, top_i = lax.top_k(sc, PEER_TOPK)
    cand_s = top_s[..., 0, :, None] + top_s[..., 1, None, :]
    cand_i = top_i[..., 0, :, None] * PEER_N_KEYS + top_i[..., 1, None, :]
    cand_s = cand_s.reshape(b, s, PEER_HEADS, PEER_TOPK * PEER_TOPK)
    cand_i = cand_i.reshape(b, s, PEER_HEADS, PEER_TOPK * PEER_TOPK)
    best_s, best_pos = lax.top_k(cand_s, PEER_TOPK)
    expert_idx = jnp.take_along_axis(cand_i, best_pos, axis=-1)
    gates = jax.nn.softmax(best_s, axis=-1)

    n_tok = b * s
    n_chunks = n_tok // PEER_TOKEN_CHUNK
    n_sel = PEER_HEADS * PEER_TOPK
    xc = xn.reshape(n_chunks, PEER_TOKEN_CHUNK, d)
    ic = expert_idx.reshape(n_chunks, PEER_TOKEN_CHUNK, n_sel)
    gc = gates.reshape(n_chunks, PEER_TOKEN_CHUNK, n_sel).astype(xn.dtype)

    def chunk_fn(args):
        xb, ib, gb = args
        u = expert_u[ib]
        act = jax.nn.gelu(jnp.einsum('ced,cd->ce', u, xb))
        return jnp.einsum('ce,ced->cd', gb * act, expert_v[ib])

    out = lax.map(chunk_fn, (xc, ic, gc))
    return out.reshape(b, s, d)


def setup_inputs(seed: int = 0) -> dict:
    key = jax.random.key(seed)
    ks = jax.random.split(key, 24)

    def w(k, shape, fan_in):
        return jax.random.normal(k, shape, jnp.float32) * (fan_in ** -0.5)

    def gain(k, shape):
        return 1.0 + 0.02 * jax.random.normal(k, shape, jnp.float32)

    L = DEPTH
    return {
        "x": jax.random.normal(ks[0], (BATCH, SEQ, D_MODEL), jnp.float32),
        "mem": jax.random.normal(ks[1], (BATCH, MEM_LEN, D_MODEL), jnp.float32),
        "norm_mix": gain(ks[2], (L, D_MODEL)),
        "w_in": w(ks[3], (L, D_MODEL, IN_COLS), D_MODEL),
        "conv_w": w(ks[4], (L, CONV_K, CONV_WIDTH), CONV_K),
        "w_branch_attn": w(ks[5], (L, SB_WIDTH, D_MODEL), SB_WIDTH),
        "w_branch_conv": w(ks[6], (L, CONV_WIDTH, D_MODEL), CONV_WIDTH),
        "w_out": w(ks[7], (L, D_MODEL, D_MODEL), D_MODEL),
        "norm_xattn": gain(ks[8], (L, D_MODEL)),
        "norm_mem": gain(ks[9], (L, D_MODEL)),
        "xattn_wq": w(ks[10], (L, D_MODEL, XATTN_HEADS * XATTN_HEAD_DIM), D_MODEL),
        "xattn_wk": w(ks[11], (L, D_MODEL, XATTN_HEADS * XATTN_HEAD_DIM), D_MODEL),
        "xattn_wv": w(ks[12], (L, D_MODEL, XATTN_HEADS * XATTN_HEAD_DIM), D_MODEL),
        "xattn_wo": w(ks[13], (L, XATTN_HEADS * XATTN_HEAD_DIM, D_MODEL), XATTN_HEADS * XATTN_HEAD_DIM),
        "norm_ffn": gain(ks[14], (L, D_MODEL)),
        "peer_w_query": w(ks[15], (L, D_MODEL, PEER_HEADS * PEER_KEY_DIM), D_MODEL),
        "peer_sub_keys": w(ks[16], (L, PEER_HEADS, 2, PEER_N_KEYS, PEER_HALF), PEER_HALF),
        "peer_u": w(ks[17], (L, PEER_N_EXPERTS, D_MODEL), D_MODEL),
        "peer_v": w(ks[18], (L, PEER_N_EXPERTS, D_MODEL), PEER_HEADS),
        "norm_final": gain(ks[19], (D_MODEL,)),
    }


def reference(x, mem, norm_mix, w_in, conv_w, w_branch_attn, w_branch_conv, w_out,
              norm_xattn, norm_mem, xattn_wq, xattn_wk, xattn_wv, xattn_wo,
              norm_ffn, peer_w_query, peer_sub_keys, peer_u, peer_v, norm_final):
    b, s, _ = x.shape
    h = x
    for l in range(DEPTH):
        xn = rmsnorm(h, norm_mix[l])
        proj = xn @ w_in[l]
        q, k, v, cx, cb, cc, ga, gcv = jnp.split(proj, IN_SPLITS, axis=-1)

        def heads(t):
            return t.reshape(b, s, SB_HEADS, SB_HEAD_DIM).transpose(0, 2, 1, 3)

        y_attn = stick_breaking_attention(heads(q), heads(k), heads(v))
        y_attn = y_attn.transpose(0, 2, 1, 3).reshape(b, s, SB_WIDTH)
        y_conv = cb * causal_short_conv(cc * cx, conv_w[l])
        merged = (jax.nn.sigmoid(ga) * (y_attn @ w_branch_attn[l])
                  + jax.nn.sigmoid(gcv) * (y_conv @ w_branch_conv[l]))
        h = h + merged @ w_out[l]

        xn = rmsnorm(h, norm_xattn[l])
        memn = rmsnorm(mem, norm_mem[l])
        h = h + memory_cross_attention(xn, memn, xattn_wq[l], xattn_wk[l], xattn_wv[l], xattn_wo[l])

        xn = rmsnorm(h, norm_ffn[l])
        h = h + peer_ffn(xn, peer_w_query[l], peer_sub_keys[l], peer_u[l], peer_v[l])
    return rmsnorm(h, norm_final)
```

```cpp
#include <hip/hip_runtime.h>
#include <hip/hip_bf16.h>
#include <cstdio>
#include <cstdint>
#include <cmath>

#ifndef MK_N_LAUNCHES
#define MK_N_LAUNCHES 10
#endif
namespace pg8 {
#define PG8_LAS __attribute__((address_space(3)))
typedef unsigned short bf16_t;
typedef short bf16x8 __attribute__((ext_vector_type(8)));
typedef float f32x4 __attribute__((ext_vector_type(4)));
typedef float f32x2 __attribute__((ext_vector_type(2)));
typedef unsigned u32x4 __attribute__((ext_vector_type(4)));
typedef unsigned u32x2 __attribute__((ext_vector_type(2)));
constexpr int BM = 256, BK = 64, HALF = 128, HTB = HALF * BK * 2  , STAGE_BYTES = 8 * HTB, NXCD = 8, WGM = 8;

__host__ __device__ __forceinline__ int lds_byte(int r, int c) { const int st = (r >> 4) * 2 + (c >> 5), rr = r & 15, cc = c & 31, ob = rr * 64 + cc * 2; return st * 1024 + (ob ^ (((ob >> 9) & 1) << 5)); }
__host__ __device__ __forceinline__ void stage_rc(int b, int& R, int& C) { const int st = b / 1024, sb = b % 1024, swz = sb ^ (((sb >> 9) & 1) << 5); R = (st >> 1) * 16 + swz / 64; C = (st & 1) * 32 + (swz % 64) / 2; }
__host__ __device__ __forceinline__ int perm32(int rho) { const int n = rho >> 4, i = rho & 15; return 8 * (i >> 2) + 4 * n + (i & 3); }

struct Unit { int pm, pn, g; };
struct GemmSet { const bf16_t* A0; const bf16_t* B0; const bf16_t* A1; const bf16_t* B1; int K; };

struct TileOrder {
    int nM, nN, nwg, G, c, passes;
    __device__ void init(int M, int N, int G_, int c_, int passes_ = 1) { nM = M / BM; nN = N / BM; nwg = nM * nN; G = G_; c = c_; passes = passes_; }
    __device__ bool next(int i, Unit& u) const {
        const int ti = (passes == 2) ? (i >> 1) : i; u.g = (passes == 2) ? (i & 1) : 0;
        const long L = (long)ti * G + c; if (L >= nwg) return false;
        int wgid = (int)L; { const int q = nwg / NXCD, r = nwg % NXCD, xcd = wgid % NXCD, off = wgid / NXCD; wgid = (xcd < r ? xcd * (q + 1) : r * (q + 1) + (xcd - r) * q) + off; }
        const int nig = WGM * nN, gid = wgid / nig, fm = gid * WGM, gsz = (nM - fm) < WGM ? (nM - fm) : WGM;
        u.pm = fm + ((wgid % nig) % gsz); u.pn = (wgid % nig) / gsz; return true;
    }
    __device__ __forceinline__ void a_ready(const Unit&) const {}
    __device__ __forceinline__ void done(const Unit&) const {}
};
struct SubOrder {
    int nN, n, idx;
    __device__ void init(int M, int N, int c0, int c_) { nN = N / BM; n = (M / BM) * nN; idx = c_ - c0; }
    __device__ bool next(int i, Unit& u) const { if (i != 0 || idx < 0 || idx >= n) return false; u.pm = idx / nN; u.pn = idx % nN; u.g = 0; return true; }
    __device__ __forceinline__ void a_ready(const Unit&) const {}
    __device__ __forceinline__ void done(const Unit&) const {}
};

typedef __bf16 bf16x2_t __attribute__((ext_vector_type(2)));
__device__ __forceinline__ unsigned cvt_pk_bf16(float lo, float hi) { f32x2 v = {lo, hi}; bf16x2_t b = __builtin_convertvector(v, bf16x2_t); return __builtin_bit_cast(unsigned, b); }
__device__ __forceinline__ float bf_lo(unsigned w) { return __builtin_bit_cast(float, w << 16); }
__device__ __forceinline__ float bf_hi(unsigned w) { return __builtin_bit_cast(float, w & 0xffff0000u); }
__device__ __forceinline__ u32x4 pack8(const f32x4 v0, const f32x4 v1) { u32x4 w; w.x = cvt_pk_bf16(v0[0], v0[1]); w.y = cvt_pk_bf16(v0[2], v0[3]); w.z = cvt_pk_bf16(v1[0], v1[1]); w.w = cvt_pk_bf16(v1[2], v1[3]); return w; }
__device__ __forceinline__ float sigmoidf_fast(float x) { return __builtin_amdgcn_rcpf(1.0f + __builtin_amdgcn_exp2f(-1.4426950408889634f * x)); }

struct EpiStore {
    static constexpr bool PERM = true, AFTER_DRAIN = false;
    bf16_t* O; int ldc; float scale;
    __device__ __forceinline__ void operator()(const f32x4 (&acc)[2][2][4][2], const Unit& u, int wr, int wc, int fr, int fq) const {
        const int row0 = u.pm * BM + wr * 64 + fr, col0 = u.pn * BM + wc * 32 + 8 * fq;
#pragma unroll
        for (int ai = 0; ai < 2; ++ai)
#pragma unroll
            for (int m = 0; m < 4; ++m) { bf16_t* rowp = O + (size_t)(row0 + ai * HALF + m * 16) * ldc + col0;
#pragma unroll
                for (int bj = 0; bj < 2; ++bj) *(u32x4*)(rowp + bj * HALF) = pack8(acc[ai][bj][m][0] * scale, acc[ai][bj][m][1] * scale); }
    }
};

struct EpiInProj {
    static constexpr bool PERM = true, AFTER_DRAIN = false;
    bf16_t *q, *k, *v, *uu, *cb, *sga, *sgc; float qscale;
    __device__ __forceinline__ void operator()(const f32x4 (&acc)[2][2][4][2], const Unit& u, int wr, int wc, int fr, int fq) const {
        const int row0 = u.pm * BM + wr * 64 + fr; const int pn = u.pn;
        if (pn >= 12 && pn < 20) {
            const int col0 = (pn - 12) * 128 + wc * 32 + 8 * fq;
#pragma unroll
            for (int ai = 0; ai < 2; ++ai)
#pragma unroll
                for (int m = 0; m < 4; ++m) *(u32x4*)(uu + (size_t)(row0 + ai * HALF + m * 16) * 1024 + col0) = pack8(acc[ai][0][m][0] * acc[ai][1][m][0], acc[ai][0][m][1] * acc[ai][1][m][1]);
            return;
        }
        bf16_t* base; float sc = 1.f; bool sig = false;
        if (pn < 4) { base = q; sc = qscale; } else if (pn < 8) base = k; else if (pn < 12) base = v; else if (pn < 24) base = cb; else if (pn < 28) { base = sga; sig = true; } else { base = sgc; sig = true; }
        const int col0 = (pn & 3) * BM + wc * 32 + 8 * fq;
#pragma unroll
        for (int ai = 0; ai < 2; ++ai)
#pragma unroll
            for (int m = 0; m < 4; ++m) { bf16_t* rowp = base + (size_t)(row0 + ai * HALF + m * 16) * 1024 + col0;
#pragma unroll
                for (int bj = 0; bj < 2; ++bj) { f32x4 v0 = acc[ai][bj][m][0], v1 = acc[ai][bj][m][1];
                    if (sig) {
#pragma unroll
                        for (int e = 0; e < 4; ++e) { v0[e] = sigmoidf_fast(v0[e]); v1[e] = sigmoidf_fast(v1[e]); } }
                    else { v0 = v0 * sc; v1 = v1 * sc; }
                    *(u32x4*)(rowp + bj * HALF) = pack8(v0, v1); } }
    }
};

struct EpiGate {
    static constexpr bool PERM = true, AFTER_DRAIN = false;
    bf16_t* merged; const bf16_t* sga; const bf16_t* sgc;
    __device__ __forceinline__ void operator()(const f32x4 (&acc)[2][2][4][2], const Unit& u, int wr, int wc, int fr, int fq) const {
        const int row0 = u.pm * BM + wr * 64 + fr, col0 = u.pn * BM + wc * 32 + 8 * fq; const bf16_t* gate = u.g ? sgc : sga;
#pragma unroll
        for (int ai = 0; ai < 2; ++ai)
#pragma unroll
            for (int m = 0; m < 4; ++m) { const size_t off = (size_t)(row0 + ai * HALF + m * 16) * 1024 + col0;
#pragma unroll
                for (int bj = 0; bj < 2; ++bj) { const u32x4 gw = *(const u32x4*)(gate + off + bj * HALF);
                    f32x4 v0 = acc[ai][bj][m][0], v1 = acc[ai][bj][m][1];
                    v0[0] *= bf_lo(gw.x); v0[1] *= bf_hi(gw.x); v0[2] *= bf_lo(gw.y); v0[3] *= bf_hi(gw.y); v1[0] *= bf_lo(gw.z); v1[1] *= bf_hi(gw.z); v1[2] *= bf_lo(gw.w); v1[3] *= bf_hi(gw.w);
                    if (u.g) { const u32x4 pw = *(const u32x4*)(merged + off + bj * HALF);
                        v0[0] += bf_lo(pw.x); v0[1] += bf_hi(pw.x); v0[2] += bf_lo(pw.y); v0[3] += bf_hi(pw.y); v1[0] += bf_lo(pw.z); v1[1] += bf_hi(pw.z); v1[2] += bf_lo(pw.w); v1[3] += bf_hi(pw.w); }
                    *(u32x4*)(merged + off + bj * HALF) = pack8(v0, v1); } }
    }
};

struct EpiResid {
    static constexpr bool PERM = false, AFTER_DRAIN = false;
    const float* base; float* hf; bf16_t* hb; float* ssq;
    __device__ __forceinline__ void operator()(const f32x4 (&acc)[2][2][4][2], const Unit& u, int wr, int wc, int fr, int fq) const {
        const int row0 = u.pm * BM + wr * 64 + fr, col0 = u.pn * BM + wc * 32 + 4 * fq;
#pragma unroll
        for (int ai = 0; ai < 2; ++ai)
#pragma unroll
            for (int m = 0; m < 4; ++m) { const int row = row0 + ai * HALF + m * 16; const size_t off = (size_t)row * 1024 + col0; float s = 0.f;
#pragma unroll
                for (int bj = 0; bj < 2; ++bj)
#pragma unroll
                    for (int n = 0; n < 2; ++n) { const f32x4 b = *(const f32x4*)(base + off + bj * HALF + n * 16); const f32x4 h = b + acc[ai][bj][m][n];
                        *(f32x4*)(hf + off + bj * HALF + n * 16) = h; s += (h[0] * h[0] + h[1] * h[1]) + (h[2] * h[2] + h[3] * h[3]);
                        u32x2 w; w.x = cvt_pk_bf16(h[0], h[1]); w.y = cvt_pk_bf16(h[2], h[3]); *(u32x2*)(hb + off + bj * HALF + n * 16) = w; }
                s += __shfl_xor(s, 16); s += __shfl_xor(s, 32);
                if (fq == 0) ssq[(size_t)row * 16 + u.pn * 4 + wc] = s; }
    }
};

struct EpiRowScale {
    static constexpr bool PERM = true, AFTER_DRAIN = false;
    bf16_t* O; int ldc; const float* ssq; float scale; float eps;
    __device__ __forceinline__ void operator()(const f32x4 (&acc)[2][2][4][2], const Unit& u, int wr, int wc, int fr, int fq) const {
        const int row0 = u.pm * BM + wr * 64 + fr, col0 = u.pn * BM + wc * 32 + 8 * fq;
#pragma unroll
        for (int ai = 0; ai < 2; ++ai)
#pragma unroll
            for (int m = 0; m < 4; ++m) { const int row = row0 + ai * HALF + m * 16; const f32x4* sp = (const f32x4*)(ssq + (size_t)row * 16);
                const f32x4 a = sp[0], b = sp[1], c = sp[2], d = sp[3]; const f32x4 t = (a + b) + (c + d);
                const float rs = __builtin_amdgcn_rsqf(((t[0] + t[1]) + (t[2] + t[3])) * (1.0f / 1024.0f) + eps) * scale;
                bf16_t* rowp = O + (size_t)row * ldc + col0;
#pragma unroll
                for (int bj = 0; bj < 2; ++bj) *(u32x4*)(rowp + bj * HALF) = pack8(acc[ai][bj][m][0] * rs, acc[ai][bj][m][1] * rs); }
    }
};

template <class Epi, class Sched, bool ALIGN_EPI = false, bool SP2 = false>
__device__ __forceinline__ void gemm_phase(PG8_LAS unsigned char* lds, const GemmSet g, const Sched& S, const Epi& E) {
    const int tid = threadIdx.x, wid = __builtin_amdgcn_readfirstlane(tid >> 6), lane = tid & 63, wr = wid >> 2, wc = wid & 3, fr = lane & 15, fq = lane >> 4;
    const int K = g.K, nt = K / BK;
    unsigned voffA[2], voffB[2];
#pragma unroll
    for (int i = 0; i < 2; ++i) { int R, C; stage_rc(tid * 16 + i * 8192, R, C); const int Rb = Epi::PERM ? ((R & ~31) + perm32(R & 31)) : R;
        voffA[i] = (unsigned)(R * K + C) * 2u; voffB[i] = (unsigned)(Rb * K + C) * 2u; }
    const size_t kstep = (size_t)(BK * 2);
    const size_t hstep = (size_t)HALF * K * 2;
    const size_t tstep = 2 * hstep;
    const unsigned ldsw = (unsigned)wid * 1024u;
    const int aoff = lds_byte(wr * 64 + fr, fq * 8), boff = lds_byte(wc * 32 + fr, fq * 8);
#define PG8_SA(b, h) (((b) * 2 + (h)) * HTB)
#define PG8_SB(b, h) ((4 + (b) * 2 + (h)) * HTB)
#define PG8_STAGE(bufoff, gbase, voff) do { _Pragma("unroll") for (int _i = 0; _i < 2; ++_i) \
        __builtin_amdgcn_global_load_lds((const unsigned*)((const char*)(gbase) + (voff)[_i]), (PG8_LAS unsigned*)(lds + (bufoff) + ldsw + _i * 8192), 16, 0, 0); } while (0)
#define PG8_LDA(dst, b, h) do { _Pragma("unroll") for (int m = 0; m < 4; ++m) _Pragma("unroll") for (int k = 0; k < 2; ++k) dst[m][k] = *(const PG8_LAS bf16x8*)(lds + PG8_SA(b, h) + aoff + m * 2048 + k * 1024); } while (0)
#define PG8_LDB(dst, b, h) do { _Pragma("unroll") for (int n = 0; n < 2; ++n) _Pragma("unroll") for (int k = 0; k < 2; ++k) dst[n][k] = *(const PG8_LAS bf16x8*)(lds + PG8_SB(b, h) + boff + n * 2048 + k * 1024); } while (0)
#define PG8_MMA(ai, bj, At, Bt) do { __builtin_amdgcn_s_setprio(1); _Pragma("unroll") for (int m = 0; m < 4; ++m) _Pragma("unroll") for (int n = 0; n < 2; ++n) _Pragma("unroll") for (int k = 0; k < 2; ++k) \
        acc[ai][bj][m][n] = __builtin_amdgcn_mfma_f32_16x16x32_bf16(Bt[n][k], At[m][k], acc[ai][bj][m][n], 0, 0, 0); __builtin_amdgcn_s_setprio(0); } while (0)
#define PG8_WAIT_V(n) asm volatile("s_waitcnt vmcnt(" #n ")" ::: "memory")
#define PG8_WAIT_L(n) asm volatile("s_waitcnt lgkmcnt(" #n ")" ::: "memory")
#define PG8_BAR __builtin_amdgcn_s_barrier()
#define PG8_SCHED __builtin_amdgcn_sched_barrier(0)
    Unit cur, nxt; int ui = 0;
    if (!S.next(0, cur)) return;
    f32x4 acc[2][2][4][2];
#pragma unroll
    for (int a = 0; a < 2; ++a)
#pragma unroll
        for (int b = 0; b < 2; ++b)
#pragma unroll
            for (int m = 0; m < 4; ++m)
#pragma unroll
                for (int n = 0; n < 2; ++n) acc[a][b][m][n] = (f32x4){0.f, 0.f, 0.f, 0.f};
    bf16x8 At[4][2], B0[2][2], B1[2][2];
    const char* cA = (const char*)(cur.g ? g.A1 : g.A0) + (size_t)cur.pm * tstep; const char* cB = (const char*)(cur.g ? g.B1 : g.B0) + (size_t)cur.pn * tstep;
    S.a_ready(cur);
    if constexpr (SP2) {
        PG8_STAGE(PG8_SB(0, 0), cB, voffB); PG8_STAGE(PG8_SB(0, 1), cB + hstep, voffB); PG8_STAGE(PG8_SA(0, 0), cA, voffA); PG8_STAGE(PG8_SA(0, 1), cA + hstep, voffA);
        if (wr == 1) PG8_BAR;
        PG8_WAIT_V(2); PG8_BAR;
        PG8_STAGE(PG8_SB(1, 0), cB + kstep, voffB); PG8_STAGE(PG8_SA(1, 0), cA + kstep, voffA); PG8_STAGE(PG8_SB(1, 1), cB + hstep + kstep, voffB);
        PG8_WAIT_V(6); PG8_BAR;
    } else {
        PG8_STAGE(PG8_SB(0, 0), cB, voffB); PG8_STAGE(PG8_SA(0, 0), cA, voffA); PG8_STAGE(PG8_SB(0, 1), cB + hstep, voffB); PG8_STAGE(PG8_SA(0, 1), cA + hstep, voffA);
        if (wr == 1) PG8_BAR;
        PG8_WAIT_V(4); PG8_BAR;
        PG8_STAGE(PG8_SB(1, 0), cB + kstep, voffB); PG8_STAGE(PG8_SA(1, 0), cA + kstep, voffA); PG8_STAGE(PG8_SB(1, 1), cB + hstep + kstep, voffB);
        PG8_WAIT_V(6); PG8_BAR;
    }
    for (;;) {
        const bool has_next = S.next(ui + 1, nxt);
        const char* nA = has_next ? (const char*)(nxt.g ? g.A1 : g.A0) + (size_t)nxt.pm * tstep : cA; const char* nB = has_next ? (const char*)(nxt.g ? g.B1 : g.B0) + (size_t)nxt.pn * tstep : cB;
        for (int t = 0; t < nt; t += 2) {
            const bool last = (t == nt - 2);
            const char* a1 = cA + (size_t)(t + 1) * kstep;
            const char* a2 = last ? nA : cA + (size_t)(t + 2) * kstep; const char* b2 = last ? nB : cB + (size_t)(t + 2) * kstep;
            const char* a3 = a2 + kstep; const char* b3 = b2 + kstep;
            if (last && has_next) S.a_ready(nxt);
            if constexpr (SP2) {
            PG8_LDB(B0, 0, 0); PG8_LDB(B1, 0, 1); PG8_SCHED; PG8_LDA(At, 0, 0); PG8_STAGE(PG8_SA(1, 1), a1 + hstep, voffA);
            PG8_WAIT_V(8); PG8_WAIT_L(0); PG8_BAR; PG8_MMA(0, 0, At, B0); PG8_MMA(0, 1, At, B1); PG8_BAR; PG8_SCHED;
            PG8_LDA(At, 0, 1); PG8_STAGE(PG8_SB(0, 0), b2, voffB); PG8_STAGE(PG8_SB(0, 1), b2 + hstep, voffB); PG8_STAGE(PG8_SA(0, 0), a2, voffA);
            PG8_WAIT_V(8); PG8_WAIT_L(0); PG8_BAR; PG8_MMA(1, 0, At, B0); PG8_MMA(1, 1, At, B1); PG8_BAR; PG8_SCHED;
            PG8_LDB(B0, 1, 0); PG8_LDB(B1, 1, 1); PG8_SCHED; PG8_LDA(At, 1, 0); PG8_STAGE(PG8_SA(0, 1), a2 + hstep, voffA);
            PG8_WAIT_V(8); PG8_WAIT_L(0); PG8_BAR; PG8_MMA(0, 0, At, B0); PG8_MMA(0, 1, At, B1); PG8_BAR; PG8_SCHED;
            PG8_LDA(At, 1, 1); PG8_STAGE(PG8_SB(1, 0), b3, voffB); PG8_STAGE(PG8_SB(1, 1), b3 + hstep, voffB); PG8_STAGE(PG8_SA(1, 0), a3, voffA);
            PG8_WAIT_V(8); PG8_WAIT_L(0); PG8_BAR; PG8_MMA(1, 0, At, B0); PG8_MMA(1, 1, At, B1); PG8_BAR; PG8_SCHED;
            } else {
            PG8_LDB(B0, 0, 0); PG8_SCHED; PG8_LDA(At, 0, 0); PG8_STAGE(PG8_SA(1, 1), a1 + hstep, voffA);
            PG8_WAIT_L(8); PG8_BAR; PG8_WAIT_L(0); PG8_MMA(0, 0, At, B0); PG8_BAR; PG8_SCHED;
            PG8_LDB(B1, 0, 1); PG8_STAGE(PG8_SB(0, 0), b2, voffB);
            PG8_BAR; PG8_WAIT_L(0); PG8_MMA(0, 1, At, B1); PG8_BAR;
            PG8_LDA(At, 0, 1); PG8_STAGE(PG8_SA(0, 0), a2, voffA);
            PG8_BAR; PG8_WAIT_L(0); PG8_MMA(1, 0, At, B0); PG8_BAR; PG8_SCHED;
            PG8_STAGE(PG8_SB(0, 1), b2 + hstep, voffB);
            PG8_WAIT_V(6); PG8_BAR; PG8_MMA(1, 1, At, B1); PG8_BAR;
            PG8_LDB(B0, 1, 0); PG8_SCHED; PG8_LDA(At, 1, 0); PG8_STAGE(PG8_SA(0, 1), a2 + hstep, voffA);
            PG8_WAIT_L(8); PG8_BAR; PG8_WAIT_L(0); PG8_MMA(0, 0, At, B0); PG8_BAR; PG8_SCHED;
            PG8_LDB(B1, 1, 1); PG8_STAGE(PG8_SB(1, 0), b3, voffB);
            PG8_BAR; PG8_WAIT_L(0); PG8_MMA(0, 1, At, B1); PG8_BAR;
            PG8_LDA(At, 1, 1); PG8_STAGE(PG8_SA(1, 0), a3, voffA);
            PG8_BAR; PG8_WAIT_L(0); PG8_MMA(1, 0, At, B0); PG8_BAR; PG8_SCHED;
            PG8_STAGE(PG8_SB(1, 1), b3 + hstep, voffB);
            PG8_WAIT_V(6); PG8_BAR; PG8_MMA(1, 1, At, B1); PG8_BAR;
            }
        }
        if constexpr (ALIGN_EPI) { if (wr == 0) PG8_BAR; }
        if constexpr (!Epi::AFTER_DRAIN) { E(acc, cur, wr, wc, fr, fq); S.done(cur); }
        if (!has_next) break;
#pragma unroll
        for (int a = 0; a < 2; ++a)
#pragma unroll
            for (int b = 0; b < 2; ++b)
#pragma unroll
                for (int m = 0; m < 4; ++m)
#pragma unroll
                    for (int n = 0; n < 2; ++n) acc[a][b][m][n] = (f32x4){0.f, 0.f, 0.f, 0.f};
        cur = nxt; cA = nA; cB = nB; ++ui;
        if constexpr (ALIGN_EPI) { if (wr == 1) PG8_BAR; }
    }
    PG8_WAIT_V(0);
    if constexpr (!ALIGN_EPI) { if (wr == 0) PG8_BAR; }
    PG8_BAR;
    if constexpr (Epi::AFTER_DRAIN) { E.fused(acc, cur, wr, wc, fr, fq, lds, wid, lane); S.done(cur); }
#undef PG8_SA
#undef PG8_SB
#undef PG8_STAGE
#undef PG8_LDA
#undef PG8_LDB
#undef PG8_MMA
#undef PG8_WAIT_V
#undef PG8_WAIT_L
#undef PG8_BAR
#undef PG8_SCHED
}
}

namespace sb {
using bf16 = __hip_bfloat16;
using bf16x8 = __attribute__((ext_vector_type(8))) short;
using s16x4 = __attribute__((ext_vector_type(4))) short;
using f32x16 = __attribute__((ext_vector_type(16))) float;
using u32x4 = __attribute__((ext_vector_type(4))) unsigned;
constexpr int SEQ = 2048, NHEAD = 16, HD = 64, DM = 1024;
constexpr int SLOTB = 8192, LDS_K = 0, LDS_V = 2 * SLOTB, LDS_BYTES = 4 * SLOTB;
__device__ __forceinline__ int crow(int r, int hi) { return (r & 3) + 8 * (r >> 2) + 4 * hi; }
__device__ __forceinline__ void glds16(const void* gsrc, unsigned lds_dst) { unsigned keep;
    asm volatile("s_mov_b32 %0, m0\n\ts_mov_b32 m0, %2\n\ts_nop 0\n\tglobal_load_lds_dwordx4 %1, off\n\ts_mov_b32 m0, %0" : "=&s"(keep) : "v"(gsrc), "s"(lds_dst) : "memory"); }
typedef __attribute__((address_space(3))) const char* lds_cptr;
typedef short v4i16_t __attribute__((ext_vector_type(4)));
typedef float f32x2_t __attribute__((ext_vector_type(2))); typedef __bf16 bf16x2_t __attribute__((ext_vector_type(2)));
__device__ __forceinline__ unsigned cvtpk(float lo, float hi) { f32x2_t v = {lo, hi}; bf16x2_t b = __builtin_convertvector(v, bf16x2_t); return __builtin_bit_cast(unsigned, b); }
__device__ __forceinline__ s16x4 vtr(lds_cptr p) { return __builtin_bit_cast(s16x4, __builtin_amdgcn_ds_read_tr16_b64_v4i16((__attribute__((address_space(3))) v4i16_t*)p)); }
__device__ __forceinline__ bf16x8 pack8(const f32x16& p, int b) { u32x4 w; w.x = cvtpk(p[b], p[b + 1]); w.y = cvtpk(p[b + 2], p[b + 3]); w.z = cvtpk(p[b + 4], p[b + 5]); w.w = cvtpk(p[b + 6], p[b + 7]); return __builtin_bit_cast(bf16x8, w); }
__device__ __forceinline__ float lo_lane(float x) { auto rr = __builtin_amdgcn_permlane32_swap(__float_as_uint(x), __float_as_uint(x), false, false); return __uint_as_float(rr[0]); }
#define SB_WAIT_BAR() asm volatile("s_waitcnt vmcnt(0) lgkmcnt(0)\n\ts_barrier" ::: "memory")

template <bool EARLY> __device__ __forceinline__ void sb_unit(int b, int h, int qb, const bf16* Q, const bf16* __restrict__ K, const bf16* __restrict__ V, bf16* O, char* shm) {
    const int tid = threadIdx.x, lane = tid & 63, r32 = lane & 31, hi = lane >> 5; const int wid = __builtin_amdgcn_readfirstlane(tid >> 6);
    const long rowbase = (long)b * SEQ; const int q0 = qb * 256;
    const bf16* Qw = Q + (rowbase + q0 + wid * 32) * DM + h * HD;
    const bf16* Kh = K + rowbase * DM + h * HD; const bf16* Vh = V + rowbase * DM + h * HD;
    const unsigned lds0 = (unsigned)(uintptr_t)shm;
    const bf16* ksrc = Kh + (long)lane * DM + wid * 8;
    const bf16* vsrc = Vh + (long)(16 * (wid & 3) + (lane >> 2)) * DM + (wid >> 2) * 32 + (lane & 3) * 8;
    const unsigned kdst = lds0 + LDS_K + wid * 1024, vdst = lds0 + LDS_V + wid * 1024;
#define SB_DMA_K(t, slot) glds16(ksrc + (long)(t) * 64 * DM, (unsigned)__builtin_amdgcn_readfirstlane(kdst + (slot)))
#define SB_DMA_V(t, slot) glds16(vsrc + (long)(t) * 64 * DM, (unsigned)__builtin_amdgcn_readfirstlane(vdst + (slot)))
    const lds_cptr shm3 = (lds_cptr)shm; const lds_cptr kp0 = shm3 + LDS_K + hi * 1024 + r32 * 16;
    const lds_cptr vp0 = shm3 + LDS_V + ((lane >> 4) & 1) * 32 + (lane & 3) * 8 + (4 * hi + ((lane & 15) >> 2)) * 64;
    const int NT = (q0 + 256) / 64;
    SB_DMA_K(NT - 1, 0); SB_DMA_V(NT - 1, 0);
    bf16x8 qr[4];
#pragma unroll
    for (int d0 = 0; d0 < 4; ++d0) qr[d0] = *reinterpret_cast<const bf16x8*>(&Qw[(long)r32 * DM + d0 * 16 + hi * 8]);
    bf16x8 tri[2], ones;
#pragma unroll
    for (int ks = 0; ks < 2; ++ks)
#pragma unroll
        for (int j = 0; j < 8; ++j) { const int kk = 16 * ks + 8 * (j >> 2) + 4 * hi + (j & 3); tri[ks][j] = (kk >= r32) ? (short)0x3F80 : (short)0; }
#pragma unroll
    for (int j = 0; j < 8; ++j) ones[j] = (short)0x3F80;
    f32x16 o0 = f32x16{}, o1 = f32x16{}; float R = 0.f;
    const int trow = q0 + wid * 32 + r32;
    const int wmin = q0 + wid * 32, wmax = wmin + 31;
    for (int it = 0; it < NT; ++it) {
        const int t = NT - 1 - it; const int sl = (it & 1) * SLOTB;
        SB_WAIT_BAR();
        if (t > 0) { SB_DMA_K(t - 1, sl ^ SLOTB); SB_DMA_V(t - 1, sl ^ SLOTB); }
        if (64 * t < wmax) {
            f32x16 p0 = f32x16{}, p1 = f32x16{};
#pragma unroll
            for (int d0 = 0; d0 < 4; ++d0) {
                const bf16x8 b0 = *(const __attribute__((address_space(3))) bf16x8*)(kp0 + sl + d0 * 2048);
                const bf16x8 b1 = *(const __attribute__((address_space(3))) bf16x8*)(kp0 + sl + d0 * 2048 + 512);
                p0 = __builtin_amdgcn_mfma_f32_32x32x16_bf16(b0, qr[d0], p0, 0, 0, 0);
                p1 = __builtin_amdgcn_mfma_f32_32x32x16_bf16(b1, qr[d0], p1, 0, 0, 0); }
            const bool diag = (64 * t + 63 >= wmin);
            f32x16 l0, l1;
#pragma unroll
            for (int r = 0; r < 16; ++r) {
                const float y0 = p0[r], y1 = p1[r];
                l0[r] = -(__builtin_fmaxf(y0, 0.f) + __builtin_amdgcn_logf(1.0f + __builtin_amdgcn_exp2f(-__builtin_fabsf(y0))));
                l1[r] = -(__builtin_fmaxf(y1, 0.f) + __builtin_amdgcn_logf(1.0f + __builtin_amdgcn_exp2f(-__builtin_fabsf(y1)))); }
            if (diag) {
#pragma unroll
                for (int r = 0; r < 16; ++r) { const int s = 64 * t + crow(r, hi); if (s >= trow) l0[r] = 0.f; if (s + 32 >= trow) l1[r] = 0.f; } }
            const bf16x8 l0a = pack8(l0, 0), l0b = pack8(l0, 8), l1a = pack8(l1, 0), l1b = pack8(l1, 8);
            f32x16 Rv;
#pragma unroll
            for (int r = 0; r < 16; ++r) Rv[r] = R;
            f32x16 c1 = __builtin_amdgcn_mfma_f32_32x32x16_bf16(tri[0], l1a, Rv, 0, 0, 0); c1 = __builtin_amdgcn_mfma_f32_32x32x16_bf16(tri[1], l1b, c1, 0, 0, 0);
            f32x16 c0 = __builtin_amdgcn_mfma_f32_32x32x16_bf16(ones, l1a, Rv, 0, 0, 0); c0 = __builtin_amdgcn_mfma_f32_32x32x16_bf16(ones, l1b, c0, 0, 0, 0);
            c0 = __builtin_amdgcn_mfma_f32_32x32x16_bf16(tri[0], l0a, c0, 0, 0, 0); c0 = __builtin_amdgcn_mfma_f32_32x32x16_bf16(tri[1], l0b, c0, 0, 0, 0);
#pragma unroll
            for (int r = 0; r < 16; ++r) { p0[r] = __builtin_amdgcn_exp2f(p0[r] + c0[r]); p1[r] = __builtin_amdgcn_exp2f(p1[r] + c1[r]); }
            if (diag) {
#pragma unroll
                for (int r = 0; r < 16; ++r) { const int s = 64 * t + crow(r, hi); if (s >= trow) p0[r] = 0.f; if (s + 32 >= trow) p1[r] = 0.f; } }
            R = lo_lane(c0[0]);
            const bf16x8 pa0 = pack8(p0, 0), pa1 = pack8(p0, 8), pa2 = pack8(p1, 0), pa3 = pack8(p1, 8);
            const lds_cptr vp = vp0 + sl;
#define SB_VF(dh, ks) ({ const s16x4 lo_ = vtr(vp + (dh) * 4096 + (ks) * 1024), hi_ = vtr(vp + (dh) * 4096 + (ks) * 1024 + 512); (bf16x8){lo_[0], lo_[1], lo_[2], lo_[3], hi_[0], hi_[1], hi_[2], hi_[3]}; })
            o0 = __builtin_amdgcn_mfma_f32_32x32x16_bf16(pa0, SB_VF(0, 0), o0, 0, 0, 0); o1 = __builtin_amdgcn_mfma_f32_32x32x16_bf16(pa0, SB_VF(1, 0), o1, 0, 0, 0);
            o0 = __builtin_amdgcn_mfma_f32_32x32x16_bf16(pa1, SB_VF(0, 1), o0, 0, 0, 0); o1 = __builtin_amdgcn_mfma_f32_32x32x16_bf16(pa1, SB_VF(1, 1), o1, 0, 0, 0);
            o0 = __builtin_amdgcn_mfma_f32_32x32x16_bf16(pa2, SB_VF(0, 2), o0, 0, 0, 0); o1 = __builtin_amdgcn_mfma_f32_32x32x16_bf16(pa2, SB_VF(1, 2), o1, 0, 0, 0);
            o0 = __builtin_amdgcn_mfma_f32_32x32x16_bf16(pa3, SB_VF(0, 3), o0, 0, 0, 0); o1 = __builtin_amdgcn_mfma_f32_32x32x16_bf16(pa3, SB_VF(1, 3), o1, 0, 0, 0);
#undef SB_VF
        }
    }
    bf16* Ow = O + (rowbase + q0 + wid * 32) * DM + h * HD;
#pragma unroll
    for (int r = 0; r < 16; ++r) { const int orow = crow(r, hi); Ow[(long)orow * DM + r32] = __float2bfloat16(o0[r]); Ow[(long)orow * DM + 32 + r32] = __float2bfloat16(o1[r]); }
#undef SB_DMA_K
#undef SB_DMA_V
}
}

constexpr int NWAVES = 8;
constexpr int N_LAUNCHES = MK_N_LAUNCHES;
constexpr int N_PHASES = 10;
constexpr int BATCH = 8, SEQ = 2048, D = 1024, M = BATCH * SEQ, MEMLEN = 256, MROWS = BATCH * MEMLEN, NIN = 8192, NPQ = 2048;
constexpr float RMS_EPS = 1e-6f;
constexpr float LOG2E = 1.4426950408889634f;
constexpr size_t MiB = 1u << 20;
constexpr size_t WS_CTL = 0, CTL_ZERO_BYTES = 1 * MiB;
constexpr size_t WS_WIN = 1 * MiB, WS_WA = 17 * MiB, WS_WC = 19 * MiB, WS_WO = 21 * MiB, WS_WQ2 = 23 * MiB, WS_WKV2 = 25 * MiB, WS_WO2 = 29 * MiB, WS_WPQ = 31 * MiB, WS_SK = 35 * MiB;
constexpr size_t WS_SSQ1 = 36 * MiB, WS_SSQ2 = 37 * MiB, WS_MEMN = 38 * MiB, WS_K2 = 42 * MiB, WS_V2T = 46 * MiB;
constexpr size_t WS_B0 = 52 * MiB, WS_B1 = 84 * MiB, WS_B2 = 116 * MiB, WS_B3 = 148 * MiB, WS_B4 = 180 * MiB, WS_B5 = 212 * MiB, WS_END = 244 * MiB;
constexpr int CW_TMO = 0, CW_CODE = 1, CW_BAR = 4096;

constexpr int RING_OFF = 0, RING_BYTES = 131072;
constexpr int LDSCTL_OFF = RING_BYTES, MISC_OFF = LDSCTL_OFF + 320;
constexpr int LDS_BYTES = 147456;
#define GAS __attribute__((address_space(1)))
#define LAS __attribute__((address_space(3)))
typedef unsigned short bf16;
typedef unsigned v4u __attribute__((ext_vector_type(4)));
typedef float f32x4 __attribute__((ext_vector_type(4)));
typedef short bf16x8 __attribute__((ext_vector_type(8)));
typedef GAS unsigned gu32;
typedef GAS unsigned long long gu64;
#define RLX_AGENT __ATOMIC_RELAXED, __HIP_MEMORY_SCOPE_AGENT
#define LDS_WAIT() asm volatile("s_waitcnt lgkmcnt(0)" ::: "memory")
#define VM_WAIT() asm volatile("s_waitcnt vmcnt(0)" ::: "memory")
__device__ __forceinline__ unsigned long long rt() { return __builtin_amdgcn_s_memrealtime(); }
__device__ __forceinline__ unsigned f2bf(float f) { unsigned u = __builtin_bit_cast(unsigned, f); return (u + 0x7fffu + ((u >> 16) & 1u)) >> 16; }
__device__ __forceinline__ unsigned pk2(float lo, float hi) { return f2bf(lo) | (f2bf(hi) << 16); }

#define XB_TMO      128
#define XB_XCNT(j)  (256  + 64 * (j))
#define XB_XSUB(j)  (1280 + 64 * (j))
#define XB_XGEN(j)  (2304 + 64 * (j))
#define XB_TOP      3328
#define XB_TOPGEN   3392
#define XCD_BAR_WORDS 3456
#define XB_SPIN_CAP (1u << 18)

__device__ __forceinline__ unsigned xb_ld(unsigned* p)              { return __hip_atomic_load(p, __ATOMIC_RELAXED, __HIP_MEMORY_SCOPE_AGENT); }
__device__ __forceinline__ unsigned xb_add(unsigned* p, unsigned v) { return __hip_atomic_fetch_add(p, v, __ATOMIC_RELAXED, __HIP_MEMORY_SCOPE_AGENT); }
__device__ __forceinline__ unsigned xb_xcc_id() { return (unsigned)__builtin_amdgcn_s_getreg((3 << 11) | 20) & 0xFu; }
#define XB_SPIN(cond, bar) do { unsigned _sp = 0; while (cond) { __builtin_amdgcn_s_sleep(1); \
    if ((++_sp & 255u) == 0u) { if (xb_ld(&(bar)[XB_TMO])) break; if (_sp > XB_SPIN_CAP) { atomicAdd(&(bar)[XB_TMO], 1u); break; } } } } while (0)

struct XcdBarrier {
    unsigned* bar; unsigned x;
    volatile LAS unsigned* st;
};

__device__ __forceinline__ XcdBarrier xcd_barrier_post(unsigned* bar, volatile LAS unsigned* st) {
    XcdBarrier b; b.bar = bar; b.x = xb_xcc_id(); b.st = st;
    if (threadIdx.x == 0) (void)xb_add(&bar[XB_XCNT(b.x)], 1u);
    return b;
}
__device__ __forceinline__ void xcd_barrier_complete(unsigned* bar, unsigned x, unsigned& nloc, unsigned& nx) {
    const unsigned G = gridDim.x * gridDim.y * gridDim.z;
    unsigned sum, cnt, mine, sp = 0u;
    for (;;) {
        sum = 0u; cnt = 0u; mine = 0u;
#pragma unroll
        for (unsigned j = 0; j < 16; ++j) { const unsigned c = xb_ld(&bar[XB_XCNT(j)]); sum += c; cnt += (c > 0u) ? 1u : 0u; mine = (j == x) ? c : mine; }
        if (sum == G) break;
        __builtin_amdgcn_s_sleep(1);
        if ((++sp & 255u) == 0u) { if (xb_ld(&bar[XB_TMO])) break; if (sp > XB_SPIN_CAP) { atomicAdd(&bar[XB_TMO], 1u); break; } }
    }
    nloc = mine > 0u ? mine : 1u; nx = cnt > 0u ? cnt : 1u;
}

__device__ __forceinline__ void xcd_barrier(const XcdBarrier& b) {
    asm volatile("s_waitcnt vmcnt(0)" ::: "memory");
    __syncthreads();
    if (threadIdx.x == 0) {
        unsigned* bar = b.bar;
        __builtin_amdgcn_s_waitcnt(0);
        unsigned nloc = b.st[0], nx = b.st[1];
        if (nloc == 0u) { xcd_barrier_complete(bar, b.x, nloc, nx); b.st[0] = nloc; b.st[1] = nx; }
        const unsigned old = xb_add(&bar[XB_XSUB(b.x)], 1u);
        const unsigned gen = old / nloc;
        if (old + 1u == (gen + 1u) * nloc) {
            __builtin_amdgcn_fence(__ATOMIC_RELEASE, "agent");
            asm volatile("s_waitcnt vmcnt(0)" ::: "memory");
            const unsigned og = xb_add(&bar[XB_TOP], 1u);
            const unsigned tg = og / nx;
            if (og + 1u == (tg + 1u) * nx) xb_add(&bar[XB_TOPGEN], 1u);
            else XB_SPIN(xb_ld(&bar[XB_TOPGEN]) == tg, bar);
            __builtin_amdgcn_fence(__ATOMIC_ACQUIRE, "agent");
            xb_add(&bar[XB_XGEN(b.x)], 1u);
            asm volatile("s_waitcnt vmcnt(0)" ::: "memory");
        } else {
            XB_SPIN(xb_ld(&bar[XB_XGEN(b.x)]) == gen, bar);
            __builtin_amdgcn_fence(__ATOMIC_ACQUIRE, "agent");
            asm volatile("s_waitcnt vmcnt(0)" ::: "memory");
        }
    }
    __syncthreads();
}


__device__ __forceinline__ float wave_sum(float v) {
#pragma unroll
    for (int o = 1; o < 64; o <<= 1) v += __shfl_xor(v, o);
    return v;
}
__device__ __forceinline__ int inproj_row(int n) {
    const int g = n >> 10, c = n & 1023;
    if (g < 3) return n;
    if (g == 3) return 3072 + (c >> 7) * 256 + (c & 127);
    if (g == 5) return 3072 + (c >> 7) * 256 + 128 + (c & 127);
    if (g == 4) return 5120 + c;
    return n;
}
template <bool INMAP> __device__ __forceinline__ void transpose_item(const float* W, int K, int N, const float* gain, bf16* WT, int row_off, LAS float* scr, int item, int lane) {
    const int nblk = N / 32, kb = item / nblk, nb = item % nblk, k0 = 64 * kb, n0 = 32 * nb;
#pragma unroll 8
    for (int i = 0; i < 32; ++i) { const int kk = 2 * i + (lane >> 5); float w = W[(size_t)(k0 + kk) * N + n0 + (lane & 31)]; if (gain) w *= gain[k0 + kk]; scr[kk * 33 + (lane & 31)] = w; }
    LDS_WAIT(); asm volatile("" ::: "memory");
    const int c = lane & 7; const int r0 = INMAP ? inproj_row(n0) : (row_off + n0);
#pragma unroll
    for (int j = 0; j < 4; ++j) { const int n = (lane >> 3) + 8 * j; const LAS float* s = scr + (8 * c) * 33 + n;
        v4u o; o.x = pk2(s[0 * 33], s[1 * 33]); o.y = pk2(s[2 * 33], s[3 * 33]); o.z = pk2(s[4 * 33], s[5 * 33]); o.w = pk2(s[6 * 33], s[7 * 33]);
        *(GAS v4u*)(WT + (size_t)(r0 + n) * K + k0 + 8 * c) = o; }
    LDS_WAIT(); asm volatile("" ::: "memory");
}
__device__ __forceinline__ void rms_row_to_bf16(const float* xrow, const float* gain, bf16* orow, int lane) {
    const GAS f32x4* xr = (const GAS f32x4*)xrow + lane; const GAS f32x4* gr = (const GAS f32x4*)gain + lane;
    f32x4 v[4]; float s = 0.f;
#pragma unroll
    for (int j = 0; j < 4; ++j) { v[j] = xr[64 * j]; s += (v[j].x * v[j].x + v[j].y * v[j].y) + (v[j].z * v[j].z + v[j].w * v[j].w); }
    const float rstd = 1.0f / sqrtf(wave_sum(s) * (1.f / 1024.f) + RMS_EPS);
    GAS unsigned long long* o8 = (GAS unsigned long long*)orow + lane;
#pragma unroll
    for (int j = 0; j < 4; ++j) { const f32x4 g = gr[64 * j]; o8[64 * j] = (unsigned long long)pk2(v[j].x * rstd * g.x, v[j].y * rstd * g.y) | ((unsigned long long)pk2(v[j].z * rstd * g.z, v[j].w * rstd * g.w) << 32); }
}
__device__ __forceinline__ void row_to_bf16(const float* xrow, const float* gain, bf16* orow, int lane) {
    const GAS f32x4* xr = (const GAS f32x4*)xrow + lane; GAS unsigned long long* o8 = (GAS unsigned long long*)orow + lane;
#pragma unroll
    for (int j = 0; j < 4; ++j) { f32x4 v = xr[64 * j]; if (gain) { const f32x4 g = ((const GAS f32x4*)gain + lane)[64 * j]; v = v * g; }
        o8[64 * j] = (unsigned long long)pk2(v.x, v.y) | ((unsigned long long)pk2(v.z, v.w) << 32); }
}
__device__ __forceinline__ void final_norm_row(const float* hrow, const float* gain, float* orow, int lane) {
    const GAS f32x4* xr = (const GAS f32x4*)hrow + lane; const GAS f32x4* gr = (const GAS f32x4*)gain + lane;
    f32x4 v[4]; float s = 0.f;
#pragma unroll
    for (int j = 0; j < 4; ++j) { v[j] = xr[64 * j]; s += (v[j].x * v[j].x + v[j].y * v[j].y) + (v[j].z * v[j].z + v[j].w * v[j].w); }
    const float rstd = 1.0f / sqrtf(wave_sum(s) * (1.f / 1024.f) + RMS_EPS);
    GAS f32x4* o = (GAS f32x4*)orow + lane;
#pragma unroll
    for (int j = 0; j < 4; ++j) o[64 * j] = v[j] * rstd * gr[64 * j];
}
__device__ __forceinline__ float bflo(unsigned w) { return __builtin_bit_cast(float, w << 16); }
__device__ __forceinline__ float bfhi(unsigned w) { return __builtin_bit_cast(float, w & 0xffff0000u); }
__device__ __forceinline__ void yconv_item(const bf16* U, const bf16* CB, const float* cw, bf16* YC, int item, int lane) {
    const int t0 = item * 8; const bool first = (t0 % SEQ) == 0;
#pragma unroll 1
    for (int ps = 0; ps < 2; ++ps) {
        const int c0 = ps * 512 + lane * 8;
        float w0[8], w1[8], w2[8];
#pragma unroll
        for (int e = 0; e < 8; ++e) { w0[e] = cw[c0 + e]; w1[e] = cw[1024 + c0 + e]; w2[e] = cw[2048 + c0 + e]; }
        v4u um2 = (v4u){0u, 0u, 0u, 0u}, um1 = (v4u){0u, 0u, 0u, 0u};
        if (!first) { um2 = *(const GAS v4u*)(U + (size_t)(t0 - 2) * 1024 + c0); um1 = *(const GAS v4u*)(U + (size_t)(t0 - 1) * 1024 + c0); }
#pragma unroll
        for (int i = 0; i < 8; ++i) {
            const v4u uc = *(const GAS v4u*)(U + (size_t)(t0 + i) * 1024 + c0); const v4u cbv = *(const GAS v4u*)(CB + (size_t)(t0 + i) * 1024 + c0);
            v4u o;
#pragma unroll
            for (int q = 0; q < 4; ++q) {
                const float a = bflo(cbv[q]) * (w0[2 * q] * bflo(um2[q]) + w1[2 * q] * bflo(um1[q]) + w2[2 * q] * bflo(uc[q]));
                const float b = bfhi(cbv[q]) * (w0[2 * q + 1] * bfhi(um2[q]) + w1[2 * q + 1] * bfhi(um1[q]) + w2[2 * q + 1] * bfhi(uc[q]));
                o[q] = pk2(a, b); }
            *(GAS v4u*)(YC + (size_t)(t0 + i) * 1024 + c0) = o;
            um2 = um1; um1 = uc; }
    }
}


namespace xa {
using bf16x8 = __attribute__((ext_vector_type(8))) short;
using s16x4 = __attribute__((ext_vector_type(4))) short;
using f32x16 = __attribute__((ext_vector_type(16))) float;
using u32x4 = __attribute__((ext_vector_type(4))) unsigned;
using u32x2 = __attribute__((ext_vector_type(2))) unsigned;
__device__ __forceinline__ int crow(int r, int hi) { return (r & 3) + 8 * (r >> 2) + 4 * hi; }
__device__ __forceinline__ void xattn_unit(int b, int head, int qt, const bf16* Q, const bf16* K2, const bf16* V2T, bf16* O, LAS unsigned char* ldsw  ) {
    const int lane = threadIdx.x & 63, r32 = lane & 31, hi = lane >> 5; const int wid = __builtin_amdgcn_readfirstlane((int)threadIdx.x >> 6);
    const size_t qrow = (size_t)b * SEQ + qt * 256 + wid * 32 + r32;
    const bf16* qp = Q + qrow * 1024 + head * 256 + hi * 8;
    LAS u32x4* qlds = (LAS u32x4*)ldsw + lane;
#pragma unroll
    for (int ks = 0; ks < 16; ++ks) qlds[ks * 64] = *(const GAS u32x4*)(qp + ks * 16);
    LDS_WAIT();
    const bf16* kp = K2 + ((size_t)b * MEMLEN + r32) * 1024 + head * 256 + hi * 8;
    const bf16* vp = V2T + ((size_t)head * 256 + r32) * 2048 + (size_t)b * MEMLEN + 4 * hi;
#pragma unroll 1
    for (int dh = 0; dh < 2; ++dh) {
    f32x16 o[4];
#pragma unroll
    for (int dt = 0; dt < 4; ++dt) o[dt] = f32x16{};
    float mrun = -1e30f, lrun = 0.f;
#pragma unroll 1
    for (int c = 0; c < 4; ++c) {
        f32x16 p0 = f32x16{}, p1 = f32x16{};
#pragma unroll 4
        for (int ks = 0; ks < 16; ++ks) {
            const bf16x8 qf = __builtin_bit_cast(bf16x8, qlds[ks * 64]);
            const bf16x8 k0 = *(const GAS bf16x8*)(kp + (size_t)(64 * c) * 1024 + ks * 16);
            const bf16x8 k1 = *(const GAS bf16x8*)(kp + (size_t)(64 * c + 32) * 1024 + ks * 16);
            p0 = __builtin_amdgcn_mfma_f32_32x32x16_bf16(k0, qf, p0, 0, 0, 0);
            p1 = __builtin_amdgcn_mfma_f32_32x32x16_bf16(k1, qf, p1, 0, 0, 0); }
        float mx = p0[0];
#pragma unroll
        for (int r = 1; r < 16; ++r) mx = __builtin_fmaxf(mx, p0[r]);
#pragma unroll
        for (int r = 0; r < 16; ++r) mx = __builtin_fmaxf(mx, p1[r]);
        { auto rr = __builtin_amdgcn_permlane32_swap(__float_as_uint(mx), __float_as_uint(mx), false, false); mx = __builtin_fmaxf(__uint_as_float(rr[0]), __uint_as_float(rr[1])); }
        const float mnew = __builtin_fmaxf(mrun, mx), alpha = __builtin_amdgcn_exp2f(mrun - mnew);
        mrun = mnew; float ps = 0.f;
#pragma unroll
        for (int r = 0; r < 16; ++r) { p0[r] = __builtin_amdgcn_exp2f(p0[r] - mnew); p1[r] = __builtin_amdgcn_exp2f(p1[r] - mnew); ps += p0[r] + p1[r]; }
        lrun = lrun * alpha + ps;
#pragma unroll
        for (int dt = 0; dt < 4; ++dt)
#pragma unroll
            for (int r = 0; r < 16; ++r) o[dt][r] *= alpha;
        bf16x8 pa[4];
        { u32x4 w;
#pragma unroll
          for (int s = 0; s < 2; ++s) {
            w.x = pg8::cvt_pk_bf16(p0[8 * s], p0[8 * s + 1]); w.y = pg8::cvt_pk_bf16(p0[8 * s + 2], p0[8 * s + 3]); w.z = pg8::cvt_pk_bf16(p0[8 * s + 4], p0[8 * s + 5]); w.w = pg8::cvt_pk_bf16(p0[8 * s + 6], p0[8 * s + 7]); pa[s] = __builtin_bit_cast(bf16x8, w);
            w.x = pg8::cvt_pk_bf16(p1[8 * s], p1[8 * s + 1]); w.y = pg8::cvt_pk_bf16(p1[8 * s + 2], p1[8 * s + 3]); w.z = pg8::cvt_pk_bf16(p1[8 * s + 4], p1[8 * s + 5]); w.w = pg8::cvt_pk_bf16(p1[8 * s + 6], p1[8 * s + 7]); pa[2 + s] = __builtin_bit_cast(bf16x8, w); } }
#pragma unroll
        for (int dt = 0; dt < 4; ++dt)
#pragma unroll
            for (int s = 0; s < 4; ++s) {
                const bf16* vq = vp + (size_t)(128 * dh + 32 * dt) * 2048 + 64 * c + 16 * s;
                const u32x2 lo = *(const GAS u32x2*)vq, hi2 = *(const GAS u32x2*)(vq + 8);
                const u32x4 vw = {lo.x, lo.y, hi2.x, hi2.y};
                o[dt] = __builtin_amdgcn_mfma_f32_32x32x16_bf16(__builtin_bit_cast(bf16x8, vw), pa[s], o[dt], 0, 0, 0); }
    }
    { auto rr = __builtin_amdgcn_permlane32_swap(__float_as_uint(lrun), __float_as_uint(lrun), false, false); lrun = __uint_as_float(rr[0]) + __uint_as_float(rr[1]); }
    const float rl = 1.0f / lrun;
    bf16* op = O + qrow * 1024 + head * 256 + 128 * dh + 4 * hi;
#pragma unroll
    for (int dt = 0; dt < 4; ++dt)
#pragma unroll
        for (int g4 = 0; g4 < 4; ++g4) { u32x2 w; w.x = pg8::cvt_pk_bf16(o[dt][4 * g4] * rl, o[dt][4 * g4 + 1] * rl); w.y = pg8::cvt_pk_bf16(o[dt][4 * g4 + 2] * rl, o[dt][4 * g4 + 3] * rl);
            *(GAS u32x2*)(op + 32 * dt + 8 * g4) = w; }
    }
}
}

namespace peer {
using bf16x8 = __attribute__((ext_vector_type(8))) short;
using f32x16 = __attribute__((ext_vector_type(16))) float;
using u32x4 = __attribute__((ext_vector_type(4))) unsigned;
using u32x2 = __attribute__((ext_vector_type(2))) unsigned;
typedef __bf16 bf16x2_t __attribute__((ext_vector_type(2)));
#define PEER_CE(a, b) do { const int _h = ((a) > (b)) ? (a) : (b); const int _l = ((a) > (b)) ? (b) : (a); (a) = _h; (b) = _l; } while (0)
#define PEER_SORT16(x, o) do { PEER_CE(x[(o)+0], x[(o)+1]); PEER_CE(x[(o)+2], x[(o)+3]); PEER_CE(x[(o)+4], x[(o)+5]); PEER_CE(x[(o)+6], x[(o)+7]); PEER_CE(x[(o)+8], x[(o)+9]); PEER_CE(x[(o)+10], x[(o)+11]); PEER_CE(x[(o)+12], x[(o)+13]); PEER_CE(x[(o)+14], x[(o)+15]); PEER_CE(x[(o)+0], x[(o)+2]); PEER_CE(x[(o)+1], x[(o)+3]); PEER_CE(x[(o)+4], x[(o)+6]); PEER_CE(x[(o)+5], x[(o)+7]); PEER_CE(x[(o)+8], x[(o)+10]); PEER_CE(x[(o)+9], x[(o)+11]); PEER_CE(x[(o)+12], x[(o)+14]); PEER_CE(x[(o)+13], x[(o)+15]); PEER_CE(x[(o)+1], x[(o)+2]); PEER_CE(x[(o)+5], x[(o)+6]); PEER_CE(x[(o)+9], x[(o)+10]); PEER_CE(x[(o)+13], x[(o)+14]); PEER_CE(x[(o)+0], x[(o)+4]); PEER_CE(x[(o)+1], x[(o)+5]); PEER_CE(x[(o)+2], x[(o)+6]); PEER_CE(x[(o)+3], x[(o)+7]); PEER_CE(x[(o)+8], x[(o)+12]); PEER_CE(x[(o)+9], x[(o)+13]); PEER_CE(x[(o)+10], x[(o)+14]); PEER_CE(x[(o)+11], x[(o)+15]); PEER_CE(x[(o)+2], x[(o)+4]); PEER_CE(x[(o)+3], x[(o)+5]); PEER_CE(x[(o)+10], x[(o)+12]); PEER_CE(x[(o)+11], x[(o)+13]); PEER_CE(x[(o)+1], x[(o)+2]); PEER_CE(x[(o)+3], x[(o)+4]); PEER_CE(x[(o)+5], x[(o)+6]); PEER_CE(x[(o)+9], x[(o)+10]); PEER_CE(x[(o)+11], x[(o)+12]); PEER_CE(x[(o)+13], x[(o)+14]); PEER_CE(x[(o)+0], x[(o)+8]); PEER_CE(x[(o)+1], x[(o)+9]); PEER_CE(x[(o)+2], x[(o)+10]); PEER_CE(x[(o)+3], x[(o)+11]); PEER_CE(x[(o)+4], x[(o)+12]); PEER_CE(x[(o)+5], x[(o)+13]); PEER_CE(x[(o)+6], x[(o)+14]); PEER_CE(x[(o)+7], x[(o)+15]); PEER_CE(x[(o)+4], x[(o)+8]); PEER_CE(x[(o)+5], x[(o)+9]); PEER_CE(x[(o)+6], x[(o)+10]); PEER_CE(x[(o)+7], x[(o)+11]); PEER_CE(x[(o)+2], x[(o)+4]); PEER_CE(x[(o)+3], x[(o)+5]); PEER_CE(x[(o)+6], x[(o)+8]); PEER_CE(x[(o)+7], x[(o)+9]); PEER_CE(x[(o)+10], x[(o)+12]); PEER_CE(x[(o)+11], x[(o)+13]); PEER_CE(x[(o)+1], x[(o)+2]); PEER_CE(x[(o)+3], x[(o)+4]); PEER_CE(x[(o)+5], x[(o)+6]); PEER_CE(x[(o)+7], x[(o)+8]); PEER_CE(x[(o)+9], x[(o)+10]); PEER_CE(x[(o)+11], x[(o)+12]); PEER_CE(x[(o)+13], x[(o)+14]); } while (0)
#define PEER_MERGE16(x, a, b) do { x[(a)+0] = (x[(a)+0] > x[(b)+15]) ? x[(a)+0] : x[(b)+15]; x[(a)+1] = (x[(a)+1] > x[(b)+14]) ? x[(a)+1] : x[(b)+14]; x[(a)+2] = (x[(a)+2] > x[(b)+13]) ? x[(a)+2] : x[(b)+13]; x[(a)+3] = (x[(a)+3] > x[(b)+12]) ? x[(a)+3] : x[(b)+12]; x[(a)+4] = (x[(a)+4] > x[(b)+11]) ? x[(a)+4] : x[(b)+11]; x[(a)+5] = (x[(a)+5] > x[(b)+10]) ? x[(a)+5] : x[(b)+10]; x[(a)+6] = (x[(a)+6] > x[(b)+9]) ? x[(a)+6] : x[(b)+9]; x[(a)+7] = (x[(a)+7] > x[(b)+8]) ? x[(a)+7] : x[(b)+8]; x[(a)+8] = (x[(a)+8] > x[(b)+7]) ? x[(a)+8] : x[(b)+7]; x[(a)+9] = (x[(a)+9] > x[(b)+6]) ? x[(a)+9] : x[(b)+6]; x[(a)+10] = (x[(a)+10] > x[(b)+5]) ? x[(a)+10] : x[(b)+5]; x[(a)+11] = (x[(a)+11] > x[(b)+4]) ? x[(a)+11] : x[(b)+4]; x[(a)+12] = (x[(a)+12] > x[(b)+3]) ? x[(a)+12] : x[(b)+3]; x[(a)+13] = (x[(a)+13] > x[(b)+2]) ? x[(a)+13] : x[(b)+2]; x[(a)+14] = (x[(a)+14] > x[(b)+1]) ? x[(a)+14] : x[(b)+1]; x[(a)+15] = (x[(a)+15] > x[(b)+0]) ? x[(a)+15] : x[(b)+0]; PEER_CE(x[(a)+0], x[(a)+8]); PEER_CE(x[(a)+1], x[(a)+9]); PEER_CE(x[(a)+2], x[(a)+10]); PEER_CE(x[(a)+3], x[(a)+11]); PEER_CE(x[(a)+4], x[(a)+12]); PEER_CE(x[(a)+5], x[(a)+13]); PEER_CE(x[(a)+6], x[(a)+14]); PEER_CE(x[(a)+7], x[(a)+15]); PEER_CE(x[(a)+0], x[(a)+4]); PEER_CE(x[(a)+1], x[(a)+5]); PEER_CE(x[(a)+2], x[(a)+6]); PEER_CE(x[(a)+3], x[(a)+7]); PEER_CE(x[(a)+8], x[(a)+12]); PEER_CE(x[(a)+9], x[(a)+13]); PEER_CE(x[(a)+10], x[(a)+14]); PEER_CE(x[(a)+11], x[(a)+15]); PEER_CE(x[(a)+0], x[(a)+2]); PEER_CE(x[(a)+1], x[(a)+3]); PEER_CE(x[(a)+4], x[(a)+6]); PEER_CE(x[(a)+5], x[(a)+7]); PEER_CE(x[(a)+8], x[(a)+10]); PEER_CE(x[(a)+9], x[(a)+11]); PEER_CE(x[(a)+12], x[(a)+14]); PEER_CE(x[(a)+13], x[(a)+15]); PEER_CE(x[(a)+0], x[(a)+1]); PEER_CE(x[(a)+2], x[(a)+3]); PEER_CE(x[(a)+4], x[(a)+5]); PEER_CE(x[(a)+6], x[(a)+7]); PEER_CE(x[(a)+8], x[(a)+9]); PEER_CE(x[(a)+10], x[(a)+11]); PEER_CE(x[(a)+12], x[(a)+13]); PEER_CE(x[(a)+14], x[(a)+15]); } while (0)
#define PEER_MERGE16_SET(x, a, b) do { x[(a)+0] = (x[(a)+0] > x[(b)+15]) ? x[(a)+0] : x[(b)+15]; x[(a)+1] = (x[(a)+1] > x[(b)+14]) ? x[(a)+1] : x[(b)+14]; x[(a)+2] = (x[(a)+2] > x[(b)+13]) ? x[(a)+2] : x[(b)+13]; x[(a)+3] = (x[(a)+3] > x[(b)+12]) ? x[(a)+3] : x[(b)+12]; x[(a)+4] = (x[(a)+4] > x[(b)+11]) ? x[(a)+4] : x[(b)+11]; x[(a)+5] = (x[(a)+5] > x[(b)+10]) ? x[(a)+5] : x[(b)+10]; x[(a)+6] = (x[(a)+6] > x[(b)+9]) ? x[(a)+6] : x[(b)+9]; x[(a)+7] = (x[(a)+7] > x[(b)+8]) ? x[(a)+7] : x[(b)+8]; x[(a)+8] = (x[(a)+8] > x[(b)+7]) ? x[(a)+8] : x[(b)+7]; x[(a)+9] = (x[(a)+9] > x[(b)+6]) ? x[(a)+9] : x[(b)+6]; x[(a)+10] = (x[(a)+10] > x[(b)+5]) ? x[(a)+10] : x[(b)+5]; x[(a)+11] = (x[(a)+11] > x[(b)+4]) ? x[(a)+11] : x[(b)+4]; x[(a)+12] = (x[(a)+12] > x[(b)+3]) ? x[(a)+12] : x[(b)+3]; x[(a)+13] = (x[(a)+13] > x[(b)+2]) ? x[(a)+13] : x[(b)+2]; x[(a)+14] = (x[(a)+14] > x[(b)+1]) ? x[(a)+14] : x[(b)+1]; x[(a)+15] = (x[(a)+15] > x[(b)+0]) ? x[(a)+15] : x[(b)+0]; } while (0)
constexpr int PEER_NCAND = 50;
__device__ const unsigned char PEER_CAND[64] = {0, 16, 32, 48, 64, 80, 96, 112, 128, 144, 160, 176, 192, 208, 224, 240, 1, 17, 33, 49, 65, 81, 97, 113, 2, 18, 34, 50, 66, 3, 19, 35, 51, 4, 20, 36, 5, 21, 6, 22, 7, 23, 8, 9, 10, 11, 12, 13, 14, 15, 0, 0, 0, 0, 0, 0, 0, 0, 0, 0, 0, 0, 0, 0};
#define PEER_CAND_SUMS(x, v0, v1, KEYF) do { x[0] = KEYF((v0)[0] + (v1)[0], 0); x[1] = KEYF((v0)[0] + (v1)[1], 1); x[2] = KEYF((v0)[0] + (v1)[2], 2); x[3] = KEYF((v0)[0] + (v1)[3], 3); x[4] = KEYF((v0)[0] + (v1)[4], 4); x[5] = KEYF((v0)[0] + (v1)[5], 5); x[6] = KEYF((v0)[0] + (v1)[6], 6); x[7] = KEYF((v0)[0] + (v1)[7], 7); x[8] = KEYF((v0)[0] + (v1)[8], 8); x[9] = KEYF((v0)[0] + (v1)[9], 9); x[10] = KEYF((v0)[0] + (v1)[10], 10); x[11] = KEYF((v0)[0] + (v1)[11], 11); x[12] = KEYF((v0)[0] + (v1)[12], 12); x[13] = KEYF((v0)[0] + (v1)[13], 13); x[14] = KEYF((v0)[0] + (v1)[14], 14); x[15] = KEYF((v0)[0] + (v1)[15], 15); x[16] = KEYF((v0)[1] + (v1)[0], 16); x[17] = KEYF((v0)[1] + (v1)[1], 17); x[18] = KEYF((v0)[1] + (v1)[2], 18); x[19] = KEYF((v0)[1] + (v1)[3], 19); x[20] = KEYF((v0)[1] + (v1)[4], 20); x[21] = KEYF((v0)[1] + (v1)[5], 21); x[22] = KEYF((v0)[1] + (v1)[6], 22); x[23] = KEYF((v0)[1] + (v1)[7], 23); x[24] = KEYF((v0)[2] + (v1)[0], 24); x[25] = KEYF((v0)[2] + (v1)[1], 25); x[26] = KEYF((v0)[2] + (v1)[2], 26); x[27] = KEYF((v0)[2] + (v1)[3], 27); x[28] = KEYF((v0)[2] + (v1)[4], 28); x[29] = KEYF((v0)[3] + (v1)[0], 29); x[30] = KEYF((v0)[3] + (v1)[1], 30); x[31] = KEYF((v0)[3] + (v1)[2], 31); x[32] = KEYF((v0)[3] + (v1)[3], 32); x[33] = KEYF((v0)[4] + (v1)[0], 33); x[34] = KEYF((v0)[4] + (v1)[1], 34); x[35] = KEYF((v0)[4] + (v1)[2], 35); x[36] = KEYF((v0)[5] + (v1)[0], 36); x[37] = KEYF((v0)[5] + (v1)[1], 37); x[38] = KEYF((v0)[6] + (v1)[0], 38); x[39] = KEYF((v0)[6] + (v1)[1], 39); x[40] = KEYF((v0)[7] + (v1)[0], 40); x[41] = KEYF((v0)[7] + (v1)[1], 41); x[42] = KEYF((v0)[8] + (v1)[0], 42); x[43] = KEYF((v0)[9] + (v1)[0], 43); x[44] = KEYF((v0)[10] + (v1)[0], 44); x[45] = KEYF((v0)[11] + (v1)[0], 45); x[46] = KEYF((v0)[12] + (v1)[0], 46); x[47] = KEYF((v0)[13] + (v1)[0], 47); x[48] = KEYF((v0)[14] + (v1)[0], 48); x[49] = KEYF((v0)[15] + (v1)[0], 49); x[50] = (int)0x80000000; x[51] = (int)0x80000000; x[52] = (int)0x80000000; x[53] = (int)0x80000000; x[54] = (int)0x80000000; x[55] = (int)0x80000000; x[56] = (int)0x80000000; x[57] = (int)0x80000000; x[58] = (int)0x80000000; x[59] = (int)0x80000000; x[60] = (int)0x80000000; x[61] = (int)0x80000000; x[62] = (int)0x80000000; x[63] = (int)0x80000000; } while (0)

__device__ __forceinline__ int crow(int r, int hi) { return (r & 3) + 8 * (r >> 2) + 4 * hi; }
__device__ __forceinline__ int f2key(float f) { const int t = __builtin_bit_cast(int, f); return t ^ ((t >> 31) & 0x7fffffff); }
__device__ __forceinline__ float key2f(int t) { return __builtin_bit_cast(float, t ^ ((t >> 31) & 0x7fffffff)); }
__device__ __forceinline__ int sel_hi(int a, int b, int hm) { int r; asm("v_bfi_b32 %0, %1, %2, %3" : "=v"(r) : "v"(hm), "v"(b), "v"(a)); return r; }
__device__ __forceinline__ int key7(float f, int low) { return (f2key(f) & ~127) | low; }
__device__ __forceinline__ int key6(float f, int ord) { return (f2key(f) & ~63) | (63 - ord); }
__device__ __forceinline__ void top16_of_64(int (&x)[64]) {
    PEER_SORT16(x, 0); PEER_SORT16(x, 16); PEER_SORT16(x, 32); PEER_SORT16(x, 48);
    PEER_MERGE16(x, 0, 16); PEER_MERGE16(x, 32, 48); PEER_MERGE16(x, 0, 32);
}
__device__ __forceinline__ float dot2_bf16(unsigned w, unsigned x, float acc) { return __builtin_amdgcn_fdot2_f32_bf16(__builtin_bit_cast(bf16x2_t, w), __builtin_bit_cast(bf16x2_t, x), acc, false); }
__device__ __forceinline__ float dot8(const u32x4 a, const u32x4 b, float acc) {
    acc = dot2_bf16(a.x, b.x, acc); acc = dot2_bf16(a.y, b.y, acc); acc = dot2_bf16(a.z, b.z, acc); acc = dot2_bf16(a.w, b.w, acc); return acc;
}
__device__ __forceinline__ float gelu_tanh(float x) {
    const float u = 0.7978845608028654f * (x + 0.044715f * x * x * x);
    const float e = __builtin_amdgcn_exp2f(2.0f * LOG2E * u);
    const float th = 1.0f - 2.0f * __builtin_amdgcn_rcpf(e + 1.0f);
    return 0.5f * x * (1.0f + th);
}
__device__ __forceinline__ void topk_half(const bf16* qp, const bf16* sp, int hi, int (&T)[16]) {
    bf16x8 qf[8];
#pragma unroll
    for (int ks = 0; ks < 8; ++ks) qf[ks] = *(const GAS bf16x8*)(qp + ks * 16);
    int x[64];
#pragma unroll
    for (int kt = 0; kt < 4; ++kt) { f32x16 sc = f32x16{};
#pragma unroll
        for (int ks = 0; ks < 8; ++ks) { const bf16x8 a = *(const GAS bf16x8*)(sp + (size_t)(32 * kt) * 128 + ks * 16); sc = __builtin_amdgcn_mfma_f32_32x32x16_bf16(a, qf[ks], sc, 0, 0, 0); }
#pragma unroll
        for (int r = 0; r < 16; ++r) x[16 * kt + r] = key7(sc[r], 127 - (32 * kt + crow(r, hi))); }
    top16_of_64(x);
#pragma unroll
    for (int i = 0; i < 16; ++i) { auto rr = __builtin_amdgcn_permlane32_swap((unsigned)x[i], (unsigned)x[i], false, false); x[i] = (int)rr[0]; x[16 + i] = (int)rr[1]; }
    PEER_MERGE16(x, 0, 16);
#pragma unroll
    for (int i = 0; i < 16; ++i) T[i] = x[i];
}
constexpr int L_ROUTE = 0, L_NLIST = 32768, L_CAND = 40960, L_COEF = 41472, L_END = 45568;
__device__ __forceinline__ void peer_tile(int tile, const bf16* PQ, const bf16* SK, const bf16* HB, const float* SSQ, const bf16* Ub, const bf16* Vb, const float* gfin, float* out, LAS unsigned char* lds) {
    const int lane = threadIdx.x & 63, r32 = lane & 31, hi = lane >> 5; const int wid = __builtin_amdgcn_readfirstlane((int)threadIdx.x >> 6);
    const int tok0 = tile * 32;
    LAS unsigned* route = (LAS unsigned*)(lds + L_ROUTE);
    LAS unsigned char* nl = lds + L_NLIST + (wid * 32 + r32) * 32;
    const LAS unsigned char* cand = lds + L_CAND;
    {
        const int h = wid; int T0[16], T1[16];
        topk_half(PQ + (size_t)(tok0 + r32) * NPQ + (h * 2 + 0) * 128 + hi * 8, SK + ((size_t)(h * 2 + 0) * 128 + r32) * 128 + hi * 8, hi, T0);
        topk_half(PQ + (size_t)(tok0 + r32) * NPQ + (h * 2 + 1) * 128 + hi * 8, SK + ((size_t)(h * 2 + 1) * 128 + r32) * 128 + hi * 8, hi, T1);
        const int hm = -hi;
        {
            u32x4 w;
#pragma unroll
            for (int q4 = 0; q4 < 4; ++q4) { unsigned a = 0;
#pragma unroll
                for (int e = 0; e < 4; ++e) { const int t = sel_hi(T0[4 * q4 + e], T1[4 * q4 + e], hm); a |= (unsigned)(127 - (t & 127)) << (8 * e); }
                w[q4] = a; }
            *(LAS u32x4*)(nl + 16 * hi) = w;
        }
        float v0[16], v1[16];
#pragma unroll
        for (int i = 0; i < 16; ++i) { v0[i] = key2f(T0[i] & ~127); v1[i] = key2f(T1[i] & ~127); }
        int x[64];
        PEER_CAND_SUMS(x, v0, v1, key6);
        top16_of_64(x);
        const float smax = key2f(x[0] & ~63);
        float p[16], ps = 0.f;
#pragma unroll
        for (int i = 0; i < 16; ++i) { p[i] = __builtin_amdgcn_exp2f((key2f(x[i] & ~63) - smax) * LOG2E); ps += p[i]; }
        const float rps = 1.0f / ps;
        LDS_WAIT();
#pragma unroll
        for (int i = 0; i < 8; ++i) {
            const int xi = sel_hi(x[i], x[8 + i], hm); const float g = __int_as_float(sel_hi(__float_as_int(p[i]), __float_as_int(p[8 + i]), hm)) * rps;
            const int ij = cand[63 - (xi & 63)]; const int n0 = nl[ij & 15], n1 = nl[16 + (ij >> 4)];
            u32x2 w; w.x = (unsigned)(n0 * 128 + n1); w.y = __float_as_uint(g);
            *(LAS u32x2*)(route + ((size_t)r32 * 128 + h * 16 + 8 * hi + i) * 2) = w; }
    }
    LDS_WAIT(); __syncthreads();
    LAS float* coef = (LAS float*)(lds + L_COEF) + wid * 128;
#pragma unroll 1
    for (int tt = 0; tt < 4; ++tt) {
        const int tl = wid * 4 + tt; const size_t tok = (size_t)tok0 + tl;
        const LAS unsigned* rt = route + tl * 256;
        const u32x4 ha = *(const GAS u32x4*)(HB + tok * 1024 + lane * 8), hb = *(const GAS u32x4*)(HB + tok * 1024 + 512 + lane * 8);
        float rstd;
        { const f32x4* sp = (const f32x4*)(SSQ + tok * 16); const f32x4 a = sp[0], b = sp[1], c = sp[2], d = sp[3]; const f32x4 t = (a + b) + (c + d);
          rstd = __builtin_amdgcn_rsqf(((t[0] + t[1]) + (t[2] + t[3])) * (1.0f / 1024.0f) + RMS_EPS); }
#pragma unroll 1
        for (int k0 = 0; k0 < 128; k0 += 8) {
            u32x4 ua[8], ub[8]; float gk[8];
#pragma unroll
            for (int j = 0; j < 8; ++j) { const u32x2 re = *(const LAS u32x2*)(rt + (k0 + j) * 2); const int e = __builtin_amdgcn_readfirstlane((int)re.x); gk[j] = __uint_as_float(re.y);
                const bf16* up = Ub + (size_t)e * 1024 + lane * 8; ua[j] = *(const GAS u32x4*)up; ub[j] = *(const GAS u32x4*)(up + 512); }
#pragma unroll
            for (int j = 0; j < 8; ++j) { const float dsum = wave_sum(dot8(ua[j], ha, dot8(ub[j], hb, 0.f)));
                const float cf = gk[j] * gelu_tanh(dsum * rstd); if (lane == 0) coef[k0 + j] = cf; }
        }
        LDS_WAIT();
        float acc[16];
#pragma unroll
        for (int i = 0; i < 16; ++i) acc[i] = 0.f;
#pragma unroll 1
        for (int k0 = 0; k0 < 128; k0 += 8) {
            u32x4 va[8], vb[8]; float cf[8];
#pragma unroll
            for (int j = 0; j < 8; ++j) { const int e = __builtin_amdgcn_readfirstlane((int)rt[(k0 + j) * 2]); cf[j] = coef[k0 + j];
                const bf16* vq = Vb + (size_t)e * 1024 + lane * 8; va[j] = *(const GAS u32x4*)vq; vb[j] = *(const GAS u32x4*)(vq + 512); }
#pragma unroll
            for (int j = 0; j < 8; ++j) {
                acc[0] += cf[j] * bflo(va[j].x); acc[1] += cf[j] * bfhi(va[j].x); acc[2] += cf[j] * bflo(va[j].y); acc[3] += cf[j] * bfhi(va[j].y);
                acc[4] += cf[j] * bflo(va[j].z); acc[5] += cf[j] * bfhi(va[j].z); acc[6] += cf[j] * bflo(va[j].w); acc[7] += cf[j] * bfhi(va[j].w);
                acc[8] += cf[j] * bflo(vb[j].x); acc[9] += cf[j] * bfhi(vb[j].x); acc[10] += cf[j] * bflo(vb[j].y); acc[11] += cf[j] * bfhi(vb[j].y);
                acc[12] += cf[j] * bflo(vb[j].z); acc[13] += cf[j] * bfhi(vb[j].z); acc[14] += cf[j] * bflo(vb[j].w); acc[15] += cf[j] * bfhi(vb[j].w); }
        }
        float* orow = out + tok * 1024; float hv[16]; float s = 0.f;
#pragma unroll
        for (int q = 0; q < 4; ++q) { const f32x4 t = *(const GAS f32x4*)(orow + (q >> 1) * 512 + lane * 8 + (q & 1) * 4);
#pragma unroll
            for (int e = 0; e < 4; ++e) { const float v = t[e] + acc[(q >> 1) * 8 + (q & 1) * 4 + e]; hv[(q >> 1) * 8 + (q & 1) * 4 + e] = v; s += v * v; } }
        const float rs = 1.0f / sqrtf(wave_sum(s) * (1.f / 1024.f) + RMS_EPS);
#pragma unroll
        for (int q = 0; q < 4; ++q) { const int cb_ = (q >> 1) * 512 + lane * 8 + (q & 1) * 4; const f32x4 g = *(const GAS f32x4*)(gfin + cb_); f32x4 t;
#pragma unroll
            for (int e = 0; e < 4; ++e) t[e] = hv[(q >> 1) * 8 + (q & 1) * 4 + e] * rs * g[e];
            *(GAS f32x4*)(orow + cb_) = t; }
    }
    LDS_WAIT(); __syncthreads();
}
}
struct Args { const float* in[20]; float* out; unsigned char* ws; int ph_lo, ph_hi, li, pad; };
__global__ void __launch_bounds__(NWAVES * 64, 2) fwd_megakernel(Args args) {
    extern __shared__ __attribute__((aligned(16))) unsigned char lds[];
    LAS unsigned char* ldsp = (LAS unsigned char*)lds;
    volatile LAS unsigned* MISC = (volatile LAS unsigned*)(ldsp + MISC_OFF);
    const int tid = threadIdx.x, lane = tid & 63, wave = __builtin_amdgcn_readfirstlane(tid >> 6);
    const int G = gridDim.x; const int bx = blockIdx.x; const int vcu = (G % 8 == 0) ? (bx % 8) * (G / 8) + bx / 8 : bx;
    unsigned char* ws = args.ws;
    gu32* ctl = (gu32*)(ws + WS_CTL);
    const float* x = args.in[0]; const float* mem = args.in[1]; const float* norm_mix = args.in[2]; const float* w_in = args.in[3]; const float* conv_w = args.in[4];
    const float* w_ba = args.in[5]; const float* w_bc = args.in[6]; const float* w_out = args.in[7]; const float* norm_xattn = args.in[8]; const float* norm_mem = args.in[9];
    const float* xwq = args.in[10]; const float* xwk = args.in[11]; const float* xwv = args.in[12]; const float* xwo = args.in[13]; const float* norm_ffn = args.in[14];
    const float* pwq = args.in[15]; const float* psk = args.in[16]; const float* pu = args.in[17]; const float* pv = args.in[18]; const float* norm_final = args.in[19];
    float* out = args.out;
    bf16* Win_t = (bf16*)(ws + WS_WIN); bf16* Wa_t = (bf16*)(ws + WS_WA); bf16* Wc_t = (bf16*)(ws + WS_WC); bf16* Wo_t = (bf16*)(ws + WS_WO); bf16* Wq2_t = (bf16*)(ws + WS_WQ2);
    bf16* Wkv2_t = (bf16*)(ws + WS_WKV2); bf16* Wo2_t = (bf16*)(ws + WS_WO2); bf16* Wpq_t = (bf16*)(ws + WS_WPQ); bf16* SKb = (bf16*)(ws + WS_SK);
    float* SSQ1 = (float*)(ws + WS_SSQ1); float* SSQ2 = (float*)(ws + WS_SSQ2); bf16* MEMN = (bf16*)(ws + WS_MEMN); bf16* K2 = (bf16*)(ws + WS_K2); bf16* V2T = (bf16*)(ws + WS_V2T);
    bf16* B0 = (bf16*)(ws + WS_B0); bf16* B1 = (bf16*)(ws + WS_B1); bf16* B2 = (bf16*)(ws + WS_B2); bf16* B3 = (bf16*)(ws + WS_B3); bf16* B4 = (bf16*)(ws + WS_B4); bf16* B5 = (bf16*)(ws + WS_B5);
    bf16* XN1 = (bf16*)out; bf16* YC = (bf16*)out; bf16* CBb = (bf16*)((unsigned char*)out + 32 * MiB);

    for (int u = tid; u < (LDS_BYTES - LDSCTL_OFF) / 4; u += NWAVES * 64) ((LAS unsigned*)(ldsp + LDSCTL_OFF))[u] = 0u;
    __syncthreads();
    XcdBarrier bar; bar.bar = (unsigned*)(ctl + CW_BAR); bar.x = 0; bar.st = nullptr;
    if (N_LAUNCHES == 1) bar = xcd_barrier_post((unsigned*)(ctl + CW_BAR), MISC + 8);
#define GRID_BAR() do { if (N_LAUNCHES == 1) xcd_barrier(bar); } while (0)
    const int lo = args.ph_lo, hi = args.ph_hi;
#define IN(k) (lo <= (k) && (k) < hi)
#define BOTH(k) (IN(k) && IN((k) + 1))
    const int gw = vcu * NWAVES + wave, NGW = G * NWAVES;

    if (IN(0)) {
        LAS float* scr = (LAS float*)(ldsp + RING_OFF + wave * 16384);
        constexpr int I_IN = 16 * 256, I_SQ = 16 * 32, I_PQ = 16 * 64;
        constexpr int NT_ITEMS = I_IN + 7 * I_SQ + I_PQ;
        for (int it = gw; it < NT_ITEMS; it += NGW) {
            int r = it;
            if (r < I_IN) { transpose_item<true>(w_in, D, NIN, nullptr, Win_t, 0, scr, r, lane); continue; } r -= I_IN;
            if (r < I_SQ) { transpose_item<false>(w_ba, D, D, nullptr, Wa_t, 0, scr, r, lane); continue; } r -= I_SQ;
            if (r < I_SQ) { transpose_item<false>(w_bc, D, D, nullptr, Wc_t, 0, scr, r, lane); continue; } r -= I_SQ;
            if (r < I_SQ) { transpose_item<false>(w_out, D, D, nullptr, Wo_t, 0, scr, r, lane); continue; } r -= I_SQ;
            if (r < I_SQ) { transpose_item<false>(xwq, D, D, norm_xattn, Wq2_t, 0, scr, r, lane); continue; } r -= I_SQ;
            if (r < I_SQ) { transpose_item<false>(xwk, D, D, nullptr, Wkv2_t, 0, scr, r, lane); continue; } r -= I_SQ;
            if (r < I_SQ) { transpose_item<false>(xwv, D, D, nullptr, Wkv2_t, D, scr, r, lane); continue; } r -= I_SQ;
            if (r < I_SQ) { transpose_item<false>(xwo, D, D, nullptr, Wo2_t, 0, scr, r, lane); continue; } r -= I_SQ;
            transpose_item<false>(pwq, D, NPQ, norm_ffn, Wpq_t, 0, scr, r, lane);
        }
        for (int it = gw; it < 512; it += NGW) {
            const GAS f32x4* s = (const GAS f32x4*)psk + (size_t)it * 128 + lane * 2; const f32x4 a = s[0], b = s[1];
            v4u o; o.x = pk2(a.x, a.y); o.y = pk2(a.z, a.w); o.z = pk2(b.x, b.y); o.w = pk2(b.z, b.w);
            *((GAS v4u*)SKb + (size_t)it * 64 + lane) = o; }
        for (int m = gw; m < M; m += NGW) rms_row_to_bf16(x + (size_t)m * D, norm_mix, XN1 + (size_t)m * D, lane);
        for (int m = gw; m < MROWS; m += NGW) rms_row_to_bf16(mem + (size_t)m * D, norm_mem, MEMN + (size_t)m * D, lane);
        if (BOTH(0)) GRID_BAR();
    }

    if (IN(1)) {
        pg8::GemmSet g{XN1, Win_t, XN1, Win_t, D}; pg8::TileOrder S; S.init(M, NIN, G, bx);
        pg8::EpiInProj E{B0, B1, B2, B3, CBb, B4, B5, 0.125f * LOG2E};
        pg8::gemm_phase<pg8::EpiInProj, pg8::TileOrder, true, true>(ldsp + RING_OFF, g, S, E);
        if (BOTH(1)) GRID_BAR();
    }

    if (IN(2)) {
        {
            const int bh = vcu >> 1, s = vcu & 1;
            if (bh < BATCH * 16) {
#pragma unroll 1
                for (int i = 0; i < 4; ++i) { const int qb = (i == 0) ? s : (i == 1) ? 7 - s : (i == 2) ? 2 + s : 5 - s;
                    sb::sb_unit<false>(bh >> 4, bh & 15, qb, (const sb::bf16*)B0, (const sb::bf16*)B1, (const sb::bf16*)B2, (sb::bf16*)B0, (char*)lds + RING_OFF); }
            }
            asm volatile("s_waitcnt vmcnt(0) lgkmcnt(0)" ::: "memory"); __syncthreads();
        }
        if (vcu < 32) {
            pg8::GemmSet g{MEMN, Wkv2_t, MEMN, Wkv2_t, D}; pg8::SubOrder S; S.init(MROWS, D, 0, vcu);
            pg8::EpiStore E{K2, D, 1.0f};
            pg8::gemm_phase<pg8::EpiStore, pg8::SubOrder, false, true>(ldsp + RING_OFF, g, S, E);
        } else if (vcu < 64) {
            pg8::GemmSet g{Wkv2_t + (size_t)D * D, MEMN, Wkv2_t + (size_t)D * D, MEMN, D}; pg8::SubOrder S; S.init(D, MROWS, 32, vcu);
            pg8::EpiStore E{V2T, MROWS, 1.0f};
            pg8::gemm_phase<pg8::EpiStore, pg8::SubOrder, false, true>(ldsp + RING_OFF, g, S, E);
        } else {
            const int cw_ = (vcu - 64) * NWAVES + wave, ncw = (G - 64) * NWAVES;
            for (int it = cw_; it < M / 8; it += ncw) yconv_item(B3, CBb, conv_w, YC, it, lane);
        }
        if (BOTH(2)) GRID_BAR();
    }

    if (IN(3)) {
        pg8::GemmSet g{B0, Wa_t, YC, Wc_t, D}; pg8::TileOrder S; S.init(M, D, G, bx, 2);
        pg8::EpiGate E{B1, B4, B5};
        pg8::gemm_phase<pg8::EpiGate, pg8::TileOrder, true, true>(ldsp + RING_OFF, g, S, E);
        if (BOTH(3)) GRID_BAR();
    }

    if (IN(4)) {
        pg8::GemmSet g{B1, Wo_t, B1, Wo_t, D}; pg8::TileOrder S; S.init(M, D, G, bx);
        pg8::EpiResid E{x, out, B2, SSQ1};
        pg8::gemm_phase<pg8::EpiResid, pg8::TileOrder, true, true>(ldsp + RING_OFF, g, S, E);
        if (BOTH(4)) GRID_BAR();
    }

    if (IN(5)) {
        pg8::GemmSet g{B2, Wq2_t, B2, Wq2_t, D}; pg8::TileOrder S; S.init(M, D, G, bx);
        pg8::EpiRowScale E{B3, D, SSQ1, LOG2E / 16.0f, RMS_EPS};
        pg8::gemm_phase<pg8::EpiRowScale, pg8::TileOrder, true, true>(ldsp + RING_OFF, g, S, E);
        for (int r = gw; r < 2 * 16384; r += NGW) {
            if (r < 16384) row_to_bf16(pu + (size_t)r * D, norm_ffn, B4 + (size_t)r * D, lane);
            else row_to_bf16(pv + (size_t)(r - 16384) * D, nullptr, B5 + (size_t)(r - 16384) * D, lane); }
        if (BOTH(5)) GRID_BAR();
    }

    if (IN(6)) {
#ifndef NO_XA
        for (int u = vcu; u < 256; u += G) xa::xattn_unit(u >> 5, (u >> 3) & 3, u & 7, B3, K2, V2T, B0, ldsp + RING_OFF + wave * 16384);
#endif
        if (BOTH(6)) GRID_BAR();
    }

    if (IN(7)) {
        pg8::GemmSet g{B0, Wo2_t, B0, Wo2_t, D}; pg8::TileOrder S; S.init(M, D, G, bx);
        pg8::EpiResid E{out, out, B1, SSQ2};
        pg8::gemm_phase<pg8::EpiResid, pg8::TileOrder, true, true>(ldsp + RING_OFF, g, S, E);
        if (BOTH(7)) GRID_BAR();
    }

    if (IN(8)) {
        pg8::GemmSet g{B1, Wpq_t, B1, Wpq_t, D}; pg8::TileOrder S; S.init(M, NPQ, G, bx);
        pg8::EpiRowScale E{B2, NPQ, SSQ2, 1.0f, RMS_EPS};
        pg8::gemm_phase<pg8::EpiRowScale, pg8::TileOrder, true, true>(ldsp + RING_OFF, g, S, E);
        if (BOTH(8)) GRID_BAR();
    }

    if (IN(9)) {
        if (tid < 64) { int cnt = 0, val = 0;
            for (int ii = 0; ii < 16; ++ii) { const int nj = 16 / (ii + 1); if (tid >= cnt && tid < cnt + nj) val = ii | ((tid - cnt) << 4); cnt += nj; }
            ldsp[RING_OFF + peer::L_CAND + tid] = (unsigned char)val; }
        LDS_WAIT(); __syncthreads();
#ifndef NO_PEER
        for (int tile = vcu; tile < M / 32; tile += G) peer::peer_tile(tile, B2, SKb, B1, SSQ2, B4, B5, norm_final, out, ldsp + RING_OFF);
#else
        for (int m = gw; m < M; m += NGW) final_norm_row(out + (size_t)m * D, norm_final, out + (size_t)m * D, lane);
#endif
    }
#undef IN
#undef BOTH
#undef GRID_BAR
}

extern "C" void kernel_launch(void* const* d_in, const int* in_sizes, int n_in, void* d_out, int out_size, void* d_ws, size_t ws_size, hipStream_t stream) {
    static int grid = 0;
    if (grid == 0) {
        if (n_in != 20 || in_sizes[0] != M * D || out_size != M * D || ws_size < WS_END) { fprintf(stderr, "kernel_launch: unexpected shapes (n_in %d, in0 %d, out %d, ws %zu); nothing launched\n", n_in, n_in > 0 ? in_sizes[0] : -1, out_size, ws_size); grid = -1; return; }
        int dev = 0, cus = 0, per_cu = 0;
        if (hipGetDevice(&dev) != hipSuccess || hipDeviceGetAttribute(&cus, hipDeviceAttributeMultiprocessorCount, dev) != hipSuccess) { grid = -1; return; }
        if (hipFuncSetAttribute((const void*)fwd_megakernel, hipFuncAttributeMaxDynamicSharedMemorySize, LDS_BYTES) != hipSuccess) { fprintf(stderr, "kernel_launch: hipFuncSetAttribute failed\n"); grid = -1; return; }
        if (hipOccupancyMaxActiveBlocksPerMultiprocessor(&per_cu, (const void*)fwd_megakernel, NWAVES * 64, LDS_BYTES) != hipSuccess || per_cu < 1)
            fprintf(stderr, "kernel_launch: note: occupancy query reports %d workgroups per CU\n", per_cu);
        (void)hipGetLastError();
        grid = cus;
    }
    if (grid < 0) return;
    if (hipMemsetAsync((char*)d_ws + WS_CTL, 0, CTL_ZERO_BYTES, stream) != hipSuccess) { fprintf(stderr, "kernel_launch: hipMemsetAsync failed\n"); return; }
    Args a{};
    for (int i = 0; i < 20; ++i) a.in[i] = (const float*)d_in[i];
    a.out = (float*)d_out; a.ws = (unsigned char*)d_ws;
    if (N_LAUNCHES == 1) { a.ph_lo = 0; a.ph_hi = N_PHASES; a.li = 0; hipLaunchKernelGGL(fwd_megakernel, dim3(grid), dim3(NWAVES * 64), LDS_BYTES, stream, a); }
    else for (int li = 0; li < N_PHASES; ++li) { a.ph_lo = li; a.ph_hi = li + 1; a.li = li; hipLaunchKernelGGL(fwd_megakernel, dim3(grid), dim3(NWAVES * 64), LDS_BYTES, stream, a); }
    const hipError_t le = hipPeekAtLastError();
    if (le != hipSuccess) fprintf(stderr, "kernel_launch: launch failed: %s\n", hipGetErrorName(le));
}
```

```cpp
#include <hip/hip_runtime.h>
#include <hip/hip_bf16.h>
#include <cstdio>
#include <cstdint>
#include <cmath>

#ifndef MK_N_LAUNCHES
#define MK_N_LAUNCHES 1
#endif
namespace pg8 {
#define PG8_LAS __attribute__((address_space(3)))
typedef unsigned short bf16_t;
typedef short bf16x8 __attribute__((ext_vector_type(8)));
typedef float f32x4 __attribute__((ext_vector_type(4)));
typedef float f32x2 __attribute__((ext_vector_type(2)));
typedef unsigned u32x4 __attribute__((ext_vector_type(4)));
typedef unsigned u32x2 __attribute__((ext_vector_type(2)));
constexpr int BM = 256, BK = 64, HALF = 128, HTB = HALF * BK * 2  , STAGE_BYTES = 8 * HTB, NXCD = 8, WGM = 8;

__host__ __device__ __forceinline__ int lds_byte(int r, int c) { const int st = (r >> 4) * 2 + (c >> 5), rr = r & 15, cc = c & 31, ob = rr * 64 + cc * 2; return st * 1024 + (ob ^ (((ob >> 9) & 1) << 5)); }
__host__ __device__ __forceinline__ void stage_rc(int b, int& R, int& C) { const int st = b / 1024, sb = b % 1024, swz = sb ^ (((sb >> 9) & 1) << 5); R = (st >> 1) * 16 + swz / 64; C = (st & 1) * 32 + (swz % 64) / 2; }
__host__ __device__ __forceinline__ int perm32(int rho) { const int n = rho >> 4, i = rho & 15; return 8 * (i >> 2) + 4 * n + (i & 3); }

struct Unit { int pm, pn, g; };
struct GemmSet { const bf16_t* A0; const bf16_t* B0; const bf16_t* A1; const bf16_t* B1; int K; };

struct TileOrder {
    int nM, nN, nwg, G, c, passes;
    __device__ void init(int M, int N, int G_, int c_, int passes_ = 1) { nM = M / BM; nN = N / BM; nwg = nM * nN; G = G_; c = c_; passes = passes_; }
    __device__ bool next(int i, Unit& u) const {
        const int ti = (passes == 2) ? (i >> 1) : i; u.g = (passes == 2) ? (i & 1) : 0;
        const long L = (long)ti * G + c; if (L >= nwg) return false;
        int wgid = (int)L; { const int q = nwg / NXCD, r = nwg % NXCD, xcd = wgid % NXCD, off = wgid / NXCD; wgid = (xcd < r ? xcd * (q + 1) : r * (q + 1) + (xcd - r) * q) + off; }
        const int nig = WGM * nN, gid = wgid / nig, fm = gid * WGM, gsz = (nM - fm) < WGM ? (nM - fm) : WGM;
        u.pm = fm + ((wgid % nig) % gsz); u.pn = (wgid % nig) / gsz; return true;
    }
    __device__ __forceinline__ void a_ready(const Unit&) const {}
    __device__ __forceinline__ void done(const Unit&) const {}
};
struct SubOrder {
    int nN, n, idx;
    __device__ void init(int M, int N, int c0, int c_) { nN = N / BM; n = (M / BM) * nN; idx = c_ - c0; }
    __device__ bool next(int i, Unit& u) const { if (i != 0 || idx < 0 || idx >= n) return false; u.pm = idx / nN; u.pn = idx % nN; u.g = 0; return true; }
    __device__ __forceinline__ void a_ready(const Unit&) const {}
    __device__ __forceinline__ void done(const Unit&) const {}
};

typedef __bf16 bf16x2_t __attribute__((ext_vector_type(2)));
__device__ __forceinline__ unsigned cvt_pk_bf16(float lo, float hi) { f32x2 v = {lo, hi}; bf16x2_t b = __builtin_convertvector(v, bf16x2_t); return __builtin_bit_cast(unsigned, b); }
__device__ __forceinline__ float bf_lo(unsigned w) { return __builtin_bit_cast(float, w << 16); }
__device__ __forceinline__ float bf_hi(unsigned w) { return __builtin_bit_cast(float, w & 0xffff0000u); }
__device__ __forceinline__ u32x4 pack8(const f32x4 v0, const f32x4 v1) { u32x4 w; w.x = cvt_pk_bf16(v0[0], v0[1]); w.y = cvt_pk_bf16(v0[2], v0[3]); w.z = cvt_pk_bf16(v1[0], v1[1]); w.w = cvt_pk_bf16(v1[2], v1[3]); return w; }
__device__ __forceinline__ float sigmoidf_fast(float x) { return __builtin_amdgcn_rcpf(1.0f + __builtin_amdgcn_exp2f(-1.4426950408889634f * x)); }

struct EpiStore {
    static constexpr bool PERM = true, AFTER_DRAIN = false;
    bf16_t* O; int ldc; float scale;
    __device__ __forceinline__ void operator()(const f32x4 (&acc)[2][2][4][2], const Unit& u, int wr, int wc, int fr, int fq) const {
        const int row0 = u.pm * BM + wr * 64 + fr, col0 = u.pn * BM + wc * 32 + 8 * fq;
#pragma unroll
        for (int ai = 0; ai < 2; ++ai)
#pragma unroll
            for (int m = 0; m < 4; ++m) { bf16_t* rowp = O + (size_t)(row0 + ai * HALF + m * 16) * ldc + col0;
#pragma unroll
                for (int bj = 0; bj < 2; ++bj) *(u32x4*)(rowp + bj * HALF) = pack8(acc[ai][bj][m][0] * scale, acc[ai][bj][m][1] * scale); }
    }
};

struct EpiInProj {
    static constexpr bool PERM = true, AFTER_DRAIN = false;
    bf16_t *q, *k, *v, *uu, *cb, *sga, *sgc; float qscale;
    __device__ __forceinline__ void operator()(const f32x4 (&acc)[2][2][4][2], const Unit& u, int wr, int wc, int fr, int fq) const {
        const int row0 = u.pm * BM + wr * 64 + fr; const int pn = u.pn;
        if (pn >= 12 && pn < 20) {
            const int col0 = (pn - 12) * 128 + wc * 32 + 8 * fq;
#pragma unroll
            for (int ai = 0; ai < 2; ++ai)
#pragma unroll
                for (int m = 0; m < 4; ++m) *(u32x4*)(uu + (size_t)(row0 + ai * HALF + m * 16) * 1024 + col0) = pack8(acc[ai][0][m][0] * acc[ai][1][m][0], acc[ai][0][m][1] * acc[ai][1][m][1]);
            return;
        }
        bf16_t* base; float sc = 1.f; bool sig = false;
        if (pn < 4) { base = q; sc = qscale; } else if (pn < 8) base = k; else if (pn < 12) base = v; else if (pn < 24) base = cb; else if (pn < 28) { base = sga; sig = true; } else { base = sgc; sig = true; }
        const int col0 = (pn & 3) * BM + wc * 32 + 8 * fq;
#pragma unroll
        for (int ai = 0; ai < 2; ++ai)
#pragma unroll
            for (int m = 0; m < 4; ++m) { bf16_t* rowp = base + (size_t)(row0 + ai * HALF + m * 16) * 1024 + col0;
#pragma unroll
                for (int bj = 0; bj < 2; ++bj) { f32x4 v0 = acc[ai][bj][m][0], v1 = acc[ai][bj][m][1];
                    if (sig) {
#pragma unroll
                        for (int e = 0; e < 4; ++e) { v0[e] = sigmoidf_fast(v0[e]); v1[e] = sigmoidf_fast(v1[e]); } }
                    else { v0 = v0 * sc; v1 = v1 * sc; }
                    *(u32x4*)(rowp + bj * HALF) = pack8(v0, v1); } }
    }
};

struct EpiGate {
    static constexpr bool PERM = true, AFTER_DRAIN = false;
    bf16_t* merged; const bf16_t* sga; const bf16_t* sgc;
    __device__ __forceinline__ void operator()(const f32x4 (&acc)[2][2][4][2], const Unit& u, int wr, int wc, int fr, int fq) const {
        const int row0 = u.pm * BM + wr * 64 + fr, col0 = u.pn * BM + wc * 32 + 8 * fq; const bf16_t* gate = u.g ? sgc : sga;
#pragma unroll
        for (int ai = 0; ai < 2; ++ai)
#pragma unroll
            for (int m = 0; m < 4; ++m) { const size_t off = (size_t)(row0 + ai * HALF + m * 16) * 1024 + col0;
#pragma unroll
                for (int bj = 0; bj < 2; ++bj) { const u32x4 gw = *(const u32x4*)(gate + off + bj * HALF);
                    f32x4 v0 = acc[ai][bj][m][0], v1 = acc[ai][bj][m][1];
                    v0[0] *= bf_lo(gw.x); v0[1] *= bf_hi(gw.x); v0[2] *= bf_lo(gw.y); v0[3] *= bf_hi(gw.y); v1[0] *= bf_lo(gw.z); v1[1] *= bf_hi(gw.z); v1[2] *= bf_lo(gw.w); v1[3] *= bf_hi(gw.w);
                    if (u.g) { const u32x4 pw = *(const u32x4*)(merged + off + bj * HALF);
                        v0[0] += bf_lo(pw.x); v0[1] += bf_hi(pw.x); v0[2] += bf_lo(pw.y); v0[3] += bf_hi(pw.y); v1[0] += bf_lo(pw.z); v1[1] += bf_hi(pw.z); v1[2] += bf_lo(pw.w); v1[3] += bf_hi(pw.w); }
                    *(u32x4*)(merged + off + bj * HALF) = pack8(v0, v1); } }
    }
};

struct EpiResid {
    static constexpr bool PERM = false, AFTER_DRAIN = false;
    const float* base; float* hf; bf16_t* hb; float* ssq;
    __device__ __forceinline__ void operator()(const f32x4 (&acc)[2][2][4][2], const Unit& u, int wr, int wc, int fr, int fq) const {
        const int row0 = u.pm * BM + wr * 64 + fr, col0 = u.pn * BM + wc * 32 + 4 * fq;
#pragma unroll
        for (int ai = 0; ai < 2; ++ai)
#pragma unroll
            for (int m = 0; m < 4; ++m) { const int row = row0 + ai * HALF + m * 16; const size_t off = (size_t)row * 1024 + col0; float s = 0.f;
#pragma unroll
                for (int bj = 0; bj < 2; ++bj)
#pragma unroll
                    for (int n = 0; n < 2; ++n) { const f32x4 b = *(const f32x4*)(base + off + bj * HALF + n * 16); const f32x4 h = b + acc[ai][bj][m][n];
                        *(f32x4*)(hf + off + bj * HALF + n * 16) = h; s += (h[0] * h[0] + h[1] * h[1]) + (h[2] * h[2] + h[3] * h[3]);
                        u32x2 w; w.x = cvt_pk_bf16(h[0], h[1]); w.y = cvt_pk_bf16(h[2], h[3]); *(u32x2*)(hb + off + bj * HALF + n * 16) = w; }
                s += __shfl_xor(s, 16); s += __shfl_xor(s, 32);
                if (fq == 0) ssq[(size_t)row * 16 + u.pn * 4 + wc] = s; }
    }
};

struct EpiRowScale {
    static constexpr bool PERM = true, AFTER_DRAIN = false;
    bf16_t* O; int ldc; const float* ssq; float scale; float eps;
    __device__ __forceinline__ void operator()(const f32x4 (&acc)[2][2][4][2], const Unit& u, int wr, int wc, int fr, int fq) const {
        const int row0 = u.pm * BM + wr * 64 + fr, col0 = u.pn * BM + wc * 32 + 8 * fq;
#pragma unroll
        for (int ai = 0; ai < 2; ++ai)
#pragma unroll
            for (int m = 0; m < 4; ++m) { const int row = row0 + ai * HALF + m * 16; const f32x4* sp = (const f32x4*)(ssq + (size_t)row * 16);
                const f32x4 a = sp[0], b = sp[1], c = sp[2], d = sp[3]; const f32x4 t = (a + b) + (c + d);
                const float rs = __builtin_amdgcn_rsqf(((t[0] + t[1]) + (t[2] + t[3])) * (1.0f / 1024.0f) + eps) * scale;
                bf16_t* rowp = O + (size_t)row * ldc + col0;
#pragma unroll
                for (int bj = 0; bj < 2; ++bj) *(u32x4*)(rowp + bj * HALF) = pack8(acc[ai][bj][m][0] * rs, acc[ai][bj][m][1] * rs); }
    }
};

template <class Epi, class Sched, bool ALIGN_EPI = false, bool SP2 = false>
__device__ __forceinline__ void gemm_phase(PG8_LAS unsigned char* lds, const GemmSet g, const Sched& S, const Epi& E) {
    const int tid = threadIdx.x, wid = __builtin_amdgcn_readfirstlane(tid >> 6), lane = tid & 63, wr = wid >> 2, wc = wid & 3, fr = lane & 15, fq = lane >> 4;
    const int K = g.K, nt = K / BK;
    unsigned voffA[2], voffB[2];
#pragma unroll
    for (int i = 0; i < 2; ++i) { int R, C; stage_rc(tid * 16 + i * 8192, R, C); const int Rb = Epi::PERM ? ((R & ~31) + perm32(R & 31)) : R;
        voffA[i] = (unsigned)(R * K + C) * 2u; voffB[i] = (unsigned)(Rb * K + C) * 2u; }
    const size_t kstep = (size_t)(BK * 2);
    const size_t hstep = (size_t)HALF * K * 2;
    const size_t tstep = 2 * hstep;
    const unsigned ldsw = (unsigned)wid * 1024u;
    const int aoff = lds_byte(wr * 64 + fr, fq * 8), boff = lds_byte(wc * 32 + fr, fq * 8);
#define PG8_SA(b, h) (((b) * 2 + (h)) * HTB)
#define PG8_SB(b, h) ((4 + (b) * 2 + (h)) * HTB)
#define PG8_STAGE(bufoff, gbase, voff) do { _Pragma("unroll") for (int _i = 0; _i < 2; ++_i) \
        __builtin_amdgcn_global_load_lds((const unsigned*)((const char*)(gbase) + (voff)[_i]), (PG8_LAS unsigned*)(lds + (bufoff) + ldsw + _i * 8192), 16, 0, 0); } while (0)
#define PG8_LDA(dst, b, h) do { _Pragma("unroll") for (int m = 0; m < 4; ++m) _Pragma("unroll") for (int k = 0; k < 2; ++k) dst[m][k] = *(const PG8_LAS bf16x8*)(lds + PG8_SA(b, h) + aoff + m * 2048 + k * 1024); } while (0)
#define PG8_LDB(dst, b, h) do { _Pragma("unroll") for (int n = 0; n < 2; ++n) _Pragma("unroll") for (int k = 0; k < 2; ++k) dst[n][k] = *(const PG8_LAS bf16x8*)(lds + PG8_SB(b, h) + boff + n * 2048 + k * 1024); } while (0)
#define PG8_MMA(ai, bj, At, Bt) do { __builtin_amdgcn_s_setprio(1); _Pragma("unroll") for (int m = 0; m < 4; ++m) _Pragma("unroll") for (int n = 0; n < 2; ++n) _Pragma("unroll") for (int k = 0; k < 2; ++k) \
        acc[ai][bj][m][n] = __builtin_amdgcn_mfma_f32_16x16x32_bf16(Bt[n][k], At[m][k], acc[ai][bj][m][n], 0, 0, 0); __builtin_amdgcn_s_setprio(0); } while (0)
#define PG8_WAIT_V(n) asm volatile("s_waitcnt vmcnt(" #n ")" ::: "memory")
#define PG8_WAIT_L(n) asm volatile("s_waitcnt lgkmcnt(" #n ")" ::: "memory")
#define PG8_BAR __builtin_amdgcn_s_barrier()
#define PG8_SCHED __builtin_amdgcn_sched_barrier(0)
    Unit cur, nxt; int ui = 0;
    if (!S.next(0, cur)) return;
    f32x4 acc[2][2][4][2];
#pragma unroll
    for (int a = 0; a < 2; ++a)
#pragma unroll
        for (int b = 0; b < 2; ++b)
#pragma unroll
            for (int m = 0; m < 4; ++m)
#pragma unroll
                for (int n = 0; n < 2; ++n) acc[a][b][m][n] = (f32x4){0.f, 0.f, 0.f, 0.f};
    bf16x8 At[4][2], B0[2][2], B1[2][2];
    const char* cA = (const char*)(cur.g ? g.A1 : g.A0) + (size_t)cur.pm * tstep; const char* cB = (const char*)(cur.g ? g.B1 : g.B0) + (size_t)cur.pn * tstep;
    S.a_ready(cur);
    if constexpr (SP2) {
        PG8_STAGE(PG8_SB(0, 0), cB, voffB); PG8_STAGE(PG8_SB(0, 1), cB + hstep, voffB); PG8_STAGE(PG8_SA(0, 0), cA, voffA); PG8_STAGE(PG8_SA(0, 1), cA + hstep, voffA);
        if (wr == 1) PG8_BAR;
        PG8_WAIT_V(2); PG8_BAR;
        PG8_STAGE(PG8_SB(1, 0), cB + kstep, voffB); PG8_STAGE(PG8_SA(1, 0), cA + kstep, voffA); PG8_STAGE(PG8_SB(1, 1), cB + hstep + kstep, voffB);
        PG8_WAIT_V(6); PG8_BAR;
    } else {
        PG8_STAGE(PG8_SB(0, 0), cB, voffB); PG8_STAGE(PG8_SA(0, 0), cA, voffA); PG8_STAGE(PG8_SB(0, 1), cB + hstep, voffB); PG8_STAGE(PG8_SA(0, 1), cA + hstep, voffA);
        if (wr == 1) PG8_BAR;
        PG8_WAIT_V(4); PG8_BAR;
        PG8_STAGE(PG8_SB(1, 0), cB + kstep, voffB); PG8_STAGE(PG8_SA(1, 0), cA + kstep, voffA); PG8_STAGE(PG8_SB(1, 1), cB + hstep + kstep, voffB);
        PG8_WAIT_V(6); PG8_BAR;
    }
    for (;;) {
        const bool has_next = S.next(ui + 1, nxt);
        const char* nA = has_next ? (const char*)(nxt.g ? g.A1 : g.A0) + (size_t)nxt.pm * tstep : cA; const char* nB = has_next ? (const char*)(nxt.g ? g.B1 : g.B0) + (size_t)nxt.pn * tstep : cB;
        for (int t = 0; t < nt; t += 2) {
            const bool last = (t == nt - 2);
            const char* a1 = cA + (size_t)(t + 1) * kstep;
            const char* a2 = last ? nA : cA + (size_t)(t + 2) * kstep; const char* b2 = last ? nB : cB + (size_t)(t + 2) * kstep;
            const char* a3 = a2 + kstep; const char* b3 = b2 + kstep;
            if (last && has_next) S.a_ready(nxt);
            if constexpr (SP2) {
            PG8_LDB(B0, 0, 0); PG8_LDB(B1, 0, 1); PG8_SCHED; PG8_LDA(At, 0, 0); PG8_STAGE(PG8_SA(1, 1), a1 + hstep, voffA);
            PG8_WAIT_V(8); PG8_WAIT_L(0); PG8_BAR; PG8_MMA(0, 0, At, B0); PG8_MMA(0, 1, At, B1); PG8_BAR; PG8_SCHED;
            PG8_LDA(At, 0, 1); PG8_STAGE(PG8_SB(0, 0), b2, voffB); PG8_STAGE(PG8_SB(0, 1), b2 + hstep, voffB); PG8_STAGE(PG8_SA(0, 0), a2, voffA);
            PG8_WAIT_V(8); PG8_WAIT_L(0); PG8_BAR; PG8_MMA(1, 0, At, B0); PG8_MMA(1, 1, At, B1); PG8_BAR; PG8_SCHED;
            PG8_LDB(B0, 1, 0); PG8_LDB(B1, 1, 1); PG8_SCHED; PG8_LDA(At, 1, 0); PG8_STAGE(PG8_SA(0, 1), a2 + hstep, voffA);
            PG8_WAIT_V(8); PG8_WAIT_L(0); PG8_BAR; PG8_MMA(0, 0, At, B0); PG8_MMA(0, 1, At, B1); PG8_BAR; PG8_SCHED;
            PG8_LDA(At, 1, 1); PG8_STAGE(PG8_SB(1, 0), b3, voffB); PG8_STAGE(PG8_SB(1, 1), b3 + hstep, voffB); PG8_STAGE(PG8_SA(1, 0), a3, voffA);
            PG8_WAIT_V(8); PG8_WAIT_L(0); PG8_BAR; PG8_MMA(1, 0, At, B0); PG8_MMA(1, 1, At, B1); PG8_BAR; PG8_SCHED;
            } else {
            PG8_LDB(B0, 0, 0); PG8_SCHED; PG8_LDA(At, 0, 0); PG8_STAGE(PG8_SA(1, 1), a1 + hstep, voffA);
            PG8_WAIT_L(8); PG8_BAR; PG8_WAIT_L(0); PG8_MMA(0, 0, At, B0); PG8_BAR; PG8_SCHED;
            PG8_LDB(B1, 0, 1); PG8_STAGE(PG8_SB(0, 0), b2, voffB);
            PG8_BAR; PG8_WAIT_L(0); PG8_MMA(0, 1, At, B1); PG8_BAR;
            PG8_LDA(At, 0, 1); PG8_STAGE(PG8_SA(0, 0), a2, voffA);
            PG8_BAR; PG8_WAIT_L(0); PG8_MMA(1, 0, At, B0); PG8_BAR; PG8_SCHED;
            PG8_STAGE(PG8_SB(0, 1), b2 + hstep, voffB);
            PG8_WAIT_V(6); PG8_BAR; PG8_MMA(1, 1, At, B1); PG8_BAR;
            PG8_LDB(B0, 1, 0); PG8_SCHED; PG8_LDA(At, 1, 0); PG8_STAGE(PG8_SA(0, 1), a2 + hstep, voffA);
            PG8_WAIT_L(8); PG8_BAR; PG8_WAIT_L(0); PG8_MMA(0, 0, At, B0); PG8_BAR; PG8_SCHED;
            PG8_LDB(B1, 1, 1); PG8_STAGE(PG8_SB(1, 0), b3, voffB);
            PG8_BAR; PG8_WAIT_L(0); PG8_MMA(0, 1, At, B1); PG8_BAR;
            PG8_LDA(At, 1, 1); PG8_STAGE(PG8_SA(1, 0), a3, voffA);
            PG8_BAR; PG8_WAIT_L(0); PG8_MMA(1, 0, At, B0); PG8_BAR; PG8_SCHED;
            PG8_STAGE(PG8_SB(1, 1), b3 + hstep, voffB);
            PG8_WAIT_V(6); PG8_BAR; PG8_MMA(1, 1, At, B1); PG8_BAR;
            }
        }
        if constexpr (ALIGN_EPI) { if (wr == 0) PG8_BAR; }
        if constexpr (!Epi::AFTER_DRAIN) { E(acc, cur, wr, wc, fr, fq); S.done(cur); }
        if (!has_next) break;
#pragma unroll
        for (int a = 0; a < 2; ++a)
#pragma unroll
            for (int b = 0; b < 2; ++b)
#pragma unroll
                for (int m = 0; m < 4; ++m)
#pragma unroll
                    for (int n = 0; n < 2; ++n) acc[a][b][m][n] = (f32x4){0.f, 0.f, 0.f, 0.f};
        cur = nxt; cA = nA; cB = nB; ++ui;
        if constexpr (ALIGN_EPI) { if (wr == 1) PG8_BAR; }
    }
    PG8_WAIT_V(0);
    if constexpr (!ALIGN_EPI) { if (wr == 0) PG8_BAR; }
    PG8_BAR;
    if constexpr (Epi::AFTER_DRAIN) { E.fused(acc, cur, wr, wc, fr, fq, lds, wid, lane); S.done(cur); }
#undef PG8_SA
#undef PG8_SB
#undef PG8_STAGE
#undef PG8_LDA
#undef PG8_LDB
#undef PG8_MMA
#undef PG8_WAIT_V
#undef PG8_WAIT_L
#undef PG8_BAR
#undef PG8_SCHED
}
}

namespace sb {
using bf16 = __hip_bfloat16;
using bf16x8 = __attribute__((ext_vector_type(8))) short;
using s16x4 = __attribute__((ext_vector_type(4))) short;
using f32x16 = __attribute__((ext_vector_type(16))) float;
using u32x4 = __attribute__((ext_vector_type(4))) unsigned;
constexpr int SEQ = 2048, NHEAD = 16, HD = 64, DM = 1024;
constexpr int SLOTB = 8192, LDS_K = 0, LDS_V = 2 * SLOTB, LDS_BYTES = 4 * SLOTB;
__device__ __forceinline__ int crow(int r, int hi) { return (r & 3) + 8 * (r >> 2) + 4 * hi; }
__device__ __forceinline__ void glds16(const void* gsrc, unsigned lds_dst) { unsigned keep;
    asm volatile("s_mov_b32 %0, m0\n\ts_mov_b32 m0, %2\n\ts_nop 0\n\tglobal_load_lds_dwordx4 %1, off\n\ts_mov_b32 m0, %0" : "=&s"(keep) : "v"(gsrc), "s"(lds_dst) : "memory"); }
typedef __attribute__((address_space(3))) const char* lds_cptr;
typedef short v4i16_t __attribute__((ext_vector_type(4)));
typedef float f32x2_t __attribute__((ext_vector_type(2))); typedef __bf16 bf16x2_t __attribute__((ext_vector_type(2)));
__device__ __forceinline__ unsigned cvtpk(float lo, float hi) { f32x2_t v = {lo, hi}; bf16x2_t b = __builtin_convertvector(v, bf16x2_t); return __builtin_bit_cast(unsigned, b); }
__device__ __forceinline__ s16x4 vtr(lds_cptr p) { return __builtin_bit_cast(s16x4, __builtin_amdgcn_ds_read_tr16_b64_v4i16((__attribute__((address_space(3))) v4i16_t*)p)); }
__device__ __forceinline__ bf16x8 pack8(const f32x16& p, int b) { u32x4 w; w.x = cvtpk(p[b], p[b + 1]); w.y = cvtpk(p[b + 2], p[b + 3]); w.z = cvtpk(p[b + 4], p[b + 5]); w.w = cvtpk(p[b + 6], p[b + 7]); return __builtin_bit_cast(bf16x8, w); }
__device__ __forceinline__ float lo_lane(float x) { auto rr = __builtin_amdgcn_permlane32_swap(__float_as_uint(x), __float_as_uint(x), false, false); return __uint_as_float(rr[0]); }
#define SB_WAIT_BAR() asm volatile("s_waitcnt vmcnt(0) lgkmcnt(0)\n\ts_barrier" ::: "memory")

template <bool EARLY> __device__ __forceinline__ void sb_unit(int b, int h, int qb, const bf16* Q, const bf16* __restrict__ K, const bf16* __restrict__ V, bf16* O, char* shm) {
    const int tid = threadIdx.x, lane = tid & 63, r32 = lane & 31, hi = lane >> 5; const int wid = __builtin_amdgcn_readfirstlane(tid >> 6);
    const long rowbase = (long)b * SEQ; const int q0 = qb * 256;
    const bf16* Qw = Q + (rowbase + q0 + wid * 32) * DM + h * HD;
    const bf16* Kh = K + rowbase * DM + h * HD; const bf16* Vh = V + rowbase * DM + h * HD;
    const unsigned lds0 = (unsigned)(uintptr_t)shm;
    const bf16* ksrc = Kh + (long)lane * DM + wid * 8;
    const bf16* vsrc = Vh + (long)(16 * (wid & 3) + (lane >> 2)) * DM + (wid >> 2) * 32 + (lane & 3) * 8;
    const unsigned kdst = lds0 + LDS_K + wid * 1024, vdst = lds0 + LDS_V + wid * 1024;
#define SB_DMA_K(t, slot) glds16(ksrc + (long)(t) * 64 * DM, (unsigned)__builtin_amdgcn_readfirstlane(kdst + (slot)))
#define SB_DMA_V(t, slot) glds16(vsrc + (long)(t) * 64 * DM, (unsigned)__builtin_amdgcn_readfirstlane(vdst + (slot)))
    const lds_cptr shm3 = (lds_cptr)shm; const lds_cptr kp0 = shm3 + LDS_K + hi * 1024 + r32 * 16;
    const lds_cptr vp0 = shm3 + LDS_V + ((lane >> 4) & 1) * 32 + (lane & 3) * 8 + (4 * hi + ((lane & 15) >> 2)) * 64;
    const int NT = (q0 + 256) / 64;
    SB_DMA_K(NT - 1, 0); SB_DMA_V(NT - 1, 0);
    bf16x8 qr[4];
#pragma unroll
    for (int d0 = 0; d0 < 4; ++d0) qr[d0] = *reinterpret_cast<const bf16x8*>(&Qw[(long)r32 * DM + d0 * 16 + hi * 8]);
    bf16x8 tri[2], ones;
#pragma unroll
    for (int ks = 0; ks < 2; ++ks)
#pragma unroll
        for (int j = 0; j < 8; ++j) { const int kk = 16 * ks + 8 * (j >> 2) + 4 * hi + (j & 3); tri[ks][j] = (kk >= r32) ? (short)0x3F80 : (short)0; }
#pragma unroll
    for (int j = 0; j < 8; ++j) ones[j] = (short)0x3F80;
    f32x16 o0 = f32x16{}, o1 = f32x16{}; float R = 0.f;
    const int trow = q0 + wid * 32 + r32;
    const int wmin = q0 + wid * 32, wmax = wmin + 31;
    for (int it = 0; it < NT; ++it) {
        const int t = NT - 1 - it; const int sl = (it & 1) * SLOTB;
        SB_WAIT_BAR();
        if (t > 0) { SB_DMA_K(t - 1, sl ^ SLOTB); SB_DMA_V(t - 1, sl ^ SLOTB); }
        if (64 * t < wmax) {
            f32x16 p0 = f32x16{}, p1 = f32x16{};
#pragma unroll
            for (int d0 = 0; d0 < 4; ++d0) {
                const bf16x8 b0 = *(const __attribute__((address_space(3))) bf16x8*)(kp0 + sl + d0 * 2048);
                const bf16x8 b1 = *(const __attribute__((address_space(3))) bf16x8*)(kp0 + sl + d0 * 2048 + 512);
                p0 = __builtin_amdgcn_mfma_f32_32x32x16_bf16(b0, qr[d0], p0, 0, 0, 0);
                p1 = __builtin_amdgcn_mfma_f32_32x32x16_bf16(b1, qr[d0], p1, 0, 0, 0); }
            const bool diag = (64 * t + 63 >= wmin);
            f32x16 l0, l1;
#pragma unroll
            for (int r = 0; r < 16; ++r) {
                const float y0 = p0[r], y1 = p1[r];
                l0[r] = -(__builtin_fmaxf(y0, 0.f) + __builtin_amdgcn_logf(1.0f + __builtin_amdgcn_exp2f(-__builtin_fabsf(y0))));
                l1[r] = -(__builtin_fmaxf(y1, 0.f) + __builtin_amdgcn_logf(1.0f + __builtin_amdgcn_exp2f(-__builtin_fabsf(y1)))); }
            if (diag) {
#pragma unroll
                for (int r = 0; r < 16; ++r) { const int s = 64 * t + crow(r, hi); if (s >= trow) l0[r] = 0.f; if (s + 32 >= trow) l1[r] = 0.f; } }
            const bf16x8 l0a = pack8(l0, 0), l0b = pack8(l0, 8), l1a = pack8(l1, 0), l1b = pack8(l1, 8);
            f32x16 Rv;
#pragma unroll
            for (int r = 0; r < 16; ++r) Rv[r] = R;
            f32x16 c1 = __builtin_amdgcn_mfma_f32_32x32x16_bf16(tri[0], l1a, Rv, 0, 0, 0); c1 = __builtin_amdgcn_mfma_f32_32x32x16_bf16(tri[1], l1b, c1, 0, 0, 0);
            f32x16 c0 = __builtin_amdgcn_mfma_f32_32x32x16_bf16(ones, l1a, Rv, 0, 0, 0); c0 = __builtin_amdgcn_mfma_f32_32x32x16_bf16(ones, l1b, c0, 0, 0, 0);
            c0 = __builtin_amdgcn_mfma_f32_32x32x16_bf16(tri[0], l0a, c0, 0, 0, 0); c0 = __builtin_amdgcn_mfma_f32_32x32x16_bf16(tri[1], l0b, c0, 0, 0, 0);
#pragma unroll
            for (int r = 0; r < 16; ++r) { p0[r] = __builtin_amdgcn_exp2f(p0[r] + c0[r]); p1[r] = __builtin_amdgcn_exp2f(p1[r] + c1[r]); }
            if (diag) {
#pragma unroll
                for (int r = 0; r < 16; ++r) { const int s = 64 * t + crow(r, hi); if (s >= trow) p0[r] = 0.f; if (s + 32 >= trow) p1[r] = 0.f; } }
            R = lo_lane(c0[0]);
            const bf16x8 pa0 = pack8(p0, 0), pa1 = pack8(p0, 8), pa2 = pack8(p1, 0), pa3 = pack8(p1, 8);
            const lds_cptr vp = vp0 + sl;
#define SB_VF(dh, ks) ({ const s16x4 lo_ = vtr(vp + (dh) * 4096 + (ks) * 1024), hi_ = vtr(vp + (dh) * 4096 + (ks) * 1024 + 512); (bf16x8){lo_[0], lo_[1], lo_[2], lo_[3], hi_[0], hi_[1], hi_[2], hi_[3]}; })
            o0 = __builtin_amdgcn_mfma_f32_32x32x16_bf16(pa0, SB_VF(0, 0), o0, 0, 0, 0); o1 = __builtin_amdgcn_mfma_f32_32x32x16_bf16(pa0, SB_VF(1, 0), o1, 0, 0, 0);
            o0 = __builtin_amdgcn_mfma_f32_32x32x16_bf16(pa1, SB_VF(0, 1), o0, 0, 0, 0); o1 = __builtin_amdgcn_mfma_f32_32x32x16_bf16(pa1, SB_VF(1, 1), o1, 0, 0, 0);
            o0 = __builtin_amdgcn_mfma_f32_32x32x16_bf16(pa2, SB_VF(0, 2), o0, 0, 0, 0); o1 = __builtin_amdgcn_mfma_f32_32x32x16_bf16(pa2, SB_VF(1, 2), o1, 0, 0, 0);
            o0 = __builtin_amdgcn_mfma_f32_32x32x16_bf16(pa3, SB_VF(0, 3), o0, 0, 0, 0); o1 = __builtin_amdgcn_mfma_f32_32x32x16_bf16(pa3, SB_VF(1, 3), o1, 0, 0, 0);
#undef SB_VF
        }
    }
    bf16* Ow = O + (rowbase + q0 + wid * 32) * DM + h * HD;
#pragma unroll
    for (int r = 0; r < 16; ++r) { const int orow = crow(r, hi); Ow[(long)orow * DM + r32] = __float2bfloat16(o0[r]); Ow[(long)orow * DM + 32 + r32] = __float2bfloat16(o1[r]); }
#undef SB_DMA_K
#undef SB_DMA_V
}
}

constexpr int NWAVES = 8;
constexpr int N_LAUNCHES = MK_N_LAUNCHES;
constexpr int N_PHASES = 10;
constexpr int BATCH = 8, SEQ = 2048, D = 1024, M = BATCH * SEQ, MEMLEN = 256, MROWS = BATCH * MEMLEN, NIN = 8192, NPQ = 2048;
constexpr float RMS_EPS = 1e-6f;
constexpr float LOG2E = 1.4426950408889634f;
constexpr size_t MiB = 1u << 20;
constexpr size_t WS_CTL = 0, CTL_ZERO_BYTES = 1 * MiB;
constexpr size_t WS_WIN = 1 * MiB, WS_WA = 17 * MiB, WS_WC = 19 * MiB, WS_WO = 21 * MiB, WS_WQ2 = 23 * MiB, WS_WKV2 = 25 * MiB, WS_WO2 = 29 * MiB, WS_WPQ = 31 * MiB, WS_SK = 35 * MiB;
constexpr size_t WS_SSQ1 = 36 * MiB, WS_SSQ2 = 37 * MiB, WS_MEMN = 38 * MiB, WS_K2 = 42 * MiB, WS_V2T = 46 * MiB;
constexpr size_t WS_B0 = 52 * MiB, WS_B1 = 84 * MiB, WS_B2 = 116 * MiB, WS_B3 = 148 * MiB, WS_B4 = 180 * MiB, WS_B5 = 212 * MiB, WS_END = 244 * MiB;
constexpr int CW_TMO = 0, CW_CODE = 1, CW_BAR = 4096;

constexpr int RING_OFF = 0, RING_BYTES = 131072;
constexpr int LDSCTL_OFF = RING_BYTES, MISC_OFF = LDSCTL_OFF + 320;
constexpr int LDS_BYTES = 147456;
#define GAS __attribute__((address_space(1)))
#define LAS __attribute__((address_space(3)))
typedef unsigned short bf16;
typedef unsigned v4u __attribute__((ext_vector_type(4)));
typedef float f32x4 __attribute__((ext_vector_type(4)));
typedef short bf16x8 __attribute__((ext_vector_type(8)));
typedef GAS unsigned gu32;
typedef GAS unsigned long long gu64;
#define RLX_AGENT __ATOMIC_RELAXED, __HIP_MEMORY_SCOPE_AGENT
#define LDS_WAIT() asm volatile("s_waitcnt lgkmcnt(0)" ::: "memory")
#define VM_WAIT() asm volatile("s_waitcnt vmcnt(0)" ::: "memory")
__device__ __forceinline__ unsigned long long rt() { return __builtin_amdgcn_s_memrealtime(); }
__device__ __forceinline__ unsigned f2bf(float f) { unsigned u = __builtin_bit_cast(unsigned, f); return (u + 0x7fffu + ((u >> 16) & 1u)) >> 16; }
__device__ __forceinline__ unsigned pk2(float lo, float hi) { return f2bf(lo) | (f2bf(hi) << 16); }

#define XB_TMO      128
#define XB_XCNT(j)  (256  + 64 * (j))
#define XB_XSUB(j)  (1280 + 64 * (j))
#define XB_XGEN(j)  (2304 + 64 * (j))
#define XB_TOP      3328
#define XB_TOPGEN   3392
#define XCD_BAR_WORDS 3456
#define XB_SPIN_CAP (1u << 18)

__device__ __forceinline__ unsigned xb_ld(unsigned* p)              { return __hip_atomic_load(p, __ATOMIC_RELAXED, __HIP_MEMORY_SCOPE_AGENT); }
__device__ __forceinline__ unsigned xb_add(unsigned* p, unsigned v) { return __hip_atomic_fetch_add(p, v, __ATOMIC_RELAXED, __HIP_MEMORY_SCOPE_AGENT); }
__device__ __forceinline__ unsigned xb_xcc_id() { return (unsigned)__builtin_amdgcn_s_getreg((3 << 11) | 20) & 0xFu; }
#define XB_SPIN(cond, bar) do { unsigned _sp = 0; while (cond) { __builtin_amdgcn_s_sleep(1); \
    if ((++_sp & 255u) == 0u) { if (xb_ld(&(bar)[XB_TMO])) break; if (_sp > XB_SPIN_CAP) { atomicAdd(&(bar)[XB_TMO], 1u); break; } } } } while (0)

struct XcdBarrier {
    unsigned* bar; unsigned x;
    volatile LAS unsigned* st;
};

__device__ __forceinline__ XcdBarrier xcd_barrier_post(unsigned* bar, volatile LAS unsigned* st) {
    XcdBarrier b; b.bar = bar; b.x = xb_xcc_id(); b.st = st;
    if (threadIdx.x == 0) (void)xb_add(&bar[XB_XCNT(b.x)], 1u);
    return b;
}
__device__ __forceinline__ void xcd_barrier_complete(unsigned* bar, unsigned x, unsigned& nloc, unsigned& nx) {
    const unsigned G = gridDim.x * gridDim.y * gridDim.z;
    unsigned sum, cnt, mine, sp = 0u;
    for (;;) {
        sum = 0u; cnt = 0u; mine = 0u;
#pragma unroll
        for (unsigned j = 0; j < 16; ++j) { const unsigned c = xb_ld(&bar[XB_XCNT(j)]); sum += c; cnt += (c > 0u) ? 1u : 0u; mine = (j == x) ? c : mine; }
        if (sum == G) break;
        __builtin_amdgcn_s_sleep(1);
        if ((++sp & 255u) == 0u) { if (xb_ld(&bar[XB_TMO])) break; if (sp > XB_SPIN_CAP) { atomicAdd(&bar[XB_TMO], 1u); break; } }
    }
    nloc = mine > 0u ? mine : 1u; nx = cnt > 0u ? cnt : 1u;
}

__device__ __forceinline__ void xcd_barrier(const XcdBarrier& b) {
    asm volatile("s_waitcnt vmcnt(0)" ::: "memory");
    __syncthreads();
    if (threadIdx.x == 0) {
        unsigned* bar = b.bar;
        __builtin_amdgcn_s_waitcnt(0);
        unsigned nloc = b.st[0], nx = b.st[1];
        if (nloc == 0u) { xcd_barrier_complete(bar, b.x, nloc, nx); b.st[0] = nloc; b.st[1] = nx; }
        const unsigned old = xb_add(&bar[XB_XSUB(b.x)], 1u);
        const unsigned gen = old / nloc;
        if (old + 1u == (gen + 1u) * nloc) {
            __builtin_amdgcn_fence(__ATOMIC_RELEASE, "agent");
            asm volatile("s_waitcnt vmcnt(0)" ::: "memory");
            const unsigned og = xb_add(&bar[XB_TOP], 1u);
            const unsigned tg = og / nx;
            if (og + 1u == (tg + 1u) * nx) xb_add(&bar[XB_TOPGEN], 1u);
            else XB_SPIN(xb_ld(&bar[XB_TOPGEN]) == tg, bar);
            __builtin_amdgcn_fence(__ATOMIC_ACQUIRE, "agent");
            xb_add(&bar[XB_XGEN(b.x)], 1u);
            asm volatile("s_waitcnt vmcnt(0)" ::: "memory");
        } else {
            XB_SPIN(xb_ld(&bar[XB_XGEN(b.x)]) == gen, bar);
            __builtin_amdgcn_fence(__ATOMIC_ACQUIRE, "agent");
            asm volatile("s_waitcnt vmcnt(0)" ::: "memory");
        }
    }
    __syncthreads();
}


__device__ __forceinline__ float wave_sum(float v) {
#pragma unroll
    for (int o = 1; o < 64; o <<= 1) v += __shfl_xor(v, o);
    return v;
}
__device__ __forceinline__ int inproj_row(int n) {
    const int g = n >> 10, c = n & 1023;
    if (g < 3) return n;
    if (g == 3) return 3072 + (c >> 7) * 256 + (c & 127);
    if (g == 5) return 3072 + (c >> 7) * 256 + 128 + (c & 127);
    if (g == 4) return 5120 + c;
    return n;
}
template <bool INMAP> __device__ __forceinline__ void transpose_item(const float* W, int K, int N, const float* gain, bf16* WT, int row_off, LAS float* scr, int item, int lane) {
    const int nblk = N / 32, kb = item / nblk, nb = item % nblk, k0 = 64 * kb, n0 = 32 * nb;
#pragma unroll 8
    for (int i = 0; i < 32; ++i) { const int kk = 2 * i + (lane >> 5); float w = W[(size_t)(k0 + kk) * N + n0 + (lane & 31)]; if (gain) w *= gain[k0 + kk]; scr[kk * 33 + (lane & 31)] = w; }
    LDS_WAIT(); asm volatile("" ::: "memory");
    const int c = lane & 7; const int r0 = INMAP ? inproj_row(n0) : (row_off + n0);
#pragma unroll
    for (int j = 0; j < 4; ++j) { const int n = (lane >> 3) + 8 * j; const LAS float* s = scr + (8 * c) * 33 + n;
        v4u o; o.x = pk2(s[0 * 33], s[1 * 33]); o.y = pk2(s[2 * 33], s[3 * 33]); o.z = pk2(s[4 * 33], s[5 * 33]); o.w = pk2(s[6 * 33], s[7 * 33]);
        *(GAS v4u*)(WT + (size_t)(r0 + n) * K + k0 + 8 * c) = o; }
    LDS_WAIT(); asm volatile("" ::: "memory");
}
__device__ __forceinline__ void rms_row_to_bf16(const float* xrow, const float* gain, bf16* orow, int lane) {
    const GAS f32x4* xr = (const GAS f32x4*)xrow + lane; const GAS f32x4* gr = (const GAS f32x4*)gain + lane;
    f32x4 v[4]; float s = 0.f;
#pragma unroll
    for (int j = 0; j < 4; ++j) { v[j] = xr[64 * j]; s += (v[j].x * v[j].x + v[j].y * v[j].y) + (v[j].z * v[j].z + v[j].w * v[j].w); }
    const float rstd = 1.0f / sqrtf(wave_sum(s) * (1.f / 1024.f) + RMS_EPS);
    GAS unsigned long long* o8 = (GAS unsigned long long*)orow + lane;
#pragma unroll
    for (int j = 0; j < 4; ++j) { const f32x4 g = gr[64 * j]; o8[64 * j] = (unsigned long long)pk2(v[j].x * rstd * g.x, v[j].y * rstd * g.y) | ((unsigned long long)pk2(v[j].z * rstd * g.z, v[j].w * rstd * g.w) << 32); }
}
__device__ __forceinline__ void row_to_bf16(const float* xrow, const float* gain, bf16* orow, int lane) {
    const GAS f32x4* xr = (const GAS f32x4*)xrow + lane; GAS unsigned long long* o8 = (GAS unsigned long long*)orow + lane;
#pragma unroll
    for (int j = 0; j < 4; ++j) { f32x4 v = xr[64 * j]; if (gain) { const f32x4 g = ((const GAS f32x4*)gain + lane)[64 * j]; v = v * g; }
        o8[64 * j] = (unsigned long long)pk2(v.x, v.y) | ((unsigned long long)pk2(v.z, v.w) << 32); }
}
__device__ __forceinline__ void final_norm_row(const float* hrow, const float* gain, float* orow, int lane) {
    const GAS f32x4* xr = (const GAS f32x4*)hrow + lane; const GAS f32x4* gr = (const GAS f32x4*)gain + lane;
    f32x4 v[4]; float s = 0.f;
#pragma unroll
    for (int j = 0; j < 4; ++j) { v[j] = xr[64 * j]; s += (v[j].x * v[j].x + v[j].y * v[j].y) + (v[j].z * v[j].z + v[j].w * v[j].w); }
    const float rstd = 1.0f / sqrtf(wave_sum(s) * (1.f / 1024.f) + RMS_EPS);
    GAS f32x4* o = (GAS f32x4*)orow + lane;
#pragma unroll
    for (int j = 0; j < 4; ++j) o[64 * j] = v[j] * rstd * gr[64 * j];
}
__device__ __forceinline__ float bflo(unsigned w) { return __builtin_bit_cast(float, w << 16); }
__device__ __forceinline__ float bfhi(unsigned w) { return __builtin_bit_cast(float, w & 0xffff0000u); }
__device__ __forceinline__ void yconv_item(const bf16* U, const bf16* CB, const float* cw, bf16* YC, int item, int lane) {
    const int t0 = item * 8; const bool first = (t0 % SEQ) == 0;
#pragma unroll 1
    for (int ps = 0; ps < 2; ++ps) {
        const int c0 = ps * 512 + lane * 8;
        float w0[8], w1[8], w2[8];
#pragma unroll
        for (int e = 0; e < 8; ++e) { w0[e] = cw[c0 + e]; w1[e] = cw[1024 + c0 + e]; w2[e] = cw[2048 + c0 + e]; }
        v4u um2 = (v4u){0u, 0u, 0u, 0u}, um1 = (v4u){0u, 0u, 0u, 0u};
        if (!first) { um2 = *(const GAS v4u*)(U + (size_t)(t0 - 2) * 1024 + c0); um1 = *(const GAS v4u*)(U + (size_t)(t0 - 1) * 1024 + c0); }
#pragma unroll
        for (int i = 0; i < 8; ++i) {
            const v4u uc = *(const GAS v4u*)(U + (size_t)(t0 + i) * 1024 + c0); const v4u cbv = *(const GAS v4u*)(CB + (size_t)(t0 + i) * 1024 + c0);
            v4u o;
#pragma unroll
            for (int q = 0; q < 4; ++q) {
                const float a = bflo(cbv[q]) * (w0[2 * q] * bflo(um2[q]) + w1[2 * q] * bflo(um1[q]) + w2[2 * q] * bflo(uc[q]));
                const float b = bfhi(cbv[q]) * (w0[2 * q + 1] * bfhi(um2[q]) + w1[2 * q + 1] * bfhi(um1[q]) + w2[2 * q + 1] * bfhi(uc[q]));
                o[q] = pk2(a, b); }
            *(GAS v4u*)(YC + (size_t)(t0 + i) * 1024 + c0) = o;
            um2 = um1; um1 = uc; }
    }
}


namespace xa {
using bf16x8 = __attribute__((ext_vector_type(8))) short;
using s16x4 = __attribute__((ext_vector_type(4))) short;
using f32x16 = __attribute__((ext_vector_type(16))) float;
using u32x4 = __attribute__((ext_vector_type(4))) unsigned;
using u32x2 = __attribute__((ext_vector_type(2))) unsigned;
__device__ __forceinline__ int crow(int r, int hi) { return (r & 3) + 8 * (r >> 2) + 4 * hi; }
__device__ __forceinline__ void xattn_unit(int b, int head, int qt, const bf16* Q, const bf16* K2, const bf16* V2T, bf16* O, LAS unsigned char* ldsw  ) {
    const int lane = threadIdx.x & 63, r32 = lane & 31, hi = lane >> 5; const int wid = __builtin_amdgcn_readfirstlane((int)threadIdx.x >> 6);
    const size_t qrow = (size_t)b * SEQ + qt * 256 + wid * 32 + r32;
    const bf16* qp = Q + qrow * 1024 + head * 256 + hi * 8;
    LAS u32x4* qlds = (LAS u32x4*)ldsw + lane;
#pragma unroll
    for (int ks = 0; ks < 16; ++ks) qlds[ks * 64] = *(const GAS u32x4*)(qp + ks * 16);
    LDS_WAIT();
    const bf16* kp = K2 + ((size_t)b * MEMLEN + r32) * 1024 + head * 256 + hi * 8;
    const bf16* vp = V2T + ((size_t)head * 256 + r32) * 2048 + (size_t)b * MEMLEN + 4 * hi;
#pragma unroll 1
    for (int dh = 0; dh < 2; ++dh) {
    f32x16 o[4];
#pragma unroll
    for (int dt = 0; dt < 4; ++dt) o[dt] = f32x16{};
    float mrun = -1e30f, lrun = 0.f;
#pragma unroll 1
    for (int c = 0; c < 4; ++c) {
        f32x16 p0 = f32x16{}, p1 = f32x16{};
#pragma unroll 4
        for (int ks = 0; ks < 16; ++ks) {
            const bf16x8 qf = __builtin_bit_cast(bf16x8, qlds[ks * 64]);
            const bf16x8 k0 = *(const GAS bf16x8*)(kp + (size_t)(64 * c) * 1024 + ks * 16);
            const bf16x8 k1 = *(const GAS bf16x8*)(kp + (size_t)(64 * c + 32) * 1024 + ks * 16);
            p0 = __builtin_amdgcn_mfma_f32_32x32x16_bf16(k0, qf, p0, 0, 0, 0);
            p1 = __builtin_amdgcn_mfma_f32_32x32x16_bf16(k1, qf, p1, 0, 0, 0); }
        float mx = p0[0];
#pragma unroll
        for (int r = 1; r < 16; ++r) mx = __builtin_fmaxf(mx, p0[r]);
#pragma unroll
        for (int r = 0; r < 16; ++r) mx = __builtin_fmaxf(mx, p1[r]);
        { auto rr = __builtin_amdgcn_permlane32_swap(__float_as_uint(mx), __float_as_uint(mx), false, false); mx = __builtin_fmaxf(__uint_as_float(rr[0]), __uint_as_float(rr[1])); }
        const float mnew = __builtin_fmaxf(mrun, mx), alpha = __builtin_amdgcn_exp2f(mrun - mnew);
        mrun = mnew; float ps = 0.f;
#pragma unroll
        for (int r = 0; r < 16; ++r) { p0[r] = __builtin_amdgcn_exp2f(p0[r] - mnew); p1[r] = __builtin_amdgcn_exp2f(p1[r] - mnew); ps += p0[r] + p1[r]; }
        lrun = lrun * alpha + ps;
#pragma unroll
        for (int dt = 0; dt < 4; ++dt)
#pragma unroll
            for (int r = 0; r < 16; ++r) o[dt][r] *= alpha;
        bf16x8 pa[4];
        { u32x4 w;
#pragma unroll
          for (int s = 0; s < 2; ++s) {
            w.x = pg8::cvt_pk_bf16(p0[8 * s], p0[8 * s + 1]); w.y = pg8::cvt_pk_bf16(p0[8 * s + 2], p0[8 * s + 3]); w.z = pg8::cvt_pk_bf16(p0[8 * s + 4], p0[8 * s + 5]); w.w = pg8::cvt_pk_bf16(p0[8 * s + 6], p0[8 * s + 7]); pa[s] = __builtin_bit_cast(bf16x8, w);
            w.x = pg8::cvt_pk_bf16(p1[8 * s], p1[8 * s + 1]); w.y = pg8::cvt_pk_bf16(p1[8 * s + 2], p1[8 * s + 3]); w.z = pg8::cvt_pk_bf16(p1[8 * s + 4], p1[8 * s + 5]); w.w = pg8::cvt_pk_bf16(p1[8 * s + 6], p1[8 * s + 7]); pa[2 + s] = __builtin_bit_cast(bf16x8, w); } }
#pragma unroll
        for (int dt = 0; dt < 4; ++dt)
#pragma unroll
            for (int s = 0; s < 4; ++s) {
                const bf16* vq = vp + (size_t)(128 * dh + 32 * dt) * 2048 + 64 * c + 16 * s;
                const u32x2 lo = *(const GAS u32x2*)vq, hi2 = *(const GAS u32x2*)(vq + 8);
                const u32x4 vw = {lo.x, lo.y, hi2.x, hi2.y};
                o[dt] = __builtin_amdgcn_mfma_f32_32x32x16_bf16(__builtin_bit_cast(bf16x8, vw), pa[s], o[dt], 0, 0, 0); }
    }
    { auto rr = __builtin_amdgcn_permlane32_swap(__float_as_uint(lrun), __float_as_uint(lrun), false, false); lrun = __uint_as_float(rr[0]) + __uint_as_float(rr[1]); }
    const float rl = 1.0f / lrun;
    bf16* op = O + qrow * 1024 + head * 256 + 128 * dh + 4 * hi;
#pragma unroll
    for (int dt = 0; dt < 4; ++dt)
#pragma unroll
        for (int g4 = 0; g4 < 4; ++g4) { u32x2 w; w.x = pg8::cvt_pk_bf16(o[dt][4 * g4] * rl, o[dt][4 * g4 + 1] * rl); w.y = pg8::cvt_pk_bf16(o[dt][4 * g4 + 2] * rl, o[dt][4 * g4 + 3] * rl);
            *(GAS u32x2*)(op + 32 * dt + 8 * g4) = w; }
    }
}
}

namespace peer {
using bf16x8 = __attribute__((ext_vector_type(8))) short;
using f32x16 = __attribute__((ext_vector_type(16))) float;
using u32x4 = __attribute__((ext_vector_type(4))) unsigned;
using u32x2 = __attribute__((ext_vector_type(2))) unsigned;
typedef __bf16 bf16x2_t __attribute__((ext_vector_type(2)));
#define PEER_CE(a, b) do { const int _h = ((a) > (b)) ? (a) : (b); const int _l = ((a) > (b)) ? (b) : (a); (a) = _h; (b) = _l; } while (0)
#define PEER_SORT16(x, o) do { PEER_CE(x[(o)+0], x[(o)+1]); PEER_CE(x[(o)+2], x[(o)+3]); PEER_CE(x[(o)+4], x[(o)+5]); PEER_CE(x[(o)+6], x[(o)+7]); PEER_CE(x[(o)+8], x[(o)+9]); PEER_CE(x[(o)+10], x[(o)+11]); PEER_CE(x[(o)+12], x[(o)+13]); PEER_CE(x[(o)+14], x[(o)+15]); PEER_CE(x[(o)+0], x[(o)+2]); PEER_CE(x[(o)+1], x[(o)+3]); PEER_CE(x[(o)+4], x[(o)+6]); PEER_CE(x[(o)+5], x[(o)+7]); PEER_CE(x[(o)+8], x[(o)+10]); PEER_CE(x[(o)+9], x[(o)+11]); PEER_CE(x[(o)+12], x[(o)+14]); PEER_CE(x[(o)+13], x[(o)+15]); PEER_CE(x[(o)+1], x[(o)+2]); PEER_CE(x[(o)+5], x[(o)+6]); PEER_CE(x[(o)+9], x[(o)+10]); PEER_CE(x[(o)+13], x[(o)+14]); PEER_CE(x[(o)+0], x[(o)+4]); PEER_CE(x[(o)+1], x[(o)+5]); PEER_CE(x[(o)+2], x[(o)+6]); PEER_CE(x[(o)+3], x[(o)+7]); PEER_CE(x[(o)+8], x[(o)+12]); PEER_CE(x[(o)+9], x[(o)+13]); PEER_CE(x[(o)+10], x[(o)+14]); PEER_CE(x[(o)+11], x[(o)+15]); PEER_CE(x[(o)+2], x[(o)+4]); PEER_CE(x[(o)+3], x[(o)+5]); PEER_CE(x[(o)+10], x[(o)+12]); PEER_CE(x[(o)+11], x[(o)+13]); PEER_CE(x[(o)+1], x[(o)+2]); PEER_CE(x[(o)+3], x[(o)+4]); PEER_CE(x[(o)+5], x[(o)+6]); PEER_CE(x[(o)+9], x[(o)+10]); PEER_CE(x[(o)+11], x[(o)+12]); PEER_CE(x[(o)+13], x[(o)+14]); PEER_CE(x[(o)+0], x[(o)+8]); PEER_CE(x[(o)+1], x[(o)+9]); PEER_CE(x[(o)+2], x[(o)+10]); PEER_CE(x[(o)+3], x[(o)+11]); PEER_CE(x[(o)+4], x[(o)+12]); PEER_CE(x[(o)+5], x[(o)+13]); PEER_CE(x[(o)+6], x[(o)+14]); PEER_CE(x[(o)+7], x[(o)+15]); PEER_CE(x[(o)+4], x[(o)+8]); PEER_CE(x[(o)+5], x[(o)+9]); PEER_CE(x[(o)+6], x[(o)+10]); PEER_CE(x[(o)+7], x[(o)+11]); PEER_CE(x[(o)+2], x[(o)+4]); PEER_CE(x[(o)+3], x[(o)+5]); PEER_CE(x[(o)+6], x[(o)+8]); PEER_CE(x[(o)+7], x[(o)+9]); PEER_CE(x[(o)+10], x[(o)+12]); PEER_CE(x[(o)+11], x[(o)+13]); PEER_CE(x[(o)+1], x[(o)+2]); PEER_CE(x[(o)+3], x[(o)+4]); PEER_CE(x[(o)+5], x[(o)+6]); PEER_CE(x[(o)+7], x[(o)+8]); PEER_CE(x[(o)+9], x[(o)+10]); PEER_CE(x[(o)+11], x[(o)+12]); PEER_CE(x[(o)+13], x[(o)+14]); } while (0)
#define PEER_MERGE16(x, a, b) do { x[(a)+0] = (x[(a)+0] > x[(b)+15]) ? x[(a)+0] : x[(b)+15]; x[(a)+1] = (x[(a)+1] > x[(b)+14]) ? x[(a)+1] : x[(b)+14]; x[(a)+2] = (x[(a)+2] > x[(b)+13]) ? x[(a)+2] : x[(b)+13]; x[(a)+3] = (x[(a)+3] > x[(b)+12]) ? x[(a)+3] : x[(b)+12]; x[(a)+4] = (x[(a)+4] > x[(b)+11]) ? x[(a)+4] : x[(b)+11]; x[(a)+5] = (x[(a)+5] > x[(b)+10]) ? x[(a)+5] : x[(b)+10]; x[(a)+6] = (x[(a)+6] > x[(b)+9]) ? x[(a)+6] : x[(b)+9]; x[(a)+7] = (x[(a)+7] > x[(b)+8]) ? x[(a)+7] : x[(b)+8]; x[(a)+8] = (x[(a)+8] > x[(b)+7]) ? x[(a)+8] : x[(b)+7]; x[(a)+9] = (x[(a)+9] > x[(b)+6]) ? x[(a)+9] : x[(b)+6]; x[(a)+10] = (x[(a)+10] > x[(b)+5]) ? x[(a)+10] : x[(b)+5]; x[(a)+11] = (x[(a)+11] > x[(b)+4]) ? x[(a)+11] : x[(b)+4]; x[(a)+12] = (x[(a)+12] > x[(b)+3]) ? x[(a)+12] : x[(b)+3]; x[(a)+13] = (x[(a)+13] > x[(b)+2]) ? x[(a)+13] : x[(b)+2]; x[(a)+14] = (x[(a)+14] > x[(b)+1]) ? x[(a)+14] : x[(b)+1]; x[(a)+15] = (x[(a)+15] > x[(b)+0]) ? x[(a)+15] : x[(b)+0]; PEER_CE(x[(a)+0], x[(a)+8]); PEER_CE(x[(a)+1], x[(a)+9]); PEER_CE(x[(a)+2], x[(a)+10]); PEER_CE(x[(a)+3], x[(a)+11]); PEER_CE(x[(a)+4], x[(a)+12]); PEER_CE(x[(a)+5], x[(a)+13]); PEER_CE(x[(a)+6], x[(a)+14]); PEER_CE(x[(a)+7], x[(a)+15]); PEER_CE(x[(a)+0], x[(a)+4]); PEER_CE(x[(a)+1], x[(a)+5]); PEER_CE(x[(a)+2], x[(a)+6]); PEER_CE(x[(a)+3], x[(a)+7]); PEER_CE(x[(a)+8], x[(a)+12]); PEER_CE(x[(a)+9], x[(a)+13]); PEER_CE(x[(a)+10], x[(a)+14]); PEER_CE(x[(a)+11], x[(a)+15]); PEER_CE(x[(a)+0], x[(a)+2]); PEER_CE(x[(a)+1], x[(a)+3]); PEER_CE(x[(a)+4], x[(a)+6]); PEER_CE(x[(a)+5], x[(a)+7]); PEER_CE(x[(a)+8], x[(a)+10]); PEER_CE(x[(a)+9], x[(a)+11]); PEER_CE(x[(a)+12], x[(a)+14]); PEER_CE(x[(a)+13], x[(a)+15]); PEER_CE(x[(a)+0], x[(a)+1]); PEER_CE(x[(a)+2], x[(a)+3]); PEER_CE(x[(a)+4], x[(a)+5]); PEER_CE(x[(a)+6], x[(a)+7]); PEER_CE(x[(a)+8], x[(a)+9]); PEER_CE(x[(a)+10], x[(a)+11]); PEER_CE(x[(a)+12], x[(a)+13]); PEER_CE(x[(a)+14], x[(a)+15]); } while (0)
#define PEER_MERGE16_SET(x, a, b) do { x[(a)+0] = (x[(a)+0] > x[(b)+15]) ? x[(a)+0] : x[(b)+15]; x[(a)+1] = (x[(a)+1] > x[(b)+14]) ? x[(a)+1] : x[(b)+14]; x[(a)+2] = (x[(a)+2] > x[(b)+13]) ? x[(a)+2] : x[(b)+13]; x[(a)+3] = (x[(a)+3] > x[(b)+12]) ? x[(a)+3] : x[(b)+12]; x[(a)+4] = (x[(a)+4] > x[(b)+11]) ? x[(a)+4] : x[(b)+11]; x[(a)+5] = (x[(a)+5] > x[(b)+10]) ? x[(a)+5] : x[(b)+10]; x[(a)+6] = (x[(a)+6] > x[(b)+9]) ? x[(a)+6] : x[(b)+9]; x[(a)+7] = (x[(a)+7] > x[(b)+8]) ? x[(a)+7] : x[(b)+8]; x[(a)+8] = (x[(a)+8] > x[(b)+7]) ? x[(a)+8] : x[(b)+7]; x[(a)+9] = (x[(a)+9] > x[(b)+6]) ? x[(a)+9] : x[(b)+6]; x[(a)+10] = (x[(a)+10] > x[(b)+5]) ? x[(a)+10] : x[(b)+5]; x[(a)+11] = (x[(a)+11] > x[(b)+4]) ? x[(a)+11] : x[(b)+4]; x[(a)+12] = (x[(a)+12] > x[(b)+3]) ? x[(a)+12] : x[(b)+3]; x[(a)+13] = (x[(a)+13] > x[(b)+2]) ? x[(a)+13] : x[(b)+2]; x[(a)+14] = (x[(a)+14] > x[(b)+1]) ? x[(a)+14] : x[(b)+1]; x[(a)+15] = (x[(a)+15] > x[(b)+0]) ? x[(a)+15] : x[(b)+0]; } while (0)
constexpr int PEER_NCAND = 50;
__device__ const unsigned char PEER_CAND[64] = {0, 16, 32, 48, 64, 80, 96, 112, 128, 144, 160, 176, 192, 208, 224, 240, 1, 17, 33, 49, 65, 81, 97, 113, 2, 18, 34, 50, 66, 3, 19, 35, 51, 4, 20, 36, 5, 21, 6, 22, 7, 23, 8, 9, 10, 11, 12, 13, 14, 15, 0, 0, 0, 0, 0, 0, 0, 0, 0, 0, 0, 0, 0, 0};
#define PEER_CAND_SUMS(x, v0, v1, KEYF) do { x[0] = KEYF((v0)[0] + (v1)[0], 0); x[1] = KEYF((v0)[0] + (v1)[1], 1); x[2] = KEYF((v0)[0] + (v1)[2], 2); x[3] = KEYF((v0)[0] + (v1)[3], 3); x[4] = KEYF((v0)[0] + (v1)[4], 4); x[5] = KEYF((v0)[0] + (v1)[5], 5); x[6] = KEYF((v0)[0] + (v1)[6], 6); x[7] = KEYF((v0)[0] + (v1)[7], 7); x[8] = KEYF((v0)[0] + (v1)[8], 8); x[9] = KEYF((v0)[0] + (v1)[9], 9); x[10] = KEYF((v0)[0] + (v1)[10], 10); x[11] = KEYF((v0)[0] + (v1)[11], 11); x[12] = KEYF((v0)[0] + (v1)[12], 12); x[13] = KEYF((v0)[0] + (v1)[13], 13); x[14] = KEYF((v0)[0] + (v1)[14], 14); x[15] = KEYF((v0)[0] + (v1)[15], 15); x[16] = KEYF((v0)[1] + (v1)[0], 16); x[17] = KEYF((v0)[1] + (v1)[1], 17); x[18] = KEYF((v0)[1] + (v1)[2], 18); x[19] = KEYF((v0)[1] + (v1)[3], 19); x[20] = KEYF((v0)[1] + (v1)[4], 20); x[21] = KEYF((v0)[1] + (v1)[5], 21); x[22] = KEYF((v0)[1] + (v1)[6], 22); x[23] = KEYF((v0)[1] + (v1)[7], 23); x[24] = KEYF((v0)[2] + (v1)[0], 24); x[25] = KEYF((v0)[2] + (v1)[1], 25); x[26] = KEYF((v0)[2] + (v1)[2], 26); x[27] = KEYF((v0)[2] + (v1)[3], 27); x[28] = KEYF((v0)[2] + (v1)[4], 28); x[29] = KEYF((v0)[3] + (v1)[0], 29); x[30] = KEYF((v0)[3] + (v1)[1], 30); x[31] = KEYF((v0)[3] + (v1)[2], 31); x[32] = KEYF((v0)[3] + (v1)[3], 32); x[33] = KEYF((v0)[4] + (v1)[0], 33); x[34] = KEYF((v0)[4] + (v1)[1], 34); x[35] = KEYF((v0)[4] + (v1)[2], 35); x[36] = KEYF((v0)[5] + (v1)[0], 36); x[37] = KEYF((v0)[5] + (v1)[1], 37); x[38] = KEYF((v0)[6] + (v1)[0], 38); x[39] = KEYF((v0)[6] + (v1)[1], 39); x[40] = KEYF((v0)[7] + (v1)[0], 40); x[41] = KEYF((v0)[7] + (v1)[1], 41); x[42] = KEYF((v0)[8] + (v1)[0], 42); x[43] = KEYF((v0)[9] + (v1)[0], 43); x[44] = KEYF((v0)[10] + (v1)[0], 44); x[45] = KEYF((v0)[11] + (v1)[0], 45); x[46] = KEYF((v0)[12] + (v1)[0], 46); x[47] = KEYF((v0)[13] + (v1)[0], 47); x[48] = KEYF((v0)[14] + (v1)[0], 48); x[49] = KEYF((v0)[15] + (v1)[0], 49); x[50] = (int)0x80000000; x[51] = (int)0x80000000; x[52] = (int)0x80000000; x[53] = (int)0x80000000; x[54] = (int)0x80000000; x[55] = (int)0x80000000; x[56] = (int)0x80000000; x[57] = (int)0x80000000; x[58] = (int)0x80000000; x[59] = (int)0x80000000; x[60] = (int)0x80000000; x[61] = (int)0x80000000; x[62] = (int)0x80000000; x[63] = (int)0x80000000; } while (0)

__device__ __forceinline__ int crow(int r, int hi) { return (r & 3) + 8 * (r >> 2) + 4 * hi; }
__device__ __forceinline__ int f2key(float f) { const int t = __builtin_bit_cast(int, f); return t ^ ((t >> 31) & 0x7fffffff); }
__device__ __forceinline__ float key2f(int t) { return __builtin_bit_cast(float, t ^ ((t >> 31) & 0x7fffffff)); }
__device__ __forceinline__ int sel_hi(int a, int b, int hm) { int r; asm("v_bfi_b32 %0, %1, %2, %3" : "=v"(r) : "v"(hm), "v"(b), "v"(a)); return r; }
__device__ __forceinline__ int key7(float f, int low) { return (f2key(f) & ~127) | low; }
__device__ __forceinline__ int key6(float f, int ord) { return (f2key(f) & ~63) | (63 - ord); }
__device__ __forceinline__ void top16_of_64(int (&x)[64]) {
    PEER_SORT16(x, 0); PEER_SORT16(x, 16); PEER_SORT16(x, 32); PEER_SORT16(x, 48);
    PEER_MERGE16(x, 0, 16); PEER_MERGE16(x, 32, 48); PEER_MERGE16(x, 0, 32);
}
__device__ __forceinline__ float dot2_bf16(unsigned w, unsigned x, float acc) { return __builtin_amdgcn_fdot2_f32_bf16(__builtin_bit_cast(bf16x2_t, w), __builtin_bit_cast(bf16x2_t, x), acc, false); }
__device__ __forceinline__ float dot8(const u32x4 a, const u32x4 b, float acc) {
    acc = dot2_bf16(a.x, b.x, acc); acc = dot2_bf16(a.y, b.y, acc); acc = dot2_bf16(a.z, b.z, acc); acc = dot2_bf16(a.w, b.w, acc); return acc;
}
__device__ __forceinline__ float gelu_tanh(float x) {
    const float u = 0.7978845608028654f * (x + 0.044715f * x * x * x);
    const float e = __builtin_amdgcn_exp2f(2.0f * LOG2E * u);
    const float th = 1.0f - 2.0f * __builtin_amdgcn_rcpf(e + 1.0f);
    return 0.5f * x * (1.0f + th);
}
__device__ __forceinline__ void topk_half(const bf16* qp, const bf16* sp, int hi, int (&T)[16]) {
    bf16x8 qf[8];
#pragma unroll
    for (int ks = 0; ks < 8; ++ks) qf[ks] = *(const GAS bf16x8*)(qp + ks * 16);
    int x[64];
#pragma unroll
    for (int kt = 0; kt < 4; ++kt) { f32x16 sc = f32x16{};
#pragma unroll
        for (int ks = 0; ks < 8; ++ks) { const bf16x8 a = *(const GAS bf16x8*)(sp + (size_t)(32 * kt) * 128 + ks * 16); sc = __builtin_amdgcn_mfma_f32_32x32x16_bf16(a, qf[ks], sc, 0, 0, 0); }
#pragma unroll
        for (int r = 0; r < 16; ++r) x[16 * kt + r] = key7(sc[r], 127 - (32 * kt + crow(r, hi))); }
    top16_of_64(x);
#pragma unroll
    for (int i = 0; i < 16; ++i) { auto rr = __builtin_amdgcn_permlane32_swap((unsigned)x[i], (unsigned)x[i], false, false); x[i] = (int)rr[0]; x[16 + i] = (int)rr[1]; }
    PEER_MERGE16(x, 0, 16);
#pragma unroll
    for (int i = 0; i < 16; ++i) T[i] = x[i];
}
constexpr int L_ROUTE = 0, L_NLIST = 32768, L_CAND = 40960, L_COEF = 41472, L_END = 45568;
__device__ __forceinline__ void peer_tile(int tile, const bf16* PQ, const bf16* SK, const bf16* HB, const float* SSQ, const bf16* Ub, const bf16* Vb, const float* gfin, float* out, LAS unsigned char* lds) {
    const int lane = threadIdx.x & 63, r32 = lane & 31, hi = lane >> 5; const int wid = __builtin_amdgcn_readfirstlane((int)threadIdx.x >> 6);
    const int tok0 = tile * 32;
    LAS unsigned* route = (LAS unsigned*)(lds + L_ROUTE);
    LAS unsigned char* nl = lds + L_NLIST + (wid * 32 + r32) * 32;
    const LAS unsigned char* cand = lds + L_CAND;
    {
        const int h = wid; int T0[16], T1[16];
        topk_half(PQ + (size_t)(tok0 + r32) * NPQ + (h * 2 + 0) * 128 + hi * 8, SK + ((size_t)(h * 2 + 0) * 128 + r32) * 128 + hi * 8, hi, T0);
        topk_half(PQ + (size_t)(tok0 + r32) * NPQ + (h * 2 + 1) * 128 + hi * 8, SK + ((size_t)(h * 2 + 1) * 128 + r32) * 128 + hi * 8, hi, T1);
        const int hm = -hi;
        {
            u32x4 w;
#pragma unroll
            for (int q4 = 0; q4 < 4; ++q4) { unsigned a = 0;
#pragma unroll
                for (int e = 0; e < 4; ++e) { const int t = sel_hi(T0[4 * q4 + e], T1[4 * q4 + e], hm); a |= (unsigned)(127 - (t & 127)) << (8 * e); }
                w[q4] = a; }
            *(LAS u32x4*)(nl + 16 * hi) = w;
        }
        float v0[16], v1[16];
#pragma unroll
        for (int i = 0; i < 16; ++i) { v0[i] = key2f(T0[i] & ~127); v1[i] = key2f(T1[i] & ~127); }
        int x[64];
        PEER_CAND_SUMS(x, v0, v1, key6);
        top16_of_64(x);
        const float smax = key2f(x[0] & ~63);
        float p[16], ps = 0.f;
#pragma unroll
        for (int i = 0; i < 16; ++i) { p[i] = __builtin_amdgcn_exp2f((key2f(x[i] & ~63) - smax) * LOG2E); ps += p[i]; }
        const float rps = 1.0f / ps;
        LDS_WAIT();
#pragma unroll
        for (int i = 0; i < 8; ++i) {
            const int xi = sel_hi(x[i], x[8 + i], hm); const float g = __int_as_float(sel_hi(__float_as_int(p[i]), __float_as_int(p[8 + i]), hm)) * rps;
            const int ij = cand[63 - (xi & 63)]; const int n0 = nl[ij & 15], n1 = nl[16 + (ij >> 4)];
            u32x2 w; w.x = (unsigned)(n0 * 128 + n1); w.y = __float_as_uint(g);
            *(LAS u32x2*)(route + ((size_t)r32 * 128 + h * 16 + 8 * hi + i) * 2) = w; }
    }
    LDS_WAIT(); __syncthreads();
    LAS float* coef = (LAS float*)(lds + L_COEF) + wid * 128;
#pragma unroll 1
    for (int tt = 0; tt < 4; ++tt) {
        const int tl = wid * 4 + tt; const size_t tok = (size_t)tok0 + tl;
        const LAS unsigned* rt = route + tl * 256;
        const u32x4 ha = *(const GAS u32x4*)(HB + tok * 1024 + lane * 8), hb = *(const GAS u32x4*)(HB + tok * 1024 + 512 + lane * 8);
        float rstd;
        { const f32x4* sp = (const f32x4*)(SSQ + tok * 16); const f32x4 a = sp[0], b = sp[1], c = sp[2], d = sp[3]; const f32x4 t = (a + b) + (c + d);
          rstd = __builtin_amdgcn_rsqf(((t[0] + t[1]) + (t[2] + t[3])) * (1.0f / 1024.0f) + RMS_EPS); }
#pragma unroll 1
        for (int k0 = 0; k0 < 128; k0 += 8) {
            u32x4 ua[8], ub[8]; float gk[8];
#pragma unroll
            for (int j = 0; j < 8; ++j) { const u32x2 re = *(const LAS u32x2*)(rt + (k0 + j) * 2); const int e = __builtin_amdgcn_readfirstlane((int)re.x); gk[j] = __uint_as_float(re.y);
                const bf16* up = Ub + (size_t)e * 1024 + lane * 8; ua[j] = *(const GAS u32x4*)up; ub[j] = *(const GAS u32x4*)(up + 512); }
#pragma unroll
            for (int j = 0; j < 8; ++j) { const float dsum = wave_sum(dot8(ua[j], ha, dot8(ub[j], hb, 0.f)));
                const float cf = gk[j] * gelu_tanh(dsum * rstd); if (lane == 0) coef[k0 + j] = cf; }
        }
        LDS_WAIT();
        float acc[16];
#pragma unroll
        for (int i = 0; i < 16; ++i) acc[i] = 0.f;
#pragma unroll 1
        for (int k0 = 0; k0 < 128; k0 += 8) {
            u32x4 va[8], vb[8]; float cf[8];
#pragma unroll
            for (int j = 0; j < 8; ++j) { const int e = __builtin_amdgcn_readfirstlane((int)rt[(k0 + j) * 2]); cf[j] = coef[k0 + j];
                const bf16* vq = Vb + (size_t)e * 1024 + lane * 8; va[j] = *(const GAS u32x4*)vq; vb[j] = *(const GAS u32x4*)(vq + 512); }
#pragma unroll
            for (int j = 0; j < 8; ++j) {
                acc[0] += cf[j] * bflo(va[j].x); acc[1] += cf[j] * bfhi(va[j].x); acc[2] += cf[j] * bflo(va[j].y); acc[3] += cf[j] * bfhi(va[j].y);
                acc[4] += cf[j] * bflo(va[j].z); acc[5] += cf[j] * bfhi(va[j].z); acc[6] += cf[j] * bflo(va[j].w); acc[7] += cf[j] * bfhi(va[j].w);
                acc[8] += cf[j] * bflo(vb[j].x); acc[9] += cf[j] * bfhi(vb[j].x); acc[10] += cf[j] * bflo(vb[j].y); acc[11] += cf[j] * bfhi(vb[j].y);
                acc[12] += cf[j] * bflo(vb[j].z); acc[13] += cf[j] * bfhi(vb[j].z); acc[14] += cf[j] * bflo(vb[j].w); acc[15] += cf[j] * bfhi(vb[j].w); }
        }
        float* orow = out + tok * 1024; float hv[16]; float s = 0.f;
#pragma unroll
        for (int q = 0; q < 4; ++q) { const f32x4 t = *(const GAS f32x4*)(orow + (q >> 1) * 512 + lane * 8 + (q & 1) * 4);
#pragma unroll
            for (int e = 0; e < 4; ++e) { const float v = t[e] + acc[(q >> 1) * 8 + (q & 1) * 4 + e]; hv[(q >> 1) * 8 + (q & 1) * 4 + e] = v; s += v * v; } }
        const float rs = 1.0f / sqrtf(wave_sum(s) * (1.f / 1024.f) + RMS_EPS);
#pragma unroll
        for (int q = 0; q < 4; ++q) { const int cb_ = (q >> 1) * 512 + lane * 8 + (q & 1) * 4; const f32x4 g = *(const GAS f32x4*)(gfin + cb_); f32x4 t;
#pragma unroll
            for (int e = 0; e < 4; ++e) t[e] = hv[(q >> 1) * 8 + (q & 1) * 4 + e] * rs * g[e];
            *(GAS f32x4*)(orow + cb_) = t; }
    }
    LDS_WAIT(); __syncthreads();
}
}
struct Args { const float* in[20]; float* out; unsigned char* ws; int ph_lo, ph_hi, li, pad; };
__global__ void __launch_bounds__(NWAVES * 64, 2) fwd_megakernel(Args args) {
    extern __shared__ __attribute__((aligned(16))) unsigned char lds[];
    LAS unsigned char* ldsp = (LAS unsigned char*)lds;
    volatile LAS unsigned* MISC = (volatile LAS unsigned*)(ldsp + MISC_OFF);
    const int tid = threadIdx.x, lane = tid & 63, wave = __builtin_amdgcn_readfirstlane(tid >> 6);
    const int G = gridDim.x; const int bx = blockIdx.x; const int vcu = (G % 8 == 0) ? (bx % 8) * (G / 8) + bx / 8 : bx;
    unsigned char* ws = args.ws;
    gu32* ctl = (gu32*)(ws + WS_CTL);
    const float* x = args.in[0]; const float* mem = args.in[1]; const float* norm_mix = args.in[2]; const float* w_in = args.in[3]; const float* conv_w = args.in[4];
    const float* w_ba = args.in[5]; const float* w_bc = args.in[6]; const float* w_out = args.in[7]; const float* norm_xattn = args.in[8]; const float* norm_mem = args.in[9];
    const float* xwq = args.in[10]; const float* xwk = args.in[11]; const float* xwv = args.in[12]; const float* xwo = args.in[13]; const float* norm_ffn = args.in[14];
    const float* pwq = args.in[15]; const float* psk = args.in[16]; const float* pu = args.in[17]; const float* pv = args.in[18]; const float* norm_final = args.in[19];
    float* out = args.out;
    bf16* Win_t = (bf16*)(ws + WS_WIN); bf16* Wa_t = (bf16*)(ws + WS_WA); bf16* Wc_t = (bf16*)(ws + WS_WC); bf16* Wo_t = (bf16*)(ws + WS_WO); bf16* Wq2_t = (bf16*)(ws + WS_WQ2);
    bf16* Wkv2_t = (bf16*)(ws + WS_WKV2); bf16* Wo2_t = (bf16*)(ws + WS_WO2); bf16* Wpq_t = (bf16*)(ws + WS_WPQ); bf16* SKb = (bf16*)(ws + WS_SK);
    float* SSQ1 = (float*)(ws + WS_SSQ1); float* SSQ2 = (float*)(ws + WS_SSQ2); bf16* MEMN = (bf16*)(ws + WS_MEMN); bf16* K2 = (bf16*)(ws + WS_K2); bf16* V2T = (bf16*)(ws + WS_V2T);
    bf16* B0 = (bf16*)(ws + WS_B0); bf16* B1 = (bf16*)(ws + WS_B1); bf16* B2 = (bf16*)(ws + WS_B2); bf16* B3 = (bf16*)(ws + WS_B3); bf16* B4 = (bf16*)(ws + WS_B4); bf16* B5 = (bf16*)(ws + WS_B5);
    bf16* XN1 = (bf16*)out; bf16* YC = (bf16*)out; bf16* CBb = (bf16*)((unsigned char*)out + 32 * MiB);

    for (int u = tid; u < (LDS_BYTES - LDSCTL_OFF) / 4; u += NWAVES * 64) ((LAS unsigned*)(ldsp + LDSCTL_OFF))[u] = 0u;
    __syncthreads();
    XcdBarrier bar; bar.bar = (unsigned*)(ctl + CW_BAR); bar.x = 0; bar.st = nullptr;
    if (N_LAUNCHES == 1) bar = xcd_barrier_post((unsigned*)(ctl + CW_BAR), MISC + 8);
#define GRID_BAR() do { if (N_LAUNCHES == 1) xcd_barrier(bar); } while (0)
    const int lo = args.ph_lo, hi = args.ph_hi;
#define IN(k) (lo <= (k) && (k) < hi)
#define BOTH(k) (IN(k) && IN((k) + 1))
    const int gw = vcu * NWAVES + wave, NGW = G * NWAVES;

    if (IN(0)) {
        LAS float* scr = (LAS float*)(ldsp + RING_OFF + wave * 16384);
        constexpr int I_IN = 16 * 256, I_SQ = 16 * 32, I_PQ = 16 * 64;
        constexpr int NT_ITEMS = I_IN + 7 * I_SQ + I_PQ;
        for (int it = gw; it < NT_ITEMS; it += NGW) {
            int r = it;
            if (r < I_IN) { transpose_item<true>(w_in, D, NIN, nullptr, Win_t, 0, scr, r, lane); continue; } r -= I_IN;
            if (r < I_SQ) { transpose_item<false>(w_ba, D, D, nullptr, Wa_t, 0, scr, r, lane); continue; } r -= I_SQ;
            if (r < I_SQ) { transpose_item<false>(w_bc, D, D, nullptr, Wc_t, 0, scr, r, lane); continue; } r -= I_SQ;
            if (r < I_SQ) { transpose_item<false>(w_out, D, D, nullptr, Wo_t, 0, scr, r, lane); continue; } r -= I_SQ;
            if (r < I_SQ) { transpose_item<false>(xwq, D, D, norm_xattn, Wq2_t, 0, scr, r, lane); continue; } r -= I_SQ;
            if (r < I_SQ) { transpose_item<false>(xwk, D, D, nullptr, Wkv2_t, 0, scr, r, lane); continue; } r -= I_SQ;
            if (r < I_SQ) { transpose_item<false>(xwv, D, D, nullptr, Wkv2_t, D, scr, r, lane); continue; } r -= I_SQ;
            if (r < I_SQ) { transpose_item<false>(xwo, D, D, nullptr, Wo2_t, 0, scr, r, lane); continue; } r -= I_SQ;
            transpose_item<false>(pwq, D, NPQ, norm_ffn, Wpq_t, 0, scr, r, lane);
        }
        for (int it = gw; it < 512; it += NGW) {
            const GAS f32x4* s = (const GAS f32x4*)psk + (size_t)it * 128 + lane * 2; const f32x4 a = s[0], b = s[1];
            v4u o; o.x = pk2(a.x, a.y); o.y = pk2(a.z, a.w); o.z = pk2(b.x, b.y); o.w = pk2(b.z, b.w);
            *((GAS v4u*)SKb + (size_t)it * 64 + lane) = o; }
        for (int m = gw; m < M; m += NGW) rms_row_to_bf16(x + (size_t)m * D, norm_mix, XN1 + (size_t)m * D, lane);
        for (int m = gw; m < MROWS; m += NGW) rms_row_to_bf16(mem + (size_t)m * D, norm_mem, MEMN + (size_t)m * D, lane);
        if (BOTH(0)) GRID_BAR();
    }

    if (IN(1)) {
        pg8::GemmSet g{XN1, Win_t, XN1, Win_t, D}; pg8::TileOrder S; S.init(M, NIN, G, bx);
        pg8::EpiInProj E{B0, B1, B2, B3, CBb, B4, B5, 0.125f * LOG2E};
        pg8::gemm_phase<pg8::EpiInProj, pg8::TileOrder, true, true>(ldsp + RING_OFF, g, S, E);
        if (BOTH(1)) GRID_BAR();
    }

    if (IN(2)) {
        {
            const int bh = vcu >> 1, s = vcu & 1;
            if (bh < BATCH * 16) {
#pragma unroll 1
                for (int i = 0; i < 4; ++i) { const int qb = (i == 0) ? s : (i == 1) ? 7 - s : (i == 2) ? 2 + s : 5 - s;
                    sb::sb_unit<false>(bh >> 4, bh & 15, qb, (const sb::bf16*)B0, (const sb::bf16*)B1, (const sb::bf16*)B2, (sb::bf16*)B0, (char*)lds + RING_OFF); }
            }
            asm volatile("s_waitcnt vmcnt(0) lgkmcnt(0)" ::: "memory"); __syncthreads();
        }
        if (vcu < 32) {
            pg8::GemmSet g{MEMN, Wkv2_t, MEMN, Wkv2_t, D}; pg8::SubOrder S; S.init(MROWS, D, 0, vcu);
            pg8::EpiStore E{K2, D, 1.0f};
            pg8::gemm_phase<pg8::EpiStore, pg8::SubOrder, false, true>(ldsp + RING_OFF, g, S, E);
        } else if (vcu < 64) {
            pg8::GemmSet g{Wkv2_t + (size_t)D * D, MEMN, Wkv2_t + (size_t)D * D, MEMN, D}; pg8::SubOrder S; S.init(D, MROWS, 32, vcu);
            pg8::EpiStore E{V2T, MROWS, 1.0f};
            pg8::gemm_phase<pg8::EpiStore, pg8::SubOrder, false, true>(ldsp + RING_OFF, g, S, E);
        } else {
            const int cw_ = (vcu - 64) * NWAVES + wave, ncw = (G - 64) * NWAVES;
            for (int it = cw_; it < M / 8; it += ncw) yconv_item(B3, CBb, conv_w, YC, it, lane);
        }
        if (BOTH(2)) GRID_BAR();
    }

    if (IN(3)) {
        pg8::GemmSet g{B0, Wa_t, YC, Wc_t, D}; pg8::TileOrder S; S.init(M, D, G, bx, 2);
        pg8::EpiGate E{B1, B4, B5};
        pg8::gemm_phase<pg8::EpiGate, pg8::TileOrder, true, true>(ldsp + RING_OFF, g, S, E);
        if (BOTH(3)) GRID_BAR();
    }

    if (IN(4)) {
        pg8::GemmSet g{B1, Wo_t, B1, Wo_t, D}; pg8::TileOrder S; S.init(M, D, G, bx);
        pg8::EpiResid E{x, out, B2, SSQ1};
        pg8::gemm_phase<pg8::EpiResid, pg8::TileOrder, true, true>(ldsp + RING_OFF, g, S, E);
        if (BOTH(4)) GRID_BAR();
    }

    if (IN(5)) {
        pg8::GemmSet g{B2, Wq2_t, B2, Wq2_t, D}; pg8::TileOrder S; S.init(M, D, G, bx);
        pg8::EpiRowScale E{B3, D, SSQ1, LOG2E / 16.0f, RMS_EPS};
        pg8::gemm_phase<pg8::EpiRowScale, pg8::TileOrder, true, true>(ldsp + RING_OFF, g, S, E);
        for (int r = gw; r < 2 * 16384; r += NGW) {
            if (r < 16384) row_to_bf16(pu + (size_t)r * D, norm_ffn, B4 + (size_t)r * D, lane);
            else row_to_bf16(pv + (size_t)(r - 16384) * D, nullptr, B5 + (size_t)(r - 16384) * D, lane); }
        if (BOTH(5)) GRID_BAR();
    }

    if (IN(6)) {
#ifndef NO_XA
        for (int u = vcu; u < 256; u += G) xa::xattn_unit(u >> 5, (u >> 3) & 3, u & 7, B3, K2, V2T, B0, ldsp + RING_OFF + wave * 16384);
#endif
        if (BOTH(6)) GRID_BAR();
    }

    if (IN(7)) {
        pg8::GemmSet g{B0, Wo2_t, B0, Wo2_t, D}; pg8::TileOrder S; S.init(M, D, G, bx);
        pg8::EpiResid E{out, out, B1, SSQ2};
        pg8::gemm_phase<pg8::EpiResid, pg8::TileOrder, true, true>(ldsp + RING_OFF, g, S, E);
        if (BOTH(7)) GRID_BAR();
    }

    if (IN(8)) {
        pg8::GemmSet g{B1, Wpq_t, B1, Wpq_t, D}; pg8::TileOrder S; S.init(M, NPQ, G, bx);
        pg8::EpiRowScale E{B2, NPQ, SSQ2, 1.0f, RMS_EPS};
        pg8::gemm_phase<pg8::EpiRowScale, pg8::TileOrder, true, true>(ldsp + RING_OFF, g, S, E);
        if (BOTH(8)) GRID_BAR();
    }

    if (IN(9)) {
        if (tid < 64) { int cnt = 0, val = 0;
            for (int ii = 0; ii < 16; ++ii) { const int nj = 16 / (ii + 1); if (tid >= cnt && tid < cnt + nj) val = ii | ((tid - cnt) << 4); cnt += nj; }
            ldsp[RING_OFF + peer::L_CAND + tid] = (unsigned char)val; }
        LDS_WAIT(); __syncthreads();
#ifndef NO_PEER
        for (int tile = vcu; tile < M / 32; tile += G) peer::peer_tile(tile, B2, SKb, B1, SSQ2, B4, B5, norm_final, out, ldsp + RING_OFF);
#else
        for (int m = gw; m < M; m += NGW) final_norm_row(out + (size_t)m * D, norm_final, out + (size_t)m * D, lane);
#endif
    }
#undef IN
#undef BOTH
#undef GRID_BAR
}

extern "C" void kernel_launch(void* const* d_in, const int* in_sizes, int n_in, void* d_out, int out_size, void* d_ws, size_t ws_size, hipStream_t stream) {
    static int grid = 0;
    if (grid == 0) {
        if (n_in != 20 || in_sizes[0] != M * D || out_size != M * D || ws_size < WS_END) { fprintf(stderr, "kernel_launch: unexpected shapes (n_in %d, in0 %d, out %d, ws %zu); nothing launched\n", n_in, n_in > 0 ? in_sizes[0] : -1, out_size, ws_size); grid = -1; return; }
        int dev = 0, cus = 0, per_cu = 0;
        if (hipGetDevice(&dev) != hipSuccess || hipDeviceGetAttribute(&cus, hipDeviceAttributeMultiprocessorCount, dev) != hipSuccess) { grid = -1; return; }
        if (hipFuncSetAttribute((const void*)fwd_megakernel, hipFuncAttributeMaxDynamicSharedMemorySize, LDS_BYTES) != hipSuccess) { fprintf(stderr, "kernel_launch: hipFuncSetAttribute failed\n"); grid = -1; return; }
        if (hipOccupancyMaxActiveBlocksPerMultiprocessor(&per_cu, (const void*)fwd_megakernel, NWAVES * 64, LDS_BYTES) != hipSuccess || per_cu < 1)
            fprintf(stderr, "kernel_launch: note: occupancy query reports %d workgroups per CU\n", per_cu);
        (void)hipGetLastError();
        grid = cus;
    }
    if (grid < 0) return;
    if (hipMemsetAsync((char*)d_ws + WS_CTL, 0, CTL_ZERO_BYTES, stream) != hipSuccess) { fprintf(stderr, "kernel_launch: hipMemsetAsync failed\n"); return; }
    Args a{};
    for (int i = 0; i < 20; ++i) a.in[i] = (const float*)d_in[i];
    a.out = (float*)d_out; a.ws = (unsigned char*)d_ws;
    if (N_LAUNCHES == 1) { a.ph_lo = 0; a.ph_hi = N_PHASES; a.li = 0; hipLaunchKernelGGL(fwd_megakernel, dim3(grid), dim3(NWAVES * 64), LDS_BYTES, stream, a); }
    else for (int li = 0; li < N_PHASES; ++li) { a.ph_lo = li; a.ph_hi = li + 1; a.li = li; hipLaunchKernelGGL(fwd_megakernel, dim3(grid), dim3(NWAVES * 64), LDS_BYTES, stream, a); }
    const hipError_t le = hipPeekAtLastError();
    if (le != hipSuccess) fprintf(stderr, "kernel_launch: launch failed: %s\n", hipGetErrorName(le));
}
```

```cpp
#include <hip/hip_runtime.h>
#include <hip/hip_bf16.h>
#include <cstdio>
#include <cstdint>
#include <cmath>

#ifndef MK_N_LAUNCHES
#define MK_N_LAUNCHES 1
#endif
namespace pg8 {
#define PG8_LAS __attribute__((address_space(3)))
typedef unsigned short bf16_t;
typedef short bf16x8 __attribute__((ext_vector_type(8)));
typedef float f32x4 __attribute__((ext_vector_type(4)));
typedef float f32x2 __attribute__((ext_vector_type(2)));
typedef unsigned u32x4 __attribute__((ext_vector_type(4)));
typedef unsigned u32x2 __attribute__((ext_vector_type(2)));
constexpr int BM = 256, BK = 64, HALF = 128, HTB = HALF * BK * 2  , STAGE_BYTES = 8 * HTB, NXCD = 8, WGM = 8;

__host__ __device__ __forceinline__ int lds_byte(int r, int c) { const int st = (r >> 4) * 2 + (c >> 5), rr = r & 15, cc = c & 31, ob = rr * 64 + cc * 2; return st * 1024 + (ob ^ (((ob >> 9) & 1) << 5)); }
__host__ __device__ __forceinline__ void stage_rc(int b, int& R, int& C) { const int st = b / 1024, sb = b % 1024, swz = sb ^ (((sb >> 9) & 1) << 5); R = (st >> 1) * 16 + swz / 64; C = (st & 1) * 32 + (swz % 64) / 2; }
__host__ __device__ __forceinline__ int perm32(int rho) { const int n = rho >> 4, i = rho & 15; return 8 * (i >> 2) + 4 * n + (i & 3); }

struct Unit { int pm, pn, g; };
struct GemmSet { const bf16_t* A0; const bf16_t* B0; const bf16_t* A1; const bf16_t* B1; int K; };

struct TileOrder {
    int nM, nN, nwg, G, c, passes;
    __device__ void init(int M, int N, int G_, int c_, int passes_ = 1) { nM = M / BM; nN = N / BM; nwg = nM * nN; G = G_; c = c_; passes = passes_; }
    __device__ bool next(int i, Unit& u) const {
        const int ti = (passes == 2) ? (i >> 1) : i; u.g = (passes == 2) ? (i & 1) : 0;
        const long L = (long)ti * G + c; if (L >= nwg) return false;
        int wgid = (int)L; { const int q = nwg / NXCD, r = nwg % NXCD, xcd = wgid % NXCD, off = wgid / NXCD; wgid = (xcd < r ? xcd * (q + 1) : r * (q + 1) + (xcd - r) * q) + off; }
        const int nig = WGM * nN, gid = wgid / nig, fm = gid * WGM, gsz = (nM - fm) < WGM ? (nM - fm) : WGM;
        u.pm = fm + ((wgid % nig) % gsz); u.pn = (wgid % nig) / gsz; return true;
    }
    __device__ __forceinline__ void a_ready(const Unit&) const {}
    __device__ __forceinline__ void done(const Unit&) const {}
};
struct SubOrder {
    int nN, n, idx;
    __device__ void init(int M, int N, int c0, int c_) { nN = N / BM; n = (M / BM) * nN; idx = c_ - c0; }
    __device__ bool next(int i, Unit& u) const { if (i != 0 || idx < 0 || idx >= n) return false; u.pm = idx / nN; u.pn = idx % nN; u.g = 0; return true; }
    __device__ __forceinline__ void a_ready(const Unit&) const {}
    __device__ __forceinline__ void done(const Unit&) const {}
};

typedef __bf16 bf16x2_t __attribute__((ext_vector_type(2)));
__device__ __forceinline__ unsigned cvt_pk_bf16(float lo, float hi) { f32x2 v = {lo, hi}; bf16x2_t b = __builtin_convertvector(v, bf16x2_t); return __builtin_bit_cast(unsigned, b); }
__device__ __forceinline__ float bf_lo(unsigned w) { return __builtin_bit_cast(float, w << 16); }
__device__ __forceinline__ float bf_hi(unsigned w) { return __builtin_bit_cast(float, w & 0xffff0000u); }
__device__ __forceinline__ u32x4 pack8(const f32x4 v0, const f32x4 v1) { u32x4 w; w.x = cvt_pk_bf16(v0[0], v0[1]); w.y = cvt_pk_bf16(v0[2], v0[3]); w.z = cvt_pk_bf16(v1[0], v1[1]); w.w = cvt_pk_bf16(v1[2], v1[3]); return w; }
__device__ __forceinline__ float sigmoidf_fast(float x) { return __builtin_amdgcn_rcpf(1.0f + __builtin_amdgcn_exp2f(-1.4426950408889634f * x)); }

struct EpiStore {
    static constexpr bool PERM = true, AFTER_DRAIN = false;
    bf16_t* O; int ldc; float scale;
    __device__ __forceinline__ void operator()(const f32x4 (&acc)[2][2][4][2], const Unit& u, int wr, int wc, int fr, int fq) const {
        const int row0 = u.pm * BM + wr * 64 + fr, col0 = u.pn * BM + wc * 32 + 8 * fq;
#pragma unroll
        for (int ai = 0; ai < 2; ++ai)
#pragma unroll
            for (int m = 0; m < 4; ++m) { bf16_t* rowp = O + (size_t)(row0 + ai * HALF + m * 16) * ldc + col0;
#pragma unroll
                for (int bj = 0; bj < 2; ++bj) *(u32x4*)(rowp + bj * HALF) = pack8(acc[ai][bj][m][0] * scale, acc[ai][bj][m][1] * scale); }
    }
};

struct EpiInProj {
    static constexpr bool PERM = true, AFTER_DRAIN = false;
    bf16_t *q, *k, *v, *uu, *cb, *sga, *sgc; float qscale;
    __device__ __forceinline__ void operator()(const f32x4 (&acc)[2][2][4][2], const Unit& u, int wr, int wc, int fr, int fq) const {
        const int row0 = u.pm * BM + wr * 64 + fr; const int pn = u.pn;
        if (pn >= 12 && pn < 20) {
            const int col0 = (pn - 12) * 128 + wc * 32 + 8 * fq;
#pragma unroll
            for (int ai = 0; ai < 2; ++ai)
#pragma unroll
                for (int m = 0; m < 4; ++m) *(u32x4*)(uu + (size_t)(row0 + ai * HALF + m * 16) * 1024 + col0) = pack8(acc[ai][0][m][0] * acc[ai][1][m][0], acc[ai][0][m][1] * acc[ai][1][m][1]);
            return;
        }
        bf16_t* base; float sc = 1.f; bool sig = false;
        if (pn < 4) { base = q; sc = qscale; } else if (pn < 8) base = k; else if (pn < 12) base = v; else if (pn < 24) base = cb; else if (pn < 28) { base = sga; sig = true; } else { base = sgc; sig = true; }
        const int col0 = (pn & 3) * BM + wc * 32 + 8 * fq;
#pragma unroll
        for (int ai = 0; ai < 2; ++ai)
#pragma unroll
            for (int m = 0; m < 4; ++m) { bf16_t* rowp = base + (size_t)(row0 + ai * HALF + m * 16) * 1024 + col0;
#pragma unroll
                for (int bj = 0; bj < 2; ++bj) { f32x4 v0 = acc[ai][bj][m][0], v1 = acc[ai][bj][m][1];
                    if (sig) {
#pragma unroll
                        for (int e = 0; e < 4; ++e) { v0[e] = sigmoidf_fast(v0[e]); v1[e] = sigmoidf_fast(v1[e]); } }
                    else { v0 = v0 * sc; v1 = v1 * sc; }
                    *(u32x4*)(rowp + bj * HALF) = pack8(v0, v1); } }
    }
};

struct EpiGate {
    static constexpr bool PERM = true, AFTER_DRAIN = false;
    bf16_t* merged; const bf16_t* sga; const bf16_t* sgc;
    __device__ __forceinline__ void operator()(const f32x4 (&acc)[2][2][4][2], const Unit& u, int wr, int wc, int fr, int fq) const {
        const int row0 = u.pm * BM + wr * 64 + fr, col0 = u.pn * BM + wc * 32 + 8 * fq; const bf16_t* gate = u.g ? sgc : sga;
#pragma unroll
        for (int ai = 0; ai < 2; ++ai)
#pragma unroll
            for (int m = 0; m < 4; ++m) { const size_t off = (size_t)(row0 + ai * HALF + m * 16) * 1024 + col0;
#pragma unroll
                for (int bj = 0; bj < 2; ++bj) { const u32x4 gw = *(const u32x4*)(gate + off + bj * HALF);
                    f32x4 v0 = acc[ai][bj][m][0], v1 = acc[ai][bj][m][1];
                    v0[0] *= bf_lo(gw.x); v0[1] *= bf_hi(gw.x); v0[2] *= bf_lo(gw.y); v0[3] *= bf_hi(gw.y); v1[0] *= bf_lo(gw.z); v1[1] *= bf_hi(gw.z); v1[2] *= bf_lo(gw.w); v1[3] *= bf_hi(gw.w);
                    if (u.g) { const u32x4 pw = *(const u32x4*)(merged + off + bj * HALF);
                        v0[0] += bf_lo(pw.x); v0[1] += bf_hi(pw.x); v0[2] += bf_lo(pw.y); v0[3] += bf_hi(pw.y); v1[0] += bf_lo(pw.z); v1[1] += bf_hi(pw.z); v1[2] += bf_lo(pw.w); v1[3] += bf_hi(pw.w); }
                    *(u32x4*)(merged + off + bj * HALF) = pack8(v0, v1); } }
    }
};

struct EpiResid {
    static constexpr bool PERM = false, AFTER_DRAIN = false;
    const float* base; float* hf; bf16_t* hb; float* ssq;
    __device__ __forceinline__ void operator()(const f32x4 (&acc)[2][2][4][2], const Unit& u, int wr, int wc, int fr, int fq) const {
        const int row0 = u.pm * BM + wr * 64 + fr, col0 = u.pn * BM + wc * 32 + 4 * fq;
#pragma unroll
        for (int ai = 0; ai < 2; ++ai)
#pragma unroll
            for (int m = 0; m < 4; ++m) { const int row = row0 + ai * HALF + m * 16; const size_t off = (size_t)row * 1024 + col0; float s = 0.f;
#pragma unroll
                for (int bj = 0; bj < 2; ++bj)
#pragma unroll
                    for (int n = 0; n < 2; ++n) { const f32x4 b = *(const f32x4*)(base + off + bj * HALF + n * 16); const f32x4 h = b + acc[ai][bj][m][n];
                        *(f32x4*)(hf + off + bj * HALF + n * 16) = h; s += (h[0] * h[0] + h[1] * h[1]) + (h[2] * h[2] + h[3] * h[3]);
                        u32x2 w; w.x = cvt_pk_bf16(h[0], h[1]); w.y = cvt_pk_bf16(h[2], h[3]); *(u32x2*)(hb + off + bj * HALF + n * 16) = w; }
                s += __shfl_xor(s, 16); s += __shfl_xor(s, 32);
                if (fq == 0) ssq[(size_t)row * 16 + u.pn * 4 + wc] = s; }
    }
};

struct EpiRowScale {
    static constexpr bool PERM = true, AFTER_DRAIN = false;
    bf16_t* O; int ldc; const float* ssq; float scale; float eps;
    __device__ __forceinline__ void operator()(const f32x4 (&acc)[2][2][4][2], const Unit& u, int wr, int wc, int fr, int fq) const {
        const int row0 = u.pm * BM + wr * 64 + fr, col0 = u.pn * BM + wc * 32 + 8 * fq;
#pragma unroll
        for (int ai = 0; ai < 2; ++ai)
#pragma unroll
            for (int m = 0; m < 4; ++m) { const int row = row0 + ai * HALF + m * 16; const f32x4* sp = (const f32x4*)(ssq + (size_t)row * 16);
                const f32x4 a = sp[0], b = sp[1], c = sp[2], d = sp[3]; const f32x4 t = (a + b) + (c + d);
                const float rs = __builtin_amdgcn_rsqf(((t[0] + t[1]) + (t[2] + t[3])) * (1.0f / 1024.0f) + eps) * scale;
                bf16_t* rowp = O + (size_t)row * ldc + col0;
#pragma unroll
                for (int bj = 0; bj < 2; ++bj) *(u32x4*)(rowp + bj * HALF) = pack8(acc[ai][bj][m][0] * rs, acc[ai][bj][m][1] * rs); }
    }
};

template <class Epi, class Sched, bool ALIGN_EPI = false, bool SP2 = false>
__device__ __forceinline__ void gemm_phase(PG8_LAS unsigned char* lds, const GemmSet g, const Sched& S, const Epi& E) {
    const int tid = threadIdx.x, wid = __builtin_amdgcn_readfirstlane(tid >> 6), lane = tid & 63, wr = wid >> 2, wc = wid & 3, fr = lane & 15, fq = lane >> 4;
    const int K = g.K, nt = K / BK;
    unsigned voffA[2], voffB[2];
#pragma unroll
    for (int i = 0; i < 2; ++i) { int R, C; stage_rc(tid * 16 + i * 8192, R, C); const int Rb = Epi::PERM ? ((R & ~31) + perm32(R & 31)) : R;
        voffA[i] = (unsigned)(R * K + C) * 2u; voffB[i] = (unsigned)(Rb * K + C) * 2u; }
    const size_t kstep = (size_t)(BK * 2);
    const size_t hstep = (size_t)HALF * K * 2;
    const size_t tstep = 2 * hstep;
    const unsigned ldsw = (unsigned)wid * 1024u;
    const int aoff = lds_byte(wr * 64 + fr, fq * 8), boff = lds_byte(wc * 32 + fr, fq * 8);
#define PG8_SA(b, h) (((b) * 2 + (h)) * HTB)
#define PG8_SB(b, h) ((4 + (b) * 2 + (h)) * HTB)
#define PG8_STAGE(bufoff, gbase, voff) do { _Pragma("unroll") for (int _i = 0; _i < 2; ++_i) \
        __builtin_amdgcn_global_load_lds((const unsigned*)((const char*)(gbase) + (voff)[_i]), (PG8_LAS unsigned*)(lds + (bufoff) + ldsw + _i * 8192), 16, 0, 0); } while (0)
#define PG8_LDA(dst, b, h) do { _Pragma("unroll") for (int m = 0; m < 4; ++m) _Pragma("unroll") for (int k = 0; k < 2; ++k) dst[m][k] = *(const PG8_LAS bf16x8*)(lds + PG8_SA(b, h) + aoff + m * 2048 + k * 1024); } while (0)
#define PG8_LDB(dst, b, h) do { _Pragma("unroll") for (int n = 0; n < 2; ++n) _Pragma("unroll") for (int k = 0; k < 2; ++k) dst[n][k] = *(const PG8_LAS bf16x8*)(lds + PG8_SB(b, h) + boff + n * 2048 + k * 1024); } while (0)
#define PG8_MMA(ai, bj, At, Bt) do { __builtin_amdgcn_s_setprio(1); _Pragma("unroll") for (int m = 0; m < 4; ++m) _Pragma("unroll") for (int n = 0; n < 2; ++n) _Pragma("unroll") for (int k = 0; k < 2; ++k) \
        acc[ai][bj][m][n] = __builtin_amdgcn_mfma_f32_16x16x32_bf16(Bt[n][k], At[m][k], acc[ai][bj][m][n], 0, 0, 0); __builtin_amdgcn_s_setprio(0); } while (0)
#define PG8_WAIT_V(n) asm volatile("s_waitcnt vmcnt(" #n ")" ::: "memory")
#define PG8_WAIT_L(n) asm volatile("s_waitcnt lgkmcnt(" #n ")" ::: "memory")
#define PG8_BAR __builtin_amdgcn_s_barrier()
#define PG8_SCHED __builtin_amdgcn_sched_barrier(0)
    Unit cur, nxt; int ui = 0;
    if (!S.next(0, cur)) return;
    f32x4 acc[2][2][4][2];
#pragma unroll
    for (int a = 0; a < 2; ++a)
#pragma unroll
        for (int b = 0; b < 2; ++b)
#pragma unroll
            for (int m = 0; m < 4; ++m)
#pragma unroll
                for (int n = 0; n < 2; ++n) acc[a][b][m][n] = (f32x4){0.f, 0.f, 0.f, 0.f};
    bf16x8 At[4][2], B0[2][2], B1[2][2];
    const char* cA = (const char*)(cur.g ? g.A1 : g.A0) + (size_t)cur.pm * tstep; const char* cB = (const char*)(cur.g ? g.B1 : g.B0) + (size_t)cur.pn * tstep;
    S.a_ready(cur);
    if constexpr (SP2) {
        PG8_STAGE(PG8_SB(0, 0), cB, voffB); PG8_STAGE(PG8_SB(0, 1), cB + hstep, voffB); PG8_STAGE(PG8_SA(0, 0), cA, voffA); PG8_STAGE(PG8_SA(0, 1), cA + hstep, voffA);
        if (wr == 1) PG8_BAR;
        PG8_WAIT_V(2); PG8_BAR;
        PG8_STAGE(PG8_SB(1, 0), cB + kstep, voffB); PG8_STAGE(PG8_SA(1, 0), cA + kstep, voffA); PG8_STAGE(PG8_SB(1, 1), cB + hstep + kstep, voffB);
        PG8_WAIT_V(6); PG8_BAR;
    } else {
        PG8_STAGE(PG8_SB(0, 0), cB, voffB); PG8_STAGE(PG8_SA(0, 0), cA, voffA); PG8_STAGE(PG8_SB(0, 1), cB + hstep, voffB); PG8_STAGE(PG8_SA(0, 1), cA + hstep, voffA);
        if (wr == 1) PG8_BAR;
        PG8_WAIT_V(4); PG8_BAR;
        PG8_STAGE(PG8_SB(1, 0), cB + kstep, voffB); PG8_STAGE(PG8_SA(1, 0), cA + kstep, voffA); PG8_STAGE(PG8_SB(1, 1), cB + hstep + kstep, voffB);
        PG8_WAIT_V(6); PG8_BAR;
    }
    for (;;) {
        const bool has_next = S.next(ui + 1, nxt);
        const char* nA = has_next ? (const char*)(nxt.g ? g.A1 : g.A0) + (size_t)nxt.pm * tstep : cA; const char* nB = has_next ? (const char*)(nxt.g ? g.B1 : g.B0) + (size_t)nxt.pn * tstep : cB;
        for (int t = 0; t < nt; t += 2) {
            const bool last = (t == nt - 2);
            const char* a1 = cA + (size_t)(t + 1) * kstep;
            const char* a2 = last ? nA : cA + (size_t)(t + 2) * kstep; const char* b2 = last ? nB : cB + (size_t)(t + 2) * kstep;
            const char* a3 = a2 + kstep; const char* b3 = b2 + kstep;
            if (last && has_next) S.a_ready(nxt);
            if constexpr (SP2) {
            PG8_LDB(B0, 0, 0); PG8_LDB(B1, 0, 1); PG8_SCHED; PG8_LDA(At, 0, 0); PG8_STAGE(PG8_SA(1, 1), a1 + hstep, voffA);
            PG8_WAIT_V(8); PG8_WAIT_L(0); PG8_BAR; PG8_MMA(0, 0, At, B0); PG8_MMA(0, 1, At, B1); PG8_BAR; PG8_SCHED;
            PG8_LDA(At, 0, 1); PG8_STAGE(PG8_SB(0, 0), b2, voffB); PG8_STAGE(PG8_SB(0, 1), b2 + hstep, voffB); PG8_STAGE(PG8_SA(0, 0), a2, voffA);
            PG8_WAIT_V(8); PG8_WAIT_L(0); PG8_BAR; PG8_MMA(1, 0, At, B0); PG8_MMA(1, 1, At, B1); PG8_BAR; PG8_SCHED;
            PG8_LDB(B0, 1, 0); PG8_LDB(B1, 1, 1); PG8_SCHED; PG8_LDA(At, 1, 0); PG8_STAGE(PG8_SA(0, 1), a2 + hstep, voffA);
            PG8_WAIT_V(8); PG8_WAIT_L(0); PG8_BAR; PG8_MMA(0, 0, At, B0); PG8_MMA(0, 1, At, B1); PG8_BAR; PG8_SCHED;
            PG8_LDA(At, 1, 1); PG8_STAGE(PG8_SB(1, 0), b3, voffB); PG8_STAGE(PG8_SB(1, 1), b3 + hstep, voffB); PG8_STAGE(PG8_SA(1, 0), a3, voffA);
            PG8_WAIT_V(8); PG8_WAIT_L(0); PG8_BAR; PG8_MMA(1, 0, At, B0); PG8_MMA(1, 1, At, B1); PG8_BAR; PG8_SCHED;
            } else {
            PG8_LDB(B0, 0, 0); PG8_SCHED; PG8_LDA(At, 0, 0); PG8_STAGE(PG8_SA(1, 1), a1 + hstep, voffA);
            PG8_WAIT_L(8); PG8_BAR; PG8_WAIT_L(0); PG8_MMA(0, 0, At, B0); PG8_BAR; PG8_SCHED;
            PG8_LDB(B1, 0, 1); PG8_STAGE(PG8_SB(0, 0), b2, voffB);
            PG8_BAR; PG8_WAIT_L(0); PG8_MMA(0, 1, At, B1); PG8_BAR;
            PG8_LDA(At, 0, 1); PG8_STAGE(PG8_SA(0, 0), a2, voffA);
            PG8_BAR; PG8_WAIT_L(0); PG8_MMA(1, 0, At, B0); PG8_BAR; PG8_SCHED;
            PG8_STAGE(PG8_SB(0, 1), b2 + hstep, voffB);
            PG8_WAIT_V(6); PG8_BAR; PG8_MMA(1, 1, At, B1); PG8_BAR;
            PG8_LDB(B0, 1, 0); PG8_SCHED; PG8_LDA(At, 1, 0); PG8_STAGE(PG8_SA(0, 1), a2 + hstep, voffA);
            PG8_WAIT_L(8); PG8_BAR; PG8_WAIT_L(0); PG8_MMA(0, 0, At, B0); PG8_BAR; PG8_SCHED;
            PG8_LDB(B1, 1, 1); PG8_STAGE(PG8_SB(1, 0), b3, voffB);
            PG8_BAR; PG8_WAIT_L(0); PG8_MMA(0, 1, At, B1); PG8_BAR;
            PG8_LDA(At, 1, 1); PG8_STAGE(PG8_SA(1, 0), a3, voffA);
            PG8_BAR; PG8_WAIT_L(0); PG8_MMA(1, 0, At, B0); PG8_BAR; PG8_SCHED;
            PG8_STAGE(PG8_SB(1, 1), b3 + hstep, voffB);
            PG8_WAIT_V(6); PG8_BAR; PG8_MMA(1, 1, At, B1); PG8_BAR;
            }
        }
        if constexpr (ALIGN_EPI) { if (wr == 0) PG8_BAR; }
        if constexpr (!Epi::AFTER_DRAIN) { E(acc, cur, wr, wc, fr, fq); S.done(cur); }
        if (!has_next) break;
#pragma unroll
        for (int a = 0; a < 2; ++a)
#pragma unroll
            for (int b = 0; b < 2; ++b)
#pragma unroll
                for (int m = 0; m < 4; ++m)
#pragma unroll
                    for (int n = 0; n < 2; ++n) acc[a][b][m][n] = (f32x4){0.f, 0.f, 0.f, 0.f};
        cur = nxt; cA = nA; cB = nB; ++ui;
        if constexpr (ALIGN_EPI) { if (wr == 1) PG8_BAR; }
    }
    PG8_WAIT_V(0);
    if constexpr (!ALIGN_EPI) { if (wr == 0) PG8_BAR; }
    PG8_BAR;
    if constexpr (Epi::AFTER_DRAIN) { E.fused(acc, cur, wr, wc, fr, fq, lds, wid, lane); S.done(cur); }
#undef PG8_SA
#undef PG8_SB
#undef PG8_STAGE
#undef PG8_LDA
#undef PG8_LDB
#undef PG8_MMA
#undef PG8_WAIT_V
#undef PG8_WAIT_L
#undef PG8_BAR
#undef PG8_SCHED
}
}

namespace sb {
using bf16 = __hip_bfloat16;
using bf16x8 = __attribute__((ext_vector_type(8))) short;
using s16x4 = __attribute__((ext_vector_type(4))) short;
using f32x16 = __attribute__((ext_vector_type(16))) float;
using u32x4 = __attribute__((ext_vector_type(4))) unsigned;
constexpr int SEQ = 2048, NHEAD = 16, HD = 64, DM = 1024;
constexpr int SLOTB = 8192, LDS_K = 0, LDS_V = 2 * SLOTB, LDS_FLAG = 4 * SLOTB, LDS_BYTES = 4 * SLOTB + 64;
constexpr float EXIT_THR = -150.0f;
__device__ __forceinline__ int crow(int r, int hi) { return (r & 3) + 8 * (r >> 2) + 4 * hi; }
__device__ __forceinline__ void glds16(const void* gsrc, unsigned lds_dst) { unsigned keep;
    asm volatile("s_mov_b32 %0, m0\n\ts_mov_b32 m0, %2\n\ts_nop 0\n\tglobal_load_lds_dwordx4 %1, off\n\ts_mov_b32 m0, %0" : "=&s"(keep) : "v"(gsrc), "s"(lds_dst) : "memory"); }
typedef __attribute__((address_space(3))) const char* lds_cptr;
typedef short v4i16_t __attribute__((ext_vector_type(4)));
typedef float f32x2_t __attribute__((ext_vector_type(2))); typedef __bf16 bf16x2_t __attribute__((ext_vector_type(2)));
__device__ __forceinline__ unsigned cvtpk(float lo, float hi) { f32x2_t v = {lo, hi}; bf16x2_t b = __builtin_convertvector(v, bf16x2_t); return __builtin_bit_cast(unsigned, b); }
__device__ __forceinline__ s16x4 vtr(lds_cptr p) { return __builtin_bit_cast(s16x4, __builtin_amdgcn_ds_read_tr16_b64_v4i16((__attribute__((address_space(3))) v4i16_t*)p)); }
__device__ __forceinline__ bf16x8 pack8(const f32x16& p, int b) { u32x4 w; w.x = cvtpk(p[b], p[b + 1]); w.y = cvtpk(p[b + 2], p[b + 3]); w.z = cvtpk(p[b + 4], p[b + 5]); w.w = cvtpk(p[b + 6], p[b + 7]); return __builtin_bit_cast(bf16x8, w); }
__device__ __forceinline__ float lo_lane(float x) { auto rr = __builtin_amdgcn_permlane32_swap(__float_as_uint(x), __float_as_uint(x), false, false); return __uint_as_float(rr[0]); }
#define SB_WAIT_BAR() asm volatile("s_waitcnt vmcnt(0) lgkmcnt(0)\n\ts_barrier" ::: "memory")

template <bool EARLY> __device__ __forceinline__ void sb_unit(int b, int h, int qb, const bf16* Q, const bf16* __restrict__ K, const bf16* __restrict__ V, bf16* O, char* shm) {
    const int tid = threadIdx.x, lane = tid & 63, r32 = lane & 31, hi = lane >> 5; const int wid = __builtin_amdgcn_readfirstlane(tid >> 6);
    const long rowbase = (long)b * SEQ; const int q0 = qb * 256;
    const bf16* Qw = Q + (rowbase + q0 + wid * 32) * DM + h * HD;
    const bf16* Kh = K + rowbase * DM + h * HD; const bf16* Vh = V + rowbase * DM + h * HD;
    const unsigned lds0 = (unsigned)(uintptr_t)shm;
    const bf16* ksrc = Kh + (long)lane * DM + wid * 8;
    const bf16* vsrc = Vh + (long)(16 * (wid & 3) + (lane >> 2)) * DM + (wid >> 2) * 32 + (lane & 3) * 8;
    const unsigned kdst = lds0 + LDS_K + wid * 1024, vdst = lds0 + LDS_V + wid * 1024;
#define SB_DMA_K(t, slot) glds16(ksrc + (long)(t) * 64 * DM, (unsigned)__builtin_amdgcn_readfirstlane(kdst + (slot)))
#define SB_DMA_V(t, slot) glds16(vsrc + (long)(t) * 64 * DM, (unsigned)__builtin_amdgcn_readfirstlane(vdst + (slot)))
    const lds_cptr shm3 = (lds_cptr)shm; const lds_cptr kp0 = shm3 + LDS_K + hi * 1024 + r32 * 16;
    const lds_cptr vp0 = shm3 + LDS_V + ((lane >> 4) & 1) * 32 + (lane & 3) * 8 + (4 * hi + ((lane & 15) >> 2)) * 64;
    const int NT = (q0 + 256) / 64;
    volatile __attribute__((address_space(3))) unsigned* flags = (volatile __attribute__((address_space(3))) unsigned*)(shm3 + LDS_FLAG);
    if (EARLY && lane == 0) flags[wid] = 0u;
    bool wdone = false;
    SB_DMA_K(NT - 1, 0); SB_DMA_V(NT - 1, 0);
    bf16x8 qr[4];
#pragma unroll
    for (int d0 = 0; d0 < 4; ++d0) qr[d0] = *reinterpret_cast<const bf16x8*>(&Qw[(long)r32 * DM + d0 * 16 + hi * 8]);
    bf16x8 tri[2], ones;
#pragma unroll
    for (int ks = 0; ks < 2; ++ks)
#pragma unroll
        for (int j = 0; j < 8; ++j) { const int kk = 16 * ks + 8 * (j >> 2) + 4 * hi + (j & 3); tri[ks][j] = (kk >= r32) ? (short)0x3F80 : (short)0; }
#pragma unroll
    for (int j = 0; j < 8; ++j) ones[j] = (short)0x3F80;
    f32x16 o0 = f32x16{}, o1 = f32x16{}; float R = 0.f;
    const int trow = q0 + wid * 32 + r32;
    const int wmin = q0 + wid * 32, wmax = wmin + 31;
    for (int it = 0; it < NT; ++it) {
        const int t = NT - 1 - it; const int sl = (it & 1) * SLOTB;
        SB_WAIT_BAR();
        if (EARLY) { const unsigned f = flags[lane & 7]; if (__all(f != 0u)) break; }
        if (t > 0) { SB_DMA_K(t - 1, sl ^ SLOTB); SB_DMA_V(t - 1, sl ^ SLOTB); }
        if (64 * t < wmax && !wdone) {
            f32x16 p0 = f32x16{}, p1 = f32x16{};
#pragma unroll
            for (int d0 = 0; d0 < 4; ++d0) {
                const bf16x8 b0 = *(const __attribute__((address_space(3))) bf16x8*)(kp0 + sl + d0 * 2048);
                const bf16x8 b1 = *(const __attribute__((address_space(3))) bf16x8*)(kp0 + sl + d0 * 2048 + 512);
                p0 = __builtin_amdgcn_mfma_f32_32x32x16_bf16(b0, qr[d0], p0, 0, 0, 0);
                p1 = __builtin_amdgcn_mfma_f32_32x32x16_bf16(b1, qr[d0], p1, 0, 0, 0); }
            const bool diag = (64 * t + 63 >= wmin);
            f32x16 l0, l1;
#pragma unroll
            for (int r = 0; r < 16; ++r) {
                const float y0 = p0[r], y1 = p1[r];
                l0[r] = -(__builtin_fmaxf(y0, 0.f) + __builtin_amdgcn_logf(1.0f + __builtin_amdgcn_exp2f(-__builtin_fabsf(y0))));
                l1[r] = -(__builtin_fmaxf(y1, 0.f) + __builtin_amdgcn_logf(1.0f + __builtin_amdgcn_exp2f(-__builtin_fabsf(y1)))); }
            if (diag) {
#pragma unroll
                for (int r = 0; r < 16; ++r) { const int s = 64 * t + crow(r, hi); if (s >= trow) l0[r] = 0.f; if (s + 32 >= trow) l1[r] = 0.f; } }
            const bf16x8 l0a = pack8(l0, 0), l0b = pack8(l0, 8), l1a = pack8(l1, 0), l1b = pack8(l1, 8);
            f32x16 Rv;
#pragma unroll
            for (int r = 0; r < 16; ++r) Rv[r] = R;
            f32x16 c1 = __builtin_amdgcn_mfma_f32_32x32x16_bf16(tri[0], l1a, Rv, 0, 0, 0); c1 = __builtin_amdgcn_mfma_f32_32x32x16_bf16(tri[1], l1b, c1, 0, 0, 0);
            f32x16 c0 = __builtin_amdgcn_mfma_f32_32x32x16_bf16(ones, l1a, Rv, 0, 0, 0); c0 = __builtin_amdgcn_mfma_f32_32x32x16_bf16(ones, l1b, c0, 0, 0, 0);
            c0 = __builtin_amdgcn_mfma_f32_32x32x16_bf16(tri[0], l0a, c0, 0, 0, 0); c0 = __builtin_amdgcn_mfma_f32_32x32x16_bf16(tri[1], l0b, c0, 0, 0, 0);
#pragma unroll
            for (int r = 0; r < 16; ++r) { p0[r] = __builtin_amdgcn_exp2f(p0[r] + c0[r]); p1[r] = __builtin_amdgcn_exp2f(p1[r] + c1[r]); }
            if (diag) {
#pragma unroll
                for (int r = 0; r < 16; ++r) { const int s = 64 * t + crow(r, hi); if (s >= trow) p0[r] = 0.f; if (s + 32 >= trow) p1[r] = 0.f; } }
            R = lo_lane(c0[0]);
            if (EARLY && !__any(R >= EXIT_THR)) { wdone = true; if (lane == 0) flags[wid] = 1u; }
            const bf16x8 pa0 = pack8(p0, 0), pa1 = pack8(p0, 8), pa2 = pack8(p1, 0), pa3 = pack8(p1, 8);
            const lds_cptr vp = vp0 + sl;
#define SB_VF(dh, ks) ({ const s16x4 lo_ = vtr(vp + (dh) * 4096 + (ks) * 1024), hi_ = vtr(vp + (dh) * 4096 + (ks) * 1024 + 512); (bf16x8){lo_[0], lo_[1], lo_[2], lo_[3], hi_[0], hi_[1], hi_[2], hi_[3]}; })
            o0 = __builtin_amdgcn_mfma_f32_32x32x16_bf16(pa0, SB_VF(0, 0), o0, 0, 0, 0); o1 = __builtin_amdgcn_mfma_f32_32x32x16_bf16(pa0, SB_VF(1, 0), o1, 0, 0, 0);
            o0 = __builtin_amdgcn_mfma_f32_32x32x16_bf16(pa1, SB_VF(0, 1), o0, 0, 0, 0); o1 = __builtin_amdgcn_mfma_f32_32x32x16_bf16(pa1, SB_VF(1, 1), o1, 0, 0, 0);
            o0 = __builtin_amdgcn_mfma_f32_32x32x16_bf16(pa2, SB_VF(0, 2), o0, 0, 0, 0); o1 = __builtin_amdgcn_mfma_f32_32x32x16_bf16(pa2, SB_VF(1, 2), o1, 0, 0, 0);
            o0 = __builtin_amdgcn_mfma_f32_32x32x16_bf16(pa3, SB_VF(0, 3), o0, 0, 0, 0); o1 = __builtin_amdgcn_mfma_f32_32x32x16_bf16(pa3, SB_VF(1, 3), o1, 0, 0, 0);
#undef SB_VF
        }
    }
    if (EARLY) SB_WAIT_BAR();
    bf16* Ow = O + (rowbase + q0 + wid * 32) * DM + h * HD;
#pragma unroll
    for (int r = 0; r < 16; ++r) { const int orow = crow(r, hi); Ow[(long)orow * DM + r32] = __float2bfloat16(o0[r]); Ow[(long)orow * DM + 32 + r32] = __float2bfloat16(o1[r]); }
#undef SB_DMA_K
#undef SB_DMA_V
}
}

constexpr int NWAVES = 8;
constexpr int N_LAUNCHES = MK_N_LAUNCHES;
constexpr int N_PHASES = 10;
constexpr int BATCH = 8, SEQ = 2048, D = 1024, M = BATCH * SEQ, MEMLEN = 256, MROWS = BATCH * MEMLEN, NIN = 8192, NPQ = 2048;
constexpr float RMS_EPS = 1e-6f;
constexpr float LOG2E = 1.4426950408889634f;
constexpr size_t MiB = 1u << 20;
constexpr size_t WS_CTL = 0, CTL_ZERO_BYTES = 1 * MiB;
constexpr size_t WS_WIN = 1 * MiB, WS_WA = 17 * MiB, WS_WC = 19 * MiB, WS_WO = 21 * MiB, WS_WQ2 = 23 * MiB, WS_WKV2 = 25 * MiB, WS_WO2 = 29 * MiB, WS_WPQ = 31 * MiB, WS_SK = 35 * MiB;
constexpr size_t WS_SSQ1 = 36 * MiB, WS_SSQ2 = 37 * MiB, WS_MEMN = 38 * MiB, WS_K2 = 42 * MiB, WS_V2T = 46 * MiB;
constexpr size_t WS_B0 = 52 * MiB, WS_B1 = 84 * MiB, WS_B2 = 116 * MiB, WS_B3 = 148 * MiB, WS_B4 = 180 * MiB, WS_B5 = 212 * MiB, WS_END = 244 * MiB;
constexpr int CW_TMO = 0, CW_CODE = 1, CW_BAR = 4096;

constexpr int RING_OFF = 0, RING_BYTES = 131072;
constexpr int LDSCTL_OFF = RING_BYTES, MISC_OFF = LDSCTL_OFF + 320;
constexpr int LDS_BYTES = 147456;
#define GAS __attribute__((address_space(1)))
#define LAS __attribute__((address_space(3)))
typedef unsigned short bf16;
typedef unsigned v4u __attribute__((ext_vector_type(4)));
typedef float f32x4 __attribute__((ext_vector_type(4)));
typedef short bf16x8 __attribute__((ext_vector_type(8)));
typedef GAS unsigned gu32;
typedef GAS unsigned long long gu64;
#define RLX_AGENT __ATOMIC_RELAXED, __HIP_MEMORY_SCOPE_AGENT
#define LDS_WAIT() asm volatile("s_waitcnt lgkmcnt(0)" ::: "memory")
#define VM_WAIT() asm volatile("s_waitcnt vmcnt(0)" ::: "memory")
__device__ __forceinline__ unsigned long long rt() { return __builtin_amdgcn_s_memrealtime(); }
__device__ __forceinline__ unsigned f2bf(float f) { unsigned u = __builtin_bit_cast(unsigned, f); return (u + 0x7fffu + ((u >> 16) & 1u)) >> 16; }
__device__ __forceinline__ unsigned pk2(float lo, float hi) { return f2bf(lo) | (f2bf(hi) << 16); }

#define XB_TMO      128
#define XB_XCNT(j)  (256  + 64 * (j))
#define XB_XSUB(j)  (1280 + 64 * (j))
#define XB_XGEN(j)  (2304 + 64 * (j))
#define XB_TOP      3328
#define XB_TOPGEN   3392
#define XCD_BAR_WORDS 3456
#define XB_SPIN_CAP (1u << 18)

__device__ __forceinline__ unsigned xb_ld(unsigned* p)              { return __hip_atomic_load(p, __ATOMIC_RELAXED, __HIP_MEMORY_SCOPE_AGENT); }
__device__ __forceinline__ unsigned xb_add(unsigned* p, unsigned v) { return __hip_atomic_fetch_add(p, v, __ATOMIC_RELAXED, __HIP_MEMORY_SCOPE_AGENT); }
__device__ __forceinline__ unsigned xb_xcc_id() { return (unsigned)__builtin_amdgcn_s_getreg((3 << 11) | 20) & 0xFu; }
#define XB_SPIN(cond, bar) do { unsigned _sp = 0; while (cond) { __builtin_amdgcn_s_sleep(1); \
    if ((++_sp & 255u) == 0u) { if (xb_ld(&(bar)[XB_TMO])) break; if (_sp > XB_SPIN_CAP) { atomicAdd(&(bar)[XB_TMO], 1u); break; } } } } while (0)

struct XcdBarrier {
    unsigned* bar; unsigned x;
    volatile LAS unsigned* st;
};

__device__ __forceinline__ XcdBarrier xcd_barrier_post(unsigned* bar, volatile LAS unsigned* st) {
    XcdBarrier b; b.bar = bar; b.x = xb_xcc_id(); b.st = st;
    if (threadIdx.x == 0) (void)xb_add(&bar[XB_XCNT(b.x)], 1u);
    return b;
}
__device__ __forceinline__ void xcd_barrier_complete(unsigned* bar, unsigned x, unsigned& nloc, unsigned& nx) {
    const unsigned G = gridDim.x * gridDim.y * gridDim.z;
    unsigned sum, cnt, mine, sp = 0u;
    for (;;) {
        sum = 0u; cnt = 0u; mine = 0u;
#pragma unroll
        for (unsigned j = 0; j < 16; ++j) { const unsigned c = xb_ld(&bar[XB_XCNT(j)]); sum += c; cnt += (c > 0u) ? 1u : 0u; mine = (j == x) ? c : mine; }
        if (sum == G) break;
        __builtin_amdgcn_s_sleep(1);
        if ((++sp & 255u) == 0u) { if (xb_ld(&bar[XB_TMO])) break; if (sp > XB_SPIN_CAP) { atomicAdd(&bar[XB_TMO], 1u); break; } }
    }
    nloc = mine > 0u ? mine : 1u; nx = cnt > 0u ? cnt : 1u;
}

__device__ __forceinline__ void xcd_barrier(const XcdBarrier& b) {
    asm volatile("s_waitcnt vmcnt(0)" ::: "memory");
    __syncthreads();
    if (threadIdx.x == 0) {
        unsigned* bar = b.bar;
        __builtin_amdgcn_s_waitcnt(0);
        unsigned nloc = b.st[0], nx = b.st[1];
        if (nloc == 0u) { xcd_barrier_complete(bar, b.x, nloc, nx); b.st[0] = nloc; b.st[1] = nx; }
        const unsigned old = xb_add(&bar[XB_XSUB(b.x)], 1u);
        const unsigned gen = old / nloc;
        if (old + 1u == (gen + 1u) * nloc) {
            __builtin_amdgcn_fence(__ATOMIC_RELEASE, "agent");
            asm volatile("s_waitcnt vmcnt(0)" ::: "memory");
            const unsigned og = xb_add(&bar[XB_TOP], 1u);
            const unsigned tg = og / nx;
            if (og + 1u == (tg + 1u) * nx) xb_add(&bar[XB_TOPGEN], 1u);
            else XB_SPIN(xb_ld(&bar[XB_TOPGEN]) == tg, bar);
            __builtin_amdgcn_fence(__ATOMIC_ACQUIRE, "agent");
            xb_add(&bar[XB_XGEN(b.x)], 1u);
            asm volatile("s_waitcnt vmcnt(0)" ::: "memory");
        } else {
            XB_SPIN(xb_ld(&bar[XB_XGEN(b.x)]) == gen, bar);
            __builtin_amdgcn_fence(__ATOMIC_ACQUIRE, "agent");
            asm volatile("s_waitcnt vmcnt(0)" ::: "memory");
        }
    }
    __syncthreads();
}


__device__ __forceinline__ float wave_sum(float v) {
#pragma unroll
    for (int o = 1; o < 64; o <<= 1) v += __shfl_xor(v, o);
    return v;
}
__device__ __forceinline__ int inproj_row(int n) {
    const int g = n >> 10, c = n & 1023;
    if (g < 3) return n;
    if (g == 3) return 3072 + (c >> 7) * 256 + (c & 127);
    if (g == 5) return 3072 + (c >> 7) * 256 + 128 + (c & 127);
    if (g == 4) return 5120 + c;
    return n;
}
template <bool INMAP> __device__ __forceinline__ void transpose_item(const float* W, int K, int N, const float* gain, bf16* WT, int row_off, LAS float* scr, int item, int lane) {
    const int nblk = N / 32, kb = item / nblk, nb = item % nblk, k0 = 64 * kb, n0 = 32 * nb;
#pragma unroll 8
    for (int i = 0; i < 32; ++i) { const int kk = 2 * i + (lane >> 5); float w = W[(size_t)(k0 + kk) * N + n0 + (lane & 31)]; if (gain) w *= gain[k0 + kk]; scr[kk * 33 + (lane & 31)] = w; }
    LDS_WAIT(); asm volatile("" ::: "memory");
    const int c = lane & 7; const int r0 = INMAP ? inproj_row(n0) : (row_off + n0);
#pragma unroll
    for (int j = 0; j < 4; ++j) { const int n = (lane >> 3) + 8 * j; const LAS float* s = scr + (8 * c) * 33 + n;
        v4u o; o.x = pk2(s[0 * 33], s[1 * 33]); o.y = pk2(s[2 * 33], s[3 * 33]); o.z = pk2(s[4 * 33], s[5 * 33]); o.w = pk2(s[6 * 33], s[7 * 33]);
        *(GAS v4u*)(WT + (size_t)(r0 + n) * K + k0 + 8 * c) = o; }
    LDS_WAIT(); asm volatile("" ::: "memory");
}
__device__ __forceinline__ void rms_row_to_bf16(const float* xrow, const float* gain, bf16* orow, int lane) {
    const GAS f32x4* xr = (const GAS f32x4*)xrow + lane; const GAS f32x4* gr = (const GAS f32x4*)gain + lane;
    f32x4 v[4]; float s = 0.f;
#pragma unroll
    for (int j = 0; j < 4; ++j) { v[j] = xr[64 * j]; s += (v[j].x * v[j].x + v[j].y * v[j].y) + (v[j].z * v[j].z + v[j].w * v[j].w); }
    const float rstd = 1.0f / sqrtf(wave_sum(s) * (1.f / 1024.f) + RMS_EPS);
    GAS unsigned long long* o8 = (GAS unsigned long long*)orow + lane;
#pragma unroll
    for (int j = 0; j < 4; ++j) { const f32x4 g = gr[64 * j]; o8[64 * j] = (unsigned long long)pk2(v[j].x * rstd * g.x, v[j].y * rstd * g.y) | ((unsigned long long)pk2(v[j].z * rstd * g.z, v[j].w * rstd * g.w) << 32); }
}
__device__ __forceinline__ void row_to_bf16(const float* xrow, const float* gain, bf16* orow, int lane) {
    const GAS f32x4* xr = (const GAS f32x4*)xrow + lane; GAS unsigned long long* o8 = (GAS unsigned long long*)orow + lane;
#pragma unroll
    for (int j = 0; j < 4; ++j) { f32x4 v = xr[64 * j]; if (gain) { const f32x4 g = ((const GAS f32x4*)gain + lane)[64 * j]; v = v * g; }
        o8[64 * j] = (unsigned long long)pk2(v.x, v.y) | ((unsigned long long)pk2(v.z, v.w) << 32); }
}
__device__ __forceinline__ void row_to_fp8(const float* xrow, const float* gain, float scale, unsigned char* orow, int lane) {
    const GAS f32x4* xr = (const GAS f32x4*)xrow + lane; GAS unsigned* o4 = (GAS unsigned*)orow + lane;
#pragma unroll
    for (int j = 0; j < 4; ++j) { f32x4 v = xr[64 * j] * scale; if (gain) { const f32x4 g = ((const GAS f32x4*)gain + lane)[64 * j]; v = v * g; }
        int w = 0; w = __builtin_amdgcn_cvt_pk_fp8_f32(v.x, v.y, w, false); w = __builtin_amdgcn_cvt_pk_fp8_f32(v.z, v.w, w, true); o4[64 * j] = (unsigned)w; }
}
__device__ __forceinline__ void final_norm_row(const float* hrow, const float* gain, float* orow, int lane) {
    const GAS f32x4* xr = (const GAS f32x4*)hrow + lane; const GAS f32x4* gr = (const GAS f32x4*)gain + lane;
    f32x4 v[4]; float s = 0.f;
#pragma unroll
    for (int j = 0; j < 4; ++j) { v[j] = xr[64 * j]; s += (v[j].x * v[j].x + v[j].y * v[j].y) + (v[j].z * v[j].z + v[j].w * v[j].w); }
    const float rstd = 1.0f / sqrtf(wave_sum(s) * (1.f / 1024.f) + RMS_EPS);
    GAS f32x4* o = (GAS f32x4*)orow + lane;
#pragma unroll
    for (int j = 0; j < 4; ++j) o[64 * j] = v[j] * rstd * gr[64 * j];
}
__device__ __forceinline__ float bflo(unsigned w) { return __builtin_bit_cast(float, w << 16); }
__device__ __forceinline__ float bfhi(unsigned w) { return __builtin_bit_cast(float, w & 0xffff0000u); }
__device__ __forceinline__ void yconv_item(const bf16* U, const bf16* CB, const float* cw, bf16* YC, int item, int lane) {
    const int t0 = item * 8; const bool first = (t0 % SEQ) == 0;
#pragma unroll 1
    for (int ps = 0; ps < 2; ++ps) {
        const int c0 = ps * 512 + lane * 8;
        float w0[8], w1[8], w2[8];
#pragma unroll
        for (int e = 0; e < 8; ++e) { w0[e] = cw[c0 + e]; w1[e] = cw[1024 + c0 + e]; w2[e] = cw[2048 + c0 + e]; }
        v4u um2 = (v4u){0u, 0u, 0u, 0u}, um1 = (v4u){0u, 0u, 0u, 0u};
        if (!first) { um2 = *(const GAS v4u*)(U + (size_t)(t0 - 2) * 1024 + c0); um1 = *(const GAS v4u*)(U + (size_t)(t0 - 1) * 1024 + c0); }
#pragma unroll
        for (int i = 0; i < 8; ++i) {
            const v4u uc = *(const GAS v4u*)(U + (size_t)(t0 + i) * 1024 + c0); const v4u cbv = *(const GAS v4u*)(CB + (size_t)(t0 + i) * 1024 + c0);
            v4u o;
#pragma unroll
            for (int q = 0; q < 4; ++q) {
                const float a = bflo(cbv[q]) * (w0[2 * q] * bflo(um2[q]) + w1[2 * q] * bflo(um1[q]) + w2[2 * q] * bflo(uc[q]));
                const float b = bfhi(cbv[q]) * (w0[2 * q + 1] * bfhi(um2[q]) + w1[2 * q + 1] * bfhi(um1[q]) + w2[2 * q + 1] * bfhi(uc[q]));
                o[q] = pk2(a, b); }
            *(GAS v4u*)(YC + (size_t)(t0 + i) * 1024 + c0) = o;
            um2 = um1; um1 = uc; }
    }
}


namespace xa {
using bf16x8 = __attribute__((ext_vector_type(8))) short;
using s16x4 = __attribute__((ext_vector_type(4))) short;
using f32x16 = __attribute__((ext_vector_type(16))) float;
using u32x4 = __attribute__((ext_vector_type(4))) unsigned;
using u32x2 = __attribute__((ext_vector_type(2))) unsigned;
__device__ __forceinline__ int crow(int r, int hi) { return (r & 3) + 8 * (r >> 2) + 4 * hi; }
__device__ __forceinline__ void xattn_unit(int b, int head, int qt, const bf16* Q, const bf16* K2, const bf16* V2T, bf16* O, LAS unsigned char* ldsw  ) {
    const int lane = threadIdx.x & 63, r32 = lane & 31, hi = lane >> 5; const int wid = __builtin_amdgcn_readfirstlane((int)threadIdx.x >> 6);
    const size_t qrow = (size_t)b * SEQ + qt * 256 + wid * 32 + r32;
    const bf16* qp = Q + qrow * 1024 + head * 256 + hi * 8;
    LAS u32x4* qlds = (LAS u32x4*)ldsw + lane;
#pragma unroll
    for (int ks = 0; ks < 16; ++ks) qlds[ks * 64] = *(const GAS u32x4*)(qp + ks * 16);
    LDS_WAIT();
    const bf16* kp = K2 + ((size_t)b * MEMLEN + r32) * 1024 + head * 256 + hi * 8;
    const bf16* vp = V2T + ((size_t)head * 256 + r32) * 2048 + (size_t)b * MEMLEN + 4 * hi;
#pragma unroll 1
    for (int dh = 0; dh < 2; ++dh) {
    f32x16 o[4];
#pragma unroll
    for (int dt = 0; dt < 4; ++dt) o[dt] = f32x16{};
    float mrun = -1e30f, lrun = 0.f;
#pragma unroll 1
    for (int c = 0; c < 4; ++c) {
        f32x16 p0 = f32x16{}, p1 = f32x16{};
#pragma unroll 4
        for (int ks = 0; ks < 16; ++ks) {
            const bf16x8 qf = __builtin_bit_cast(bf16x8, qlds[ks * 64]);
            const bf16x8 k0 = *(const GAS bf16x8*)(kp + (size_t)(64 * c) * 1024 + ks * 16);
            const bf16x8 k1 = *(const GAS bf16x8*)(kp + (size_t)(64 * c + 32) * 1024 + ks * 16);
            p0 = __builtin_amdgcn_mfma_f32_32x32x16_bf16(k0, qf, p0, 0, 0, 0);
            p1 = __builtin_amdgcn_mfma_f32_32x32x16_bf16(k1, qf, p1, 0, 0, 0); }
        float mx = p0[0];
#pragma unroll
        for (int r = 1; r < 16; ++r) mx = __builtin_fmaxf(mx, p0[r]);
#pragma unroll
        for (int r = 0; r < 16; ++r) mx = __builtin_fmaxf(mx, p1[r]);
        { auto rr = __builtin_amdgcn_permlane32_swap(__float_as_uint(mx), __float_as_uint(mx), false, false); mx = __builtin_fmaxf(__uint_as_float(rr[0]), __uint_as_float(rr[1])); }
        const float mnew = __builtin_fmaxf(mrun, mx), alpha = __builtin_amdgcn_exp2f(mrun - mnew);
        mrun = mnew; float ps = 0.f;
#pragma unroll
        for (int r = 0; r < 16; ++r) { p0[r] = __builtin_amdgcn_exp2f(p0[r] - mnew); p1[r] = __builtin_amdgcn_exp2f(p1[r] - mnew); ps += p0[r] + p1[r]; }
        lrun = lrun * alpha + ps;
#pragma unroll
        for (int dt = 0; dt < 4; ++dt)
#pragma unroll
            for (int r = 0; r < 16; ++r) o[dt][r] *= alpha;
        bf16x8 pa[4];
        { u32x4 w;
#pragma unroll
          for (int s = 0; s < 2; ++s) {
            w.x = pg8::cvt_pk_bf16(p0[8 * s], p0[8 * s + 1]); w.y = pg8::cvt_pk_bf16(p0[8 * s + 2], p0[8 * s + 3]); w.z = pg8::cvt_pk_bf16(p0[8 * s + 4], p0[8 * s + 5]); w.w = pg8::cvt_pk_bf16(p0[8 * s + 6], p0[8 * s + 7]); pa[s] = __builtin_bit_cast(bf16x8, w);
            w.x = pg8::cvt_pk_bf16(p1[8 * s], p1[8 * s + 1]); w.y = pg8::cvt_pk_bf16(p1[8 * s + 2], p1[8 * s + 3]); w.z = pg8::cvt_pk_bf16(p1[8 * s + 4], p1[8 * s + 5]); w.w = pg8::cvt_pk_bf16(p1[8 * s + 6], p1[8 * s + 7]); pa[2 + s] = __builtin_bit_cast(bf16x8, w); } }
#pragma unroll
        for (int dt = 0; dt < 4; ++dt)
#pragma unroll
            for (int s = 0; s < 4; ++s) {
                const bf16* vq = vp + (size_t)(128 * dh + 32 * dt) * 2048 + 64 * c + 16 * s;
                const u32x2 lo = *(const GAS u32x2*)vq, hi2 = *(const GAS u32x2*)(vq + 8);
                const u32x4 vw = {lo.x, lo.y, hi2.x, hi2.y};
                o[dt] = __builtin_amdgcn_mfma_f32_32x32x16_bf16(__builtin_bit_cast(bf16x8, vw), pa[s], o[dt], 0, 0, 0); }
    }
    { auto rr = __builtin_amdgcn_permlane32_swap(__float_as_uint(lrun), __float_as_uint(lrun), false, false); lrun = __uint_as_float(rr[0]) + __uint_as_float(rr[1]); }
    const float rl = 1.0f / lrun;
    bf16* op = O + qrow * 1024 + head * 256 + 128 * dh + 4 * hi;
#pragma unroll
    for (int dt = 0; dt < 4; ++dt)
#pragma unroll
        for (int g4 = 0; g4 < 4; ++g4) { u32x2 w; w.x = pg8::cvt_pk_bf16(o[dt][4 * g4] * rl, o[dt][4 * g4 + 1] * rl); w.y = pg8::cvt_pk_bf16(o[dt][4 * g4 + 2] * rl, o[dt][4 * g4 + 3] * rl);
            *(GAS u32x2*)(op + 32 * dt + 8 * g4) = w; }
    }
}
}

namespace peer {
using bf16x8 = __attribute__((ext_vector_type(8))) short;
using f32x16 = __attribute__((ext_vector_type(16))) float;
using u32x4 = __attribute__((ext_vector_type(4))) unsigned;
using u32x2 = __attribute__((ext_vector_type(2))) unsigned;
typedef __bf16 bf16x2_t __attribute__((ext_vector_type(2)));
#define PEER_CE(a, b) do { const int _h = ((a) > (b)) ? (a) : (b); const int _l = ((a) > (b)) ? (b) : (a); (a) = _h; (b) = _l; } while (0)
#define PEER_SORT16(x, o) do { PEER_CE(x[(o)+0], x[(o)+1]); PEER_CE(x[(o)+2], x[(o)+3]); PEER_CE(x[(o)+4], x[(o)+5]); PEER_CE(x[(o)+6], x[(o)+7]); PEER_CE(x[(o)+8], x[(o)+9]); PEER_CE(x[(o)+10], x[(o)+11]); PEER_CE(x[(o)+12], x[(o)+13]); PEER_CE(x[(o)+14], x[(o)+15]); PEER_CE(x[(o)+0], x[(o)+2]); PEER_CE(x[(o)+1], x[(o)+3]); PEER_CE(x[(o)+4], x[(o)+6]); PEER_CE(x[(o)+5], x[(o)+7]); PEER_CE(x[(o)+8], x[(o)+10]); PEER_CE(x[(o)+9], x[(o)+11]); PEER_CE(x[(o)+12], x[(o)+14]); PEER_CE(x[(o)+13], x[(o)+15]); PEER_CE(x[(o)+1], x[(o)+2]); PEER_CE(x[(o)+5], x[(o)+6]); PEER_CE(x[(o)+9], x[(o)+10]); PEER_CE(x[(o)+13], x[(o)+14]); PEER_CE(x[(o)+0], x[(o)+4]); PEER_CE(x[(o)+1], x[(o)+5]); PEER_CE(x[(o)+2], x[(o)+6]); PEER_CE(x[(o)+3], x[(o)+7]); PEER_CE(x[(o)+8], x[(o)+12]); PEER_CE(x[(o)+9], x[(o)+13]); PEER_CE(x[(o)+10], x[(o)+14]); PEER_CE(x[(o)+11], x[(o)+15]); PEER_CE(x[(o)+2], x[(o)+4]); PEER_CE(x[(o)+3], x[(o)+5]); PEER_CE(x[(o)+10], x[(o)+12]); PEER_CE(x[(o)+11], x[(o)+13]); PEER_CE(x[(o)+1], x[(o)+2]); PEER_CE(x[(o)+3], x[(o)+4]); PEER_CE(x[(o)+5], x[(o)+6]); PEER_CE(x[(o)+9], x[(o)+10]); PEER_CE(x[(o)+11], x[(o)+12]); PEER_CE(x[(o)+13], x[(o)+14]); PEER_CE(x[(o)+0], x[(o)+8]); PEER_CE(x[(o)+1], x[(o)+9]); PEER_CE(x[(o)+2], x[(o)+10]); PEER_CE(x[(o)+3], x[(o)+11]); PEER_CE(x[(o)+4], x[(o)+12]); PEER_CE(x[(o)+5], x[(o)+13]); PEER_CE(x[(o)+6], x[(o)+14]); PEER_CE(x[(o)+7], x[(o)+15]); PEER_CE(x[(o)+4], x[(o)+8]); PEER_CE(x[(o)+5], x[(o)+9]); PEER_CE(x[(o)+6], x[(o)+10]); PEER_CE(x[(o)+7], x[(o)+11]); PEER_CE(x[(o)+2], x[(o)+4]); PEER_CE(x[(o)+3], x[(o)+5]); PEER_CE(x[(o)+6], x[(o)+8]); PEER_CE(x[(o)+7], x[(o)+9]); PEER_CE(x[(o)+10], x[(o)+12]); PEER_CE(x[(o)+11], x[(o)+13]); PEER_CE(x[(o)+1], x[(o)+2]); PEER_CE(x[(o)+3], x[(o)+4]); PEER_CE(x[(o)+5], x[(o)+6]); PEER_CE(x[(o)+7], x[(o)+8]); PEER_CE(x[(o)+9], x[(o)+10]); PEER_CE(x[(o)+11], x[(o)+12]); PEER_CE(x[(o)+13], x[(o)+14]); } while (0)
#define PEER_MERGE16(x, a, b) do { x[(a)+0] = (x[(a)+0] > x[(b)+15]) ? x[(a)+0] : x[(b)+15]; x[(a)+1] = (x[(a)+1] > x[(b)+14]) ? x[(a)+1] : x[(b)+14]; x[(a)+2] = (x[(a)+2] > x[(b)+13]) ? x[(a)+2] : x[(b)+13]; x[(a)+3] = (x[(a)+3] > x[(b)+12]) ? x[(a)+3] : x[(b)+12]; x[(a)+4] = (x[(a)+4] > x[(b)+11]) ? x[(a)+4] : x[(b)+11]; x[(a)+5] = (x[(a)+5] > x[(b)+10]) ? x[(a)+5] : x[(b)+10]; x[(a)+6] = (x[(a)+6] > x[(b)+9]) ? x[(a)+6] : x[(b)+9]; x[(a)+7] = (x[(a)+7] > x[(b)+8]) ? x[(a)+7] : x[(b)+8]; x[(a)+8] = (x[(a)+8] > x[(b)+7]) ? x[(a)+8] : x[(b)+7]; x[(a)+9] = (x[(a)+9] > x[(b)+6]) ? x[(a)+9] : x[(b)+6]; x[(a)+10] = (x[(a)+10] > x[(b)+5]) ? x[(a)+10] : x[(b)+5]; x[(a)+11] = (x[(a)+11] > x[(b)+4]) ? x[(a)+11] : x[(b)+4]; x[(a)+12] = (x[(a)+12] > x[(b)+3]) ? x[(a)+12] : x[(b)+3]; x[(a)+13] = (x[(a)+13] > x[(b)+2]) ? x[(a)+13] : x[(b)+2]; x[(a)+14] = (x[(a)+14] > x[(b)+1]) ? x[(a)+14] : x[(b)+1]; x[(a)+15] = (x[(a)+15] > x[(b)+0]) ? x[(a)+15] : x[(b)+0]; PEER_CE(x[(a)+0], x[(a)+8]); PEER_CE(x[(a)+1], x[(a)+9]); PEER_CE(x[(a)+2], x[(a)+10]); PEER_CE(x[(a)+3], x[(a)+11]); PEER_CE(x[(a)+4], x[(a)+12]); PEER_CE(x[(a)+5], x[(a)+13]); PEER_CE(x[(a)+6], x[(a)+14]); PEER_CE(x[(a)+7], x[(a)+15]); PEER_CE(x[(a)+0], x[(a)+4]); PEER_CE(x[(a)+1], x[(a)+5]); PEER_CE(x[(a)+2], x[(a)+6]); PEER_CE(x[(a)+3], x[(a)+7]); PEER_CE(x[(a)+8], x[(a)+12]); PEER_CE(x[(a)+9], x[(a)+13]); PEER_CE(x[(a)+10], x[(a)+14]); PEER_CE(x[(a)+11], x[(a)+15]); PEER_CE(x[(a)+0], x[(a)+2]); PEER_CE(x[(a)+1], x[(a)+3]); PEER_CE(x[(a)+4], x[(a)+6]); PEER_CE(x[(a)+5], x[(a)+7]); PEER_CE(x[(a)+8], x[(a)+10]); PEER_CE(x[(a)+9], x[(a)+11]); PEER_CE(x[(a)+12], x[(a)+14]); PEER_CE(x[(a)+13], x[(a)+15]); PEER_CE(x[(a)+0], x[(a)+1]); PEER_CE(x[(a)+2], x[(a)+3]); PEER_CE(x[(a)+4], x[(a)+5]); PEER_CE(x[(a)+6], x[(a)+7]); PEER_CE(x[(a)+8], x[(a)+9]); PEER_CE(x[(a)+10], x[(a)+11]); PEER_CE(x[(a)+12], x[(a)+13]); PEER_CE(x[(a)+14], x[(a)+15]); } while (0)
#define PEER_MERGE16_SET(x, a, b) do { x[(a)+0] = (x[(a)+0] > x[(b)+15]) ? x[(a)+0] : x[(b)+15]; x[(a)+1] = (x[(a)+1] > x[(b)+14]) ? x[(a)+1] : x[(b)+14]; x[(a)+2] = (x[(a)+2] > x[(b)+13]) ? x[(a)+2] : x[(b)+13]; x[(a)+3] = (x[(a)+3] > x[(b)+12]) ? x[(a)+3] : x[(b)+12]; x[(a)+4] = (x[(a)+4] > x[(b)+11]) ? x[(a)+4] : x[(b)+11]; x[(a)+5] = (x[(a)+5] > x[(b)+10]) ? x[(a)+5] : x[(b)+10]; x[(a)+6] = (x[(a)+6] > x[(b)+9]) ? x[(a)+6] : x[(b)+9]; x[(a)+7] = (x[(a)+7] > x[(b)+8]) ? x[(a)+7] : x[(b)+8]; x[(a)+8] = (x[(a)+8] > x[(b)+7]) ? x[(a)+8] : x[(b)+7]; x[(a)+9] = (x[(a)+9] > x[(b)+6]) ? x[(a)+9] : x[(b)+6]; x[(a)+10] = (x[(a)+10] > x[(b)+5]) ? x[(a)+10] : x[(b)+5]; x[(a)+11] = (x[(a)+11] > x[(b)+4]) ? x[(a)+11] : x[(b)+4]; x[(a)+12] = (x[(a)+12] > x[(b)+3]) ? x[(a)+12] : x[(b)+3]; x[(a)+13] = (x[(a)+13] > x[(b)+2]) ? x[(a)+13] : x[(b)+2]; x[(a)+14] = (x[(a)+14] > x[(b)+1]) ? x[(a)+14] : x[(b)+1]; x[(a)+15] = (x[(a)+15] > x[(b)+0]) ? x[(a)+15] : x[(b)+0]; } while (0)
constexpr int PEER_NCAND = 50;
__device__ const unsigned char PEER_CAND[64] = {0, 16, 32, 48, 64, 80, 96, 112, 128, 144, 160, 176, 192, 208, 224, 240, 1, 17, 33, 49, 65, 81, 97, 113, 2, 18, 34, 50, 66, 3, 19, 35, 51, 4, 20, 36, 5, 21, 6, 22, 7, 23, 8, 9, 10, 11, 12, 13, 14, 15, 0, 0, 0, 0, 0, 0, 0, 0, 0, 0, 0, 0, 0, 0};
#define PEER_CAND_SUMS(x, v0, v1, KEYF) do { x[0] = KEYF((v0)[0] + (v1)[0], 0); x[1] = KEYF((v0)[0] + (v1)[1], 1); x[2] = KEYF((v0)[0] + (v1)[2], 2); x[3] = KEYF((v0)[0] + (v1)[3], 3); x[4] = KEYF((v0)[0] + (v1)[4], 4); x[5] = KEYF((v0)[0] + (v1)[5], 5); x[6] = KEYF((v0)[0] + (v1)[6], 6); x[7] = KEYF((v0)[0] + (v1)[7], 7); x[8] = KEYF((v0)[0] + (v1)[8], 8); x[9] = KEYF((v0)[0] + (v1)[9], 9); x[10] = KEYF((v0)[0] + (v1)[10], 10); x[11] = KEYF((v0)[0] + (v1)[11], 11); x[12] = KEYF((v0)[0] + (v1)[12], 12); x[13] = KEYF((v0)[0] + (v1)[13], 13); x[14] = KEYF((v0)[0] + (v1)[14], 14); x[15] = KEYF((v0)[0] + (v1)[15], 15); x[16] = KEYF((v0)[1] + (v1)[0], 16); x[17] = KEYF((v0)[1] + (v1)[1], 17); x[18] = KEYF((v0)[1] + (v1)[2], 18); x[19] = KEYF((v0)[1] + (v1)[3], 19); x[20] = KEYF((v0)[1] + (v1)[4], 20); x[21] = KEYF((v0)[1] + (v1)[5], 21); x[22] = KEYF((v0)[1] + (v1)[6], 22); x[23] = KEYF((v0)[1] + (v1)[7], 23); x[24] = KEYF((v0)[2] + (v1)[0], 24); x[25] = KEYF((v0)[2] + (v1)[1], 25); x[26] = KEYF((v0)[2] + (v1)[2], 26); x[27] = KEYF((v0)[2] + (v1)[3], 27); x[28] = KEYF((v0)[2] + (v1)[4], 28); x[29] = KEYF((v0)[3] + (v1)[0], 29); x[30] = KEYF((v0)[3] + (v1)[1], 30); x[31] = KEYF((v0)[3] + (v1)[2], 31); x[32] = KEYF((v0)[3] + (v1)[3], 32); x[33] = KEYF((v0)[4] + (v1)[0], 33); x[34] = KEYF((v0)[4] + (v1)[1], 34); x[35] = KEYF((v0)[4] + (v1)[2], 35); x[36] = KEYF((v0)[5] + (v1)[0], 36); x[37] = KEYF((v0)[5] + (v1)[1], 37); x[38] = KEYF((v0)[6] + (v1)[0], 38); x[39] = KEYF((v0)[6] + (v1)[1], 39); x[40] = KEYF((v0)[7] + (v1)[0], 40); x[41] = KEYF((v0)[7] + (v1)[1], 41); x[42] = KEYF((v0)[8] + (v1)[0], 42); x[43] = KEYF((v0)[9] + (v1)[0], 43); x[44] = KEYF((v0)[10] + (v1)[0], 44); x[45] = KEYF((v0)[11] + (v1)[0], 45); x[46] = KEYF((v0)[12] + (v1)[0], 46); x[47] = KEYF((v0)[13] + (v1)[0], 47); x[48] = KEYF((v0)[14] + (v1)[0], 48); x[49] = KEYF((v0)[15] + (v1)[0], 49); x[50] = (int)0x80000000; x[51] = (int)0x80000000; x[52] = (int)0x80000000; x[53] = (int)0x80000000; x[54] = (int)0x80000000; x[55] = (int)0x80000000; x[56] = (int)0x80000000; x[57] = (int)0x80000000; x[58] = (int)0x80000000; x[59] = (int)0x80000000; x[60] = (int)0x80000000; x[61] = (int)0x80000000; x[62] = (int)0x80000000; x[63] = (int)0x80000000; } while (0)

__device__ __forceinline__ int crow(int r, int hi) { return (r & 3) + 8 * (r >> 2) + 4 * hi; }
__device__ __forceinline__ int f2key(float f) { const int t = __builtin_bit_cast(int, f); return t ^ ((t >> 31) & 0x7fffffff); }
__device__ __forceinline__ float key2f(int t) { return __builtin_bit_cast(float, t ^ ((t >> 31) & 0x7fffffff)); }
__device__ __forceinline__ int sel_hi(int a, int b, int hm) { int r; asm("v_bfi_b32 %0, %1, %2, %3" : "=v"(r) : "v"(hm), "v"(b), "v"(a)); return r; }
__device__ __forceinline__ float fsel(float a, float b, int m) { return __int_as_float(sel_hi(__float_as_int(a), __float_as_int(b), m)); }
typedef float f32x2 __attribute__((ext_vector_type(2)));
__device__ __forceinline__ int key7(float f, int low) { return (f2key(f) & ~127) | low; }
__device__ __forceinline__ int key6(float f, int ord) { return (f2key(f) & ~63) | (63 - ord); }
__device__ __forceinline__ void top16_of_64(int (&x)[64]) {
    PEER_SORT16(x, 0); PEER_SORT16(x, 16); PEER_SORT16(x, 32); PEER_SORT16(x, 48);
    PEER_MERGE16(x, 0, 16); PEER_MERGE16(x, 32, 48); PEER_MERGE16(x, 0, 32);
}
__device__ __forceinline__ float dot2_bf16(unsigned w, unsigned x, float acc) { return __builtin_amdgcn_fdot2_f32_bf16(__builtin_bit_cast(bf16x2_t, w), __builtin_bit_cast(bf16x2_t, x), acc, false); }
__device__ __forceinline__ float dot8(const u32x4 a, const u32x4 b, float acc) {
    acc = dot2_bf16(a.x, b.x, acc); acc = dot2_bf16(a.y, b.y, acc); acc = dot2_bf16(a.z, b.z, acc); acc = dot2_bf16(a.w, b.w, acc); return acc;
}
__device__ __forceinline__ float gelu_tanh(float x) {
    const float u = 0.7978845608028654f * (x + 0.044715f * x * x * x);
    const float e = __builtin_amdgcn_exp2f(2.0f * LOG2E * u);
    const float th = 1.0f - 2.0f * __builtin_amdgcn_rcpf(e + 1.0f);
    return 0.5f * x * (1.0f + th);
}
__device__ __forceinline__ void topk_half(const bf16* qp, const bf16* sp, int hi, int (&T)[16]) {
    bf16x8 qf[8];
#pragma unroll
    for (int ks = 0; ks < 8; ++ks) qf[ks] = *(const GAS bf16x8*)(qp + ks * 16);
    const int hi4 = hi << 2;
    int x[64];
#pragma unroll
    for (int kt = 0; kt < 4; ++kt) { f32x16 sc = f32x16{};
#pragma unroll
        for (int ks = 0; ks < 8; ++ks) { const bf16x8 a = *(const GAS bf16x8*)(sp + (size_t)(32 * kt) * 128 + ks * 16); sc = __builtin_amdgcn_mfma_f32_32x32x16_bf16(a, qf[ks], sc, 0, 0, 0); }
#pragma unroll
        for (int r = 0; r < 16; ++r) x[16 * kt + r] = ((f2key(sc[r]) & ~127) | (127 - (32 * kt + crow(r, 0)))) ^ hi4; }
    top16_of_64(x);
#pragma unroll
    for (int i = 0; i < 16; ++i) { auto rr = __builtin_amdgcn_permlane32_swap((unsigned)x[i], (unsigned)x[i], false, false); x[i] = (int)rr[0]; x[16 + i] = (int)rr[1]; }
    PEER_MERGE16(x, 0, 16);
#pragma unroll
    for (int i = 0; i < 16; ++i) T[i] = x[i];
}
__device__ __forceinline__ float fp8dot4(unsigned w, float h0, float h1, float h2, float h3) {
    const f32x2 lo = __builtin_amdgcn_cvt_pk_f32_fp8((int)w, false), hi = __builtin_amdgcn_cvt_pk_f32_fp8((int)w, true);
    return (lo.x * h0 + lo.y * h1) + (hi.x * h2 + hi.y * h3);
}
__device__ __forceinline__ float fp8dot16(const u32x4 u, const float (&h)[16]) {
    return (fp8dot4(u.x, h[0], h[1], h[2], h[3]) + fp8dot4(u.y, h[4], h[5], h[6], h[7])) + (fp8dot4(u.z, h[8], h[9], h[10], h[11]) + fp8dot4(u.w, h[12], h[13], h[14], h[15]));
}
__device__ __forceinline__ void fp8axpy4(unsigned w, float c, float& a0, float& a1, float& a2, float& a3) {
    const f32x2 lo = __builtin_amdgcn_cvt_pk_f32_fp8((int)w, false), hi = __builtin_amdgcn_cvt_pk_f32_fp8((int)w, true);
    a0 += c * lo.x; a1 += c * lo.y; a2 += c * hi.x; a3 += c * hi.y;
}
__device__ __forceinline__ void fp8axpy16(const u32x4 v, float c, float (&a)[16]) {
    fp8axpy4(v.x, c, a[0], a[1], a[2], a[3]); fp8axpy4(v.y, c, a[4], a[5], a[6], a[7]); fp8axpy4(v.z, c, a[8], a[9], a[10], a[11]); fp8axpy4(v.w, c, a[12], a[13], a[14], a[15]);
}
constexpr int L_ROUTE = 0, L_NLIST = 32768, L_CAND = 40960, L_COEF = 41472, L_END = 45568;
__device__ __forceinline__ void peer_tile(int tile, const bf16* PQ, const bf16* SK, const float* SSQ, const unsigned char* U8, const unsigned char* V8, const float* gfin, float* out, LAS unsigned char* lds) {
    const int lane = threadIdx.x & 63, r32 = lane & 31, hi = lane >> 5; const int wid = __builtin_amdgcn_readfirstlane((int)threadIdx.x >> 6);
    const int tok0 = tile * 32;
    LAS unsigned* route = (LAS unsigned*)(lds + L_ROUTE);
    LAS unsigned char* nl = lds + L_NLIST + (wid * 32 + r32) * 32;
    const LAS unsigned char* cand = lds + L_CAND;
    {
        const int h = wid; int T0[16], T1[16];
        topk_half(PQ + (size_t)(tok0 + r32) * NPQ + (h * 2 + 0) * 128 + hi * 8, SK + ((size_t)(h * 2 + 0) * 128 + r32) * 128 + hi * 8, hi, T0);
        topk_half(PQ + (size_t)(tok0 + r32) * NPQ + (h * 2 + 1) * 128 + hi * 8, SK + ((size_t)(h * 2 + 1) * 128 + r32) * 128 + hi * 8, hi, T1);
        const int hm = -hi;
        {
            u32x4 w;
#pragma unroll
            for (int q4 = 0; q4 < 4; ++q4) { unsigned a = 0;
#pragma unroll
                for (int e = 0; e < 4; ++e) { const int t = sel_hi(T0[4 * q4 + e], T1[4 * q4 + e], hm); a |= (unsigned)(127 - (t & 127)) << (8 * e); }
                w[q4] = a; }
            *(LAS u32x4*)(nl + 16 * hi) = w;
        }
        float v0[16], v1[16];
#pragma unroll
        for (int i = 0; i < 16; ++i) { v0[i] = key2f(T0[i] & ~127); v1[i] = key2f(T1[i] & ~127); }
        int x[64];
        PEER_CAND_SUMS(x, v0, v1, key6);
        top16_of_64(x);
        const float smax = key2f(x[0] & ~63);
        float p[16], ps = 0.f;
#pragma unroll
        for (int i = 0; i < 16; ++i) { p[i] = __builtin_amdgcn_exp2f((key2f(x[i] & ~63) - smax) * LOG2E); ps += p[i]; }
        const float rps = 1.0f / ps;
        LDS_WAIT();
#pragma unroll
        for (int i = 0; i < 8; ++i) {
            const int xi = sel_hi(x[i], x[8 + i], hm); const float g = __int_as_float(sel_hi(__float_as_int(p[i]), __float_as_int(p[8 + i]), hm)) * rps;
            const int ij = cand[63 - (xi & 63)]; const int n0 = nl[ij & 15], n1 = nl[16 + (ij >> 4)];
            u32x2 w; w.x = (unsigned)(n0 * 128 + n1); w.y = __float_as_uint(g);
            *(LAS u32x2*)(route + ((size_t)r32 * 128 + h * 16 + 8 * hi + i) * 2) = w; }
    }
    LDS_WAIT(); __syncthreads();
    const int m0 = -(lane & 1), m1 = -((lane >> 1) & 1);
    const int jj = ((lane & 1) << 1) | ((lane >> 1) & 1);
#pragma unroll 1
    for (int tt = 0; tt < 4; ++tt) {
        const int tl = wid * 4 + tt; const size_t tok = (size_t)tok0 + tl;
        const LAS unsigned* rt = route + tl * 256;
        float* orow = out + tok * 1024;
        float rstd;
        { const f32x4* sp = (const f32x4*)(SSQ + tok * 16); const f32x4 a = sp[0], b = sp[1], c = sp[2], d = sp[3]; const f32x4 t = (a + b) + (c + d);
          rstd = __builtin_amdgcn_rsqf(((t[0] + t[1]) + (t[2] + t[3])) * (1.0f / 1024.0f) + RMS_EPS); }
        float hr[16];
        { const float sc = rstd * (1.0f / 256.0f);
#pragma unroll
          for (int q = 0; q < 4; ++q) { const f32x4 t = *(const GAS f32x4*)(orow + lane * 16 + q * 4); hr[4 * q] = t.x * sc; hr[4 * q + 1] = t.y * sc; hr[4 * q + 2] = t.z * sc; hr[4 * q + 3] = t.w * sc; } }
        float acc[16];
#pragma unroll
        for (int i = 0; i < 16; ++i) acc[i] = 0.f;
        u32x4 uA[4], vA[4], uB[4], vB[4];
#define PEER_LOAD(U_, V_, k0_) do { _Pragma("unroll") for (int j = 0; j < 4; ++j) { const int e = __builtin_amdgcn_readfirstlane((int)rt[((k0_) + j) * 2]); \
            U_[j] = *(const GAS u32x4*)(U8 + (size_t)e * 1024 + lane * 16); V_[j] = *(const GAS u32x4*)(V8 + (size_t)e * 1024 + lane * 16); } } while (0)
#define PEER_COMPUTE(U_, V_, k0_) do { float d_[4]; \
            _Pragma("unroll") for (int j = 0; j < 4; ++j) d_[j] = fp8dot16(U_[j], hr); \
            float e_[2]; \
            _Pragma("unroll") for (int i = 0; i < 2; ++i) { const float keep = fsel(d_[i], d_[i + 2], m0), send = fsel(d_[i + 2], d_[i], m0); e_[i] = keep + __shfl_xor(send, 1); } \
            float g_ = fsel(e_[0], e_[1], m1) + __shfl_xor(fsel(e_[1], e_[0], m1), 2); \
            g_ += __shfl_xor(g_, 4); g_ += __shfl_xor(g_, 8); g_ += __shfl_xor(g_, 16); g_ += __shfl_xor(g_, 32); \
            const float cfl = __uint_as_float(rt[((k0_) + jj) * 2 + 1]) * gelu_tanh(g_) * (1.0f / 16.0f); \
            _Pragma("unroll") for (int j = 0; j < 4; ++j) { const int src = ((j & 1) << 1) | ((j >> 1) & 1); \
                const float cj = __int_as_float(__builtin_amdgcn_readlane(__float_as_int(cfl), src)); \
                fp8axpy16(V_[j], cj, acc); } } while (0)
        PEER_LOAD(uA, vA, 0);
#pragma unroll 1
        for (int k0 = 0; k0 < 128; k0 += 8) {
            PEER_LOAD(uB, vB, k0 + 4);
            PEER_COMPUTE(uA, vA, k0);
            PEER_LOAD(uA, vA, (k0 + 8) & 127);
            PEER_COMPUTE(uB, vB, k0 + 4);
        }
#undef PEER_LOAD
#undef PEER_COMPUTE
        float hv[16]; float s = 0.f;
#pragma unroll
        for (int q = 0; q < 4; ++q) { const f32x4 t = *(const GAS f32x4*)(orow + lane * 16 + q * 4);
            hv[4 * q] = t.x + acc[4 * q]; hv[4 * q + 1] = t.y + acc[4 * q + 1]; hv[4 * q + 2] = t.z + acc[4 * q + 2]; hv[4 * q + 3] = t.w + acc[4 * q + 3];
            s += (hv[4 * q] * hv[4 * q] + hv[4 * q + 1] * hv[4 * q + 1]) + (hv[4 * q + 2] * hv[4 * q + 2] + hv[4 * q + 3] * hv[4 * q + 3]); }
        const float rs = 1.0f / sqrtf(wave_sum(s) * (1.f / 1024.f) + RMS_EPS);
#pragma unroll
        for (int q = 0; q < 4; ++q) { const f32x4 g = *(const GAS f32x4*)(gfin + lane * 16 + q * 4); f32x4 t;
            t.x = hv[4 * q] * rs * g.x; t.y = hv[4 * q + 1] * rs * g.y; t.z = hv[4 * q + 2] * rs * g.z; t.w = hv[4 * q + 3] * rs * g.w;
            *(GAS f32x4*)(orow + lane * 16 + q * 4) = t; }
    }
    LDS_WAIT(); __syncthreads();
}
}
struct Args { const float* in[20]; float* out; unsigned char* ws; int ph_lo, ph_hi, li, pad; };
__global__ void __launch_bounds__(NWAVES * 64, 2) fwd_megakernel(Args args) {
    extern __shared__ __attribute__((aligned(16))) unsigned char lds[];
    LAS unsigned char* ldsp = (LAS unsigned char*)lds;
    volatile LAS unsigned* MISC = (volatile LAS unsigned*)(ldsp + MISC_OFF);
    const int tid = threadIdx.x, lane = tid & 63, wave = __builtin_amdgcn_readfirstlane(tid >> 6);
    const int G = gridDim.x; const int bx = blockIdx.x; const int vcu = (G % 8 == 0) ? (bx % 8) * (G / 8) + bx / 8 : bx;
    unsigned char* ws = args.ws;
    gu32* ctl = (gu32*)(ws + WS_CTL);
    const float* x = args.in[0]; const float* mem = args.in[1]; const float* norm_mix = args.in[2]; const float* w_in = args.in[3]; const float* conv_w = args.in[4];
    const float* w_ba = args.in[5]; const float* w_bc = args.in[6]; const float* w_out = args.in[7]; const float* norm_xattn = args.in[8]; const float* norm_mem = args.in[9];
    const float* xwq = args.in[10]; const float* xwk = args.in[11]; const float* xwv = args.in[12]; const float* xwo = args.in[13]; const float* norm_ffn = args.in[14];
    const float* pwq = args.in[15]; const float* psk = args.in[16]; const float* pu = args.in[17]; const float* pv = args.in[18]; const float* norm_final = args.in[19];
    float* out = args.out;
    bf16* Win_t = (bf16*)(ws + WS_WIN); bf16* Wa_t = (bf16*)(ws + WS_WA); bf16* Wc_t = (bf16*)(ws + WS_WC); bf16* Wo_t = (bf16*)(ws + WS_WO); bf16* Wq2_t = (bf16*)(ws + WS_WQ2);
    bf16* Wkv2_t = (bf16*)(ws + WS_WKV2); bf16* Wo2_t = (bf16*)(ws + WS_WO2); bf16* Wpq_t = (bf16*)(ws + WS_WPQ); bf16* SKb = (bf16*)(ws + WS_SK);
    float* SSQ1 = (float*)(ws + WS_SSQ1); float* SSQ2 = (float*)(ws + WS_SSQ2); bf16* MEMN = (bf16*)(ws + WS_MEMN); bf16* K2 = (bf16*)(ws + WS_K2); bf16* V2T = (bf16*)(ws + WS_V2T);
    bf16* B0 = (bf16*)(ws + WS_B0); bf16* B1 = (bf16*)(ws + WS_B1); bf16* B2 = (bf16*)(ws + WS_B2); bf16* B3 = (bf16*)(ws + WS_B3); bf16* B4 = (bf16*)(ws + WS_B4); bf16* B5 = (bf16*)(ws + WS_B5);
    bf16* XN1 = (bf16*)out; bf16* YC = (bf16*)out; bf16* CBb = (bf16*)((unsigned char*)out + 32 * MiB);

    for (int u = tid; u < (LDS_BYTES - LDSCTL_OFF) / 4; u += NWAVES * 64) ((LAS unsigned*)(ldsp + LDSCTL_OFF))[u] = 0u;
    __syncthreads();
    XcdBarrier bar; bar.bar = (unsigned*)(ctl + CW_BAR); bar.x = 0; bar.st = nullptr;
    if (N_LAUNCHES == 1) bar = xcd_barrier_post((unsigned*)(ctl + CW_BAR), MISC + 8);
#define GRID_BAR() do { if (N_LAUNCHES == 1) xcd_barrier(bar); } while (0)
    const int lo = args.ph_lo, hi = args.ph_hi;
#define IN(k) (lo <= (k) && (k) < hi)
#define BOTH(k) (IN(k) && IN((k) + 1))
    const int gw = vcu * NWAVES + wave, NGW = G * NWAVES;

    if (IN(0)) {
        LAS float* scr = (LAS float*)(ldsp + RING_OFF + wave * 16384);
        constexpr int I_IN = 16 * 256, I_SQ = 16 * 32, I_PQ = 16 * 64;
        constexpr int NT_ITEMS = I_IN + 7 * I_SQ + I_PQ;
        for (int it = gw; it < NT_ITEMS; it += NGW) {
            int r = it;
            if (r < I_IN) { transpose_item<true>(w_in, D, NIN, nullptr, Win_t, 0, scr, r, lane); continue; } r -= I_IN;
            if (r < I_SQ) { transpose_item<false>(w_ba, D, D, nullptr, Wa_t, 0, scr, r, lane); continue; } r -= I_SQ;
            if (r < I_SQ) { transpose_item<false>(w_bc, D, D, nullptr, Wc_t, 0, scr, r, lane); continue; } r -= I_SQ;
            if (r < I_SQ) { transpose_item<false>(w_out, D, D, nullptr, Wo_t, 0, scr, r, lane); continue; } r -= I_SQ;
            if (r < I_SQ) { transpose_item<false>(xwq, D, D, norm_xattn, Wq2_t, 0, scr, r, lane); continue; } r -= I_SQ;
            if (r < I_SQ) { transpose_item<false>(xwk, D, D, nullptr, Wkv2_t, 0, scr, r, lane); continue; } r -= I_SQ;
            if (r < I_SQ) { transpose_item<false>(xwv, D, D, nullptr, Wkv2_t, D, scr, r, lane); continue; } r -= I_SQ;
            if (r < I_SQ) { transpose_item<false>(xwo, D, D, nullptr, Wo2_t, 0, scr, r, lane); continue; } r -= I_SQ;
            transpose_item<false>(pwq, D, NPQ, norm_ffn, Wpq_t, 0, scr, r, lane);
        }
        for (int it = gw; it < 512; it += NGW) {
            const GAS f32x4* s = (const GAS f32x4*)psk + (size_t)it * 128 + lane * 2; const f32x4 a = s[0], b = s[1];
            v4u o; o.x = pk2(a.x, a.y); o.y = pk2(a.z, a.w); o.z = pk2(b.x, b.y); o.w = pk2(b.z, b.w);
            *((GAS v4u*)SKb + (size_t)it * 64 + lane) = o; }
        for (int m = gw; m < M; m += NGW) rms_row_to_bf16(x + (size_t)m * D, norm_mix, XN1 + (size_t)m * D, lane);
        for (int m = gw; m < MROWS; m += NGW) rms_row_to_bf16(mem + (size_t)m * D, norm_mem, MEMN + (size_t)m * D, lane);
        if (BOTH(0)) GRID_BAR();
    }

    if (IN(1)) {
        pg8::GemmSet g{XN1, Win_t, XN1, Win_t, D}; pg8::TileOrder S; S.init(M, NIN, G, bx);
        pg8::EpiInProj E{B0, B1, B2, B3, CBb, B4, B5, 0.125f * LOG2E};
        pg8::gemm_phase<pg8::EpiInProj, pg8::TileOrder, true, true>(ldsp + RING_OFF, g, S, E);
        if (BOTH(1)) GRID_BAR();
    }

    if (IN(2)) {
        {
            const int bh = vcu >> 1, s = vcu & 1;
            if (bh < BATCH * 16) {
#pragma unroll 1
                for (int i = 0; i < 4; ++i) { const int qb = (i == 0) ? s : (i == 1) ? 7 - s : (i == 2) ? 2 + s : 5 - s;
                    sb::sb_unit<true>(bh >> 4, bh & 15, qb, (const sb::bf16*)B0, (const sb::bf16*)B1, (const sb::bf16*)B2, (sb::bf16*)B0, (char*)lds + RING_OFF); }
            }
            asm volatile("s_waitcnt vmcnt(0) lgkmcnt(0)" ::: "memory"); __syncthreads();
        }
        if (vcu < 32) {
            pg8::GemmSet g{MEMN, Wkv2_t, MEMN, Wkv2_t, D}; pg8::SubOrder S; S.init(MROWS, D, 0, vcu);
            pg8::EpiStore E{K2, D, 1.0f};
            pg8::gemm_phase<pg8::EpiStore, pg8::SubOrder, false, true>(ldsp + RING_OFF, g, S, E);
        } else if (vcu < 64) {
            pg8::GemmSet g{Wkv2_t + (size_t)D * D, MEMN, Wkv2_t + (size_t)D * D, MEMN, D}; pg8::SubOrder S; S.init(D, MROWS, 32, vcu);
            pg8::EpiStore E{V2T, MROWS, 1.0f};
            pg8::gemm_phase<pg8::EpiStore, pg8::SubOrder, false, true>(ldsp + RING_OFF, g, S, E);
        } else {
            const int cw_ = (vcu - 64) * NWAVES + wave, ncw = (G - 64) * NWAVES;
            for (int it = cw_; it < M / 8; it += ncw) yconv_item(B3, CBb, conv_w, YC, it, lane);
        }
        if (BOTH(2)) GRID_BAR();
    }

    if (IN(3)) {
        pg8::GemmSet g{B0, Wa_t, YC, Wc_t, D}; pg8::TileOrder S; S.init(M, D, G, bx, 2);
        pg8::EpiGate E{B1, B4, B5};
        pg8::gemm_phase<pg8::EpiGate, pg8::TileOrder, true, true>(ldsp + RING_OFF, g, S, E);
        if (BOTH(3)) GRID_BAR();
    }

    if (IN(4)) {
        pg8::GemmSet g{B1, Wo_t, B1, Wo_t, D}; pg8::TileOrder S; S.init(M, D, G, bx);
        pg8::EpiResid E{x, out, B2, SSQ1};
        pg8::gemm_phase<pg8::EpiResid, pg8::TileOrder, true, true>(ldsp + RING_OFF, g, S, E);
        if (BOTH(4)) GRID_BAR();
    }

    if (IN(5)) {
        pg8::GemmSet g{B2, Wq2_t, B2, Wq2_t, D}; pg8::TileOrder S; S.init(M, D, G, bx);
        pg8::EpiRowScale E{B3, D, SSQ1, LOG2E / 16.0f, RMS_EPS};
        pg8::gemm_phase<pg8::EpiRowScale, pg8::TileOrder, true, true>(ldsp + RING_OFF, g, S, E);
        for (int r = gw; r < 2 * 16384; r += NGW) {
            if (r < 16384) row_to_fp8(pu + (size_t)r * D, norm_ffn, 256.0f, (unsigned char*)B4 + (size_t)r * D, lane);
            else row_to_fp8(pv + (size_t)(r - 16384) * D, nullptr, 16.0f, (unsigned char*)B4 + 16 * MiB + (size_t)(r - 16384) * D, lane); }
        if (BOTH(5)) GRID_BAR();
    }

    if (IN(6)) {
#ifndef NO_XA
        for (int u = vcu; u < 256; u += G) xa::xattn_unit(u >> 5, (u >> 3) & 3, u & 7, B3, K2, V2T, B0, ldsp + RING_OFF + wave * 16384);
#endif
        if (BOTH(6)) GRID_BAR();
    }

    if (IN(7)) {
        pg8::GemmSet g{B0, Wo2_t, B0, Wo2_t, D}; pg8::TileOrder S; S.init(M, D, G, bx);
        pg8::EpiResid E{out, out, B1, SSQ2};
        pg8::gemm_phase<pg8::EpiResid, pg8::TileOrder, true, true>(ldsp + RING_OFF, g, S, E);
        if (BOTH(7)) GRID_BAR();
    }

    if (IN(8)) {
        pg8::GemmSet g{B1, Wpq_t, B1, Wpq_t, D}; pg8::TileOrder S; S.init(M, NPQ, G, bx);
        pg8::EpiRowScale E{B2, NPQ, SSQ2, 1.0f, RMS_EPS};
        pg8::gemm_phase<pg8::EpiRowScale, pg8::TileOrder, true, true>(ldsp + RING_OFF, g, S, E);
        if (BOTH(8)) GRID_BAR();
    }

    if (IN(9)) {
        if (tid < 64) { int cnt = 0, val = 0;
            for (int ii = 0; ii < 16; ++ii) { const int nj = 16 / (ii + 1); if (tid >= cnt && tid < cnt + nj) val = ii | ((tid - cnt) << 4); cnt += nj; }
            ldsp[RING_OFF + peer::L_CAND + tid] = (unsigned char)val; }
        LDS_WAIT(); __syncthreads();
#ifndef NO_PEER
        for (int tile = vcu; tile < M / 32; tile += G) peer::peer_tile(tile, B2, SKb, SSQ2, (const unsigned char*)B4, (const unsigned char*)B4 + 16 * MiB, norm_final, out, ldsp + RING_OFF);
#else
        for (int m = gw; m < M; m += NGW) final_norm_row(out + (size_t)m * D, norm_final, out + (size_t)m * D, lane);
#endif
    }
#undef IN
#undef BOTH
#undef GRID_BAR
}

extern "C" void kernel_launch(void* const* d_in, const int* in_sizes, int n_in, void* d_out, int out_size, void* d_ws, size_t ws_size, hipStream_t stream) {
    static int grid = 0;
    if (grid == 0) {
        if (n_in != 20 || in_sizes[0] != M * D || out_size != M * D || ws_size < WS_END) { fprintf(stderr, "kernel_launch: unexpected shapes (n_in %d, in0 %d, out %d, ws %zu); nothing launched\n", n_in, n_in > 0 ? in_sizes[0] : -1, out_size, ws_size); grid = -1; return; }
        int dev = 0, cus = 0, per_cu = 0;
        if (hipGetDevice(&dev) != hipSuccess || hipDeviceGetAttribute(&cus, hipDeviceAttributeMultiprocessorCount, dev) != hipSuccess) { grid = -1; return; }
        if (hipFuncSetAttribute((const void*)fwd_megakernel, hipFuncAttributeMaxDynamicSharedMemorySize, LDS_BYTES) != hipSuccess) { fprintf(stderr, "kernel_launch: hipFuncSetAttribute failed\n"); grid = -1; return; }
        if (hipOccupancyMaxActiveBlocksPerMultiprocessor(&per_cu, (const void*)fwd_megakernel, NWAVES * 64, LDS_BYTES) != hipSuccess || per_cu < 1)
            fprintf(stderr, "kernel_launch: note: occupancy query reports %d workgroups per CU\n", per_cu);
        (void)hipGetLastError();
        grid = cus;
    }
    if (grid < 0) return;
    if (hipMemsetAsync((char*)d_ws + WS_CTL, 0, CTL_ZERO_BYTES, stream) != hipSuccess) { fprintf(stderr, "kernel_launch: hipMemsetAsync failed\n"); return; }
    Args a{};
    for (int i = 0; i < 20; ++i) a.in[i] = (const float*)d_in[i];
    a.out = (float*)d_out; a.ws = (unsigned char*)d_ws;
    if (N_LAUNCHES == 1) { a.ph_lo = 0; a.ph_hi = N_PHASES; a.li = 0; hipLaunchKernelGGL(fwd_megakernel, dim3(grid), dim3(NWAVES * 64), LDS_BYTES, stream, a); }
    else for (int li = 0; li < N_PHASES; ++li) { a.ph_lo = li; a.ph_hi = li + 1; a.li = li; hipLaunchKernelGGL(fwd_megakernel, dim3(grid), dim3(NWAVES * 64), LDS_BYTES, stream, a);
#ifdef PROBE_DUP
        if (li == PROBE_DUP) hipLaunchKernelGGL(fwd_megakernel, dim3(grid), dim3(NWAVES * 64), LDS_BYTES, stream, a);
#endif
    }
    const hipError_t le = hipPeekAtLastError();
    if (le != hipSuccess) fprintf(stderr, "kernel_launch: launch failed: %s\n", hipGetErrorName(le));
}
```

```cpp
#include <hip/hip_runtime.h>
#include <hip/hip_bf16.h>
#include <cstdio>
#include <cstdint>
#include <cmath>

#ifndef MK_N_LAUNCHES
#define MK_N_LAUNCHES 1
#endif
namespace pg8 {
#define PG8_LAS __attribute__((address_space(3)))
typedef unsigned short bf16_t;
typedef short bf16x8 __attribute__((ext_vector_type(8)));
typedef float f32x4 __attribute__((ext_vector_type(4)));
typedef float f32x2 __attribute__((ext_vector_type(2)));
typedef unsigned u32x4 __attribute__((ext_vector_type(4)));
typedef unsigned u32x2 __attribute__((ext_vector_type(2)));
constexpr int BM = 256, BK = 64, HALF = 128, HTB = HALF * BK * 2  , STAGE_BYTES = 8 * HTB, NXCD = 8, WGM = 8;

__host__ __device__ __forceinline__ int lds_byte(int r, int c) { const int st = (r >> 4) * 2 + (c >> 5), rr = r & 15, cc = c & 31, ob = rr * 64 + cc * 2; return st * 1024 + (ob ^ (((ob >> 9) & 1) << 5)); }
__host__ __device__ __forceinline__ void stage_rc(int b, int& R, int& C) { const int st = b / 1024, sb = b % 1024, swz = sb ^ (((sb >> 9) & 1) << 5); R = (st >> 1) * 16 + swz / 64; C = (st & 1) * 32 + (swz % 64) / 2; }
__host__ __device__ __forceinline__ int perm32(int rho) { const int n = rho >> 4, i = rho & 15; return 8 * (i >> 2) + 4 * n + (i & 3); }

struct Unit { int pm, pn, g; };
struct GemmSet { const bf16_t* A0; const bf16_t* B0; const bf16_t* A1; const bf16_t* B1; int K; };

struct TileOrder {
    int nM, nN, nwg, G, c, passes;
    __device__ void init(int M, int N, int G_, int c_, int passes_ = 1) { nM = M / BM; nN = N / BM; nwg = nM * nN; G = G_; c = c_; passes = passes_; }
    __device__ bool next(int i, Unit& u) const {
        const int ti = (passes == 2) ? (i >> 1) : i; u.g = (passes == 2) ? (i & 1) : 0;
        const long L = (long)ti * G + c; if (L >= nwg) return false;
        int wgid = (int)L; { const int q = nwg / NXCD, r = nwg % NXCD, xcd = wgid % NXCD, off = wgid / NXCD; wgid = (xcd < r ? xcd * (q + 1) : r * (q + 1) + (xcd - r) * q) + off; }
        const int nig = WGM * nN, gid = wgid / nig, fm = gid * WGM, gsz = (nM - fm) < WGM ? (nM - fm) : WGM;
        u.pm = fm + ((wgid % nig) % gsz); u.pn = (wgid % nig) / gsz; return true;
    }
    __device__ __forceinline__ void a_ready(const Unit&) const {}
    __device__ __forceinline__ void done(const Unit&) const {}
};
struct SubOrder {
    int nN, n, idx;
    __device__ void init(int M, int N, int c0, int c_) { nN = N / BM; n = (M / BM) * nN; idx = c_ - c0; }
    __device__ bool next(int i, Unit& u) const { if (i != 0 || idx < 0 || idx >= n) return false; u.pm = idx / nN; u.pn = idx % nN; u.g = 0; return true; }
    __device__ __forceinline__ void a_ready(const Unit&) const {}
    __device__ __forceinline__ void done(const Unit&) const {}
};

typedef __bf16 bf16x2_t __attribute__((ext_vector_type(2)));
__device__ __forceinline__ unsigned cvt_pk_bf16(float lo, float hi) { f32x2 v = {lo, hi}; bf16x2_t b = __builtin_convertvector(v, bf16x2_t); return __builtin_bit_cast(unsigned, b); }
__device__ __forceinline__ float bf_lo(unsigned w) { return __builtin_bit_cast(float, w << 16); }
__device__ __forceinline__ float bf_hi(unsigned w) { return __builtin_bit_cast(float, w & 0xffff0000u); }
__device__ __forceinline__ u32x4 pack8(const f32x4 v0, const f32x4 v1) { u32x4 w; w.x = cvt_pk_bf16(v0[0], v0[1]); w.y = cvt_pk_bf16(v0[2], v0[3]); w.z = cvt_pk_bf16(v1[0], v1[1]); w.w = cvt_pk_bf16(v1[2], v1[3]); return w; }
__device__ __forceinline__ float sigmoidf_fast(float x) { return __builtin_amdgcn_rcpf(1.0f + __builtin_amdgcn_exp2f(-1.4426950408889634f * x)); }

struct EpiStore {
    static constexpr bool PERM = true, AFTER_DRAIN = false;
    bf16_t* O; int ldc; float scale;
    __device__ __forceinline__ void operator()(const f32x4 (&acc)[2][2][4][2], const Unit& u, int wr, int wc, int fr, int fq) const {
        const int row0 = u.pm * BM + wr * 64 + fr, col0 = u.pn * BM + wc * 32 + 8 * fq;
#pragma unroll
        for (int ai = 0; ai < 2; ++ai)
#pragma unroll
            for (int m = 0; m < 4; ++m) { bf16_t* rowp = O + (size_t)(row0 + ai * HALF + m * 16) * ldc + col0;
#pragma unroll
                for (int bj = 0; bj < 2; ++bj) *(u32x4*)(rowp + bj * HALF) = pack8(acc[ai][bj][m][0] * scale, acc[ai][bj][m][1] * scale); }
    }
};

struct EpiStoreKPerm {
    static constexpr bool PERM = true, AFTER_DRAIN = false;
    bf16_t* O; int ldc;
    __device__ __forceinline__ void operator()(const f32x4 (&acc)[2][2][4][2], const Unit& u, int wr, int wc, int fr, int fq) const {
        const int row0 = u.pm * BM + wr * 64 + fr, colg = u.pn * BM + wc * 32;
#pragma unroll
        for (int ai = 0; ai < 2; ++ai)
#pragma unroll
            for (int m = 0; m < 4; ++m) { bf16_t* rowp = O + (size_t)(row0 + ai * HALF + m * 16) * ldc + colg;
#pragma unroll
                for (int bj = 0; bj < 2; ++bj)
#pragma unroll
                    for (int n = 0; n < 2; ++n) { const f32x4 v = acc[ai][bj][m][n]; u32x2 w; w.x = cvt_pk_bf16(v[0], v[1]); w.y = cvt_pk_bf16(v[2], v[3]);
                        *(u32x2*)(rowp + bj * HALF + 8 * ((2 * fq + n) & 3) + 4 * (fq >> 1)) = w; } }
    }
};

struct EpiInProj {
    static constexpr bool PERM = true, AFTER_DRAIN = false;
    bf16_t *q, *k, *v, *uu, *cb, *sga, *sgc; float qscale;
    __device__ __forceinline__ void operator()(const f32x4 (&acc)[2][2][4][2], const Unit& u, int wr, int wc, int fr, int fq) const {
        const int row0 = u.pm * BM + wr * 64 + fr; const int pn = u.pn;
        if (pn >= 12 && pn < 20) {
            const int col0 = (pn - 12) * 128 + wc * 32 + 8 * fq;
#pragma unroll
            for (int ai = 0; ai < 2; ++ai)
#pragma unroll
                for (int m = 0; m < 4; ++m) *(u32x4*)(uu + (size_t)(row0 + ai * HALF + m * 16) * 1024 + col0) = pack8(acc[ai][0][m][0] * acc[ai][1][m][0], acc[ai][0][m][1] * acc[ai][1][m][1]);
            return;
        }
        bf16_t* base; float sc = 1.f; bool sig = false;
        if (pn < 4) { base = q; sc = qscale; } else if (pn < 8) base = k; else if (pn < 12) base = v; else if (pn < 24) base = cb; else if (pn < 28) { base = sga; sig = true; } else { base = sgc; sig = true; }
        const int col0 = (pn & 3) * BM + wc * 32 + 8 * fq;
#pragma unroll
        for (int ai = 0; ai < 2; ++ai)
#pragma unroll
            for (int m = 0; m < 4; ++m) { bf16_t* rowp = base + (size_t)(row0 + ai * HALF + m * 16) * 1024 + col0;
#pragma unroll
                for (int bj = 0; bj < 2; ++bj) { f32x4 v0 = acc[ai][bj][m][0], v1 = acc[ai][bj][m][1];
                    if (sig) {
#pragma unroll
                        for (int e = 0; e < 4; ++e) { v0[e] = sigmoidf_fast(v0[e]); v1[e] = sigmoidf_fast(v1[e]); } }
                    else { v0 = v0 * sc; v1 = v1 * sc; }
                    *(u32x4*)(rowp + bj * HALF) = pack8(v0, v1); } }
    }
};

struct EpiGate {
    static constexpr bool PERM = true, AFTER_DRAIN = false;
    bf16_t* merged; const bf16_t* sga; const bf16_t* sgc;
    __device__ __forceinline__ void operator()(const f32x4 (&acc)[2][2][4][2], const Unit& u, int wr, int wc, int fr, int fq) const {
        const int row0 = u.pm * BM + wr * 64 + fr, col0 = u.pn * BM + wc * 32 + 8 * fq; const bf16_t* gate = u.g ? sgc : sga;
#pragma unroll
        for (int ai = 0; ai < 2; ++ai)
#pragma unroll
            for (int m = 0; m < 4; ++m) { const size_t off = (size_t)(row0 + ai * HALF + m * 16) * 1024 + col0;
#pragma unroll
                for (int bj = 0; bj < 2; ++bj) { const u32x4 gw = *(const u32x4*)(gate + off + bj * HALF);
                    f32x4 v0 = acc[ai][bj][m][0], v1 = acc[ai][bj][m][1];
                    v0[0] *= bf_lo(gw.x); v0[1] *= bf_hi(gw.x); v0[2] *= bf_lo(gw.y); v0[3] *= bf_hi(gw.y); v1[0] *= bf_lo(gw.z); v1[1] *= bf_hi(gw.z); v1[2] *= bf_lo(gw.w); v1[3] *= bf_hi(gw.w);
                    if (u.g) { const u32x4 pw = *(const u32x4*)(merged + off + bj * HALF);
                        v0[0] += bf_lo(pw.x); v0[1] += bf_hi(pw.x); v0[2] += bf_lo(pw.y); v0[3] += bf_hi(pw.y); v1[0] += bf_lo(pw.z); v1[1] += bf_hi(pw.z); v1[2] += bf_lo(pw.w); v1[3] += bf_hi(pw.w); }
                    *(u32x4*)(merged + off + bj * HALF) = pack8(v0, v1); } }
    }
};

struct EpiResid {
    static constexpr bool PERM = false, AFTER_DRAIN = false;
    const float* base; float* hf; bf16_t* hb; float* ssq;
    __device__ __forceinline__ void operator()(const f32x4 (&acc)[2][2][4][2], const Unit& u, int wr, int wc, int fr, int fq) const {
        const int row0 = u.pm * BM + wr * 64 + fr, col0 = u.pn * BM + wc * 32 + 4 * fq;
#pragma unroll
        for (int ai = 0; ai < 2; ++ai)
#pragma unroll
            for (int m = 0; m < 4; ++m) { const int row = row0 + ai * HALF + m * 16; const size_t off = (size_t)row * 1024 + col0; float s = 0.f;
#pragma unroll
                for (int bj = 0; bj < 2; ++bj)
#pragma unroll
                    for (int n = 0; n < 2; ++n) { const f32x4 b = *(const f32x4*)(base + off + bj * HALF + n * 16); const f32x4 h = b + acc[ai][bj][m][n];
                        *(f32x4*)(hf + off + bj * HALF + n * 16) = h; s += (h[0] * h[0] + h[1] * h[1]) + (h[2] * h[2] + h[3] * h[3]);
                        u32x2 w; w.x = cvt_pk_bf16(h[0], h[1]); w.y = cvt_pk_bf16(h[2], h[3]); *(u32x2*)(hb + off + bj * HALF + n * 16) = w; }
                s += __shfl_xor(s, 16); s += __shfl_xor(s, 32);
                if (fq == 0) ssq[(size_t)row * 16 + u.pn * 4 + wc] = s; }
    }
};

struct EpiRowScale {
    static constexpr bool PERM = true, AFTER_DRAIN = false;
    bf16_t* O; int ldc; const float* ssq; float scale; float eps;
    __device__ __forceinline__ void operator()(const f32x4 (&acc)[2][2][4][2], const Unit& u, int wr, int wc, int fr, int fq) const {
        const int row0 = u.pm * BM + wr * 64 + fr, col0 = u.pn * BM + wc * 32 + 8 * fq;
#pragma unroll
        for (int ai = 0; ai < 2; ++ai)
#pragma unroll
            for (int m = 0; m < 4; ++m) { const int row = row0 + ai * HALF + m * 16; const f32x4* sp = (const f32x4*)(ssq + (size_t)row * 16);
                const f32x4 a = sp[0], b = sp[1], c = sp[2], d = sp[3]; const f32x4 t = (a + b) + (c + d);
                const float rs = __builtin_amdgcn_rsqf(((t[0] + t[1]) + (t[2] + t[3])) * (1.0f / 1024.0f) + eps) * scale;
                bf16_t* rowp = O + (size_t)row * ldc + col0;
#pragma unroll
                for (int bj = 0; bj < 2; ++bj) *(u32x4*)(rowp + bj * HALF) = pack8(acc[ai][bj][m][0] * rs, acc[ai][bj][m][1] * rs); }
    }
};

template <class Epi, class Sched, bool ALIGN_EPI = false, bool SP2 = false>
__device__ __forceinline__ void gemm_phase(PG8_LAS unsigned char* lds, const GemmSet g, const Sched& S, const Epi& E) {
    const int tid = threadIdx.x, wid = __builtin_amdgcn_readfirstlane(tid >> 6), lane = tid & 63, wr = wid >> 2, wc = wid & 3, fr = lane & 15, fq = lane >> 4;
    const int K = g.K, nt = K / BK;
    unsigned voffA[2], voffB[2];
#pragma unroll
    for (int i = 0; i < 2; ++i) { int R, C; stage_rc(tid * 16 + i * 8192, R, C); const int Rb = Epi::PERM ? ((R & ~31) + perm32(R & 31)) : R;
        voffA[i] = (unsigned)(R * K + C) * 2u; voffB[i] = (unsigned)(Rb * K + C) * 2u; }
    const size_t kstep = (size_t)(BK * 2);
    const size_t hstep = (size_t)HALF * K * 2;
    const size_t tstep = 2 * hstep;
    const unsigned ldsw = (unsigned)wid * 1024u;
    const int aoff = lds_byte(wr * 64 + fr, fq * 8), boff = lds_byte(wc * 32 + fr, fq * 8);
#define PG8_SA(b, h) (((b) * 2 + (h)) * HTB)
#define PG8_SB(b, h) ((4 + (b) * 2 + (h)) * HTB)
#define PG8_STAGE(bufoff, gbase, voff) do { _Pragma("unroll") for (int _i = 0; _i < 2; ++_i) \
        __builtin_amdgcn_global_load_lds((const unsigned*)((const char*)(gbase) + (voff)[_i]), (PG8_LAS unsigned*)(lds + (bufoff) + ldsw + _i * 8192), 16, 0, 0); } while (0)
#define PG8_LDA(dst, b, h) do { _Pragma("unroll") for (int m = 0; m < 4; ++m) _Pragma("unroll") for (int k = 0; k < 2; ++k) dst[m][k] = *(const PG8_LAS bf16x8*)(lds + PG8_SA(b, h) + aoff + m * 2048 + k * 1024); } while (0)
#define PG8_LDB(dst, b, h) do { _Pragma("unroll") for (int n = 0; n < 2; ++n) _Pragma("unroll") for (int k = 0; k < 2; ++k) dst[n][k] = *(const PG8_LAS bf16x8*)(lds + PG8_SB(b, h) + boff + n * 2048 + k * 1024); } while (0)
#define PG8_MMA(ai, bj, At, Bt) do { __builtin_amdgcn_s_setprio(1); _Pragma("unroll") for (int m = 0; m < 4; ++m) _Pragma("unroll") for (int n = 0; n < 2; ++n) _Pragma("unroll") for (int k = 0; k < 2; ++k) \
        acc[ai][bj][m][n] = __builtin_amdgcn_mfma_f32_16x16x32_bf16(Bt[n][k], At[m][k], acc[ai][bj][m][n], 0, 0, 0); __builtin_amdgcn_s_setprio(0); } while (0)
#define PG8_WAIT_V(n) asm volatile("s_waitcnt vmcnt(" #n ")" ::: "memory")
#define PG8_WAIT_L(n) asm volatile("s_waitcnt lgkmcnt(" #n ")" ::: "memory")
#define PG8_BAR __builtin_amdgcn_s_barrier()
#define PG8_SCHED __builtin_amdgcn_sched_barrier(0)
    Unit cur, nxt; int ui = 0;
    if (!S.next(0, cur)) return;
    f32x4 acc[2][2][4][2];
#pragma unroll
    for (int a = 0; a < 2; ++a)
#pragma unroll
        for (int b = 0; b < 2; ++b)
#pragma unroll
            for (int m = 0; m < 4; ++m)
#pragma unroll
                for (int n = 0; n < 2; ++n) acc[a][b][m][n] = (f32x4){0.f, 0.f, 0.f, 0.f};
    bf16x8 At[4][2], B0[2][2], B1[2][2];
    const char* cA = (const char*)(cur.g ? g.A1 : g.A0) + (size_t)cur.pm * tstep; const char* cB = (const char*)(cur.g ? g.B1 : g.B0) + (size_t)cur.pn * tstep;
    S.a_ready(cur);
    if constexpr (SP2) {
        PG8_STAGE(PG8_SB(0, 0), cB, voffB); PG8_STAGE(PG8_SB(0, 1), cB + hstep, voffB); PG8_STAGE(PG8_SA(0, 0), cA, voffA); PG8_STAGE(PG8_SA(0, 1), cA + hstep, voffA);
        if (wr == 1) PG8_BAR;
        PG8_WAIT_V(2); PG8_BAR;
        PG8_STAGE(PG8_SB(1, 0), cB + kstep, voffB); PG8_STAGE(PG8_SA(1, 0), cA + kstep, voffA); PG8_STAGE(PG8_SB(1, 1), cB + hstep + kstep, voffB);
        PG8_WAIT_V(6); PG8_BAR;
    } else {
        PG8_STAGE(PG8_SB(0, 0), cB, voffB); PG8_STAGE(PG8_SA(0, 0), cA, voffA); PG8_STAGE(PG8_SB(0, 1), cB + hstep, voffB); PG8_STAGE(PG8_SA(0, 1), cA + hstep, voffA);
        if (wr == 1) PG8_BAR;
        PG8_WAIT_V(4); PG8_BAR;
        PG8_STAGE(PG8_SB(1, 0), cB + kstep, voffB); PG8_STAGE(PG8_SA(1, 0), cA + kstep, voffA); PG8_STAGE(PG8_SB(1, 1), cB + hstep + kstep, voffB);
        PG8_WAIT_V(6); PG8_BAR;
    }
    for (;;) {
        const bool has_next = S.next(ui + 1, nxt);
        const char* nA = has_next ? (const char*)(nxt.g ? g.A1 : g.A0) + (size_t)nxt.pm * tstep : cA; const char* nB = has_next ? (const char*)(nxt.g ? g.B1 : g.B0) + (size_t)nxt.pn * tstep : cB;
        for (int t = 0; t < nt; t += 2) {
            const bool last = (t == nt - 2);
            const char* a1 = cA + (size_t)(t + 1) * kstep;
            const char* a2 = last ? nA : cA + (size_t)(t + 2) * kstep; const char* b2 = last ? nB : cB + (size_t)(t + 2) * kstep;
            const char* a3 = a2 + kstep; const char* b3 = b2 + kstep;
            if (last && has_next) S.a_ready(nxt);
            if constexpr (SP2) {
            PG8_LDB(B0, 0, 0); PG8_LDB(B1, 0, 1); PG8_SCHED; PG8_LDA(At, 0, 0); PG8_STAGE(PG8_SA(1, 1), a1 + hstep, voffA);
            PG8_WAIT_V(8); PG8_WAIT_L(0); PG8_BAR; PG8_MMA(0, 0, At, B0); PG8_MMA(0, 1, At, B1); PG8_BAR; PG8_SCHED;
            PG8_LDA(At, 0, 1); PG8_STAGE(PG8_SB(0, 0), b2, voffB); PG8_STAGE(PG8_SB(0, 1), b2 + hstep, voffB); PG8_STAGE(PG8_SA(0, 0), a2, voffA);
            PG8_WAIT_V(8); PG8_WAIT_L(0); PG8_BAR; PG8_MMA(1, 0, At, B0); PG8_MMA(1, 1, At, B1); PG8_BAR; PG8_SCHED;
            PG8_LDB(B0, 1, 0); PG8_LDB(B1, 1, 1); PG8_SCHED; PG8_LDA(At, 1, 0); PG8_STAGE(PG8_SA(0, 1), a2 + hstep, voffA);
            PG8_WAIT_V(8); PG8_WAIT_L(0); PG8_BAR; PG8_MMA(0, 0, At, B0); PG8_MMA(0, 1, At, B1); PG8_BAR; PG8_SCHED;
            PG8_LDA(At, 1, 1); PG8_STAGE(PG8_SB(1, 0), b3, voffB); PG8_STAGE(PG8_SB(1, 1), b3 + hstep, voffB); PG8_STAGE(PG8_SA(1, 0), a3, voffA);
            PG8_WAIT_V(8); PG8_WAIT_L(0); PG8_BAR; PG8_MMA(1, 0, At, B0); PG8_MMA(1, 1, At, B1); PG8_BAR; PG8_SCHED;
            } else {
            PG8_LDB(B0, 0, 0); PG8_SCHED; PG8_LDA(At, 0, 0); PG8_STAGE(PG8_SA(1, 1), a1 + hstep, voffA);
            PG8_WAIT_L(8); PG8_BAR; PG8_WAIT_L(0); PG8_MMA(0, 0, At, B0); PG8_BAR; PG8_SCHED;
            PG8_LDB(B1, 0, 1); PG8_STAGE(PG8_SB(0, 0), b2, voffB);
            PG8_BAR; PG8_WAIT_L(0); PG8_MMA(0, 1, At, B1); PG8_BAR;
            PG8_LDA(At, 0, 1); PG8_STAGE(PG8_SA(0, 0), a2, voffA);
            PG8_BAR; PG8_WAIT_L(0); PG8_MMA(1, 0, At, B0); PG8_BAR; PG8_SCHED;
            PG8_STAGE(PG8_SB(0, 1), b2 + hstep, voffB);
            PG8_WAIT_V(6); PG8_BAR; PG8_MMA(1, 1, At, B1); PG8_BAR;
            PG8_LDB(B0, 1, 0); PG8_SCHED; PG8_LDA(At, 1, 0); PG8_STAGE(PG8_SA(0, 1), a2 + hstep, voffA);
            PG8_WAIT_L(8); PG8_BAR; PG8_WAIT_L(0); PG8_MMA(0, 0, At, B0); PG8_BAR; PG8_SCHED;
            PG8_LDB(B1, 1, 1); PG8_STAGE(PG8_SB(1, 0), b3, voffB);
            PG8_BAR; PG8_WAIT_L(0); PG8_MMA(0, 1, At, B1); PG8_BAR;
            PG8_LDA(At, 1, 1); PG8_STAGE(PG8_SA(1, 0), a3, voffA);
            PG8_BAR; PG8_WAIT_L(0); PG8_MMA(1, 0, At, B0); PG8_BAR; PG8_SCHED;
            PG8_STAGE(PG8_SB(1, 1), b3 + hstep, voffB);
            PG8_WAIT_V(6); PG8_BAR; PG8_MMA(1, 1, At, B1); PG8_BAR;
            }
        }
        if constexpr (ALIGN_EPI) { if (wr == 0) PG8_BAR; }
        if constexpr (!Epi::AFTER_DRAIN) { E(acc, cur, wr, wc, fr, fq); S.done(cur); }
        if (!has_next) break;
#pragma unroll
        for (int a = 0; a < 2; ++a)
#pragma unroll
            for (int b = 0; b < 2; ++b)
#pragma unroll
                for (int m = 0; m < 4; ++m)
#pragma unroll
                    for (int n = 0; n < 2; ++n) acc[a][b][m][n] = (f32x4){0.f, 0.f, 0.f, 0.f};
        cur = nxt; cA = nA; cB = nB; ++ui;
        if constexpr (ALIGN_EPI) { if (wr == 1) PG8_BAR; }
    }
    PG8_WAIT_V(0);
    if constexpr (!ALIGN_EPI) { if (wr == 0) PG8_BAR; }
    PG8_BAR;
    if constexpr (Epi::AFTER_DRAIN) { E.fused(acc, cur, wr, wc, fr, fq, lds, wid, lane); S.done(cur); }
#undef PG8_SA
#undef PG8_SB
#undef PG8_STAGE
#undef PG8_LDA
#undef PG8_LDB
#undef PG8_MMA
#undef PG8_WAIT_V
#undef PG8_WAIT_L
#undef PG8_BAR
#undef PG8_SCHED
}
}

namespace sb {
using bf16 = __hip_bfloat16;
using bf16x8 = __attribute__((ext_vector_type(8))) short;
using s16x4 = __attribute__((ext_vector_type(4))) short;
using f32x16 = __attribute__((ext_vector_type(16))) float;
using u32x4 = __attribute__((ext_vector_type(4))) unsigned;
constexpr int SEQ = 2048, NHEAD = 16, HD = 64, DM = 1024;
constexpr int SLOTB = 8192, LDS_K = 0, LDS_V = 2 * SLOTB, LDS_FLAG = 4 * SLOTB, LDS_BYTES = 4 * SLOTB + 64;
constexpr float EXIT_THR = -150.0f;
__device__ __forceinline__ int crow(int r, int hi) { return (r & 3) + 8 * (r >> 2) + 4 * hi; }
__device__ __forceinline__ void glds16(const void* gsrc, unsigned lds_dst) { unsigned keep;
    asm volatile("s_mov_b32 %0, m0\n\ts_mov_b32 m0, %2\n\ts_nop 0\n\tglobal_load_lds_dwordx4 %1, off\n\ts_mov_b32 m0, %0" : "=&s"(keep) : "v"(gsrc), "s"(lds_dst) : "memory"); }
typedef __attribute__((address_space(3))) const char* lds_cptr;
typedef short v4i16_t __attribute__((ext_vector_type(4)));
typedef float f32x2_t __attribute__((ext_vector_type(2))); typedef __bf16 bf16x2_t __attribute__((ext_vector_type(2)));
__device__ __forceinline__ unsigned cvtpk(float lo, float hi) { f32x2_t v = {lo, hi}; bf16x2_t b = __builtin_convertvector(v, bf16x2_t); return __builtin_bit_cast(unsigned, b); }
__device__ __forceinline__ s16x4 vtr(lds_cptr p) { return __builtin_bit_cast(s16x4, __builtin_amdgcn_ds_read_tr16_b64_v4i16((__attribute__((address_space(3))) v4i16_t*)p)); }
__device__ __forceinline__ bf16x8 pack8(const f32x16& p, int b) { u32x4 w; w.x = cvtpk(p[b], p[b + 1]); w.y = cvtpk(p[b + 2], p[b + 3]); w.z = cvtpk(p[b + 4], p[b + 5]); w.w = cvtpk(p[b + 6], p[b + 7]); return __builtin_bit_cast(bf16x8, w); }
__device__ __forceinline__ float lo_lane(float x) { auto rr = __builtin_amdgcn_permlane32_swap(__float_as_uint(x), __float_as_uint(x), false, false); return __uint_as_float(rr[0]); }
#define SB_WAIT_BAR() asm volatile("s_waitcnt vmcnt(0) lgkmcnt(0)\n\ts_barrier" ::: "memory")

template <bool EARLY> __device__ __forceinline__ void sb_unit(int b, int h, int qb, const bf16* Q, const bf16* __restrict__ K, const bf16* __restrict__ V, bf16* O, char* shm) {
    const int tid = threadIdx.x, lane = tid & 63, r32 = lane & 31, hi = lane >> 5; const int wid = __builtin_amdgcn_readfirstlane(tid >> 6);
    const long rowbase = (long)b * SEQ; const int q0 = qb * 256;
    const bf16* Qw = Q + (rowbase + q0 + wid * 32) * DM + h * HD;
    const bf16* Kh = K + rowbase * DM + h * HD; const bf16* Vh = V + rowbase * DM + h * HD;
    const unsigned lds0 = (unsigned)(uintptr_t)shm;
    const bf16* ksrc = Kh + (long)lane * DM + wid * 8;
    const bf16* vsrc = Vh + (long)(16 * (wid & 3) + (lane >> 2)) * DM + (wid >> 2) * 32 + (lane & 3) * 8;
    const unsigned kdst = lds0 + LDS_K + wid * 1024, vdst = lds0 + LDS_V + wid * 1024;
#define SB_DMA_K(t, slot) glds16(ksrc + (long)(t) * 64 * DM, (unsigned)__builtin_amdgcn_readfirstlane(kdst + (slot)))
#define SB_DMA_V(t, slot) glds16(vsrc + (long)(t) * 64 * DM, (unsigned)__builtin_amdgcn_readfirstlane(vdst + (slot)))
    const lds_cptr shm3 = (lds_cptr)shm; const lds_cptr kp0 = shm3 + LDS_K + hi * 1024 + r32 * 16;
    const lds_cptr vp0 = shm3 + LDS_V + ((lane >> 4) & 1) * 32 + (lane & 3) * 8 + (4 * hi + ((lane & 15) >> 2)) * 64;
    const int NT = (q0 + 256) / 64;
    volatile __attribute__((address_space(3))) unsigned* flags = (volatile __attribute__((address_space(3))) unsigned*)(shm3 + LDS_FLAG);
    if (EARLY && lane == 0) flags[wid] = 0u;
    bool wdone = false;
    SB_DMA_K(NT - 1, 0); SB_DMA_V(NT - 1, 0);
    bf16x8 qr[4];
#pragma unroll
    for (int d0 = 0; d0 < 4; ++d0) qr[d0] = *reinterpret_cast<const bf16x8*>(&Qw[(long)r32 * DM + d0 * 16 + hi * 8]);
    bf16x8 tri[2], ones;
#pragma unroll
    for (int ks = 0; ks < 2; ++ks)
#pragma unroll
        for (int j = 0; j < 8; ++j) { const int kk = 16 * ks + 8 * (j >> 2) + 4 * hi + (j & 3); tri[ks][j] = (kk >= r32) ? (short)0x3F80 : (short)0; }
#pragma unroll
    for (int j = 0; j < 8; ++j) ones[j] = (short)0x3F80;
    f32x16 o0 = f32x16{}, o1 = f32x16{}; float R = 0.f;
    const int trow = q0 + wid * 32 + r32;
    const int wmin = q0 + wid * 32, wmax = wmin + 31;
    for (int it = 0; it < NT; ++it) {
        const int t = NT - 1 - it; const int sl = (it & 1) * SLOTB;
        SB_WAIT_BAR();
        if (EARLY) { const unsigned f = flags[lane & 7]; if (__all(f != 0u)) break; }
        if (t > 0) { SB_DMA_K(t - 1, sl ^ SLOTB); SB_DMA_V(t - 1, sl ^ SLOTB); }
        if (64 * t < wmax && !wdone) {
            f32x16 p0 = f32x16{}, p1 = f32x16{};
#pragma unroll
            for (int d0 = 0; d0 < 4; ++d0) {
                const bf16x8 b0 = *(const __attribute__((address_space(3))) bf16x8*)(kp0 + sl + d0 * 2048);
                const bf16x8 b1 = *(const __attribute__((address_space(3))) bf16x8*)(kp0 + sl + d0 * 2048 + 512);
                p0 = __builtin_amdgcn_mfma_f32_32x32x16_bf16(b0, qr[d0], p0, 0, 0, 0);
                p1 = __builtin_amdgcn_mfma_f32_32x32x16_bf16(b1, qr[d0], p1, 0, 0, 0); }
            const bool diag = (64 * t + 63 >= wmin);
            f32x16 l0, l1;
#pragma unroll
            for (int r = 0; r < 16; ++r) {
                const float y0 = p0[r], y1 = p1[r];
                l0[r] = -(__builtin_fmaxf(y0, 0.f) + __builtin_amdgcn_logf(1.0f + __builtin_amdgcn_exp2f(-__builtin_fabsf(y0))));
                l1[r] = -(__builtin_fmaxf(y1, 0.f) + __builtin_amdgcn_logf(1.0f + __builtin_amdgcn_exp2f(-__builtin_fabsf(y1)))); }
            if (diag) {
#pragma unroll
                for (int r = 0; r < 16; ++r) { const int s = 64 * t + crow(r, hi); if (s >= trow) l0[r] = 0.f; if (s + 32 >= trow) l1[r] = 0.f; } }
            const bf16x8 l0a = pack8(l0, 0), l0b = pack8(l0, 8), l1a = pack8(l1, 0), l1b = pack8(l1, 8);
            f32x16 Rv;
#pragma unroll
            for (int r = 0; r < 16; ++r) Rv[r] = R;
            f32x16 c1 = __builtin_amdgcn_mfma_f32_32x32x16_bf16(tri[0], l1a, Rv, 0, 0, 0); c1 = __builtin_amdgcn_mfma_f32_32x32x16_bf16(tri[1], l1b, c1, 0, 0, 0);
            f32x16 c0 = __builtin_amdgcn_mfma_f32_32x32x16_bf16(ones, l1a, Rv, 0, 0, 0); c0 = __builtin_amdgcn_mfma_f32_32x32x16_bf16(ones, l1b, c0, 0, 0, 0);
            c0 = __builtin_amdgcn_mfma_f32_32x32x16_bf16(tri[0], l0a, c0, 0, 0, 0); c0 = __builtin_amdgcn_mfma_f32_32x32x16_bf16(tri[1], l0b, c0, 0, 0, 0);
#pragma unroll
            for (int r = 0; r < 16; ++r) { p0[r] = __builtin_amdgcn_exp2f(p0[r] + c0[r]); p1[r] = __builtin_amdgcn_exp2f(p1[r] + c1[r]); }
            if (diag) {
#pragma unroll
                for (int r = 0; r < 16; ++r) { const int s = 64 * t + crow(r, hi); if (s >= trow) p0[r] = 0.f; if (s + 32 >= trow) p1[r] = 0.f; } }
            R = lo_lane(c0[0]);
            if (EARLY && !__any(R >= EXIT_THR)) { wdone = true; if (lane == 0) flags[wid] = 1u; }
            const bf16x8 pa0 = pack8(p0, 0), pa1 = pack8(p0, 8), pa2 = pack8(p1, 0), pa3 = pack8(p1, 8);
            const lds_cptr vp = vp0 + sl;
#define SB_VF(dh, ks) ({ const s16x4 lo_ = vtr(vp + (dh) * 4096 + (ks) * 1024), hi_ = vtr(vp + (dh) * 4096 + (ks) * 1024 + 512); (bf16x8){lo_[0], lo_[1], lo_[2], lo_[3], hi_[0], hi_[1], hi_[2], hi_[3]}; })
            o0 = __builtin_amdgcn_mfma_f32_32x32x16_bf16(pa0, SB_VF(0, 0), o0, 0, 0, 0); o1 = __builtin_amdgcn_mfma_f32_32x32x16_bf16(pa0, SB_VF(1, 0), o1, 0, 0, 0);
            o0 = __builtin_amdgcn_mfma_f32_32x32x16_bf16(pa1, SB_VF(0, 1), o0, 0, 0, 0); o1 = __builtin_amdgcn_mfma_f32_32x32x16_bf16(pa1, SB_VF(1, 1), o1, 0, 0, 0);
            o0 = __builtin_amdgcn_mfma_f32_32x32x16_bf16(pa2, SB_VF(0, 2), o0, 0, 0, 0); o1 = __builtin_amdgcn_mfma_f32_32x32x16_bf16(pa2, SB_VF(1, 2), o1, 0, 0, 0);
            o0 = __builtin_amdgcn_mfma_f32_32x32x16_bf16(pa3, SB_VF(0, 3), o0, 0, 0, 0); o1 = __builtin_amdgcn_mfma_f32_32x32x16_bf16(pa3, SB_VF(1, 3), o1, 0, 0, 0);
#undef SB_VF
        }
    }
    if (EARLY) SB_WAIT_BAR();
    bf16* Ow = O + (rowbase + q0 + wid * 32) * DM + h * HD;
#pragma unroll
    for (int r = 0; r < 16; ++r) { const int orow = crow(r, hi); Ow[(long)orow * DM + r32] = __float2bfloat16(o0[r]); Ow[(long)orow * DM + 32 + r32] = __float2bfloat16(o1[r]); }
#undef SB_DMA_K
#undef SB_DMA_V
}
}

constexpr int NWAVES = 8;
constexpr int N_LAUNCHES = MK_N_LAUNCHES;
constexpr int N_PHASES = 10;
constexpr int BATCH = 8, SEQ = 2048, D = 1024, M = BATCH * SEQ, MEMLEN = 256, MROWS = BATCH * MEMLEN, NIN = 8192, NPQ = 2048;
constexpr float RMS_EPS = 1e-6f;
constexpr float LOG2E = 1.4426950408889634f;
constexpr size_t MiB = 1u << 20;
constexpr size_t WS_CTL = 0, CTL_ZERO_BYTES = 1 * MiB;
constexpr size_t WS_WIN = 1 * MiB, WS_WA = 17 * MiB, WS_WC = 19 * MiB, WS_WO = 21 * MiB, WS_WQ2 = 23 * MiB, WS_WKV2 = 25 * MiB, WS_WO2 = 29 * MiB, WS_WPQ = 31 * MiB, WS_SK = 35 * MiB;
constexpr size_t WS_SSQ1 = 36 * MiB, WS_SSQ2 = 37 * MiB, WS_MEMN = 38 * MiB, WS_K2 = 42 * MiB, WS_V2T = 46 * MiB;
constexpr size_t WS_B0 = 52 * MiB, WS_B1 = 84 * MiB, WS_B2 = 116 * MiB, WS_B3 = 148 * MiB, WS_B4 = 180 * MiB, WS_B5 = 212 * MiB, WS_END = 244 * MiB;
constexpr int CW_TMO = 0, CW_CODE = 1, CW_BAR = 4096;

constexpr int RING_OFF = 0, RING_BYTES = 131072;
constexpr int LDSCTL_OFF = RING_BYTES, MISC_OFF = LDSCTL_OFF + 320;
constexpr int LDS_BYTES = 147456;
#define GAS __attribute__((address_space(1)))
#define LAS __attribute__((address_space(3)))
typedef unsigned short bf16;
typedef unsigned v4u __attribute__((ext_vector_type(4)));
typedef float f32x4 __attribute__((ext_vector_type(4)));
typedef short bf16x8 __attribute__((ext_vector_type(8)));
typedef GAS unsigned gu32;
typedef GAS unsigned long long gu64;
#define RLX_AGENT __ATOMIC_RELAXED, __HIP_MEMORY_SCOPE_AGENT
#define LDS_WAIT() asm volatile("s_waitcnt lgkmcnt(0)" ::: "memory")
#define VM_WAIT() asm volatile("s_waitcnt vmcnt(0)" ::: "memory")
__device__ __forceinline__ unsigned long long rt() { return __builtin_amdgcn_s_memrealtime(); }
__device__ __forceinline__ unsigned f2bf(float f) { unsigned u = __builtin_bit_cast(unsigned, f); return (u + 0x7fffu + ((u >> 16) & 1u)) >> 16; }
__device__ __forceinline__ unsigned pk2(float lo, float hi) { return f2bf(lo) | (f2bf(hi) << 16); }

#define XB_TMO      128
#define XB_XCNT(j)  (256  + 64 * (j))
#define XB_XSUB(j)  (1280 + 64 * (j))
#define XB_XGEN(j)  (2304 + 64 * (j))
#define XB_TOP      3328
#define XB_TOPGEN   3392
#define XCD_BAR_WORDS 3456
#define XB_SPIN_CAP (1u << 18)

__device__ __forceinline__ unsigned xb_ld(unsigned* p)              { return __hip_atomic_load(p, __ATOMIC_RELAXED, __HIP_MEMORY_SCOPE_AGENT); }
__device__ __forceinline__ unsigned xb_add(unsigned* p, unsigned v) { return __hip_atomic_fetch_add(p, v, __ATOMIC_RELAXED, __HIP_MEMORY_SCOPE_AGENT); }
__device__ __forceinline__ unsigned xb_xcc_id() { return (unsigned)__builtin_amdgcn_s_getreg((3 << 11) | 20) & 0xFu; }
#define XB_SPIN(cond, bar) do { unsigned _sp = 0; while (cond) { __builtin_amdgcn_s_sleep(1); \
    if ((++_sp & 255u) == 0u) { if (xb_ld(&(bar)[XB_TMO])) break; if (_sp > XB_SPIN_CAP) { atomicAdd(&(bar)[XB_TMO], 1u); break; } } } } while (0)

struct XcdBarrier {
    unsigned* bar; unsigned x;
    volatile LAS unsigned* st;
};

__device__ __forceinline__ XcdBarrier xcd_barrier_post(unsigned* bar, volatile LAS unsigned* st) {
    XcdBarrier b; b.bar = bar; b.x = xb_xcc_id(); b.st = st;
    if (threadIdx.x == 0) (void)xb_add(&bar[XB_XCNT(b.x)], 1u);
    return b;
}
__device__ __forceinline__ void xcd_barrier_complete(unsigned* bar, unsigned x, unsigned& nloc, unsigned& nx) {
    const unsigned G = gridDim.x * gridDim.y * gridDim.z;
    unsigned sum, cnt, mine, sp = 0u;
    for (;;) {
        sum = 0u; cnt = 0u; mine = 0u;
#pragma unroll
        for (unsigned j = 0; j < 16; ++j) { const unsigned c = xb_ld(&bar[XB_XCNT(j)]); sum += c; cnt += (c > 0u) ? 1u : 0u; mine = (j == x) ? c : mine; }
        if (sum == G) break;
        __builtin_amdgcn_s_sleep(1);
        if ((++sp & 255u) == 0u) { if (xb_ld(&bar[XB_TMO])) break; if (sp > XB_SPIN_CAP) { atomicAdd(&bar[XB_TMO], 1u); break; } }
    }
    nloc = mine > 0u ? mine : 1u; nx = cnt > 0u ? cnt : 1u;
}

__device__ __forceinline__ void xcd_barrier(const XcdBarrier& b) {
    asm volatile("s_waitcnt vmcnt(0)" ::: "memory");
    __syncthreads();
    if (threadIdx.x == 0) {
        unsigned* bar = b.bar;
        __builtin_amdgcn_s_waitcnt(0);
        unsigned nloc = b.st[0], nx = b.st[1];
        if (nloc == 0u) { xcd_barrier_complete(bar, b.x, nloc, nx); b.st[0] = nloc; b.st[1] = nx; }
        const unsigned old = xb_add(&bar[XB_XSUB(b.x)], 1u);
        const unsigned gen = old / nloc;
        if (old + 1u == (gen + 1u) * nloc) {
            __builtin_amdgcn_fence(__ATOMIC_RELEASE, "agent");
            asm volatile("s_waitcnt vmcnt(0)" ::: "memory");
            const unsigned og = xb_add(&bar[XB_TOP], 1u);
            const unsigned tg = og / nx;
            if (og + 1u == (tg + 1u) * nx) xb_add(&bar[XB_TOPGEN], 1u);
            else XB_SPIN(xb_ld(&bar[XB_TOPGEN]) == tg, bar);
            __builtin_amdgcn_fence(__ATOMIC_ACQUIRE, "agent");
            xb_add(&bar[XB_XGEN(b.x)], 1u);
            asm volatile("s_waitcnt vmcnt(0)" ::: "memory");
        } else {
            XB_SPIN(xb_ld(&bar[XB_XGEN(b.x)]) == gen, bar);
            __builtin_amdgcn_fence(__ATOMIC_ACQUIRE, "agent");
            asm volatile("s_waitcnt vmcnt(0)" ::: "memory");
        }
    }
    __syncthreads();
}


__device__ __forceinline__ float wave_sum(float v) {
#pragma unroll
    for (int o = 1; o < 64; o <<= 1) v += __shfl_xor(v, o);
    return v;
}
__device__ __forceinline__ int inproj_row(int n) {
    const int g = n >> 10, c = n & 1023;
    if (g < 3) return n;
    if (g == 3) return 3072 + (c >> 7) * 256 + (c & 127);
    if (g == 5) return 3072 + (c >> 7) * 256 + 128 + (c & 127);
    if (g == 4) return 5120 + c;
    return n;
}
template <bool INMAP> __device__ __forceinline__ void transpose_item(const float* W, int K, int N, const float* gain, bf16* WT, int row_off, LAS float* scr, int item, int lane) {
    const int nblk = N / 32, kb = item / nblk, nb = item % nblk, k0 = 64 * kb, n0 = 32 * nb;
#pragma unroll 8
    for (int i = 0; i < 32; ++i) { const int kk = 2 * i + (lane >> 5); float w = W[(size_t)(k0 + kk) * N + n0 + (lane & 31)]; if (gain) w *= gain[k0 + kk]; scr[kk * 33 + (lane & 31)] = w; }
    LDS_WAIT(); asm volatile("" ::: "memory");
    const int c = lane & 7; const int r0 = INMAP ? inproj_row(n0) : (row_off + n0);
#pragma unroll
    for (int j = 0; j < 4; ++j) { const int n = (lane >> 3) + 8 * j; const LAS float* s = scr + (8 * c) * 33 + n;
        v4u o; o.x = pk2(s[0 * 33], s[1 * 33]); o.y = pk2(s[2 * 33], s[3 * 33]); o.z = pk2(s[4 * 33], s[5 * 33]); o.w = pk2(s[6 * 33], s[7 * 33]);
        *(GAS v4u*)(WT + (size_t)(r0 + n) * K + k0 + 8 * c) = o; }
    LDS_WAIT(); asm volatile("" ::: "memory");
}
__device__ __forceinline__ void rms_row_to_bf16(const float* xrow, const float* gain, bf16* orow, int lane) {
    const GAS f32x4* xr = (const GAS f32x4*)xrow + lane; const GAS f32x4* gr = (const GAS f32x4*)gain + lane;
    f32x4 v[4]; float s = 0.f;
#pragma unroll
    for (int j = 0; j < 4; ++j) { v[j] = xr[64 * j]; s += (v[j].x * v[j].x + v[j].y * v[j].y) + (v[j].z * v[j].z + v[j].w * v[j].w); }
    const float rstd = 1.0f / sqrtf(wave_sum(s) * (1.f / 1024.f) + RMS_EPS);
    GAS unsigned long long* o8 = (GAS unsigned long long*)orow + lane;
#pragma unroll
    for (int j = 0; j < 4; ++j) { const f32x4 g = gr[64 * j]; o8[64 * j] = (unsigned long long)pk2(v[j].x * rstd * g.x, v[j].y * rstd * g.y) | ((unsigned long long)pk2(v[j].z * rstd * g.z, v[j].w * rstd * g.w) << 32); }
}
__device__ __forceinline__ void row_to_bf16(const float* xrow, const float* gain, bf16* orow, int lane) {
    const GAS f32x4* xr = (const GAS f32x4*)xrow + lane; GAS unsigned long long* o8 = (GAS unsigned long long*)orow + lane;
#pragma unroll
    for (int j = 0; j < 4; ++j) { f32x4 v = xr[64 * j]; if (gain) { const f32x4 g = ((const GAS f32x4*)gain + lane)[64 * j]; v = v * g; }
        o8[64 * j] = (unsigned long long)pk2(v.x, v.y) | ((unsigned long long)pk2(v.z, v.w) << 32); }
}
__device__ __forceinline__ void row_to_fp8(const float* xrow, const float* gain, float scale, unsigned char* orow, int lane) {
    const GAS f32x4* xr = (const GAS f32x4*)xrow + lane; GAS unsigned* o4 = (GAS unsigned*)orow + lane;
#pragma unroll
    for (int j = 0; j < 4; ++j) { f32x4 v = xr[64 * j] * scale; if (gain) { const f32x4 g = ((const GAS f32x4*)gain + lane)[64 * j]; v = v * g; }
        int w = 0; w = __builtin_amdgcn_cvt_pk_fp8_f32(v.x, v.y, w, false); w = __builtin_amdgcn_cvt_pk_fp8_f32(v.z, v.w, w, true); o4[64 * j] = (unsigned)w; }
}
__device__ __forceinline__ void final_norm_row(const float* hrow, const float* gain, float* orow, int lane) {
    const GAS f32x4* xr = (const GAS f32x4*)hrow + lane; const GAS f32x4* gr = (const GAS f32x4*)gain + lane;
    f32x4 v[4]; float s = 0.f;
#pragma unroll
    for (int j = 0; j < 4; ++j) { v[j] = xr[64 * j]; s += (v[j].x * v[j].x + v[j].y * v[j].y) + (v[j].z * v[j].z + v[j].w * v[j].w); }
    const float rstd = 1.0f / sqrtf(wave_sum(s) * (1.f / 1024.f) + RMS_EPS);
    GAS f32x4* o = (GAS f32x4*)orow + lane;
#pragma unroll
    for (int j = 0; j < 4; ++j) o[64 * j] = v[j] * rstd * gr[64 * j];
}
__device__ __forceinline__ float bflo(unsigned w) { return __builtin_bit_cast(float, w << 16); }
__device__ __forceinline__ float bfhi(unsigned w) { return __builtin_bit_cast(float, w & 0xffff0000u); }
__device__ __forceinline__ void yconv_item(const bf16* U, const bf16* CB, const float* cw, bf16* YC, int item, int lane) {
    const int t0 = item * 8; const bool first = (t0 % SEQ) == 0;
#pragma unroll 1
    for (int ps = 0; ps < 2; ++ps) {
        const int c0 = ps * 512 + lane * 8;
        float w0[8], w1[8], w2[8];
#pragma unroll
        for (int e = 0; e < 8; ++e) { w0[e] = cw[c0 + e]; w1[e] = cw[1024 + c0 + e]; w2[e] = cw[2048 + c0 + e]; }
        v4u um2 = (v4u){0u, 0u, 0u, 0u}, um1 = (v4u){0u, 0u, 0u, 0u};
        if (!first) { um2 = *(const GAS v4u*)(U + (size_t)(t0 - 2) * 1024 + c0); um1 = *(const GAS v4u*)(U + (size_t)(t0 - 1) * 1024 + c0); }
#pragma unroll
        for (int i = 0; i < 8; ++i) {
            const v4u uc = *(const GAS v4u*)(U + (size_t)(t0 + i) * 1024 + c0); const v4u cbv = *(const GAS v4u*)(CB + (size_t)(t0 + i) * 1024 + c0);
            v4u o;
#pragma unroll
            for (int q = 0; q < 4; ++q) {
                const float a = bflo(cbv[q]) * (w0[2 * q] * bflo(um2[q]) + w1[2 * q] * bflo(um1[q]) + w2[2 * q] * bflo(uc[q]));
                const float b = bfhi(cbv[q]) * (w0[2 * q + 1] * bfhi(um2[q]) + w1[2 * q + 1] * bfhi(um1[q]) + w2[2 * q + 1] * bfhi(uc[q]));
                o[q] = pk2(a, b); }
            *(GAS v4u*)(YC + (size_t)(t0 + i) * 1024 + c0) = o;
            um2 = um1; um1 = uc; }
    }
}


namespace xa {
using bf16x8 = __attribute__((ext_vector_type(8))) short;
using f32x4 = __attribute__((ext_vector_type(4))) float;
using u32x4 = __attribute__((ext_vector_type(4))) unsigned;
using u32x2 = __attribute__((ext_vector_type(2))) unsigned;
typedef __attribute__((address_space(3))) const char* lds_cptr;
constexpr int BUFB = 65536, VOFF = 32768;
#define XA_WAIT_BAR() asm volatile("s_waitcnt vmcnt(0) lgkmcnt(0)\n\ts_barrier" ::: "memory")
__device__ __forceinline__ void xattn_unit(int b, int head, int qh, const bf16* Q, const bf16* K2, const bf16* V2P, bf16* O, char* shm) {
    const int lane = threadIdx.x & 63, kr = lane & 15, g = lane >> 4; const int wid = __builtin_amdgcn_readfirstlane((int)threadIdx.x >> 6);
    const unsigned lds0 = (unsigned)(uintptr_t)shm; const lds_cptr shm3 = (lds_cptr)shm;
    const size_t qrow = (size_t)b * SEQ + qh * 128 + wid * 16 + kr;
    const bf16* ksrc = K2 + ((size_t)b * MEMLEN + lane) * 1024 + head * 256 + 8 * wid;
    const bf16* vsrc = V2P + ((size_t)head * 256 + lane) * 2048 + (size_t)b * MEMLEN + 8 * wid;
#define XA_DMA(c, bufo) do { _Pragma("unroll") for (int i = 0; i < 4; ++i) { \
        sb::glds16(ksrc + (size_t)(64 * (c)) * 1024 + 64 * i, (unsigned)__builtin_amdgcn_readfirstlane(lds0 + (bufo) + (wid + 8 * i) * 1024)); \
        sb::glds16(vsrc + (size_t)(64 * i) * 2048 + 64 * (c), (unsigned)__builtin_amdgcn_readfirstlane(lds0 + (bufo) + VOFF + wid * 4096 + i * 1024)); } } while (0)
    XA_DMA(0, 0);
    bf16x8 qf[8];
#pragma unroll
    for (int ks = 0; ks < 8; ++ks) qf[ks] = *(const GAS bf16x8*)(Q + qrow * 1024 + head * 256 + 32 * ks + 8 * g);
    f32x4 o[16];
#pragma unroll
    for (int dt = 0; dt < 16; ++dt) o[dt] = (f32x4){0.f, 0.f, 0.f, 0.f};
    float mrun = -1e30f, lrun = 0.f;
    const lds_cptr kfr = shm3 + g * 1024 + kr * 16, vfr = shm3 + VOFF + g * 4096 + kr * 16;
#pragma unroll 1
    for (int c = 0; c < 4; ++c) {
        const int bo = (c & 1) * BUFB;
        XA_WAIT_BAR();
        if (c < 3) XA_DMA(c + 1, bo ^ BUFB);
        f32x4 s[4];
#pragma unroll
        for (int kt = 0; kt < 4; ++kt) { s[kt] = (f32x4){0.f, 0.f, 0.f, 0.f};
#pragma unroll
            for (int ks = 0; ks < 8; ++ks) { const bf16x8 a = *(const __attribute__((address_space(3))) bf16x8*)(kfr + bo + ks * 4096 + kt * 256);
                s[kt] = __builtin_amdgcn_mfma_f32_16x16x32_bf16(a, qf[ks], s[kt], 0, 0, 0); } }
        float mx = __builtin_fmaxf(__builtin_fmaxf(s[0].x, s[0].y), __builtin_fmaxf(s[0].z, s[0].w));
#pragma unroll
        for (int kt = 1; kt < 4; ++kt) mx = __builtin_fmaxf(mx, __builtin_fmaxf(__builtin_fmaxf(s[kt].x, s[kt].y), __builtin_fmaxf(s[kt].z, s[kt].w)));
        mx = __builtin_fmaxf(mx, __shfl_xor(mx, 16)); mx = __builtin_fmaxf(mx, __shfl_xor(mx, 32));
        const float mnew = __builtin_fmaxf(mrun, mx), alpha = __builtin_amdgcn_exp2f(mrun - mnew);
        mrun = mnew; float ps = 0.f;
#pragma unroll
        for (int kt = 0; kt < 4; ++kt) { s[kt].x = __builtin_amdgcn_exp2f(s[kt].x - mnew); s[kt].y = __builtin_amdgcn_exp2f(s[kt].y - mnew); s[kt].z = __builtin_amdgcn_exp2f(s[kt].z - mnew); s[kt].w = __builtin_amdgcn_exp2f(s[kt].w - mnew);
            ps += (s[kt].x + s[kt].y) + (s[kt].z + s[kt].w); }
        lrun = lrun * alpha + ps;
#pragma unroll
        for (int dt = 0; dt < 16; ++dt) o[dt] = o[dt] * alpha;
        bf16x8 pb[2];
#pragma unroll
        for (int k2 = 0; k2 < 2; ++k2) { u32x4 w; w.x = pg8::cvt_pk_bf16(s[2 * k2].x, s[2 * k2].y); w.y = pg8::cvt_pk_bf16(s[2 * k2].z, s[2 * k2].w);
            w.z = pg8::cvt_pk_bf16(s[2 * k2 + 1].x, s[2 * k2 + 1].y); w.w = pg8::cvt_pk_bf16(s[2 * k2 + 1].z, s[2 * k2 + 1].w); pb[k2] = __builtin_bit_cast(bf16x8, w); }
#pragma unroll
        for (int dt = 0; dt < 16; ++dt)
#pragma unroll
            for (int k2 = 0; k2 < 2; ++k2) { const bf16x8 a = *(const __attribute__((address_space(3))) bf16x8*)(vfr + bo + k2 * 16384 + dt * 256);
                o[dt] = __builtin_amdgcn_mfma_f32_16x16x32_bf16(a, pb[k2], o[dt], 0, 0, 0); }
    }
    lrun += __shfl_xor(lrun, 16); lrun += __shfl_xor(lrun, 32);
    const float rl = 1.0f / lrun;
    bf16* op = O + qrow * 1024 + head * 256 + 4 * g;
#pragma unroll
    for (int dt = 0; dt < 16; ++dt) { u32x2 w; w.x = pg8::cvt_pk_bf16(o[dt].x * rl, o[dt].y * rl); w.y = pg8::cvt_pk_bf16(o[dt].z * rl, o[dt].w * rl); *(GAS u32x2*)(op + 16 * dt) = w; }
#undef XA_DMA
}
}

namespace peer {
using bf16x8 = __attribute__((ext_vector_type(8))) short;
using f32x16 = __attribute__((ext_vector_type(16))) float;
using u32x4 = __attribute__((ext_vector_type(4))) unsigned;
using u32x2 = __attribute__((ext_vector_type(2))) unsigned;
typedef __bf16 bf16x2_t __attribute__((ext_vector_type(2)));
#define PEER_CE(a, b) do { const int _h = ((a) > (b)) ? (a) : (b); const int _l = ((a) > (b)) ? (b) : (a); (a) = _h; (b) = _l; } while (0)
#define PEER_SORT16(x, o) do { PEER_CE(x[(o)+0], x[(o)+1]); PEER_CE(x[(o)+2], x[(o)+3]); PEER_CE(x[(o)+4], x[(o)+5]); PEER_CE(x[(o)+6], x[(o)+7]); PEER_CE(x[(o)+8], x[(o)+9]); PEER_CE(x[(o)+10], x[(o)+11]); PEER_CE(x[(o)+12], x[(o)+13]); PEER_CE(x[(o)+14], x[(o)+15]); PEER_CE(x[(o)+0], x[(o)+2]); PEER_CE(x[(o)+1], x[(o)+3]); PEER_CE(x[(o)+4], x[(o)+6]); PEER_CE(x[(o)+5], x[(o)+7]); PEER_CE(x[(o)+8], x[(o)+10]); PEER_CE(x[(o)+9], x[(o)+11]); PEER_CE(x[(o)+12], x[(o)+14]); PEER_CE(x[(o)+13], x[(o)+15]); PEER_CE(x[(o)+1], x[(o)+2]); PEER_CE(x[(o)+5], x[(o)+6]); PEER_CE(x[(o)+9], x[(o)+10]); PEER_CE(x[(o)+13], x[(o)+14]); PEER_CE(x[(o)+0], x[(o)+4]); PEER_CE(x[(o)+1], x[(o)+5]); PEER_CE(x[(o)+2], x[(o)+6]); PEER_CE(x[(o)+3], x[(o)+7]); PEER_CE(x[(o)+8], x[(o)+12]); PEER_CE(x[(o)+9], x[(o)+13]); PEER_CE(x[(o)+10], x[(o)+14]); PEER_CE(x[(o)+11], x[(o)+15]); PEER_CE(x[(o)+2], x[(o)+4]); PEER_CE(x[(o)+3], x[(o)+5]); PEER_CE(x[(o)+10], x[(o)+12]); PEER_CE(x[(o)+11], x[(o)+13]); PEER_CE(x[(o)+1], x[(o)+2]); PEER_CE(x[(o)+3], x[(o)+4]); PEER_CE(x[(o)+5], x[(o)+6]); PEER_CE(x[(o)+9], x[(o)+10]); PEER_CE(x[(o)+11], x[(o)+12]); PEER_CE(x[(o)+13], x[(o)+14]); PEER_CE(x[(o)+0], x[(o)+8]); PEER_CE(x[(o)+1], x[(o)+9]); PEER_CE(x[(o)+2], x[(o)+10]); PEER_CE(x[(o)+3], x[(o)+11]); PEER_CE(x[(o)+4], x[(o)+12]); PEER_CE(x[(o)+5], x[(o)+13]); PEER_CE(x[(o)+6], x[(o)+14]); PEER_CE(x[(o)+7], x[(o)+15]); PEER_CE(x[(o)+4], x[(o)+8]); PEER_CE(x[(o)+5], x[(o)+9]); PEER_CE(x[(o)+6], x[(o)+10]); PEER_CE(x[(o)+7], x[(o)+11]); PEER_CE(x[(o)+2], x[(o)+4]); PEER_CE(x[(o)+3], x[(o)+5]); PEER_CE(x[(o)+6], x[(o)+8]); PEER_CE(x[(o)+7], x[(o)+9]); PEER_CE(x[(o)+10], x[(o)+12]); PEER_CE(x[(o)+11], x[(o)+13]); PEER_CE(x[(o)+1], x[(o)+2]); PEER_CE(x[(o)+3], x[(o)+4]); PEER_CE(x[(o)+5], x[(o)+6]); PEER_CE(x[(o)+7], x[(o)+8]); PEER_CE(x[(o)+9], x[(o)+10]); PEER_CE(x[(o)+11], x[(o)+12]); PEER_CE(x[(o)+13], x[(o)+14]); } while (0)
#define PEER_MERGE16(x, a, b) do { x[(a)+0] = (x[(a)+0] > x[(b)+15]) ? x[(a)+0] : x[(b)+15]; x[(a)+1] = (x[(a)+1] > x[(b)+14]) ? x[(a)+1] : x[(b)+14]; x[(a)+2] = (x[(a)+2] > x[(b)+13]) ? x[(a)+2] : x[(b)+13]; x[(a)+3] = (x[(a)+3] > x[(b)+12]) ? x[(a)+3] : x[(b)+12]; x[(a)+4] = (x[(a)+4] > x[(b)+11]) ? x[(a)+4] : x[(b)+11]; x[(a)+5] = (x[(a)+5] > x[(b)+10]) ? x[(a)+5] : x[(b)+10]; x[(a)+6] = (x[(a)+6] > x[(b)+9]) ? x[(a)+6] : x[(b)+9]; x[(a)+7] = (x[(a)+7] > x[(b)+8]) ? x[(a)+7] : x[(b)+8]; x[(a)+8] = (x[(a)+8] > x[(b)+7]) ? x[(a)+8] : x[(b)+7]; x[(a)+9] = (x[(a)+9] > x[(b)+6]) ? x[(a)+9] : x[(b)+6]; x[(a)+10] = (x[(a)+10] > x[(b)+5]) ? x[(a)+10] : x[(b)+5]; x[(a)+11] = (x[(a)+11] > x[(b)+4]) ? x[(a)+11] : x[(b)+4]; x[(a)+12] = (x[(a)+12] > x[(b)+3]) ? x[(a)+12] : x[(b)+3]; x[(a)+13] = (x[(a)+13] > x[(b)+2]) ? x[(a)+13] : x[(b)+2]; x[(a)+14] = (x[(a)+14] > x[(b)+1]) ? x[(a)+14] : x[(b)+1]; x[(a)+15] = (x[(a)+15] > x[(b)+0]) ? x[(a)+15] : x[(b)+0]; PEER_CE(x[(a)+0], x[(a)+8]); PEER_CE(x[(a)+1], x[(a)+9]); PEER_CE(x[(a)+2], x[(a)+10]); PEER_CE(x[(a)+3], x[(a)+11]); PEER_CE(x[(a)+4], x[(a)+12]); PEER_CE(x[(a)+5], x[(a)+13]); PEER_CE(x[(a)+6], x[(a)+14]); PEER_CE(x[(a)+7], x[(a)+15]); PEER_CE(x[(a)+0], x[(a)+4]); PEER_CE(x[(a)+1], x[(a)+5]); PEER_CE(x[(a)+2], x[(a)+6]); PEER_CE(x[(a)+3], x[(a)+7]); PEER_CE(x[(a)+8], x[(a)+12]); PEER_CE(x[(a)+9], x[(a)+13]); PEER_CE(x[(a)+10], x[(a)+14]); PEER_CE(x[(a)+11], x[(a)+15]); PEER_CE(x[(a)+0], x[(a)+2]); PEER_CE(x[(a)+1], x[(a)+3]); PEER_CE(x[(a)+4], x[(a)+6]); PEER_CE(x[(a)+5], x[(a)+7]); PEER_CE(x[(a)+8], x[(a)+10]); PEER_CE(x[(a)+9], x[(a)+11]); PEER_CE(x[(a)+12], x[(a)+14]); PEER_CE(x[(a)+13], x[(a)+15]); PEER_CE(x[(a)+0], x[(a)+1]); PEER_CE(x[(a)+2], x[(a)+3]); PEER_CE(x[(a)+4], x[(a)+5]); PEER_CE(x[(a)+6], x[(a)+7]); PEER_CE(x[(a)+8], x[(a)+9]); PEER_CE(x[(a)+10], x[(a)+11]); PEER_CE(x[(a)+12], x[(a)+13]); PEER_CE(x[(a)+14], x[(a)+15]); } while (0)
#define PEER_MERGE16_SET(x, a, b) do { x[(a)+0] = (x[(a)+0] > x[(b)+15]) ? x[(a)+0] : x[(b)+15]; x[(a)+1] = (x[(a)+1] > x[(b)+14]) ? x[(a)+1] : x[(b)+14]; x[(a)+2] = (x[(a)+2] > x[(b)+13]) ? x[(a)+2] : x[(b)+13]; x[(a)+3] = (x[(a)+3] > x[(b)+12]) ? x[(a)+3] : x[(b)+12]; x[(a)+4] = (x[(a)+4] > x[(b)+11]) ? x[(a)+4] : x[(b)+11]; x[(a)+5] = (x[(a)+5] > x[(b)+10]) ? x[(a)+5] : x[(b)+10]; x[(a)+6] = (x[(a)+6] > x[(b)+9]) ? x[(a)+6] : x[(b)+9]; x[(a)+7] = (x[(a)+7] > x[(b)+8]) ? x[(a)+7] : x[(b)+8]; x[(a)+8] = (x[(a)+8] > x[(b)+7]) ? x[(a)+8] : x[(b)+7]; x[(a)+9] = (x[(a)+9] > x[(b)+6]) ? x[(a)+9] : x[(b)+6]; x[(a)+10] = (x[(a)+10] > x[(b)+5]) ? x[(a)+10] : x[(b)+5]; x[(a)+11] = (x[(a)+11] > x[(b)+4]) ? x[(a)+11] : x[(b)+4]; x[(a)+12] = (x[(a)+12] > x[(b)+3]) ? x[(a)+12] : x[(b)+3]; x[(a)+13] = (x[(a)+13] > x[(b)+2]) ? x[(a)+13] : x[(b)+2]; x[(a)+14] = (x[(a)+14] > x[(b)+1]) ? x[(a)+14] : x[(b)+1]; x[(a)+15] = (x[(a)+15] > x[(b)+0]) ? x[(a)+15] : x[(b)+0]; } while (0)
constexpr int PEER_NCAND = 50;
__device__ const unsigned char PEER_CAND[64] = {0, 16, 32, 48, 64, 80, 96, 112, 128, 144, 160, 176, 192, 208, 224, 240, 1, 17, 33, 49, 65, 81, 97, 113, 2, 18, 34, 50, 66, 3, 19, 35, 51, 4, 20, 36, 5, 21, 6, 22, 7, 23, 8, 9, 10, 11, 12, 13, 14, 15, 0, 0, 0, 0, 0, 0, 0, 0, 0, 0, 0, 0, 0, 0};
#define PEER_CAND_SUMS(x, v0, v1, KEYF) do { x[0] = KEYF((v0)[0] + (v1)[0], 0); x[1] = KEYF((v0)[0] + (v1)[1], 1); x[2] = KEYF((v0)[0] + (v1)[2], 2); x[3] = KEYF((v0)[0] + (v1)[3], 3); x[4] = KEYF((v0)[0] + (v1)[4], 4); x[5] = KEYF((v0)[0] + (v1)[5], 5); x[6] = KEYF((v0)[0] + (v1)[6], 6); x[7] = KEYF((v0)[0] + (v1)[7], 7); x[8] = KEYF((v0)[0] + (v1)[8], 8); x[9] = KEYF((v0)[0] + (v1)[9], 9); x[10] = KEYF((v0)[0] + (v1)[10], 10); x[11] = KEYF((v0)[0] + (v1)[11], 11); x[12] = KEYF((v0)[0] + (v1)[12], 12); x[13] = KEYF((v0)[0] + (v1)[13], 13); x[14] = KEYF((v0)[0] + (v1)[14], 14); x[15] = KEYF((v0)[0] + (v1)[15], 15); x[16] = KEYF((v0)[1] + (v1)[0], 16); x[17] = KEYF((v0)[1] + (v1)[1], 17); x[18] = KEYF((v0)[1] + (v1)[2], 18); x[19] = KEYF((v0)[1] + (v1)[3], 19); x[20] = KEYF((v0)[1] + (v1)[4], 20); x[21] = KEYF((v0)[1] + (v1)[5], 21); x[22] = KEYF((v0)[1] + (v1)[6], 22); x[23] = KEYF((v0)[1] + (v1)[7], 23); x[24] = KEYF((v0)[2] + (v1)[0], 24); x[25] = KEYF((v0)[2] + (v1)[1], 25); x[26] = KEYF((v0)[2] + (v1)[2], 26); x[27] = KEYF((v0)[2] + (v1)[3], 27); x[28] = KEYF((v0)[2] + (v1)[4], 28); x[29] = KEYF((v0)[3] + (v1)[0], 29); x[30] = KEYF((v0)[3] + (v1)[1], 30); x[31] = KEYF((v0)[3] + (v1)[2], 31); x[32] = KEYF((v0)[3] + (v1)[3], 32); x[33] = KEYF((v0)[4] + (v1)[0], 33); x[34] = KEYF((v0)[4] + (v1)[1], 34); x[35] = KEYF((v0)[4] + (v1)[2], 35); x[36] = KEYF((v0)[5] + (v1)[0], 36); x[37] = KEYF((v0)[5] + (v1)[1], 37); x[38] = KEYF((v0)[6] + (v1)[0], 38); x[39] = KEYF((v0)[6] + (v1)[1], 39); x[40] = KEYF((v0)[7] + (v1)[0], 40); x[41] = KEYF((v0)[7] + (v1)[1], 41); x[42] = KEYF((v0)[8] + (v1)[0], 42); x[43] = KEYF((v0)[9] + (v1)[0], 43); x[44] = KEYF((v0)[10] + (v1)[0], 44); x[45] = KEYF((v0)[11] + (v1)[0], 45); x[46] = KEYF((v0)[12] + (v1)[0], 46); x[47] = KEYF((v0)[13] + (v1)[0], 47); x[48] = KEYF((v0)[14] + (v1)[0], 48); x[49] = KEYF((v0)[15] + (v1)[0], 49); x[50] = (int)0x80000000; x[51] = (int)0x80000000; x[52] = (int)0x80000000; x[53] = (int)0x80000000; x[54] = (int)0x80000000; x[55] = (int)0x80000000; x[56] = (int)0x80000000; x[57] = (int)0x80000000; x[58] = (int)0x80000000; x[59] = (int)0x80000000; x[60] = (int)0x80000000; x[61] = (int)0x80000000; x[62] = (int)0x80000000; x[63] = (int)0x80000000; } while (0)

__device__ __forceinline__ int crow(int r, int hi) { return (r & 3) + 8 * (r >> 2) + 4 * hi; }
__device__ __forceinline__ int f2key(float f) { const int t = __builtin_bit_cast(int, f); return t ^ ((t >> 31) & 0x7fffffff); }
__device__ __forceinline__ float key2f(int t) { return __builtin_bit_cast(float, t ^ ((t >> 31) & 0x7fffffff)); }
__device__ __forceinline__ int sel_hi(int a, int b, int hm) { int r; asm("v_bfi_b32 %0, %1, %2, %3" : "=v"(r) : "v"(hm), "v"(b), "v"(a)); return r; }
__device__ __forceinline__ float fsel(float a, float b, int m) { return __int_as_float(sel_hi(__float_as_int(a), __float_as_int(b), m)); }
typedef float f32x2 __attribute__((ext_vector_type(2)));
__device__ __forceinline__ int key7(float f, int low) { return (f2key(f) & ~127) | low; }
__device__ __forceinline__ int key6(float f, int ord) { return (f2key(f) & ~63) | (63 - ord); }
__device__ __forceinline__ void top16_of_64(int (&x)[64]) {
    PEER_SORT16(x, 0); PEER_SORT16(x, 16); PEER_SORT16(x, 32); PEER_SORT16(x, 48);
    PEER_MERGE16(x, 0, 16); PEER_MERGE16(x, 32, 48); PEER_MERGE16(x, 0, 32);
}
__device__ __forceinline__ float dot2_bf16(unsigned w, unsigned x, float acc) { return __builtin_amdgcn_fdot2_f32_bf16(__builtin_bit_cast(bf16x2_t, w), __builtin_bit_cast(bf16x2_t, x), acc, false); }
__device__ __forceinline__ float dot8(const u32x4 a, const u32x4 b, float acc) {
    acc = dot2_bf16(a.x, b.x, acc); acc = dot2_bf16(a.y, b.y, acc); acc = dot2_bf16(a.z, b.z, acc); acc = dot2_bf16(a.w, b.w, acc); return acc;
}
__device__ __forceinline__ float gelu_tanh(float x) {
    const float u = 0.7978845608028654f * (x + 0.044715f * x * x * x);
    const float e = __builtin_amdgcn_exp2f(2.0f * LOG2E * u);
    const float th = 1.0f - 2.0f * __builtin_amdgcn_rcpf(e + 1.0f);
    return 0.5f * x * (1.0f + th);
}
__device__ __forceinline__ void topk_half(const bf16* qp, const bf16* sp, int hi, int (&T)[16]) {
    bf16x8 qf[8];
#pragma unroll
    for (int ks = 0; ks < 8; ++ks) qf[ks] = *(const GAS bf16x8*)(qp + ks * 16);
    const int hi4 = hi << 2;
    int x[64];
#pragma unroll
    for (int kt = 0; kt < 4; ++kt) { f32x16 sc = f32x16{};
#pragma unroll
        for (int ks = 0; ks < 8; ++ks) { const bf16x8 a = *(const GAS bf16x8*)(sp + (size_t)(32 * kt) * 128 + ks * 16); sc = __builtin_amdgcn_mfma_f32_32x32x16_bf16(a, qf[ks], sc, 0, 0, 0); }
#pragma unroll
        for (int r = 0; r < 16; ++r) x[16 * kt + r] = ((f2key(sc[r]) & ~127) | (127 - (32 * kt + crow(r, 0)))) ^ hi4; }
    top16_of_64(x);
#pragma unroll
    for (int i = 0; i < 16; ++i) { auto rr = __builtin_amdgcn_permlane32_swap((unsigned)x[i], (unsigned)x[i], false, false); x[i] = (int)rr[0]; x[16 + i] = (int)rr[1]; }
    PEER_MERGE16(x, 0, 16);
#pragma unroll
    for (int i = 0; i < 16; ++i) T[i] = x[i];
}
__device__ __forceinline__ float fp8dot4(unsigned w, float h0, float h1, float h2, float h3) {
    const f32x2 lo = __builtin_amdgcn_cvt_pk_f32_fp8((int)w, false), hi = __builtin_amdgcn_cvt_pk_f32_fp8((int)w, true);
    return (lo.x * h0 + lo.y * h1) + (hi.x * h2 + hi.y * h3);
}
__device__ __forceinline__ float fp8dot16(const u32x4 u, const float (&h)[16]) {
    return (fp8dot4(u.x, h[0], h[1], h[2], h[3]) + fp8dot4(u.y, h[4], h[5], h[6], h[7])) + (fp8dot4(u.z, h[8], h[9], h[10], h[11]) + fp8dot4(u.w, h[12], h[13], h[14], h[15]));
}
__device__ __forceinline__ void fp8axpy4(unsigned w, float c, float& a0, float& a1, float& a2, float& a3) {
    const f32x2 lo = __builtin_amdgcn_cvt_pk_f32_fp8((int)w, false), hi = __builtin_amdgcn_cvt_pk_f32_fp8((int)w, true);
    a0 += c * lo.x; a1 += c * lo.y; a2 += c * hi.x; a3 += c * hi.y;
}
__device__ __forceinline__ void fp8axpy16(const u32x4 v, float c, float (&a)[16]) {
    fp8axpy4(v.x, c, a[0], a[1], a[2], a[3]); fp8axpy4(v.y, c, a[4], a[5], a[6], a[7]); fp8axpy4(v.z, c, a[8], a[9], a[10], a[11]); fp8axpy4(v.w, c, a[12], a[13], a[14], a[15]);
}
constexpr int L_ROUTE = 0, L_NLIST = 32768, L_CAND = 40960, L_COEF = 41472, L_END = 45568;
__device__ __forceinline__ void peer_tile(int tile, const bf16* PQ, const bf16* SK, const float* SSQ, const unsigned char* U8, const unsigned char* V8, const float* gfin, float* out, LAS unsigned char* lds, int mode = 3, float* outw = nullptr) {
    const int lane = threadIdx.x & 63, r32 = lane & 31, hi = lane >> 5; const int wid = __builtin_amdgcn_readfirstlane((int)threadIdx.x >> 6);
    const int tok0 = tile * 32; if (!outw) outw = out;
    LAS unsigned* route = (LAS unsigned*)(lds + L_ROUTE);
    LAS unsigned char* nl = lds + L_NLIST + (wid * 32 + r32) * 32;
    const LAS unsigned char* cand = lds + L_CAND;
    if (mode & 1) {
        const int h = wid; int T0[16], T1[16];
        topk_half(PQ + (size_t)(tok0 + r32) * NPQ + (h * 2 + 0) * 128 + hi * 8, SK + ((size_t)(h * 2 + 0) * 128 + r32) * 128 + hi * 8, hi, T0);
        topk_half(PQ + (size_t)(tok0 + r32) * NPQ + (h * 2 + 1) * 128 + hi * 8, SK + ((size_t)(h * 2 + 1) * 128 + r32) * 128 + hi * 8, hi, T1);
        const int hm = -hi;
        {
            u32x4 w;
#pragma unroll
            for (int q4 = 0; q4 < 4; ++q4) { unsigned a = 0;
#pragma unroll
                for (int e = 0; e < 4; ++e) { const int t = sel_hi(T0[4 * q4 + e], T1[4 * q4 + e], hm); a |= (unsigned)(127 - (t & 127)) << (8 * e); }
                w[q4] = a; }
            *(LAS u32x4*)(nl + 16 * hi) = w;
        }
        float v0[16], v1[16];
#pragma unroll
        for (int i = 0; i < 16; ++i) { v0[i] = key2f(T0[i] & ~127); v1[i] = key2f(T1[i] & ~127); }
        int x[64];
        PEER_CAND_SUMS(x, v0, v1, key6);
        top16_of_64(x);
        const float smax = key2f(x[0] & ~63);
        float p[16], ps = 0.f;
#pragma unroll
        for (int i = 0; i < 16; ++i) { p[i] = __builtin_amdgcn_exp2f((key2f(x[i] & ~63) - smax) * LOG2E); ps += p[i]; }
        const float rps = 1.0f / ps;
        LDS_WAIT();
#pragma unroll
        for (int i = 0; i < 8; ++i) {
            const int xi = sel_hi(x[i], x[8 + i], hm); const float g = __int_as_float(sel_hi(__float_as_int(p[i]), __float_as_int(p[8 + i]), hm)) * rps;
            const int ij = cand[63 - (xi & 63)]; const int n0 = nl[ij & 15], n1 = nl[16 + (ij >> 4)];
            u32x2 w; w.x = (unsigned)(n0 * 128 + n1); w.y = __float_as_uint(g);
            *(LAS u32x2*)(route + ((size_t)r32 * 128 + h * 16 + 8 * hi + i) * 2) = w; }
    }
    LDS_WAIT(); __syncthreads();
    const int m0 = -(lane & 1), m1 = -((lane >> 1) & 1), m2 = -((lane >> 2) & 1);
    const int jj = ((lane & 1) << 2) | (lane & 2) | ((lane >> 2) & 1);
#pragma unroll 1
    for (int tt = 0; tt < ((mode & 2) ? 4 : 0); ++tt) {
        const int tl = wid * 4 + tt; const size_t tok = (size_t)tok0 + tl;
        const LAS unsigned* rt = route + tl * 256;
        float* orow = out + tok * 1024; float* wrow = outw + tok * 1024;
        float rstd;
        { const f32x4* sp = (const f32x4*)(SSQ + tok * 16); const f32x4 a = sp[0], b = sp[1], c = sp[2], d = sp[3]; const f32x4 t = (a + b) + (c + d);
          rstd = __builtin_amdgcn_rsqf(((t[0] + t[1]) + (t[2] + t[3])) * (1.0f / 1024.0f) + RMS_EPS); }
        float hr[16];
        { const float sc = rstd * (1.0f / 256.0f);
#pragma unroll
          for (int q = 0; q < 4; ++q) { const f32x4 t = *(const GAS f32x4*)(orow + lane * 16 + q * 4); hr[4 * q] = t.x * sc; hr[4 * q + 1] = t.y * sc; hr[4 * q + 2] = t.z * sc; hr[4 * q + 3] = t.w * sc; } }
        float acc[16];
#pragma unroll
        for (int i = 0; i < 16; ++i) acc[i] = 0.f;
        u32x4 uA[8], uB[8], vv[8];
#define PEER_LOADU(U_, k0_) do { _Pragma("unroll") for (int j = 0; j < 8; ++j) { const int e = __builtin_amdgcn_readfirstlane((int)rt[((k0_) + j) * 2]); U_[j] = *(const GAS u32x4*)(U8 + (size_t)e * 1024 + lane * 16); } } while (0)
#define PEER_LOADV(V_, k0_) do { _Pragma("unroll") for (int j = 0; j < 8; ++j) { const int e = __builtin_amdgcn_readfirstlane((int)rt[((k0_) + j) * 2]); V_[j] = *(const GAS u32x4*)(V8 + (size_t)e * 1024 + lane * 16); } } while (0)
#define PEER_COMPUTE(U_, V_, k0_) do { float d_[8]; \
            _Pragma("unroll") for (int j = 0; j < 8; ++j) d_[j] = fp8dot16(U_[j], hr); \
            float e_[4], f_[2]; \
            _Pragma("unroll") for (int i = 0; i < 4; ++i) { const float keep = fsel(d_[i], d_[i + 4], m0), send = fsel(d_[i + 4], d_[i], m0); e_[i] = keep + __shfl_xor(send, 1); } \
            _Pragma("unroll") for (int i = 0; i < 2; ++i) { const float keep = fsel(e_[i], e_[i + 2], m1), send = fsel(e_[i + 2], e_[i], m1); f_[i] = keep + __shfl_xor(send, 2); } \
            float g_ = fsel(f_[0], f_[1], m2) + __shfl_xor(fsel(f_[1], f_[0], m2), 4); \
            g_ += __shfl_xor(g_, 8); g_ += __shfl_xor(g_, 16); g_ += __shfl_xor(g_, 32); \
            const float cfl = __uint_as_float(rt[((k0_) + jj) * 2 + 1]) * gelu_tanh(g_) * (1.0f / 16.0f); \
            _Pragma("unroll") for (int j = 0; j < 8; ++j) { const int src = ((j & 1) << 2) | (j & 2) | ((j >> 2) & 1); \
                const float cj = __int_as_float(__builtin_amdgcn_readlane(__float_as_int(cfl), src)); \
                fp8axpy16(V_[j], cj, acc); } } while (0)
        PEER_LOADU(uA, 0);
#pragma unroll 1
        for (int k0 = 0; k0 < 128; k0 += 16) {
            PEER_LOADV(vv, k0); PEER_LOADU(uB, k0 + 8); __builtin_amdgcn_sched_barrier(0);
            PEER_COMPUTE(uA, vv, k0); __builtin_amdgcn_sched_barrier(0);
            PEER_LOADV(vv, k0 + 8); PEER_LOADU(uA, (k0 + 16) & 127); __builtin_amdgcn_sched_barrier(0);
            PEER_COMPUTE(uB, vv, k0 + 8); __builtin_amdgcn_sched_barrier(0);
        }
#undef PEER_LOADU
#undef PEER_LOADV
#undef PEER_COMPUTE
        float hv[16]; float s = 0.f;
#pragma unroll
        for (int q = 0; q < 4; ++q) { const f32x4 t = *(const GAS f32x4*)(orow + lane * 16 + q * 4);
            hv[4 * q] = t.x + acc[4 * q]; hv[4 * q + 1] = t.y + acc[4 * q + 1]; hv[4 * q + 2] = t.z + acc[4 * q + 2]; hv[4 * q + 3] = t.w + acc[4 * q + 3];
            s += (hv[4 * q] * hv[4 * q] + hv[4 * q + 1] * hv[4 * q + 1]) + (hv[4 * q + 2] * hv[4 * q + 2] + hv[4 * q + 3] * hv[4 * q + 3]); }
        const float rs = 1.0f / sqrtf(wave_sum(s) * (1.f / 1024.f) + RMS_EPS);
#pragma unroll
        for (int q = 0; q < 4; ++q) { const f32x4 g = *(const GAS f32x4*)(gfin + lane * 16 + q * 4); f32x4 t;
            t.x = hv[4 * q] * rs * g.x; t.y = hv[4 * q + 1] * rs * g.y; t.z = hv[4 * q + 2] * rs * g.z; t.w = hv[4 * q + 3] * rs * g.w;
            *(GAS f32x4*)(wrow + lane * 16 + q * 4) = t; }
    }
    LDS_WAIT(); __syncthreads();
}
}
struct Args { const float* in[20]; float* out; unsigned char* ws; int ph_lo, ph_hi, li, pad; };
__global__ void __launch_bounds__(NWAVES * 64, 2) fwd_megakernel(Args args) {
    extern __shared__ __attribute__((aligned(16))) unsigned char lds[];
    LAS unsigned char* ldsp = (LAS unsigned char*)lds;
    volatile LAS unsigned* MISC = (volatile LAS unsigned*)(ldsp + MISC_OFF);
    const int tid = threadIdx.x, lane = tid & 63, wave = __builtin_amdgcn_readfirstlane(tid >> 6);
    const int G = gridDim.x; const int bx = blockIdx.x; const int vcu = (G % 8 == 0) ? (bx % 8) * (G / 8) + bx / 8 : bx;
    unsigned char* ws = args.ws;
    gu32* ctl = (gu32*)(ws + WS_CTL);
    const float* x = args.in[0]; const float* mem = args.in[1]; const float* norm_mix = args.in[2]; const float* w_in = args.in[3]; const float* conv_w = args.in[4];
    const float* w_ba = args.in[5]; const float* w_bc = args.in[6]; const float* w_out = args.in[7]; const float* norm_xattn = args.in[8]; const float* norm_mem = args.in[9];
    const float* xwq = args.in[10]; const float* xwk = args.in[11]; const float* xwv = args.in[12]; const float* xwo = args.in[13]; const float* norm_ffn = args.in[14];
    const float* pwq = args.in[15]; const float* psk = args.in[16]; const float* pu = args.in[17]; const float* pv = args.in[18]; const float* norm_final = args.in[19];
    float* out = args.out;
    bf16* Win_t = (bf16*)(ws + WS_WIN); bf16* Wa_t = (bf16*)(ws + WS_WA); bf16* Wc_t = (bf16*)(ws + WS_WC); bf16* Wo_t = (bf16*)(ws + WS_WO); bf16* Wq2_t = (bf16*)(ws + WS_WQ2);
    bf16* Wkv2_t = (bf16*)(ws + WS_WKV2); bf16* Wo2_t = (bf16*)(ws + WS_WO2); bf16* Wpq_t = (bf16*)(ws + WS_WPQ); bf16* SKb = (bf16*)(ws + WS_SK);
    float* SSQ1 = (float*)(ws + WS_SSQ1); float* SSQ2 = (float*)(ws + WS_SSQ2); bf16* MEMN = (bf16*)(ws + WS_MEMN); bf16* K2 = (bf16*)(ws + WS_K2); bf16* V2T = (bf16*)(ws + WS_V2T);
    bf16* B0 = (bf16*)(ws + WS_B0); bf16* B1 = (bf16*)(ws + WS_B1); bf16* B2 = (bf16*)(ws + WS_B2); bf16* B3 = (bf16*)(ws + WS_B3); bf16* B4 = (bf16*)(ws + WS_B4); bf16* B5 = (bf16*)(ws + WS_B5);
    bf16* XN1 = (bf16*)out; bf16* YC = (bf16*)out; bf16* CBb = (bf16*)((unsigned char*)out + 32 * MiB);

    for (int u = tid; u < (LDS_BYTES - LDSCTL_OFF) / 4; u += NWAVES * 64) ((LAS unsigned*)(ldsp + LDSCTL_OFF))[u] = 0u;
    __syncthreads();
    XcdBarrier bar; bar.bar = (unsigned*)(ctl + CW_BAR); bar.x = 0; bar.st = nullptr;
    if (N_LAUNCHES == 1) bar = xcd_barrier_post((unsigned*)(ctl + CW_BAR), MISC + 8);
#define GRID_BAR() do { if (N_LAUNCHES == 1) xcd_barrier(bar); } while (0)
    const int lo = args.ph_lo, hi = args.ph_hi;
#define IN(k) (lo <= (k) && (k) < hi)
#define BOTH(k) (IN(k) && IN((k) + 1))
    const int gw = vcu * NWAVES + wave, NGW = G * NWAVES;

    if (IN(0)) {
        LAS float* scr = (LAS float*)(ldsp + RING_OFF + wave * 16384);
        constexpr int I_IN = 16 * 256, I_SQ = 16 * 32, I_PQ = 16 * 64;
        constexpr int NT_ITEMS = I_IN + 7 * I_SQ + I_PQ;
        for (int it = gw; it < NT_ITEMS; it += NGW) {
            int r = it;
            if (r < I_IN) { transpose_item<true>(w_in, D, NIN, nullptr, Win_t, 0, scr, r, lane); continue; } r -= I_IN;
            if (r < I_SQ) { transpose_item<false>(w_ba, D, D, nullptr, Wa_t, 0, scr, r, lane); continue; } r -= I_SQ;
            if (r < I_SQ) { transpose_item<false>(w_bc, D, D, nullptr, Wc_t, 0, scr, r, lane); continue; } r -= I_SQ;
            if (r < I_SQ) { transpose_item<false>(w_out, D, D, nullptr, Wo_t, 0, scr, r, lane); continue; } r -= I_SQ;
            if (r < I_SQ) { transpose_item<false>(xwq, D, D, norm_xattn, Wq2_t, 0, scr, r, lane); continue; } r -= I_SQ;
            if (r < I_SQ) { transpose_item<false>(xwk, D, D, nullptr, Wkv2_t, 0, scr, r, lane); continue; } r -= I_SQ;
            if (r < I_SQ) { transpose_item<false>(xwv, D, D, nullptr, Wkv2_t, D, scr, r, lane); continue; } r -= I_SQ;
            if (r < I_SQ) { transpose_item<false>(xwo, D, D, nullptr, Wo2_t, 0, scr, r, lane); continue; } r -= I_SQ;
            transpose_item<false>(pwq, D, NPQ, norm_ffn, Wpq_t, 0, scr, r, lane);
        }
        for (int it = gw; it < 512; it += NGW) {
            const GAS f32x4* s = (const GAS f32x4*)psk + (size_t)it * 128 + lane * 2; const f32x4 a = s[0], b = s[1];
            v4u o; o.x = pk2(a.x, a.y); o.y = pk2(a.z, a.w); o.z = pk2(b.x, b.y); o.w = pk2(b.z, b.w);
            *((GAS v4u*)SKb + (size_t)it * 64 + lane) = o; }
        for (int m = gw; m < M; m += NGW) rms_row_to_bf16(x + (size_t)m * D, norm_mix, XN1 + (size_t)m * D, lane);
        for (int m = gw; m < MROWS; m += NGW) rms_row_to_bf16(mem + (size_t)m * D, norm_mem, MEMN + (size_t)m * D, lane);
        if (BOTH(0)) GRID_BAR();
    }

    if (IN(1)) {
        pg8::GemmSet g{XN1, Win_t, XN1, Win_t, D}; pg8::TileOrder S; S.init(M, NIN, G, bx);
        pg8::EpiInProj E{B0, B1, B2, B3, CBb, B4, B5, 0.125f * LOG2E};
        pg8::gemm_phase<pg8::EpiInProj, pg8::TileOrder, true, true>(ldsp + RING_OFF, g, S, E);
        if (BOTH(1)) GRID_BAR();
    }

    if (IN(2)) {
        {
            const int bh = vcu >> 1, s = vcu & 1;
            if (bh < BATCH * 16) {
#pragma unroll 1
                for (int i = 0; i < 4; ++i) { const int qb = (i == 0) ? s : (i == 1) ? 7 - s : (i == 2) ? 2 + s : 5 - s;
                    sb::sb_unit<true>(bh >> 4, bh & 15, qb, (const sb::bf16*)B0, (const sb::bf16*)B1, (const sb::bf16*)B2, (sb::bf16*)B0, (char*)lds + RING_OFF); }
            }
            asm volatile("s_waitcnt vmcnt(0) lgkmcnt(0)" ::: "memory"); __syncthreads();
        }
        if (vcu < 32) {
            pg8::GemmSet g{MEMN, Wkv2_t, MEMN, Wkv2_t, D}; pg8::SubOrder S; S.init(MROWS, D, 0, vcu);
            pg8::EpiStore E{K2, D, 1.0f};
            pg8::gemm_phase<pg8::EpiStore, pg8::SubOrder, false, true>(ldsp + RING_OFF, g, S, E);
        } else if (vcu < 64) {
            pg8::GemmSet g{Wkv2_t + (size_t)D * D, MEMN, Wkv2_t + (size_t)D * D, MEMN, D}; pg8::SubOrder S; S.init(D, MROWS, 32, vcu);
            pg8::EpiStoreKPerm E{V2T, MROWS};
            pg8::gemm_phase<pg8::EpiStoreKPerm, pg8::SubOrder, false, true>(ldsp + RING_OFF, g, S, E);
        } else {
            const int cw_ = (vcu - 64) * NWAVES + wave, ncw = (G - 64) * NWAVES;
            for (int it = cw_; it < M / 8; it += ncw) yconv_item(B3, CBb, conv_w, YC, it, lane);
        }
        if (BOTH(2)) GRID_BAR();
    }

    if (IN(3)) {
        pg8::GemmSet g{B0, Wa_t, YC, Wc_t, D}; pg8::TileOrder S; S.init(M, D, G, bx, 2);
        pg8::EpiGate E{B1, B4, B5};
        pg8::gemm_phase<pg8::EpiGate, pg8::TileOrder, true, true>(ldsp + RING_OFF, g, S, E);
        if (BOTH(3)) GRID_BAR();
    }

    if (IN(4)) {
        pg8::GemmSet g{B1, Wo_t, B1, Wo_t, D}; pg8::TileOrder S; S.init(M, D, G, bx);
        pg8::EpiResid E{x, out, B2, SSQ1};
        pg8::gemm_phase<pg8::EpiResid, pg8::TileOrder, true, true>(ldsp + RING_OFF, g, S, E);
        if (BOTH(4)) GRID_BAR();
    }

    if (IN(5)) {
        pg8::GemmSet g{B2, Wq2_t, B2, Wq2_t, D}; pg8::TileOrder S; S.init(M, D, G, bx);
        pg8::EpiRowScale E{B3, D, SSQ1, LOG2E / 16.0f, RMS_EPS};
        pg8::gemm_phase<pg8::EpiRowScale, pg8::TileOrder, true, true>(ldsp + RING_OFF, g, S, E);
        for (int r = gw; r < 2 * 16384; r += NGW) {
            if (r < 16384) row_to_fp8(pu + (size_t)r * D, norm_ffn, 256.0f, (unsigned char*)B4 + (size_t)r * D, lane);
            else row_to_fp8(pv + (size_t)(r - 16384) * D, nullptr, 16.0f, (unsigned char*)B4 + 16 * MiB + (size_t)(r - 16384) * D, lane); }
        if (BOTH(5)) GRID_BAR();
    }

    if (IN(6)) {
#ifndef NO_XA
        for (int u = 2 * vcu; u < 512; u += 2 * G) { xa::xattn_unit(u >> 6, (u >> 4) & 3, u & 15, B3, K2, V2T, B0, (char*)lds + RING_OFF); xa::xattn_unit(u >> 6, (u >> 4) & 3, (u & 15) + 1, B3, K2, V2T, B0, (char*)lds + RING_OFF); }
        asm volatile("s_waitcnt vmcnt(0) lgkmcnt(0)" ::: "memory"); __syncthreads();
#endif
        if (BOTH(6)) GRID_BAR();
    }

    if (IN(7)) {
        pg8::GemmSet g{B0, Wo2_t, B0, Wo2_t, D}; pg8::TileOrder S; S.init(M, D, G, bx);
        pg8::EpiResid E{out, out, B1, SSQ2};
        pg8::gemm_phase<pg8::EpiResid, pg8::TileOrder, true, true>(ldsp + RING_OFF, g, S, E);
        if (BOTH(7)) GRID_BAR();
    }

    if (IN(8)) {
        pg8::GemmSet g{B1, Wpq_t, B1, Wpq_t, D}; pg8::TileOrder S; S.init(M, NPQ, G, bx);
        pg8::EpiRowScale E{B2, NPQ, SSQ2, 1.0f, RMS_EPS};
        pg8::gemm_phase<pg8::EpiRowScale, pg8::TileOrder, true, true>(ldsp + RING_OFF, g, S, E);
        if (BOTH(8)) GRID_BAR();
    }

    if (IN(9)) {
        if (tid < 64) { int cnt = 0, val = 0;
            for (int ii = 0; ii < 16; ++ii) { const int nj = 16 / (ii + 1); if (tid >= cnt && tid < cnt + nj) val = ii | ((tid - cnt) << 4); cnt += nj; }
            ldsp[RING_OFF + peer::L_CAND + tid] = (unsigned char)val; }
        LDS_WAIT(); __syncthreads();
#ifndef NO_PEER
        for (int tile = vcu; tile < M / 32; tile += G) {
#ifdef PROBE_P9
            peer::peer_tile(tile, B2, SKb, SSQ2, (const unsigned char*)B4, (const unsigned char*)B4 + 16 * MiB, norm_final, out, ldsp + RING_OFF, PROBE_P9, (float*)B0);
#endif
            peer::peer_tile(tile, B2, SKb, SSQ2, (const unsigned char*)B4, (const unsigned char*)B4 + 16 * MiB, norm_final, out, ldsp + RING_OFF); }
#else
        for (int m = gw; m < M; m += NGW) final_norm_row(out + (size_t)m * D, norm_final, out + (size_t)m * D, lane);
#endif
    }
#undef IN
#undef BOTH
#undef GRID_BAR
}

extern "C" void kernel_launch(void* const* d_in, const int* in_sizes, int n_in, void* d_out, int out_size, void* d_ws, size_t ws_size, hipStream_t stream) {
    static int grid = 0;
    if (grid == 0) {
        if (n_in != 20 || in_sizes[0] != M * D || out_size != M * D || ws_size < WS_END) { fprintf(stderr, "kernel_launch: unexpected shapes (n_in %d, in0 %d, out %d, ws %zu); nothing launched\n", n_in, n_in > 0 ? in_sizes[0] : -1, out_size, ws_size); grid = -1; return; }
        int dev = 0, cus = 0, per_cu = 0;
        if (hipGetDevice(&dev) != hipSuccess || hipDeviceGetAttribute(&cus, hipDeviceAttributeMultiprocessorCount, dev) != hipSuccess) { grid = -1; return; }
        if (hipFuncSetAttribute((const void*)fwd_megakernel, hipFuncAttributeMaxDynamicSharedMemorySize, LDS_BYTES) != hipSuccess) { fprintf(stderr, "kernel_launch: hipFuncSetAttribute failed\n"); grid = -1; return; }
        if (hipOccupancyMaxActiveBlocksPerMultiprocessor(&per_cu, (const void*)fwd_megakernel, NWAVES * 64, LDS_BYTES) != hipSuccess || per_cu < 1)
            fprintf(stderr, "kernel_launch: note: occupancy query reports %d workgroups per CU\n", per_cu);
        (void)hipGetLastError();
        grid = cus;
    }
    if (grid < 0) return;
    if (hipMemsetAsync((char*)d_ws + WS_CTL, 0, CTL_ZERO_BYTES, stream) != hipSuccess) { fprintf(stderr, "kernel_launch: hipMemsetAsync failed\n"); return; }
    Args a{};
    for (int i = 0; i < 20; ++i) a.in[i] = (const float*)d_in[i];
    a.out = (float*)d_out; a.ws = (unsigned char*)d_ws;
    if (N_LAUNCHES == 1) { a.ph_lo = 0; a.ph_hi = N_PHASES; a.li = 0; hipLaunchKernelGGL(fwd_megakernel, dim3(grid), dim3(NWAVES * 64), LDS_BYTES, stream, a); }
    else for (int li = 0; li < N_PHASES; ++li) { a.ph_lo = li; a.ph_hi = li + 1; a.li = li; hipLaunchKernelGGL(fwd_megakernel, dim3(grid), dim3(NWAVES * 64), LDS_BYTES, stream, a);
#ifdef PROBE_DUP
        if (li == PROBE_DUP) hipLaunchKernelGGL(fwd_megakernel, dim3(grid), dim3(NWAVES * 64), LDS_BYTES, stream, a);
#endif
    }
    const hipError_t le = hipPeekAtLastError();
    if (le != hipSuccess) fprintf(stderr, "kernel_launch: launch failed: %s\n", hipGetErrorName(le));
}
```

```cpp
#include <hip/hip_runtime.h>
#include <hip/hip_bf16.h>
#include <cstdio>
#include <cstdint>
#include <cmath>

#ifndef MK_N_LAUNCHES
#define MK_N_LAUNCHES 1
#endif
namespace pg8 {
#define PG8_LAS __attribute__((address_space(3)))
typedef unsigned short bf16_t;
typedef short bf16x8 __attribute__((ext_vector_type(8)));
typedef float f32x4 __attribute__((ext_vector_type(4)));
typedef float f32x2 __attribute__((ext_vector_type(2)));
typedef unsigned u32x4 __attribute__((ext_vector_type(4)));
typedef unsigned u32x2 __attribute__((ext_vector_type(2)));
constexpr int BM = 256, BK = 64, HALF = 128, HTB = HALF * BK * 2  , STAGE_BYTES = 8 * HTB, NXCD = 8, WGM = 8;

__host__ __device__ __forceinline__ int lds_byte(int r, int c) { const int st = (r >> 4) * 2 + (c >> 5), rr = r & 15, cc = c & 31, ob = rr * 64 + cc * 2; return st * 1024 + (ob ^ (((ob >> 9) & 1) << 5)); }
__host__ __device__ __forceinline__ void stage_rc(int b, int& R, int& C) { const int st = b / 1024, sb = b % 1024, swz = sb ^ (((sb >> 9) & 1) << 5); R = (st >> 1) * 16 + swz / 64; C = (st & 1) * 32 + (swz % 64) / 2; }
__host__ __device__ __forceinline__ int perm32(int rho) { const int n = rho >> 4, i = rho & 15; return 8 * (i >> 2) + 4 * n + (i & 3); }

struct Unit { int pm, pn, g; };
struct GemmSet { const bf16_t* A0; const bf16_t* B0; const bf16_t* A1; const bf16_t* B1; int K; };

struct TileOrder {
    int nM, nN, nwg, G, c, passes;
    __device__ void init(int M, int N, int G_, int c_, int passes_ = 1) { nM = M / BM; nN = N / BM; nwg = nM * nN; G = G_; c = c_; passes = passes_; }
    __device__ bool next(int i, Unit& u) const {
        const int ti = (passes == 2) ? (i >> 1) : i; u.g = (passes == 2) ? (i & 1) : 0;
        const long L = (long)ti * G + c; if (L >= nwg) return false;
        int wgid = (int)L; { const int q = nwg / NXCD, r = nwg % NXCD, xcd = wgid % NXCD, off = wgid / NXCD; wgid = (xcd < r ? xcd * (q + 1) : r * (q + 1) + (xcd - r) * q) + off; }
        const int nig = WGM * nN, gid = wgid / nig, fm = gid * WGM, gsz = (nM - fm) < WGM ? (nM - fm) : WGM;
        u.pm = fm + ((wgid % nig) % gsz); u.pn = (wgid % nig) / gsz; return true;
    }
    __device__ __forceinline__ void a_ready(const Unit&) const {}
    __device__ __forceinline__ void done(const Unit&) const {}
};
struct SubOrder {
    int nN, n, idx;
    __device__ void init(int M, int N, int c0, int c_) { nN = N / BM; n = (M / BM) * nN; idx = c_ - c0; }
    __device__ bool next(int i, Unit& u) const { if (i != 0 || idx < 0 || idx >= n) return false; u.pm = idx / nN; u.pn = idx % nN; u.g = 0; return true; }
    __device__ __forceinline__ void a_ready(const Unit&) const {}
    __device__ __forceinline__ void done(const Unit&) const {}
};

typedef __bf16 bf16x2_t __attribute__((ext_vector_type(2)));
__device__ __forceinline__ unsigned cvt_pk_bf16(float lo, float hi) { f32x2 v = {lo, hi}; bf16x2_t b = __builtin_convertvector(v, bf16x2_t); return __builtin_bit_cast(unsigned, b); }
__device__ __forceinline__ float bf_lo(unsigned w) { return __builtin_bit_cast(float, w << 16); }
__device__ __forceinline__ float bf_hi(unsigned w) { return __builtin_bit_cast(float, w & 0xffff0000u); }
__device__ __forceinline__ u32x4 pack8(const f32x4 v0, const f32x4 v1) { u32x4 w; w.x = cvt_pk_bf16(v0[0], v0[1]); w.y = cvt_pk_bf16(v0[2], v0[3]); w.z = cvt_pk_bf16(v1[0], v1[1]); w.w = cvt_pk_bf16(v1[2], v1[3]); return w; }
__device__ __forceinline__ float sigmoidf_fast(float x) { return __builtin_amdgcn_rcpf(1.0f + __builtin_amdgcn_exp2f(-1.4426950408889634f * x)); }

struct EpiStore {
    static constexpr bool PERM = true, AFTER_DRAIN = false;
    bf16_t* O; int ldc; float scale;
    __device__ __forceinline__ void operator()(const f32x4 (&acc)[2][2][4][2], const Unit& u, int wr, int wc, int fr, int fq) const {
        const int row0 = u.pm * BM + wr * 64 + fr, col0 = u.pn * BM + wc * 32 + 8 * fq;
#pragma unroll
        for (int ai = 0; ai < 2; ++ai)
#pragma unroll
            for (int m = 0; m < 4; ++m) { bf16_t* rowp = O + (size_t)(row0 + ai * HALF + m * 16) * ldc + col0;
#pragma unroll
                for (int bj = 0; bj < 2; ++bj) *(u32x4*)(rowp + bj * HALF) = pack8(acc[ai][bj][m][0] * scale, acc[ai][bj][m][1] * scale); }
    }
};

struct EpiStoreKPerm {
    static constexpr bool PERM = true, AFTER_DRAIN = false;
    bf16_t* O; int ldc;
    __device__ __forceinline__ void operator()(const f32x4 (&acc)[2][2][4][2], const Unit& u, int wr, int wc, int fr, int fq) const {
        const int row0 = u.pm * BM + wr * 64 + fr, colg = u.pn * BM + wc * 32;
#pragma unroll
        for (int ai = 0; ai < 2; ++ai)
#pragma unroll
            for (int m = 0; m < 4; ++m) { bf16_t* rowp = O + (size_t)(row0 + ai * HALF + m * 16) * ldc + colg;
#pragma unroll
                for (int bj = 0; bj < 2; ++bj)
#pragma unroll
                    for (int n = 0; n < 2; ++n) { const f32x4 v = acc[ai][bj][m][n]; u32x2 w; w.x = cvt_pk_bf16(v[0], v[1]); w.y = cvt_pk_bf16(v[2], v[3]);
                        *(u32x2*)(rowp + bj * HALF + 8 * ((2 * fq + n) & 3) + 4 * (fq >> 1)) = w; } }
    }
};

struct EpiInProj {
    static constexpr bool PERM = true, AFTER_DRAIN = false;
    bf16_t *q, *k, *v, *uu, *cb, *sga, *sgc; float qscale;
    __device__ __forceinline__ void operator()(const f32x4 (&acc)[2][2][4][2], const Unit& u, int wr, int wc, int fr, int fq) const {
        const int row0 = u.pm * BM + wr * 64 + fr; const int pn = u.pn;
        if (pn >= 12 && pn < 20) {
            const int col0 = (pn - 12) * 128 + wc * 32 + 8 * fq;
#pragma unroll
            for (int ai = 0; ai < 2; ++ai)
#pragma unroll
                for (int m = 0; m < 4; ++m) *(u32x4*)(uu + (size_t)(row0 + ai * HALF + m * 16) * 1024 + col0) = pack8(acc[ai][0][m][0] * acc[ai][1][m][0], acc[ai][0][m][1] * acc[ai][1][m][1]);
            return;
        }
        bf16_t* base; float sc = 1.f; bool sig = false;
        if (pn < 4) { base = q; sc = qscale; } else if (pn < 8) base = k; else if (pn < 12) base = v; else if (pn < 24) base = cb; else if (pn < 28) { base = sga; sig = true; } else { base = sgc; sig = true; }
        const int col0 = (pn & 3) * BM + wc * 32 + 8 * fq;
#pragma unroll
        for (int ai = 0; ai < 2; ++ai)
#pragma unroll
            for (int m = 0; m < 4; ++m) { bf16_t* rowp = base + (size_t)(row0 + ai * HALF + m * 16) * 1024 + col0;
#pragma unroll
                for (int bj = 0; bj < 2; ++bj) { f32x4 v0 = acc[ai][bj][m][0], v1 = acc[ai][bj][m][1];
                    if (sig) {
#pragma unroll
                        for (int e = 0; e < 4; ++e) { v0[e] = sigmoidf_fast(v0[e]); v1[e] = sigmoidf_fast(v1[e]); } }
                    else { v0 = v0 * sc; v1 = v1 * sc; }
                    *(u32x4*)(rowp + bj * HALF) = pack8(v0, v1); } }
    }
};

struct EpiGate {
    static constexpr bool PERM = true, AFTER_DRAIN = false;
    bf16_t* merged; const bf16_t* sga; const bf16_t* sgc;
    __device__ __forceinline__ void operator()(const f32x4 (&acc)[2][2][4][2], const Unit& u, int wr, int wc, int fr, int fq) const {
        const int row0 = u.pm * BM + wr * 64 + fr, col0 = u.pn * BM + wc * 32 + 8 * fq; const bf16_t* gate = u.g ? sgc : sga;
#pragma unroll
        for (int ai = 0; ai < 2; ++ai)
#pragma unroll
            for (int m = 0; m < 4; ++m) { const size_t off = (size_t)(row0 + ai * HALF + m * 16) * 1024 + col0;
#pragma unroll
                for (int bj = 0; bj < 2; ++bj) { const u32x4 gw = *(const u32x4*)(gate + off + bj * HALF);
                    f32x4 v0 = acc[ai][bj][m][0], v1 = acc[ai][bj][m][1];
                    v0[0] *= bf_lo(gw.x); v0[1] *= bf_hi(gw.x); v0[2] *= bf_lo(gw.y); v0[3] *= bf_hi(gw.y); v1[0] *= bf_lo(gw.z); v1[1] *= bf_hi(gw.z); v1[2] *= bf_lo(gw.w); v1[3] *= bf_hi(gw.w);
                    if (u.g) { const u32x4 pw = *(const u32x4*)(merged + off + bj * HALF);
                        v0[0] += bf_lo(pw.x); v0[1] += bf_hi(pw.x); v0[2] += bf_lo(pw.y); v0[3] += bf_hi(pw.y); v1[0] += bf_lo(pw.z); v1[1] += bf_hi(pw.z); v1[2] += bf_lo(pw.w); v1[3] += bf_hi(pw.w); }
                    *(u32x4*)(merged + off + bj * HALF) = pack8(v0, v1); } }
    }
};

struct EpiResid {
    static constexpr bool PERM = false, AFTER_DRAIN = false;
    const float* base; float* hf; bf16_t* hb; float* ssq;
    __device__ __forceinline__ void operator()(const f32x4 (&acc)[2][2][4][2], const Unit& u, int wr, int wc, int fr, int fq) const {
        const int row0 = u.pm * BM + wr * 64 + fr, col0 = u.pn * BM + wc * 32 + 4 * fq;
#pragma unroll
        for (int ai = 0; ai < 2; ++ai)
#pragma unroll
            for (int m = 0; m < 4; ++m) { const int row = row0 + ai * HALF + m * 16; const size_t off = (size_t)row * 1024 + col0; float s = 0.f;
#pragma unroll
                for (int bj = 0; bj < 2; ++bj)
#pragma unroll
                    for (int n = 0; n < 2; ++n) { const f32x4 b = *(const f32x4*)(base + off + bj * HALF + n * 16); const f32x4 h = b + acc[ai][bj][m][n];
                        *(f32x4*)(hf + off + bj * HALF + n * 16) = h; s += (h[0] * h[0] + h[1] * h[1]) + (h[2] * h[2] + h[3] * h[3]);
                        u32x2 w; w.x = cvt_pk_bf16(h[0], h[1]); w.y = cvt_pk_bf16(h[2], h[3]); *(u32x2*)(hb + off + bj * HALF + n * 16) = w; }
                s += __shfl_xor(s, 16); s += __shfl_xor(s, 32);
                if (fq == 0) ssq[(size_t)row * 16 + u.pn * 4 + wc] = s; }
    }
};

struct EpiRowScale {
    static constexpr bool PERM = true, AFTER_DRAIN = false;
    bf16_t* O; int ldc; const float* ssq; float scale; float eps;
    __device__ __forceinline__ void operator()(const f32x4 (&acc)[2][2][4][2], const Unit& u, int wr, int wc, int fr, int fq) const {
        const int row0 = u.pm * BM + wr * 64 + fr, col0 = u.pn * BM + wc * 32 + 8 * fq;
#pragma unroll
        for (int ai = 0; ai < 2; ++ai)
#pragma unroll
            for (int m = 0; m < 4; ++m) { const int row = row0 + ai * HALF + m * 16; const f32x4* sp = (const f32x4*)(ssq + (size_t)row * 16);
                const f32x4 a = sp[0], b = sp[1], c = sp[2], d = sp[3]; const f32x4 t = (a + b) + (c + d);
                const float rs = __builtin_amdgcn_rsqf(((t[0] + t[1]) + (t[2] + t[3])) * (1.0f / 1024.0f) + eps) * scale;
                bf16_t* rowp = O + (size_t)row * ldc + col0;
#pragma unroll
                for (int bj = 0; bj < 2; ++bj) *(u32x4*)(rowp + bj * HALF) = pack8(acc[ai][bj][m][0] * rs, acc[ai][bj][m][1] * rs); }
    }
};

template <class Epi, class Sched, bool ALIGN_EPI = false, bool SP2 = false>
__device__ __forceinline__ void gemm_phase(PG8_LAS unsigned char* lds, const GemmSet g, const Sched& S, const Epi& E) {
    const int tid = threadIdx.x, wid = __builtin_amdgcn_readfirstlane(tid >> 6), lane = tid & 63, wr = wid >> 2, wc = wid & 3, fr = lane & 15, fq = lane >> 4;
    const int K = g.K, nt = K / BK;
    unsigned voffA[2], voffB[2];
#pragma unroll
    for (int i = 0; i < 2; ++i) { int R, C; stage_rc(tid * 16 + i * 8192, R, C); const int Rb = Epi::PERM ? ((R & ~31) + perm32(R & 31)) : R;
        voffA[i] = (unsigned)(R * K + C) * 2u; voffB[i] = (unsigned)(Rb * K + C) * 2u; }
    const size_t kstep = (size_t)(BK * 2);
    const size_t hstep = (size_t)HALF * K * 2;
    const size_t tstep = 2 * hstep;
    const unsigned ldsw = (unsigned)wid * 1024u;
    const int aoff = lds_byte(wr * 64 + fr, fq * 8), boff = lds_byte(wc * 32 + fr, fq * 8);
#define PG8_SA(b, h) (((b) * 2 + (h)) * HTB)
#define PG8_SB(b, h) ((4 + (b) * 2 + (h)) * HTB)
#define PG8_STAGE(bufoff, gbase, voff) do { _Pragma("unroll") for (int _i = 0; _i < 2; ++_i) \
        __builtin_amdgcn_global_load_lds((const unsigned*)((const char*)(gbase) + (voff)[_i]), (PG8_LAS unsigned*)(lds + (bufoff) + ldsw + _i * 8192), 16, 0, 0); } while (0)
#define PG8_LDA(dst, b, h) do { _Pragma("unroll") for (int m = 0; m < 4; ++m) _Pragma("unroll") for (int k = 0; k < 2; ++k) dst[m][k] = *(const PG8_LAS bf16x8*)(lds + PG8_SA(b, h) + aoff + m * 2048 + k * 1024); } while (0)
#define PG8_LDB(dst, b, h) do { _Pragma("unroll") for (int n = 0; n < 2; ++n) _Pragma("unroll") for (int k = 0; k < 2; ++k) dst[n][k] = *(const PG8_LAS bf16x8*)(lds + PG8_SB(b, h) + boff + n * 2048 + k * 1024); } while (0)
#define PG8_MMA(ai, bj, At, Bt) do { __builtin_amdgcn_s_setprio(1); _Pragma("unroll") for (int m = 0; m < 4; ++m) _Pragma("unroll") for (int n = 0; n < 2; ++n) _Pragma("unroll") for (int k = 0; k < 2; ++k) \
        acc[ai][bj][m][n] = __builtin_amdgcn_mfma_f32_16x16x32_bf16(Bt[n][k], At[m][k], acc[ai][bj][m][n], 0, 0, 0); __builtin_amdgcn_s_setprio(0); } while (0)
#define PG8_WAIT_V(n) asm volatile("s_waitcnt vmcnt(" #n ")" ::: "memory")
#define PG8_WAIT_L(n) asm volatile("s_waitcnt lgkmcnt(" #n ")" ::: "memory")
#define PG8_BAR __builtin_amdgcn_s_barrier()
#define PG8_SCHED __builtin_amdgcn_sched_barrier(0)
    Unit cur, nxt; int ui = 0;
    if (!S.next(0, cur)) return;
    f32x4 acc[2][2][4][2];
#pragma unroll
    for (int a = 0; a < 2; ++a)
#pragma unroll
        for (int b = 0; b < 2; ++b)
#pragma unroll
            for (int m = 0; m < 4; ++m)
#pragma unroll
                for (int n = 0; n < 2; ++n) acc[a][b][m][n] = (f32x4){0.f, 0.f, 0.f, 0.f};
    bf16x8 At[4][2], B0[2][2], B1[2][2];
    const char* cA = (const char*)(cur.g ? g.A1 : g.A0) + (size_t)cur.pm * tstep; const char* cB = (const char*)(cur.g ? g.B1 : g.B0) + (size_t)cur.pn * tstep;
    S.a_ready(cur);
    if constexpr (SP2) {
        PG8_STAGE(PG8_SB(0, 0), cB, voffB); PG8_STAGE(PG8_SB(0, 1), cB + hstep, voffB); PG8_STAGE(PG8_SA(0, 0), cA, voffA); PG8_STAGE(PG8_SA(0, 1), cA + hstep, voffA);
        if (wr == 1) PG8_BAR;
        PG8_WAIT_V(2); PG8_BAR;
        PG8_STAGE(PG8_SB(1, 0), cB + kstep, voffB); PG8_STAGE(PG8_SA(1, 0), cA + kstep, voffA); PG8_STAGE(PG8_SB(1, 1), cB + hstep + kstep, voffB);
        PG8_WAIT_V(6); PG8_BAR;
    } else {
        PG8_STAGE(PG8_SB(0, 0), cB, voffB); PG8_STAGE(PG8_SA(0, 0), cA, voffA); PG8_STAGE(PG8_SB(0, 1), cB + hstep, voffB); PG8_STAGE(PG8_SA(0, 1), cA + hstep, voffA);
        if (wr == 1) PG8_BAR;
        PG8_WAIT_V(4); PG8_BAR;
        PG8_STAGE(PG8_SB(1, 0), cB + kstep, voffB); PG8_STAGE(PG8_SA(1, 0), cA + kstep, voffA); PG8_STAGE(PG8_SB(1, 1), cB + hstep + kstep, voffB);
        PG8_WAIT_V(6); PG8_BAR;
    }
    for (;;) {
        const bool has_next = S.next(ui + 1, nxt);
        const char* nA = has_next ? (const char*)(nxt.g ? g.A1 : g.A0) + (size_t)nxt.pm * tstep : cA; const char* nB = has_next ? (const char*)(nxt.g ? g.B1 : g.B0) + (size_t)nxt.pn * tstep : cB;
        for (int t = 0; t < nt; t += 2) {
            const bool last = (t == nt - 2);
            const char* a1 = cA + (size_t)(t + 1) * kstep;
            const char* a2 = last ? nA : cA + (size_t)(t + 2) * kstep; const char* b2 = last ? nB : cB + (size_t)(t + 2) * kstep;
            const char* a3 = a2 + kstep; const char* b3 = b2 + kstep;
            if (last && has_next) S.a_ready(nxt);
            if constexpr (SP2) {
            PG8_LDB(B0, 0, 0); PG8_LDB(B1, 0, 1); PG8_SCHED; PG8_LDA(At, 0, 0); PG8_STAGE(PG8_SA(1, 1), a1 + hstep, voffA);
            PG8_WAIT_V(8); PG8_WAIT_L(0); PG8_BAR; PG8_MMA(0, 0, At, B0); PG8_MMA(0, 1, At, B1); PG8_BAR; PG8_SCHED;
            PG8_LDA(At, 0, 1); PG8_STAGE(PG8_SB(0, 0), b2, voffB); PG8_STAGE(PG8_SB(0, 1), b2 + hstep, voffB); PG8_STAGE(PG8_SA(0, 0), a2, voffA);
            PG8_WAIT_V(8); PG8_WAIT_L(0); PG8_BAR; PG8_MMA(1, 0, At, B0); PG8_MMA(1, 1, At, B1); PG8_BAR; PG8_SCHED;
            PG8_LDB(B0, 1, 0); PG8_LDB(B1, 1, 1); PG8_SCHED; PG8_LDA(At, 1, 0); PG8_STAGE(PG8_SA(0, 1), a2 + hstep, voffA);
            PG8_WAIT_V(8); PG8_WAIT_L(0); PG8_BAR; PG8_MMA(0, 0, At, B0); PG8_MMA(0, 1, At, B1); PG8_BAR; PG8_SCHED;
            PG8_LDA(At, 1, 1); PG8_STAGE(PG8_SB(1, 0), b3, voffB); PG8_STAGE(PG8_SB(1, 1), b3 + hstep, voffB); PG8_STAGE(PG8_SA(1, 0), a3, voffA);
            PG8_WAIT_V(8); PG8_WAIT_L(0); PG8_BAR; PG8_MMA(1, 0, At, B0); PG8_MMA(1, 1, At, B1); PG8_BAR; PG8_SCHED;
            } else {
            PG8_LDB(B0, 0, 0); PG8_SCHED; PG8_LDA(At, 0, 0); PG8_STAGE(PG8_SA(1, 1), a1 + hstep, voffA);
            PG8_WAIT_L(8); PG8_BAR; PG8_WAIT_L(0); PG8_MMA(0, 0, At, B0); PG8_BAR; PG8_SCHED;
            PG8_LDB(B1, 0, 1); PG8_STAGE(PG8_SB(0, 0), b2, voffB);
            PG8_BAR; PG8_WAIT_L(0); PG8_MMA(0, 1, At, B1); PG8_BAR;
            PG8_LDA(At, 0, 1); PG8_STAGE(PG8_SA(0, 0), a2, voffA);
            PG8_BAR; PG8_WAIT_L(0); PG8_MMA(1, 0, At, B0); PG8_BAR; PG8_SCHED;
            PG8_STAGE(PG8_SB(0, 1), b2 + hstep, voffB);
            PG8_WAIT_V(6); PG8_BAR; PG8_MMA(1, 1, At, B1); PG8_BAR;
            PG8_LDB(B0, 1, 0); PG8_SCHED; PG8_LDA(At, 1, 0); PG8_STAGE(PG8_SA(0, 1), a2 + hstep, voffA);
            PG8_WAIT_L(8); PG8_BAR; PG8_WAIT_L(0); PG8_MMA(0, 0, At, B0); PG8_BAR; PG8_SCHED;
            PG8_LDB(B1, 1, 1); PG8_STAGE(PG8_SB(1, 0), b3, voffB);
            PG8_BAR; PG8_WAIT_L(0); PG8_MMA(0, 1, At, B1); PG8_BAR;
            PG8_LDA(At, 1, 1); PG8_STAGE(PG8_SA(1, 0), a3, voffA);
            PG8_BAR; PG8_WAIT_L(0); PG8_MMA(1, 0, At, B0); PG8_BAR; PG8_SCHED;
            PG8_STAGE(PG8_SB(1, 1), b3 + hstep, voffB);
            PG8_WAIT_V(6); PG8_BAR; PG8_MMA(1, 1, At, B1); PG8_BAR;
            }
        }
        if constexpr (ALIGN_EPI) { if (wr == 0) PG8_BAR; }
        if constexpr (!Epi::AFTER_DRAIN) { E(acc, cur, wr, wc, fr, fq); S.done(cur); }
        if (!has_next) break;
#pragma unroll
        for (int a = 0; a < 2; ++a)
#pragma unroll
            for (int b = 0; b < 2; ++b)
#pragma unroll
                for (int m = 0; m < 4; ++m)
#pragma unroll
                    for (int n = 0; n < 2; ++n) acc[a][b][m][n] = (f32x4){0.f, 0.f, 0.f, 0.f};
        cur = nxt; cA = nA; cB = nB; ++ui;
        if constexpr (ALIGN_EPI) { if (wr == 1) PG8_BAR; }
    }
    PG8_WAIT_V(0);
    if constexpr (!ALIGN_EPI) { if (wr == 0) PG8_BAR; }
    PG8_BAR;
    if constexpr (Epi::AFTER_DRAIN) { E.fused(acc, cur, wr, wc, fr, fq, lds, wid, lane); S.done(cur); }
#undef PG8_SA
#undef PG8_SB
#undef PG8_STAGE
#undef PG8_LDA
#undef PG8_LDB
#undef PG8_MMA
#undef PG8_WAIT_V
#undef PG8_WAIT_L
#undef PG8_BAR
#undef PG8_SCHED
}
}

namespace sb {
using bf16 = __hip_bfloat16;
using bf16x8 = __attribute__((ext_vector_type(8))) short;
using s16x4 = __attribute__((ext_vector_type(4))) short;
using f32x16 = __attribute__((ext_vector_type(16))) float;
using u32x4 = __attribute__((ext_vector_type(4))) unsigned;
constexpr int SEQ = 2048, NHEAD = 16, HD = 64, DM = 1024;
constexpr int SLOTB = 8192, LDS_K = 0, LDS_V = 2 * SLOTB, LDS_FLAG = 4 * SLOTB, LDS_BYTES = 4 * SLOTB + 64;
constexpr float EXIT_THR = -150.0f;
__device__ __forceinline__ int crow(int r, int hi) { return (r & 3) + 8 * (r >> 2) + 4 * hi; }
__device__ __forceinline__ void glds16(const void* gsrc, unsigned lds_dst) { unsigned keep;
    asm volatile("s_mov_b32 %0, m0\n\ts_mov_b32 m0, %2\n\ts_nop 0\n\tglobal_load_lds_dwordx4 %1, off\n\ts_mov_b32 m0, %0" : "=&s"(keep) : "v"(gsrc), "s"(lds_dst) : "memory"); }
typedef __attribute__((address_space(3))) const char* lds_cptr;
typedef short v4i16_t __attribute__((ext_vector_type(4)));
typedef float f32x2_t __attribute__((ext_vector_type(2))); typedef __bf16 bf16x2_t __attribute__((ext_vector_type(2)));
__device__ __forceinline__ unsigned cvtpk(float lo, float hi) { f32x2_t v = {lo, hi}; bf16x2_t b = __builtin_convertvector(v, bf16x2_t); return __builtin_bit_cast(unsigned, b); }
__device__ __forceinline__ s16x4 vtr(lds_cptr p) { return __builtin_bit_cast(s16x4, __builtin_amdgcn_ds_read_tr16_b64_v4i16((__attribute__((address_space(3))) v4i16_t*)p)); }
__device__ __forceinline__ bf16x8 pack8(const f32x16& p, int b) { u32x4 w; w.x = cvtpk(p[b], p[b + 1]); w.y = cvtpk(p[b + 2], p[b + 3]); w.z = cvtpk(p[b + 4], p[b + 5]); w.w = cvtpk(p[b + 6], p[b + 7]); return __builtin_bit_cast(bf16x8, w); }
__device__ __forceinline__ float lo_lane(float x) { auto rr = __builtin_amdgcn_permlane32_swap(__float_as_uint(x), __float_as_uint(x), false, false); return __uint_as_float(rr[0]); }
#define SB_WAIT_BAR() asm volatile("s_waitcnt vmcnt(0) lgkmcnt(0)\n\ts_barrier" ::: "memory")

template <bool EARLY> __device__ __forceinline__ void sb_unit(int b, int h, int qb, const bf16* Q, const bf16* __restrict__ K, const bf16* __restrict__ V, bf16* O, char* shm) {
    const int tid = threadIdx.x, lane = tid & 63, r32 = lane & 31, hi = lane >> 5; const int wid = __builtin_amdgcn_readfirstlane(tid >> 6);
    const long rowbase = (long)b * SEQ; const int q0 = qb * 256;
    const bf16* Qw = Q + (rowbase + q0 + wid * 32) * DM + h * HD;
    const bf16* Kh = K + rowbase * DM + h * HD; const bf16* Vh = V + rowbase * DM + h * HD;
    const unsigned lds0 = (unsigned)(uintptr_t)shm;
    const bf16* ksrc = Kh + (long)lane * DM + wid * 8;
    const bf16* vsrc = Vh + (long)(16 * (wid & 3) + (lane >> 2)) * DM + (wid >> 2) * 32 + (lane & 3) * 8;
    const unsigned kdst = lds0 + LDS_K + wid * 1024, vdst = lds0 + LDS_V + wid * 1024;
#define SB_DMA_K(t, slot) glds16(ksrc + (long)(t) * 64 * DM, (unsigned)__builtin_amdgcn_readfirstlane(kdst + (slot)))
#define SB_DMA_V(t, slot) glds16(vsrc + (long)(t) * 64 * DM, (unsigned)__builtin_amdgcn_readfirstlane(vdst + (slot)))
    const lds_cptr shm3 = (lds_cptr)shm; const lds_cptr kp0 = shm3 + LDS_K + hi * 1024 + r32 * 16;
    const lds_cptr vp0 = shm3 + LDS_V + ((lane >> 4) & 1) * 32 + (lane & 3) * 8 + (4 * hi + ((lane & 15) >> 2)) * 64;
    const int NT = (q0 + 256) / 64;
    volatile __attribute__((address_space(3))) unsigned* flags = (volatile __attribute__((address_space(3))) unsigned*)(shm3 + LDS_FLAG);
    if (EARLY && lane == 0) flags[wid] = 0u;
    bool wdone = false;
    SB_DMA_K(NT - 1, 0); SB_DMA_V(NT - 1, 0);
    bf16x8 qr[4];
#pragma unroll
    for (int d0 = 0; d0 < 4; ++d0) qr[d0] = *reinterpret_cast<const bf16x8*>(&Qw[(long)r32 * DM + d0 * 16 + hi * 8]);
    bf16x8 tri[2], ones;
#pragma unroll
    for (int ks = 0; ks < 2; ++ks)
#pragma unroll
        for (int j = 0; j < 8; ++j) { const int kk = 16 * ks + 8 * (j >> 2) + 4 * hi + (j & 3); tri[ks][j] = (kk >= r32) ? (short)0x3F80 : (short)0; }
#pragma unroll
    for (int j = 0; j < 8; ++j) ones[j] = (short)0x3F80;
    f32x16 o0 = f32x16{}, o1 = f32x16{}; float R = 0.f;
    const int trow = q0 + wid * 32 + r32;
    const int wmin = q0 + wid * 32, wmax = wmin + 31;
    for (int it = 0; it < NT; ++it) {
        const int t = NT - 1 - it; const int sl = (it & 1) * SLOTB;
        SB_WAIT_BAR();
        if (EARLY) { const unsigned f = flags[lane & 7]; if (__all(f != 0u)) break; }
        if (t > 0) { SB_DMA_K(t - 1, sl ^ SLOTB); SB_DMA_V(t - 1, sl ^ SLOTB); }
        if (64 * t < wmax && !wdone) {
            f32x16 p0 = f32x16{}, p1 = f32x16{};
#pragma unroll
            for (int d0 = 0; d0 < 4; ++d0) {
                const bf16x8 b0 = *(const __attribute__((address_space(3))) bf16x8*)(kp0 + sl + d0 * 2048);
                const bf16x8 b1 = *(const __attribute__((address_space(3))) bf16x8*)(kp0 + sl + d0 * 2048 + 512);
                p0 = __builtin_amdgcn_mfma_f32_32x32x16_bf16(b0, qr[d0], p0, 0, 0, 0);
                p1 = __builtin_amdgcn_mfma_f32_32x32x16_bf16(b1, qr[d0], p1, 0, 0, 0); }
            const bool diag = (64 * t + 63 >= wmin);
            f32x16 l0, l1;
#pragma unroll
            for (int r = 0; r < 16; ++r) {
                const float y0 = p0[r], y1 = p1[r];
                l0[r] = -(__builtin_fmaxf(y0, 0.f) + __builtin_amdgcn_logf(1.0f + __builtin_amdgcn_exp2f(-__builtin_fabsf(y0))));
                l1[r] = -(__builtin_fmaxf(y1, 0.f) + __builtin_amdgcn_logf(1.0f + __builtin_amdgcn_exp2f(-__builtin_fabsf(y1)))); }
            if (diag) {
#pragma unroll
                for (int r = 0; r < 16; ++r) { const int s = 64 * t + crow(r, hi); if (s >= trow) l0[r] = 0.f; if (s + 32 >= trow) l1[r] = 0.f; } }
            const bf16x8 l0a = pack8(l0, 0), l0b = pack8(l0, 8), l1a = pack8(l1, 0), l1b = pack8(l1, 8);
            f32x16 Rv;
#pragma unroll
            for (int r = 0; r < 16; ++r) Rv[r] = R;
            f32x16 c1 = __builtin_amdgcn_mfma_f32_32x32x16_bf16(tri[0], l1a, Rv, 0, 0, 0); c1 = __builtin_amdgcn_mfma_f32_32x32x16_bf16(tri[1], l1b, c1, 0, 0, 0);
            f32x16 c0 = __builtin_amdgcn_mfma_f32_32x32x16_bf16(ones, l1a, Rv, 0, 0, 0); c0 = __builtin_amdgcn_mfma_f32_32x32x16_bf16(ones, l1b, c0, 0, 0, 0);
            c0 = __builtin_amdgcn_mfma_f32_32x32x16_bf16(tri[0], l0a, c0, 0, 0, 0); c0 = __builtin_amdgcn_mfma_f32_32x32x16_bf16(tri[1], l0b, c0, 0, 0, 0);
#pragma unroll
            for (int r = 0; r < 16; ++r) { p0[r] = __builtin_amdgcn_exp2f(p0[r] + c0[r]); p1[r] = __builtin_amdgcn_exp2f(p1[r] + c1[r]); }
            if (diag) {
#pragma unroll
                for (int r = 0; r < 16; ++r) { const int s = 64 * t + crow(r, hi); if (s >= trow) p0[r] = 0.f; if (s + 32 >= trow) p1[r] = 0.f; } }
            R = lo_lane(c0[0]);
            if (EARLY && !__any(R >= EXIT_THR)) { wdone = true; if (lane == 0) flags[wid] = 1u; }
            const bf16x8 pa0 = pack8(p0, 0), pa1 = pack8(p0, 8), pa2 = pack8(p1, 0), pa3 = pack8(p1, 8);
            const lds_cptr vp = vp0 + sl;
#define SB_VF(dh, ks) ({ const s16x4 lo_ = vtr(vp + (dh) * 4096 + (ks) * 1024), hi_ = vtr(vp + (dh) * 4096 + (ks) * 1024 + 512); (bf16x8){lo_[0], lo_[1], lo_[2], lo_[3], hi_[0], hi_[1], hi_[2], hi_[3]}; })
            o0 = __builtin_amdgcn_mfma_f32_32x32x16_bf16(pa0, SB_VF(0, 0), o0, 0, 0, 0); o1 = __builtin_amdgcn_mfma_f32_32x32x16_bf16(pa0, SB_VF(1, 0), o1, 0, 0, 0);
            o0 = __builtin_amdgcn_mfma_f32_32x32x16_bf16(pa1, SB_VF(0, 1), o0, 0, 0, 0); o1 = __builtin_amdgcn_mfma_f32_32x32x16_bf16(pa1, SB_VF(1, 1), o1, 0, 0, 0);
            o0 = __builtin_amdgcn_mfma_f32_32x32x16_bf16(pa2, SB_VF(0, 2), o0, 0, 0, 0); o1 = __builtin_amdgcn_mfma_f32_32x32x16_bf16(pa2, SB_VF(1, 2), o1, 0, 0, 0);
            o0 = __builtin_amdgcn_mfma_f32_32x32x16_bf16(pa3, SB_VF(0, 3), o0, 0, 0, 0); o1 = __builtin_amdgcn_mfma_f32_32x32x16_bf16(pa3, SB_VF(1, 3), o1, 0, 0, 0);
#undef SB_VF
        }
    }
    if (EARLY) SB_WAIT_BAR();
    bf16* Ow = O + (rowbase + q0 + wid * 32) * DM + h * HD;
#pragma unroll
    for (int r = 0; r < 16; ++r) { const int orow = crow(r, hi); Ow[(long)orow * DM + r32] = __float2bfloat16(o0[r]); Ow[(long)orow * DM + 32 + r32] = __float2bfloat16(o1[r]); }
#undef SB_DMA_K
#undef SB_DMA_V
}
}

constexpr int NWAVES = 8;
constexpr int N_LAUNCHES = MK_N_LAUNCHES;
constexpr int N_PHASES = 10;
constexpr int BATCH = 8, SEQ = 2048, D = 1024, M = BATCH * SEQ, MEMLEN = 256, MROWS = BATCH * MEMLEN, NIN = 8192, NPQ = 2048;
constexpr float RMS_EPS = 1e-6f;
constexpr float LOG2E = 1.4426950408889634f;
constexpr size_t MiB = 1u << 20;
constexpr size_t WS_CTL = 0, CTL_ZERO_BYTES = 1 * MiB;
constexpr size_t WS_WIN = 1 * MiB, WS_WA = 17 * MiB, WS_WC = 19 * MiB, WS_WO = 21 * MiB, WS_WQ2 = 23 * MiB, WS_WKV2 = 25 * MiB, WS_WO2 = 29 * MiB, WS_WPQ = 31 * MiB, WS_SK = 35 * MiB;
constexpr size_t WS_SSQ1 = 36 * MiB, WS_SSQ2 = 37 * MiB, WS_MEMN = 38 * MiB, WS_K2 = 42 * MiB, WS_V2T = 46 * MiB;
constexpr size_t WS_B0 = 52 * MiB, WS_B1 = 84 * MiB, WS_B2 = 116 * MiB, WS_B3 = 148 * MiB, WS_B4 = 180 * MiB, WS_B5 = 212 * MiB, WS_END = 244 * MiB;
constexpr int CW_TMO = 0, CW_CODE = 1, CW_BAR = 4096;

constexpr int RING_OFF = 0, RING_BYTES = 131072;
constexpr int LDSCTL_OFF = RING_BYTES, MISC_OFF = LDSCTL_OFF + 320;
constexpr int LDS_BYTES = 147456;
#define GAS __attribute__((address_space(1)))
#define LAS __attribute__((address_space(3)))
typedef unsigned short bf16;
typedef unsigned v4u __attribute__((ext_vector_type(4)));
typedef float f32x4 __attribute__((ext_vector_type(4)));
typedef short bf16x8 __attribute__((ext_vector_type(8)));
typedef GAS unsigned gu32;
typedef GAS unsigned long long gu64;
#define RLX_AGENT __ATOMIC_RELAXED, __HIP_MEMORY_SCOPE_AGENT
#define LDS_WAIT() asm volatile("s_waitcnt lgkmcnt(0)" ::: "memory")
#define VM_WAIT() asm volatile("s_waitcnt vmcnt(0)" ::: "memory")
__device__ __forceinline__ unsigned long long rt() { return __builtin_amdgcn_s_memrealtime(); }
__device__ __forceinline__ unsigned f2bf(float f) { unsigned u = __builtin_bit_cast(unsigned, f); return (u + 0x7fffu + ((u >> 16) & 1u)) >> 16; }
__device__ __forceinline__ unsigned pk2(float lo, float hi) { return f2bf(lo) | (f2bf(hi) << 16); }

#define XB_TMO      128
#define XB_XCNT(j)  (256  + 64 * (j))
#define XB_XSUB(j)  (1280 + 64 * (j))
#define XB_XGEN(j)  (2304 + 64 * (j))
#define XB_TOP      3328
#define XB_TOPGEN   3392
#define XCD_BAR_WORDS 3456
#define XB_SPIN_CAP (1u << 18)

__device__ __forceinline__ unsigned xb_ld(unsigned* p)              { return __hip_atomic_load(p, __ATOMIC_RELAXED, __HIP_MEMORY_SCOPE_AGENT); }
__device__ __forceinline__ unsigned xb_add(unsigned* p, unsigned v) { return __hip_atomic_fetch_add(p, v, __ATOMIC_RELAXED, __HIP_MEMORY_SCOPE_AGENT); }
__device__ __forceinline__ unsigned xb_xcc_id() { return (unsigned)__builtin_amdgcn_s_getreg((3 << 11) | 20) & 0xFu; }
#define XB_SPIN(cond, bar) do { unsigned _sp = 0; while (cond) { __builtin_amdgcn_s_sleep(1); \
    if ((++_sp & 255u) == 0u) { if (xb_ld(&(bar)[XB_TMO])) break; if (_sp > XB_SPIN_CAP) { atomicAdd(&(bar)[XB_TMO], 1u); break; } } } } while (0)

struct XcdBarrier {
    unsigned* bar; unsigned x;
    volatile LAS unsigned* st;
};

__device__ __forceinline__ XcdBarrier xcd_barrier_post(unsigned* bar, volatile LAS unsigned* st) {
    XcdBarrier b; b.bar = bar; b.x = xb_xcc_id(); b.st = st;
    if (threadIdx.x == 0) (void)xb_add(&bar[XB_XCNT(b.x)], 1u);
    return b;
}
__device__ __forceinline__ void xcd_barrier_complete(unsigned* bar, unsigned x, unsigned& nloc, unsigned& nx) {
    const unsigned G = gridDim.x * gridDim.y * gridDim.z;
    unsigned sum, cnt, mine, sp = 0u;
    for (;;) {
        sum = 0u; cnt = 0u; mine = 0u;
#pragma unroll
        for (unsigned j = 0; j < 16; ++j) { const unsigned c = xb_ld(&bar[XB_XCNT(j)]); sum += c; cnt += (c > 0u) ? 1u : 0u; mine = (j == x) ? c : mine; }
        if (sum == G) break;
        __builtin_amdgcn_s_sleep(1);
        if ((++sp & 255u) == 0u) { if (xb_ld(&bar[XB_TMO])) break; if (sp > XB_SPIN_CAP) { atomicAdd(&bar[XB_TMO], 1u); break; } }
    }
    nloc = mine > 0u ? mine : 1u; nx = cnt > 0u ? cnt : 1u;
}

__device__ __forceinline__ void xcd_barrier(const XcdBarrier& b) {
    asm volatile("s_waitcnt vmcnt(0)" ::: "memory");
    __syncthreads();
    if (threadIdx.x == 0) {
        unsigned* bar = b.bar;
        __builtin_amdgcn_s_waitcnt(0);
        unsigned nloc = b.st[0], nx = b.st[1];
        if (nloc == 0u) { xcd_barrier_complete(bar, b.x, nloc, nx); b.st[0] = nloc; b.st[1] = nx; }
        const unsigned old = xb_add(&bar[XB_XSUB(b.x)], 1u);
        const unsigned gen = old / nloc;
        if (old + 1u == (gen + 1u) * nloc) {
            __builtin_amdgcn_fence(__ATOMIC_RELEASE, "agent");
            asm volatile("s_waitcnt vmcnt(0)" ::: "memory");
            const unsigned og = xb_add(&bar[XB_TOP], 1u);
            const unsigned tg = og / nx;
            if (og + 1u == (tg + 1u) * nx) xb_add(&bar[XB_TOPGEN], 1u);
            else XB_SPIN(xb_ld(&bar[XB_TOPGEN]) == tg, bar);
            __builtin_amdgcn_fence(__ATOMIC_ACQUIRE, "agent");
            xb_add(&bar[XB_XGEN(b.x)], 1u);
            asm volatile("s_waitcnt vmcnt(0)" ::: "memory");
        } else {
            XB_SPIN(xb_ld(&bar[XB_XGEN(b.x)]) == gen, bar);
            __builtin_amdgcn_fence(__ATOMIC_ACQUIRE, "agent");
            asm volatile("s_waitcnt vmcnt(0)" ::: "memory");
        }
    }
    __syncthreads();
}


__device__ __forceinline__ float wave_sum(float v) {
#pragma unroll
    for (int o = 1; o < 64; o <<= 1) v += __shfl_xor(v, o);
    return v;
}
__device__ __forceinline__ int inproj_row(int n) {
    const int g = n >> 10, c = n & 1023;
    if (g < 3) return n;
    if (g == 3) return 3072 + (c >> 7) * 256 + (c & 127);
    if (g == 5) return 3072 + (c >> 7) * 256 + 128 + (c & 127);
    if (g == 4) return 5120 + c;
    return n;
}
template <bool INMAP> __device__ __forceinline__ void transpose_item(const float* W, int K, int N, const float* gain, bf16* WT, int row_off, LAS float* scr, int item, int lane) {
    const int nblk = N / 32, kb = item / nblk, nb = item % nblk, k0 = 64 * kb, n0 = 32 * nb;
#pragma unroll 8
    for (int i = 0; i < 32; ++i) { const int kk = 2 * i + (lane >> 5); float w = W[(size_t)(k0 + kk) * N + n0 + (lane & 31)]; if (gain) w *= gain[k0 + kk]; scr[kk * 33 + (lane & 31)] = w; }
    LDS_WAIT(); asm volatile("" ::: "memory");
    const int c = lane & 7; const int r0 = INMAP ? inproj_row(n0) : (row_off + n0);
#pragma unroll
    for (int j = 0; j < 4; ++j) { const int n = (lane >> 3) + 8 * j; const LAS float* s = scr + (8 * c) * 33 + n;
        v4u o; o.x = pk2(s[0 * 33], s[1 * 33]); o.y = pk2(s[2 * 33], s[3 * 33]); o.z = pk2(s[4 * 33], s[5 * 33]); o.w = pk2(s[6 * 33], s[7 * 33]);
        *(GAS v4u*)(WT + (size_t)(r0 + n) * K + k0 + 8 * c) = o; }
    LDS_WAIT(); asm volatile("" ::: "memory");
}
__device__ __forceinline__ void rms_row_to_bf16(const float* xrow, const float* gain, bf16* orow, int lane) {
    const GAS f32x4* xr = (const GAS f32x4*)xrow + lane; const GAS f32x4* gr = (const GAS f32x4*)gain + lane;
    f32x4 v[4]; float s = 0.f;
#pragma unroll
    for (int j = 0; j < 4; ++j) { v[j] = xr[64 * j]; s += (v[j].x * v[j].x + v[j].y * v[j].y) + (v[j].z * v[j].z + v[j].w * v[j].w); }
    const float rstd = 1.0f / sqrtf(wave_sum(s) * (1.f / 1024.f) + RMS_EPS);
    GAS unsigned long long* o8 = (GAS unsigned long long*)orow + lane;
#pragma unroll
    for (int j = 0; j < 4; ++j) { const f32x4 g = gr[64 * j]; o8[64 * j] = (unsigned long long)pk2(v[j].x * rstd * g.x, v[j].y * rstd * g.y) | ((unsigned long long)pk2(v[j].z * rstd * g.z, v[j].w * rstd * g.w) << 32); }
}
__device__ __forceinline__ void row_to_bf16(const float* xrow, const float* gain, bf16* orow, int lane) {
    const GAS f32x4* xr = (const GAS f32x4*)xrow + lane; GAS unsigned long long* o8 = (GAS unsigned long long*)orow + lane;
#pragma unroll
    for (int j = 0; j < 4; ++j) { f32x4 v = xr[64 * j]; if (gain) { const f32x4 g = ((const GAS f32x4*)gain + lane)[64 * j]; v = v * g; }
        o8[64 * j] = (unsigned long long)pk2(v.x, v.y) | ((unsigned long long)pk2(v.z, v.w) << 32); }
}
__device__ __forceinline__ void row_to_fp8(const float* xrow, const float* gain, float scale, unsigned char* orow, int lane) {
    const GAS f32x4* xr = (const GAS f32x4*)xrow + lane; GAS unsigned* o4 = (GAS unsigned*)orow + lane;
#pragma unroll
    for (int j = 0; j < 4; ++j) { f32x4 v = xr[64 * j] * scale; if (gain) { const f32x4 g = ((const GAS f32x4*)gain + lane)[64 * j]; v = v * g; }
        int w = 0; w = __builtin_amdgcn_cvt_pk_fp8_f32(v.x, v.y, w, false); w = __builtin_amdgcn_cvt_pk_fp8_f32(v.z, v.w, w, true); o4[64 * j] = (unsigned)w; }
}
__device__ __forceinline__ void final_norm_row(const float* hrow, const float* gain, float* orow, int lane) {
    const GAS f32x4* xr = (const GAS f32x4*)hrow + lane; const GAS f32x4* gr = (const GAS f32x4*)gain + lane;
    f32x4 v[4]; float s = 0.f;
#pragma unroll
    for (int j = 0; j < 4; ++j) { v[j] = xr[64 * j]; s += (v[j].x * v[j].x + v[j].y * v[j].y) + (v[j].z * v[j].z + v[j].w * v[j].w); }
    const float rstd = 1.0f / sqrtf(wave_sum(s) * (1.f / 1024.f) + RMS_EPS);
    GAS f32x4* o = (GAS f32x4*)orow + lane;
#pragma unroll
    for (int j = 0; j < 4; ++j) o[64 * j] = v[j] * rstd * gr[64 * j];
}
__device__ __forceinline__ float bflo(unsigned w) { return __builtin_bit_cast(float, w << 16); }
__device__ __forceinline__ float bfhi(unsigned w) { return __builtin_bit_cast(float, w & 0xffff0000u); }
__device__ __forceinline__ void yconv_item(const bf16* U, const bf16* CB, const float* cw, bf16* YC, int item, int lane) {
    const int t0 = item * 8; const bool first = (t0 % SEQ) == 0;
#pragma unroll 1
    for (int ps = 0; ps < 2; ++ps) {
        const int c0 = ps * 512 + lane * 8;
        float w0[8], w1[8], w2[8];
#pragma unroll
        for (int e = 0; e < 8; ++e) { w0[e] = cw[c0 + e]; w1[e] = cw[1024 + c0 + e]; w2[e] = cw[2048 + c0 + e]; }
        v4u um2 = (v4u){0u, 0u, 0u, 0u}, um1 = (v4u){0u, 0u, 0u, 0u};
        if (!first) { um2 = *(const GAS v4u*)(U + (size_t)(t0 - 2) * 1024 + c0); um1 = *(const GAS v4u*)(U + (size_t)(t0 - 1) * 1024 + c0); }
#pragma unroll
        for (int i = 0; i < 8; ++i) {
            const v4u uc = *(const GAS v4u*)(U + (size_t)(t0 + i) * 1024 + c0); const v4u cbv = *(const GAS v4u*)(CB + (size_t)(t0 + i) * 1024 + c0);
            v4u o;
#pragma unroll
            for (int q = 0; q < 4; ++q) {
                const float a = bflo(cbv[q]) * (w0[2 * q] * bflo(um2[q]) + w1[2 * q] * bflo(um1[q]) + w2[2 * q] * bflo(uc[q]));
                const float b = bfhi(cbv[q]) * (w0[2 * q + 1] * bfhi(um2[q]) + w1[2 * q + 1] * bfhi(um1[q]) + w2[2 * q + 1] * bfhi(uc[q]));
                o[q] = pk2(a, b); }
            *(GAS v4u*)(YC + (size_t)(t0 + i) * 1024 + c0) = o;
            um2 = um1; um1 = uc; }
    }
}


namespace xa {
using bf16x8 = __attribute__((ext_vector_type(8))) short;
using f32x4 = __attribute__((ext_vector_type(4))) float;
using u32x4 = __attribute__((ext_vector_type(4))) unsigned;
using u32x2 = __attribute__((ext_vector_type(2))) unsigned;
typedef __attribute__((address_space(3))) const char* lds_cptr;
constexpr int BUFB = 65536, VOFF = 32768;
#define XA_WAIT_BAR() asm volatile("s_waitcnt vmcnt(0) lgkmcnt(0)\n\ts_barrier" ::: "memory")
__device__ __forceinline__ void xattn_unit(int b, int head, int qh, const bf16* Q, const bf16* K2, const bf16* V2P, bf16* O, char* shm) {
    const int lane = threadIdx.x & 63, kr = lane & 15, g = lane >> 4; const int wid = __builtin_amdgcn_readfirstlane((int)threadIdx.x >> 6);
    const unsigned lds0 = (unsigned)(uintptr_t)shm; const lds_cptr shm3 = (lds_cptr)shm;
    const size_t qrow = (size_t)b * SEQ + qh * 128 + wid * 16 + kr;
    const bf16* ksrc = K2 + ((size_t)b * MEMLEN + lane) * 1024 + head * 256 + 8 * wid;
    const bf16* vsrc = V2P + ((size_t)head * 256 + lane) * 2048 + (size_t)b * MEMLEN + 8 * wid;
#define XA_DMA(c, bufo) do { _Pragma("unroll") for (int i = 0; i < 4; ++i) { \
        sb::glds16(ksrc + (size_t)(64 * (c)) * 1024 + 64 * i, (unsigned)__builtin_amdgcn_readfirstlane(lds0 + (bufo) + (wid + 8 * i) * 1024)); \
        sb::glds16(vsrc + (size_t)(64 * i) * 2048 + 64 * (c), (unsigned)__builtin_amdgcn_readfirstlane(lds0 + (bufo) + VOFF + wid * 4096 + i * 1024)); } } while (0)
    XA_DMA(0, 0);
    bf16x8 qf[8];
#pragma unroll
    for (int ks = 0; ks < 8; ++ks) qf[ks] = *(const GAS bf16x8*)(Q + qrow * 1024 + head * 256 + 32 * ks + 8 * g);
    f32x4 o[16];
#pragma unroll
    for (int dt = 0; dt < 16; ++dt) o[dt] = (f32x4){0.f, 0.f, 0.f, 0.f};
    float mrun = -1e30f, lrun = 0.f;
    const lds_cptr kfr = shm3 + g * 1024 + kr * 16, vfr = shm3 + VOFF + g * 4096 + kr * 16;
#pragma unroll 1
    for (int c = 0; c < 4; ++c) {
        const int bo = (c & 1) * BUFB;
        XA_WAIT_BAR();
        if (c < 3) XA_DMA(c + 1, bo ^ BUFB);
        f32x4 s[4];
#pragma unroll
        for (int kt = 0; kt < 4; ++kt) { s[kt] = (f32x4){0.f, 0.f, 0.f, 0.f};
#pragma unroll
            for (int ks = 0; ks < 8; ++ks) { const bf16x8 a = *(const __attribute__((address_space(3))) bf16x8*)(kfr + bo + ks * 4096 + kt * 256);
                s[kt] = __builtin_amdgcn_mfma_f32_16x16x32_bf16(a, qf[ks], s[kt], 0, 0, 0); } }
        float mx = __builtin_fmaxf(__builtin_fmaxf(s[0].x, s[0].y), __builtin_fmaxf(s[0].z, s[0].w));
#pragma unroll
        for (int kt = 1; kt < 4; ++kt) mx = __builtin_fmaxf(mx, __builtin_fmaxf(__builtin_fmaxf(s[kt].x, s[kt].y), __builtin_fmaxf(s[kt].z, s[kt].w)));
        mx = __builtin_fmaxf(mx, __shfl_xor(mx, 16)); mx = __builtin_fmaxf(mx, __shfl_xor(mx, 32));
        const float mnew = __builtin_fmaxf(mrun, mx), alpha = __builtin_amdgcn_exp2f(mrun - mnew);
        mrun = mnew; float ps = 0.f;
#pragma unroll
        for (int kt = 0; kt < 4; ++kt) { s[kt].x = __builtin_amdgcn_exp2f(s[kt].x - mnew); s[kt].y = __builtin_amdgcn_exp2f(s[kt].y - mnew); s[kt].z = __builtin_amdgcn_exp2f(s[kt].z - mnew); s[kt].w = __builtin_amdgcn_exp2f(s[kt].w - mnew);
            ps += (s[kt].x + s[kt].y) + (s[kt].z + s[kt].w); }
        lrun = lrun * alpha + ps;
#pragma unroll
        for (int dt = 0; dt < 16; ++dt) o[dt] = o[dt] * alpha;
        bf16x8 pb[2];
#pragma unroll
        for (int k2 = 0; k2 < 2; ++k2) { u32x4 w; w.x = pg8::cvt_pk_bf16(s[2 * k2].x, s[2 * k2].y); w.y = pg8::cvt_pk_bf16(s[2 * k2].z, s[2 * k2].w);
            w.z = pg8::cvt_pk_bf16(s[2 * k2 + 1].x, s[2 * k2 + 1].y); w.w = pg8::cvt_pk_bf16(s[2 * k2 + 1].z, s[2 * k2 + 1].w); pb[k2] = __builtin_bit_cast(bf16x8, w); }
#pragma unroll
        for (int dt = 0; dt < 16; ++dt)
#pragma unroll
            for (int k2 = 0; k2 < 2; ++k2) { const bf16x8 a = *(const __attribute__((address_space(3))) bf16x8*)(vfr + bo + k2 * 16384 + dt * 256);
                o[dt] = __builtin_amdgcn_mfma_f32_16x16x32_bf16(a, pb[k2], o[dt], 0, 0, 0); }
    }
    lrun += __shfl_xor(lrun, 16); lrun += __shfl_xor(lrun, 32);
    const float rl = 1.0f / lrun;
    bf16* op = O + qrow * 1024 + head * 256 + 4 * g;
#pragma unroll
    for (int dt = 0; dt < 16; ++dt) { u32x2 w; w.x = pg8::cvt_pk_bf16(o[dt].x * rl, o[dt].y * rl); w.y = pg8::cvt_pk_bf16(o[dt].z * rl, o[dt].w * rl); *(GAS u32x2*)(op + 16 * dt) = w; }
#undef XA_DMA
}
}

namespace peer {
using bf16x8 = __attribute__((ext_vector_type(8))) short;
using f32x16 = __attribute__((ext_vector_type(16))) float;
using u32x4 = __attribute__((ext_vector_type(4))) unsigned;
using u32x2 = __attribute__((ext_vector_type(2))) unsigned;
typedef __bf16 bf16x2_t __attribute__((ext_vector_type(2)));
#define PEER_CE(a, b) do { const int _h = ((a) > (b)) ? (a) : (b); const int _l = ((a) > (b)) ? (b) : (a); (a) = _h; (b) = _l; } while (0)
#define PEER_SORT16(x, o) do { PEER_CE(x[(o)+0], x[(o)+1]); PEER_CE(x[(o)+2], x[(o)+3]); PEER_CE(x[(o)+4], x[(o)+5]); PEER_CE(x[(o)+6], x[(o)+7]); PEER_CE(x[(o)+8], x[(o)+9]); PEER_CE(x[(o)+10], x[(o)+11]); PEER_CE(x[(o)+12], x[(o)+13]); PEER_CE(x[(o)+14], x[(o)+15]); PEER_CE(x[(o)+0], x[(o)+2]); PEER_CE(x[(o)+1], x[(o)+3]); PEER_CE(x[(o)+4], x[(o)+6]); PEER_CE(x[(o)+5], x[(o)+7]); PEER_CE(x[(o)+8], x[(o)+10]); PEER_CE(x[(o)+9], x[(o)+11]); PEER_CE(x[(o)+12], x[(o)+14]); PEER_CE(x[(o)+13], x[(o)+15]); PEER_CE(x[(o)+1], x[(o)+2]); PEER_CE(x[(o)+5], x[(o)+6]); PEER_CE(x[(o)+9], x[(o)+10]); PEER_CE(x[(o)+13], x[(o)+14]); PEER_CE(x[(o)+0], x[(o)+4]); PEER_CE(x[(o)+1], x[(o)+5]); PEER_CE(x[(o)+2], x[(o)+6]); PEER_CE(x[(o)+3], x[(o)+7]); PEER_CE(x[(o)+8], x[(o)+12]); PEER_CE(x[(o)+9], x[(o)+13]); PEER_CE(x[(o)+10], x[(o)+14]); PEER_CE(x[(o)+11], x[(o)+15]); PEER_CE(x[(o)+2], x[(o)+4]); PEER_CE(x[(o)+3], x[(o)+5]); PEER_CE(x[(o)+10], x[(o)+12]); PEER_CE(x[(o)+11], x[(o)+13]); PEER_CE(x[(o)+1], x[(o)+2]); PEER_CE(x[(o)+3], x[(o)+4]); PEER_CE(x[(o)+5], x[(o)+6]); PEER_CE(x[(o)+9], x[(o)+10]); PEER_CE(x[(o)+11], x[(o)+12]); PEER_CE(x[(o)+13], x[(o)+14]); PEER_CE(x[(o)+0], x[(o)+8]); PEER_CE(x[(o)+1], x[(o)+9]); PEER_CE(x[(o)+2], x[(o)+10]); PEER_CE(x[(o)+3], x[(o)+11]); PEER_CE(x[(o)+4], x[(o)+12]); PEER_CE(x[(o)+5], x[(o)+13]); PEER_CE(x[(o)+6], x[(o)+14]); PEER_CE(x[(o)+7], x[(o)+15]); PEER_CE(x[(o)+4], x[(o)+8]); PEER_CE(x[(o)+5], x[(o)+9]); PEER_CE(x[(o)+6], x[(o)+10]); PEER_CE(x[(o)+7], x[(o)+11]); PEER_CE(x[(o)+2], x[(o)+4]); PEER_CE(x[(o)+3], x[(o)+5]); PEER_CE(x[(o)+6], x[(o)+8]); PEER_CE(x[(o)+7], x[(o)+9]); PEER_CE(x[(o)+10], x[(o)+12]); PEER_CE(x[(o)+11], x[(o)+13]); PEER_CE(x[(o)+1], x[(o)+2]); PEER_CE(x[(o)+3], x[(o)+4]); PEER_CE(x[(o)+5], x[(o)+6]); PEER_CE(x[(o)+7], x[(o)+8]); PEER_CE(x[(o)+9], x[(o)+10]); PEER_CE(x[(o)+11], x[(o)+12]); PEER_CE(x[(o)+13], x[(o)+14]); } while (0)
#define PEER_MERGE16(x, a, b) do { x[(a)+0] = (x[(a)+0] > x[(b)+15]) ? x[(a)+0] : x[(b)+15]; x[(a)+1] = (x[(a)+1] > x[(b)+14]) ? x[(a)+1] : x[(b)+14]; x[(a)+2] = (x[(a)+2] > x[(b)+13]) ? x[(a)+2] : x[(b)+13]; x[(a)+3] = (x[(a)+3] > x[(b)+12]) ? x[(a)+3] : x[(b)+12]; x[(a)+4] = (x[(a)+4] > x[(b)+11]) ? x[(a)+4] : x[(b)+11]; x[(a)+5] = (x[(a)+5] > x[(b)+10]) ? x[(a)+5] : x[(b)+10]; x[(a)+6] = (x[(a)+6] > x[(b)+9]) ? x[(a)+6] : x[(b)+9]; x[(a)+7] = (x[(a)+7] > x[(b)+8]) ? x[(a)+7] : x[(b)+8]; x[(a)+8] = (x[(a)+8] > x[(b)+7]) ? x[(a)+8] : x[(b)+7]; x[(a)+9] = (x[(a)+9] > x[(b)+6]) ? x[(a)+9] : x[(b)+6]; x[(a)+10] = (x[(a)+10] > x[(b)+5]) ? x[(a)+10] : x[(b)+5]; x[(a)+11] = (x[(a)+11] > x[(b)+4]) ? x[(a)+11] : x[(b)+4]; x[(a)+12] = (x[(a)+12] > x[(b)+3]) ? x[(a)+12] : x[(b)+3]; x[(a)+13] = (x[(a)+13] > x[(b)+2]) ? x[(a)+13] : x[(b)+2]; x[(a)+14] = (x[(a)+14] > x[(b)+1]) ? x[(a)+14] : x[(b)+1]; x[(a)+15] = (x[(a)+15] > x[(b)+0]) ? x[(a)+15] : x[(b)+0]; PEER_CE(x[(a)+0], x[(a)+8]); PEER_CE(x[(a)+1], x[(a)+9]); PEER_CE(x[(a)+2], x[(a)+10]); PEER_CE(x[(a)+3], x[(a)+11]); PEER_CE(x[(a)+4], x[(a)+12]); PEER_CE(x[(a)+5], x[(a)+13]); PEER_CE(x[(a)+6], x[(a)+14]); PEER_CE(x[(a)+7], x[(a)+15]); PEER_CE(x[(a)+0], x[(a)+4]); PEER_CE(x[(a)+1], x[(a)+5]); PEER_CE(x[(a)+2], x[(a)+6]); PEER_CE(x[(a)+3], x[(a)+7]); PEER_CE(x[(a)+8], x[(a)+12]); PEER_CE(x[(a)+9], x[(a)+13]); PEER_CE(x[(a)+10], x[(a)+14]); PEER_CE(x[(a)+11], x[(a)+15]); PEER_CE(x[(a)+0], x[(a)+2]); PEER_CE(x[(a)+1], x[(a)+3]); PEER_CE(x[(a)+4], x[(a)+6]); PEER_CE(x[(a)+5], x[(a)+7]); PEER_CE(x[(a)+8], x[(a)+10]); PEER_CE(x[(a)+9], x[(a)+11]); PEER_CE(x[(a)+12], x[(a)+14]); PEER_CE(x[(a)+13], x[(a)+15]); PEER_CE(x[(a)+0], x[(a)+1]); PEER_CE(x[(a)+2], x[(a)+3]); PEER_CE(x[(a)+4], x[(a)+5]); PEER_CE(x[(a)+6], x[(a)+7]); PEER_CE(x[(a)+8], x[(a)+9]); PEER_CE(x[(a)+10], x[(a)+11]); PEER_CE(x[(a)+12], x[(a)+13]); PEER_CE(x[(a)+14], x[(a)+15]); } while (0)
#define PEER_MERGE16_SET(x, a, b) do { x[(a)+0] = (x[(a)+0] > x[(b)+15]) ? x[(a)+0] : x[(b)+15]; x[(a)+1] = (x[(a)+1] > x[(b)+14]) ? x[(a)+1] : x[(b)+14]; x[(a)+2] = (x[(a)+2] > x[(b)+13]) ? x[(a)+2] : x[(b)+13]; x[(a)+3] = (x[(a)+3] > x[(b)+12]) ? x[(a)+3] : x[(b)+12]; x[(a)+4] = (x[(a)+4] > x[(b)+11]) ? x[(a)+4] : x[(b)+11]; x[(a)+5] = (x[(a)+5] > x[(b)+10]) ? x[(a)+5] : x[(b)+10]; x[(a)+6] = (x[(a)+6] > x[(b)+9]) ? x[(a)+6] : x[(b)+9]; x[(a)+7] = (x[(a)+7] > x[(b)+8]) ? x[(a)+7] : x[(b)+8]; x[(a)+8] = (x[(a)+8] > x[(b)+7]) ? x[(a)+8] : x[(b)+7]; x[(a)+9] = (x[(a)+9] > x[(b)+6]) ? x[(a)+9] : x[(b)+6]; x[(a)+10] = (x[(a)+10] > x[(b)+5]) ? x[(a)+10] : x[(b)+5]; x[(a)+11] = (x[(a)+11] > x[(b)+4]) ? x[(a)+11] : x[(b)+4]; x[(a)+12] = (x[(a)+12] > x[(b)+3]) ? x[(a)+12] : x[(b)+3]; x[(a)+13] = (x[(a)+13] > x[(b)+2]) ? x[(a)+13] : x[(b)+2]; x[(a)+14] = (x[(a)+14] > x[(b)+1]) ? x[(a)+14] : x[(b)+1]; x[(a)+15] = (x[(a)+15] > x[(b)+0]) ? x[(a)+15] : x[(b)+0]; } while (0)
constexpr int PEER_NCAND = 50;
__device__ const unsigned char PEER_CAND[64] = {0, 16, 32, 48, 64, 80, 96, 112, 128, 144, 160, 176, 192, 208, 224, 240, 1, 17, 33, 49, 65, 81, 97, 113, 2, 18, 34, 50, 66, 3, 19, 35, 51, 4, 20, 36, 5, 21, 6, 22, 7, 23, 8, 9, 10, 11, 12, 13, 14, 15, 0, 0, 0, 0, 0, 0, 0, 0, 0, 0, 0, 0, 0, 0};
#define PEER_CAND_SUMS(x, v0, v1, KEYF) do { x[0] = KEYF((v0)[0] + (v1)[0], 0); x[1] = KEYF((v0)[0] + (v1)[1], 1); x[2] = KEYF((v0)[0] + (v1)[2], 2); x[3] = KEYF((v0)[0] + (v1)[3], 3); x[4] = KEYF((v0)[0] + (v1)[4], 4); x[5] = KEYF((v0)[0] + (v1)[5], 5); x[6] = KEYF((v0)[0] + (v1)[6], 6); x[7] = KEYF((v0)[0] + (v1)[7], 7); x[8] = KEYF((v0)[0] + (v1)[8], 8); x[9] = KEYF((v0)[0] + (v1)[9], 9); x[10] = KEYF((v0)[0] + (v1)[10], 10); x[11] = KEYF((v0)[0] + (v1)[11], 11); x[12] = KEYF((v0)[0] + (v1)[12], 12); x[13] = KEYF((v0)[0] + (v1)[13], 13); x[14] = KEYF((v0)[0] + (v1)[14], 14); x[15] = KEYF((v0)[0] + (v1)[15], 15); x[16] = KEYF((v0)[1] + (v1)[0], 16); x[17] = KEYF((v0)[1] + (v1)[1], 17); x[18] = KEYF((v0)[1] + (v1)[2], 18); x[19] = KEYF((v0)[1] + (v1)[3], 19); x[20] = KEYF((v0)[1] + (v1)[4], 20); x[21] = KEYF((v0)[1] + (v1)[5], 21); x[22] = KEYF((v0)[1] + (v1)[6], 22); x[23] = KEYF((v0)[1] + (v1)[7], 23); x[24] = KEYF((v0)[2] + (v1)[0], 24); x[25] = KEYF((v0)[2] + (v1)[1], 25); x[26] = KEYF((v0)[2] + (v1)[2], 26); x[27] = KEYF((v0)[2] + (v1)[3], 27); x[28] = KEYF((v0)[2] + (v1)[4], 28); x[29] = KEYF((v0)[3] + (v1)[0], 29); x[30] = KEYF((v0)[3] + (v1)[1], 30); x[31] = KEYF((v0)[3] + (v1)[2], 31); x[32] = KEYF((v0)[3] + (v1)[3], 32); x[33] = KEYF((v0)[4] + (v1)[0], 33); x[34] = KEYF((v0)[4] + (v1)[1], 34); x[35] = KEYF((v0)[4] + (v1)[2], 35); x[36] = KEYF((v0)[5] + (v1)[0], 36); x[37] = KEYF((v0)[5] + (v1)[1], 37); x[38] = KEYF((v0)[6] + (v1)[0], 38); x[39] = KEYF((v0)[6] + (v1)[1], 39); x[40] = KEYF((v0)[7] + (v1)[0], 40); x[41] = KEYF((v0)[7] + (v1)[1], 41); x[42] = KEYF((v0)[8] + (v1)[0], 42); x[43] = KEYF((v0)[9] + (v1)[0], 43); x[44] = KEYF((v0)[10] + (v1)[0], 44); x[45] = KEYF((v0)[11] + (v1)[0], 45); x[46] = KEYF((v0)[12] + (v1)[0], 46); x[47] = KEYF((v0)[13] + (v1)[0], 47); x[48] = KEYF((v0)[14] + (v1)[0], 48); x[49] = KEYF((v0)[15] + (v1)[0], 49); x[50] = (int)0x80000000; x[51] = (int)0x80000000; x[52] = (int)0x80000000; x[53] = (int)0x80000000; x[54] = (int)0x80000000; x[55] = (int)0x80000000; x[56] = (int)0x80000000; x[57] = (int)0x80000000; x[58] = (int)0x80000000; x[59] = (int)0x80000000; x[60] = (int)0x80000000; x[61] = (int)0x80000000; x[62] = (int)0x80000000; x[63] = (int)0x80000000; } while (0)

__device__ __forceinline__ int crow(int r, int hi) { return (r & 3) + 8 * (r >> 2) + 4 * hi; }
__device__ __forceinline__ int f2key(float f) { const int t = __builtin_bit_cast(int, f); return t ^ ((t >> 31) & 0x7fffffff); }
__device__ __forceinline__ float key2f(int t) { return __builtin_bit_cast(float, t ^ ((t >> 31) & 0x7fffffff)); }
__device__ __forceinline__ int sel_hi(int a, int b, int hm) { int r; asm("v_bfi_b32 %0, %1, %2, %3" : "=v"(r) : "v"(hm), "v"(b), "v"(a)); return r; }
__device__ __forceinline__ float fsel(float a, float b, int m) { return __int_as_float(sel_hi(__float_as_int(a), __float_as_int(b), m)); }
typedef float f32x2 __attribute__((ext_vector_type(2)));
__device__ __forceinline__ int key7(float f, int low) { return (f2key(f) & ~127) | low; }
__device__ __forceinline__ int key6(float f, int ord) { return (f2key(f) & ~63) | (63 - ord); }
__device__ __forceinline__ void top16_of_64(int (&x)[64]) {
    PEER_SORT16(x, 0); PEER_SORT16(x, 16); PEER_SORT16(x, 32); PEER_SORT16(x, 48);
    PEER_MERGE16(x, 0, 16); PEER_MERGE16(x, 32, 48); PEER_MERGE16(x, 0, 32);
}
__device__ __forceinline__ float dot2_bf16(unsigned w, unsigned x, float acc) { return __builtin_amdgcn_fdot2_f32_bf16(__builtin_bit_cast(bf16x2_t, w), __builtin_bit_cast(bf16x2_t, x), acc, false); }
__device__ __forceinline__ float dot8(const u32x4 a, const u32x4 b, float acc) {
    acc = dot2_bf16(a.x, b.x, acc); acc = dot2_bf16(a.y, b.y, acc); acc = dot2_bf16(a.z, b.z, acc); acc = dot2_bf16(a.w, b.w, acc); return acc;
}
__device__ __forceinline__ float gelu_tanh(float x) {
    const float u = 0.7978845608028654f * (x + 0.044715f * x * x * x);
    const float e = __builtin_amdgcn_exp2f(2.0f * LOG2E * u);
    const float th = 1.0f - 2.0f * __builtin_amdgcn_rcpf(e + 1.0f);
    return 0.5f * x * (1.0f + th);
}
__device__ __forceinline__ void topk_half(const bf16* qp, const bf16* sp, int hi, int (&T)[16]) {
    bf16x8 qf[8];
#pragma unroll
    for (int ks = 0; ks < 8; ++ks) qf[ks] = *(const GAS bf16x8*)(qp + ks * 16);
    const int hi4 = hi << 2;
    int x[64];
#pragma unroll
    for (int kt = 0; kt < 4; ++kt) { f32x16 sc = f32x16{};
#pragma unroll
        for (int ks = 0; ks < 8; ++ks) { const bf16x8 a = *(const GAS bf16x8*)(sp + (size_t)(32 * kt) * 128 + ks * 16); sc = __builtin_amdgcn_mfma_f32_32x32x16_bf16(a, qf[ks], sc, 0, 0, 0); }
#pragma unroll
        for (int r = 0; r < 16; ++r) x[16 * kt + r] = ((f2key(sc[r]) & ~127) | (127 - (32 * kt + crow(r, 0)))) ^ hi4; }
    top16_of_64(x);
#pragma unroll
    for (int i = 0; i < 16; ++i) { auto rr = __builtin_amdgcn_permlane32_swap((unsigned)x[i], (unsigned)x[i], false, false); x[i] = (int)rr[0]; x[16 + i] = (int)rr[1]; }
    PEER_MERGE16(x, 0, 16);
#pragma unroll
    for (int i = 0; i < 16; ++i) T[i] = x[i];
}
__device__ __forceinline__ float fp8dot4(unsigned w, float h0, float h1, float h2, float h3) {
    const f32x2 lo = __builtin_amdgcn_cvt_pk_f32_fp8((int)w, false), hi = __builtin_amdgcn_cvt_pk_f32_fp8((int)w, true);
    return (lo.x * h0 + lo.y * h1) + (hi.x * h2 + hi.y * h3);
}
__device__ __forceinline__ float fp8dot16(const u32x4 u, const float (&h)[16]) {
    return (fp8dot4(u.x, h[0], h[1], h[2], h[3]) + fp8dot4(u.y, h[4], h[5], h[6], h[7])) + (fp8dot4(u.z, h[8], h[9], h[10], h[11]) + fp8dot4(u.w, h[12], h[13], h[14], h[15]));
}
__device__ __forceinline__ void fp8axpy4(unsigned w, float c, float& a0, float& a1, float& a2, float& a3) {
    const f32x2 lo = __builtin_amdgcn_cvt_pk_f32_fp8((int)w, false), hi = __builtin_amdgcn_cvt_pk_f32_fp8((int)w, true);
    a0 += c * lo.x; a1 += c * lo.y; a2 += c * hi.x; a3 += c * hi.y;
}
__device__ __forceinline__ void fp8axpy16(const u32x4 v, float c, float (&a)[16]) {
    fp8axpy4(v.x, c, a[0], a[1], a[2], a[3]); fp8axpy4(v.y, c, a[4], a[5], a[6], a[7]); fp8axpy4(v.z, c, a[8], a[9], a[10], a[11]); fp8axpy4(v.w, c, a[12], a[13], a[14], a[15]);
}
constexpr int L_ROUTE = 0, L_NLIST = 32768, L_CAND = 40960, L_OFF = 41472, L_SORT = 43008, L_END = 43008 + 32768;
constexpr int NSL = 4, SL_SHIFT = 12;
__device__ __forceinline__ void peer_tile(int tile, const bf16* PQ, const bf16* SK, const float* SSQ, const unsigned char* U8, const unsigned char* V8, const float* gfin, float* out, LAS unsigned char* lds, int mode = 3, float* outw = nullptr) {
    const int lane = threadIdx.x & 63, r32 = lane & 31, hi = lane >> 5; const int wid = __builtin_amdgcn_readfirstlane((int)threadIdx.x >> 6);
    const int tok0 = tile * 32; if (!outw) outw = out;
    LAS unsigned* route = (LAS unsigned*)(lds + L_ROUTE);
    LAS unsigned char* nl = lds + L_NLIST + (wid * 32 + r32) * 32;
    const LAS unsigned char* cand = lds + L_CAND;
    if (mode & 1) {
        const int h = wid; int T0[16], T1[16];
        topk_half(PQ + (size_t)(tok0 + r32) * NPQ + (h * 2 + 0) * 128 + hi * 8, SK + ((size_t)(h * 2 + 0) * 128 + r32) * 128 + hi * 8, hi, T0);
        topk_half(PQ + (size_t)(tok0 + r32) * NPQ + (h * 2 + 1) * 128 + hi * 8, SK + ((size_t)(h * 2 + 1) * 128 + r32) * 128 + hi * 8, hi, T1);
        const int hm = -hi;
        {
            u32x4 w;
#pragma unroll
            for (int q4 = 0; q4 < 4; ++q4) { unsigned a = 0;
#pragma unroll
                for (int e = 0; e < 4; ++e) { const int t = sel_hi(T0[4 * q4 + e], T1[4 * q4 + e], hm); a |= (unsigned)(127 - (t & 127)) << (8 * e); }
                w[q4] = a; }
            *(LAS u32x4*)(nl + 16 * hi) = w;
        }
        float v0[16], v1[16];
#pragma unroll
        for (int i = 0; i < 16; ++i) { v0[i] = key2f(T0[i] & ~127); v1[i] = key2f(T1[i] & ~127); }
        int x[64];
        PEER_CAND_SUMS(x, v0, v1, key6);
        top16_of_64(x);
        const float smax = key2f(x[0] & ~63);
        float p[16], ps = 0.f;
#pragma unroll
        for (int i = 0; i < 16; ++i) { p[i] = __builtin_amdgcn_exp2f((key2f(x[i] & ~63) - smax) * LOG2E); ps += p[i]; }
        const float rps = 1.0f / ps;
        LDS_WAIT();
#pragma unroll
        for (int i = 0; i < 8; ++i) {
            const int xi = sel_hi(x[i], x[8 + i], hm); const float g = __int_as_float(sel_hi(__float_as_int(p[i]), __float_as_int(p[8 + i]), hm)) * rps;
            const int ij = cand[63 - (xi & 63)]; const int n0 = nl[ij & 15], n1 = nl[16 + (ij >> 4)];
            u32x2 w; w.x = (unsigned)(n0 * 128 + n1); w.y = __float_as_uint(g);
            *(LAS u32x2*)(route + ((size_t)r32 * 128 + h * 16 + 8 * hi + i) * 2) = w; }
    }
    LDS_WAIT(); __syncthreads();
    if (mode & 2) {
    const int m0 = -(lane & 1), m1 = -((lane >> 1) & 1);
    const int jj = ((lane & 1) << 1) | ((lane >> 1) & 1);
    LAS unsigned* srtw = (LAS unsigned*)(lds + L_SORT) + wid * 1024;
    LAS unsigned char* offw = lds + L_OFF + wid * 128;
    const unsigned long long lt = (1ull << lane) - 1ull;
#pragma unroll 1
    for (int tt = 0; tt < 4; ++tt) {
        const LAS unsigned* rt0 = route + (wid * 4 + tt) * 256; LAS unsigned* srt = srtw + tt * 256; LAS unsigned char* offb = offw + tt * 32;
        const u32x2 ea = *(const LAS u32x2*)(rt0 + lane * 2), eb = *(const LAS u32x2*)(rt0 + (lane + 64) * 2);
        const int sa = (int)ea.x >> SL_SHIFT, sb_ = (int)eb.x >> SL_SHIFT; int base = 0, pa = 0, pb = 0;
#pragma unroll 1
        for (int v = 0; v < NSL; ++v) { const unsigned long long ma = __ballot(sa == v), mb = __ballot(sb_ == v); const int ca = __popcll(ma), cb2 = __popcll(mb);
            if (lane == 0) offb[v] = (unsigned char)base;
            if (sa == v) pa = base + __popcll(ma & lt); if (sb_ == v) pb = base + ca + __popcll(mb & lt); base += ca + cb2; }
        if (lane == 0) offb[NSL] = (unsigned char)128;
        *(LAS u32x2*)(srt + pa * 2) = ea; *(LAS u32x2*)(srt + pb * 2) = eb;
    }
    LDS_WAIT();
    float hr[4][16], acc[4][16];
#pragma unroll
    for (int tt = 0; tt < 4; ++tt) {
        const size_t tok = (size_t)tok0 + wid * 4 + tt; const float* orow = out + tok * 1024;
        const f32x4* sp = (const f32x4*)(SSQ + tok * 16); const f32x4 a = sp[0], b = sp[1], c = sp[2], d = sp[3]; const f32x4 t4 = (a + b) + (c + d);
        const float sc = __builtin_amdgcn_rsqf(((t4[0] + t4[1]) + (t4[2] + t4[3])) * (1.0f / 1024.0f) + RMS_EPS) * (1.0f / 256.0f);
#pragma unroll
        for (int q = 0; q < 4; ++q) { const f32x4 t = *(const GAS f32x4*)(orow + lane * 16 + q * 4); hr[tt][4 * q] = t.x * sc; hr[tt][4 * q + 1] = t.y * sc; hr[tt][4 * q + 2] = t.z * sc; hr[tt][4 * q + 3] = t.w * sc; }
#pragma unroll
        for (int i = 0; i < 16; ++i) acc[tt][i] = 0.f;
    }
#define PEER_BATCH(tt_, k_, hi_) do { const LAS unsigned* srt = srtw + (tt_) * 256; u32x4 uu[4], vv[4]; float d_[4]; \
        _Pragma("unroll") for (int j = 0; j < 4; ++j) { const int ix = ((k_) + j < (hi_)) ? (k_) + j : (hi_) - 1; const int e = __builtin_amdgcn_readfirstlane((int)srt[ix * 2]); \
            uu[j] = *(const GAS u32x4*)(U8 + (size_t)e * 1024 + lane * 16); vv[j] = *(const GAS u32x4*)(V8 + (size_t)e * 1024 + lane * 16); } \
        _Pragma("unroll") for (int j = 0; j < 4; ++j) d_[j] = fp8dot16(uu[j], hr[tt_]); \
        float e_[2]; \
        _Pragma("unroll") for (int i = 0; i < 2; ++i) { const float keep = fsel(d_[i], d_[i + 2], m0), send = fsel(d_[i + 2], d_[i], m0); e_[i] = keep + __shfl_xor(send, 1); } \
        float g_ = fsel(e_[0], e_[1], m1) + __shfl_xor(fsel(e_[1], e_[0], m1), 2); \
        g_ += __shfl_xor(g_, 4); g_ += __shfl_xor(g_, 8); g_ += __shfl_xor(g_, 16); g_ += __shfl_xor(g_, 32); \
        const int mi = (k_) + jj; const float gate = (mi < (hi_)) ? __uint_as_float(srt[(mi < (hi_) ? mi : (hi_) - 1) * 2 + 1]) : 0.f; \
        const float cfl = gate * gelu_tanh(g_) * (1.0f / 16.0f); \
        _Pragma("unroll") for (int j = 0; j < 4; ++j) { const int src = ((j & 1) << 1) | ((j >> 1) & 1); \
            const float cj = __int_as_float(__builtin_amdgcn_readlane(__float_as_int(cfl), src)); \
            fp8axpy16(vv[j], cj, acc[tt_]); } } while (0)
#pragma unroll 1
    for (int r = 0; r < NSL; ++r) {
#pragma unroll
        for (int tt = 0; tt < 4; ++tt) {
            const int lo = __builtin_amdgcn_readfirstlane((int)offw[tt * 32 + r]), hi2 = __builtin_amdgcn_readfirstlane((int)offw[tt * 32 + r + 1]);
#pragma unroll 1
            for (int k = lo; k < hi2; k += 4) PEER_BATCH(tt, k, hi2);
        }
    }
#undef PEER_BATCH
#pragma unroll
    for (int tt = 0; tt < 4; ++tt) {
        const size_t tok = (size_t)tok0 + wid * 4 + tt; const float* orow = out + tok * 1024; float* wrow = outw + tok * 1024;
        float hv[16]; float s = 0.f;
#pragma unroll
        for (int q = 0; q < 4; ++q) { const f32x4 t = *(const GAS f32x4*)(orow + lane * 16 + q * 4);
            hv[4 * q] = t.x + acc[tt][4 * q]; hv[4 * q + 1] = t.y + acc[tt][4 * q + 1]; hv[4 * q + 2] = t.z + acc[tt][4 * q + 2]; hv[4 * q + 3] = t.w + acc[tt][4 * q + 3];
            s += (hv[4 * q] * hv[4 * q] + hv[4 * q + 1] * hv[4 * q + 1]) + (hv[4 * q + 2] * hv[4 * q + 2] + hv[4 * q + 3] * hv[4 * q + 3]); }
        const float rs = 1.0f / sqrtf(wave_sum(s) * (1.f / 1024.f) + RMS_EPS);
#pragma unroll
        for (int q = 0; q < 4; ++q) { const f32x4 g = *(const GAS f32x4*)(gfin + lane * 16 + q * 4); f32x4 t;
            t.x = hv[4 * q] * rs * g.x; t.y = hv[4 * q + 1] * rs * g.y; t.z = hv[4 * q + 2] * rs * g.z; t.w = hv[4 * q + 3] * rs * g.w;
            *(GAS f32x4*)(wrow + lane * 16 + q * 4) = t; }
    }
    }
    LDS_WAIT(); __syncthreads();
}
}
struct Args { const float* in[20]; float* out; unsigned char* ws; int ph_lo, ph_hi, li, pad; };
__global__ void __launch_bounds__(NWAVES * 64, 2) fwd_megakernel(Args args) {
    extern __shared__ __attribute__((aligned(16))) unsigned char lds[];
    LAS unsigned char* ldsp = (LAS unsigned char*)lds;
    volatile LAS unsigned* MISC = (volatile LAS unsigned*)(ldsp + MISC_OFF);
    const int tid = threadIdx.x, lane = tid & 63, wave = __builtin_amdgcn_readfirstlane(tid >> 6);
    const int G = gridDim.x; const int bx = blockIdx.x; const int vcu = (G % 8 == 0) ? (bx % 8) * (G / 8) + bx / 8 : bx;
    unsigned char* ws = args.ws;
    gu32* ctl = (gu32*)(ws + WS_CTL);
    const float* x = args.in[0]; const float* mem = args.in[1]; const float* norm_mix = args.in[2]; const float* w_in = args.in[3]; const float* conv_w = args.in[4];
    const float* w_ba = args.in[5]; const float* w_bc = args.in[6]; const float* w_out = args.in[7]; const float* norm_xattn = args.in[8]; const float* norm_mem = args.in[9];
    const float* xwq = args.in[10]; const float* xwk = args.in[11]; const float* xwv = args.in[12]; const float* xwo = args.in[13]; const float* norm_ffn = args.in[14];
    const float* pwq = args.in[15]; const float* psk = args.in[16]; const float* pu = args.in[17]; const float* pv = args.in[18]; const float* norm_final = args.in[19];
    float* out = args.out;
    bf16* Win_t = (bf16*)(ws + WS_WIN); bf16* Wa_t = (bf16*)(ws + WS_WA); bf16* Wc_t = (bf16*)(ws + WS_WC); bf16* Wo_t = (bf16*)(ws + WS_WO); bf16* Wq2_t = (bf16*)(ws + WS_WQ2);
    bf16* Wkv2_t = (bf16*)(ws + WS_WKV2); bf16* Wo2_t = (bf16*)(ws + WS_WO2); bf16* Wpq_t = (bf16*)(ws + WS_WPQ); bf16* SKb = (bf16*)(ws + WS_SK);
    float* SSQ1 = (float*)(ws + WS_SSQ1); float* SSQ2 = (float*)(ws + WS_SSQ2); bf16* MEMN = (bf16*)(ws + WS_MEMN); bf16* K2 = (bf16*)(ws + WS_K2); bf16* V2T = (bf16*)(ws + WS_V2T);
    bf16* B0 = (bf16*)(ws + WS_B0); bf16* B1 = (bf16*)(ws + WS_B1); bf16* B2 = (bf16*)(ws + WS_B2); bf16* B3 = (bf16*)(ws + WS_B3); bf16* B4 = (bf16*)(ws + WS_B4); bf16* B5 = (bf16*)(ws + WS_B5);
    bf16* XN1 = (bf16*)out; bf16* YC = (bf16*)out; bf16* CBb = (bf16*)((unsigned char*)out + 32 * MiB);

    for (int u = tid; u < (LDS_BYTES - LDSCTL_OFF) / 4; u += NWAVES * 64) ((LAS unsigned*)(ldsp + LDSCTL_OFF))[u] = 0u;
    __syncthreads();
    XcdBarrier bar; bar.bar = (unsigned*)(ctl + CW_BAR); bar.x = 0; bar.st = nullptr;
    if (N_LAUNCHES == 1) bar = xcd_barrier_post((unsigned*)(ctl + CW_BAR), MISC + 8);
#define GRID_BAR() do { if (N_LAUNCHES == 1) xcd_barrier(bar); } while (0)
    const int lo = args.ph_lo, hi = args.ph_hi;
#define IN(k) (lo <= (k) && (k) < hi)
#define BOTH(k) (IN(k) && IN((k) + 1))
    const int gw = vcu * NWAVES + wave, NGW = G * NWAVES;

    if (IN(0)) {
        LAS float* scr = (LAS float*)(ldsp + RING_OFF + wave * 16384);
        constexpr int I_IN = 16 * 256, I_SQ = 16 * 32, I_PQ = 16 * 64;
        constexpr int NT_ITEMS = I_IN + 7 * I_SQ + I_PQ;
        for (int it = gw; it < NT_ITEMS; it += NGW) {
            int r = it;
            if (r < I_IN) { transpose_item<true>(w_in, D, NIN, nullptr, Win_t, 0, scr, r, lane); continue; } r -= I_IN;
            if (r < I_SQ) { transpose_item<false>(w_ba, D, D, nullptr, Wa_t, 0, scr, r, lane); continue; } r -= I_SQ;
            if (r < I_SQ) { transpose_item<false>(w_bc, D, D, nullptr, Wc_t, 0, scr, r, lane); continue; } r -= I_SQ;
            if (r < I_SQ) { transpose_item<false>(w_out, D, D, nullptr, Wo_t, 0, scr, r, lane); continue; } r -= I_SQ;
            if (r < I_SQ) { transpose_item<false>(xwq, D, D, norm_xattn, Wq2_t, 0, scr, r, lane); continue; } r -= I_SQ;
            if (r < I_SQ) { transpose_item<false>(xwk, D, D, nullptr, Wkv2_t, 0, scr, r, lane); continue; } r -= I_SQ;
            if (r < I_SQ) { transpose_item<false>(xwv, D, D, nullptr, Wkv2_t, D, scr, r, lane); continue; } r -= I_SQ;
            if (r < I_SQ) { transpose_item<false>(xwo, D, D, nullptr, Wo2_t, 0, scr, r, lane); continue; } r -= I_SQ;
            transpose_item<false>(pwq, D, NPQ, norm_ffn, Wpq_t, 0, scr, r, lane);
        }
        for (int it = gw; it < 512; it += NGW) {
            const GAS f32x4* s = (const GAS f32x4*)psk + (size_t)it * 128 + lane * 2; const f32x4 a = s[0], b = s[1];
            v4u o; o.x = pk2(a.x, a.y); o.y = pk2(a.z, a.w); o.z = pk2(b.x, b.y); o.w = pk2(b.z, b.w);
            *((GAS v4u*)SKb + (size_t)it * 64 + lane) = o; }
        for (int m = gw; m < M; m += NGW) rms_row_to_bf16(x + (size_t)m * D, norm_mix, XN1 + (size_t)m * D, lane);
        for (int m = gw; m < MROWS; m += NGW) rms_row_to_bf16(mem + (size_t)m * D, norm_mem, MEMN + (size_t)m * D, lane);
        if (BOTH(0)) GRID_BAR();
    }

    if (IN(1)) {
        pg8::GemmSet g{XN1, Win_t, XN1, Win_t, D}; pg8::TileOrder S; S.init(M, NIN, G, bx);
        pg8::EpiInProj E{B0, B1, B2, B3, CBb, B4, B5, 0.125f * LOG2E};
        pg8::gemm_phase<pg8::EpiInProj, pg8::TileOrder, true, true>(ldsp + RING_OFF, g, S, E);
        if (BOTH(1)) GRID_BAR();
    }

    if (IN(2)) {
        {
            const int bh = vcu >> 1, s = vcu & 1;
            if (bh < BATCH * 16) {
#pragma unroll 1
                for (int i = 0; i < 4; ++i) { const int qb = (i == 0) ? s : (i == 1) ? 7 - s : (i == 2) ? 2 + s : 5 - s;
                    sb::sb_unit<true>(bh >> 4, bh & 15, qb, (const sb::bf16*)B0, (const sb::bf16*)B1, (const sb::bf16*)B2, (sb::bf16*)B0, (char*)lds + RING_OFF); }
            }
            asm volatile("s_waitcnt vmcnt(0) lgkmcnt(0)" ::: "memory"); __syncthreads();
        }
        if (vcu < 32) {
            pg8::GemmSet g{MEMN, Wkv2_t, MEMN, Wkv2_t, D}; pg8::SubOrder S; S.init(MROWS, D, 0, vcu);
            pg8::EpiStore E{K2, D, 1.0f};
            pg8::gemm_phase<pg8::EpiStore, pg8::SubOrder, false, true>(ldsp + RING_OFF, g, S, E);
        } else if (vcu < 64) {
            pg8::GemmSet g{Wkv2_t + (size_t)D * D, MEMN, Wkv2_t + (size_t)D * D, MEMN, D}; pg8::SubOrder S; S.init(D, MROWS, 32, vcu);
            pg8::EpiStoreKPerm E{V2T, MROWS};
            pg8::gemm_phase<pg8::EpiStoreKPerm, pg8::SubOrder, false, true>(ldsp + RING_OFF, g, S, E);
        } else {
            const int cw_ = (vcu - 64) * NWAVES + wave, ncw = (G - 64) * NWAVES;
            for (int it = cw_; it < M / 8; it += ncw) yconv_item(B3, CBb, conv_w, YC, it, lane);
        }
        if (BOTH(2)) GRID_BAR();
    }

    if (IN(3)) {
        pg8::GemmSet g{B0, Wa_t, YC, Wc_t, D}; pg8::TileOrder S; S.init(M, D, G, bx, 2);
        pg8::EpiGate E{B1, B4, B5};
        pg8::gemm_phase<pg8::EpiGate, pg8::TileOrder, true, true>(ldsp + RING_OFF, g, S, E);
        if (BOTH(3)) GRID_BAR();
    }

    if (IN(4)) {
        pg8::GemmSet g{B1, Wo_t, B1, Wo_t, D}; pg8::TileOrder S; S.init(M, D, G, bx);
        pg8::EpiResid E{x, out, B2, SSQ1};
        pg8::gemm_phase<pg8::EpiResid, pg8::TileOrder, true, true>(ldsp + RING_OFF, g, S, E);
        if (BOTH(4)) GRID_BAR();
    }

    if (IN(5)) {
        pg8::GemmSet g{B2, Wq2_t, B2, Wq2_t, D}; pg8::TileOrder S; S.init(M, D, G, bx);
        pg8::EpiRowScale E{B3, D, SSQ1, LOG2E / 16.0f, RMS_EPS};
        pg8::gemm_phase<pg8::EpiRowScale, pg8::TileOrder, true, true>(ldsp + RING_OFF, g, S, E);
        for (int r = gw; r < 2 * 16384; r += NGW) {
            if (r < 16384) row_to_fp8(pu + (size_t)r * D, norm_ffn, 256.0f, (unsigned char*)B4 + (size_t)r * D, lane);
            else row_to_fp8(pv + (size_t)(r - 16384) * D, nullptr, 16.0f, (unsigned char*)B4 + 16 * MiB + (size_t)(r - 16384) * D, lane); }
        if (BOTH(5)) GRID_BAR();
    }

    if (IN(6)) {
#ifndef NO_XA
        for (int u = 2 * vcu; u < 512; u += 2 * G) { xa::xattn_unit(u >> 6, (u >> 4) & 3, u & 15, B3, K2, V2T, B0, (char*)lds + RING_OFF); xa::xattn_unit(u >> 6, (u >> 4) & 3, (u & 15) + 1, B3, K2, V2T, B0, (char*)lds + RING_OFF); }
        asm volatile("s_waitcnt vmcnt(0) lgkmcnt(0)" ::: "memory"); __syncthreads();
#endif
        if (BOTH(6)) GRID_BAR();
    }

    if (IN(7)) {
        pg8::GemmSet g{B0, Wo2_t, B0, Wo2_t, D}; pg8::TileOrder S; S.init(M, D, G, bx);
        pg8::EpiResid E{out, out, B1, SSQ2};
        pg8::gemm_phase<pg8::EpiResid, pg8::TileOrder, true, true>(ldsp + RING_OFF, g, S, E);
        if (BOTH(7)) GRID_BAR();
    }

    if (IN(8)) {
        pg8::GemmSet g{B1, Wpq_t, B1, Wpq_t, D}; pg8::TileOrder S; S.init(M, NPQ, G, bx);
        pg8::EpiRowScale E{B2, NPQ, SSQ2, 1.0f, RMS_EPS};
        pg8::gemm_phase<pg8::EpiRowScale, pg8::TileOrder, true, true>(ldsp + RING_OFF, g, S, E);
        if (BOTH(8)) GRID_BAR();
    }

    if (IN(9)) {
        if (tid < 64) { int cnt = 0, val = 0;
            for (int ii = 0; ii < 16; ++ii) { const int nj = 16 / (ii + 1); if (tid >= cnt && tid < cnt + nj) val = ii | ((tid - cnt) << 4); cnt += nj; }
            ldsp[RING_OFF + peer::L_CAND + tid] = (unsigned char)val; }
        LDS_WAIT(); __syncthreads();
#ifndef NO_PEER
        for (int tile = vcu; tile < M / 32; tile += G) {
#ifdef PROBE_P9
            peer::peer_tile(tile, B2, SKb, SSQ2, (const unsigned char*)B4, (const unsigned char*)B4 + 16 * MiB, norm_final, out, ldsp + RING_OFF, PROBE_P9, (float*)B0);
#endif
            peer::peer_tile(tile, B2, SKb, SSQ2, (const unsigned char*)B4, (const unsigned char*)B4 + 16 * MiB, norm_final, out, ldsp + RING_OFF); }
#else
        for (int m = gw; m < M; m += NGW) final_norm_row(out + (size_t)m * D, norm_final, out + (size_t)m * D, lane);
#endif
    }
#undef IN
#undef BOTH
#undef GRID_BAR
}

extern "C" void kernel_launch(void* const* d_in, const int* in_sizes, int n_in, void* d_out, int out_size, void* d_ws, size_t ws_size, hipStream_t stream) {
    static int grid = 0;
    if (grid == 0) {
        if (n_in != 20 || in_sizes[0] != M * D || out_size != M * D || ws_size < WS_END) { fprintf(stderr, "kernel_launch: unexpected shapes (n_in %d, in0 %d, out %d, ws %zu); nothing launched\n", n_in, n_in > 0 ? in_sizes[0] : -1, out_size, ws_size); grid = -1; return; }
        int dev = 0, cus = 0, per_cu = 0;
        if (hipGetDevice(&dev) != hipSuccess || hipDeviceGetAttribute(&cus, hipDeviceAttributeMultiprocessorCount, dev) != hipSuccess) { grid = -1; return; }
        if (hipFuncSetAttribute((const void*)fwd_megakernel, hipFuncAttributeMaxDynamicSharedMemorySize, LDS_BYTES) != hipSuccess) { fprintf(stderr, "kernel_launch: hipFuncSetAttribute failed\n"); grid = -1; return; }
        if (hipOccupancyMaxActiveBlocksPerMultiprocessor(&per_cu, (const void*)fwd_megakernel, NWAVES * 64, LDS_BYTES) != hipSuccess || per_cu < 1)
            fprintf(stderr, "kernel_launch: note: occupancy query reports %d workgroups per CU\n", per_cu);
        (void)hipGetLastError();
        grid = cus;
    }
    if (grid < 0) return;
    if (hipMemsetAsync((char*)d_ws + WS_CTL, 0, CTL_ZERO_BYTES, stream) != hipSuccess) { fprintf(stderr, "kernel_launch: hipMemsetAsync failed\n"); return; }
    Args a{};
    for (int i = 0; i < 20; ++i) a.in[i] = (const float*)d_in[i];
    a.out = (float*)d_out; a.ws = (unsigned char*)d_ws;
    if (N_LAUNCHES == 1) { a.ph_lo = 0; a.ph_hi = N_PHASES; a.li = 0; hipLaunchKernelGGL(fwd_megakernel, dim3(grid), dim3(NWAVES * 64), LDS_BYTES, stream, a); }
    else for (int li = 0; li < N_PHASES; ++li) { a.ph_lo = li; a.ph_hi = li + 1; a.li = li; hipLaunchKernelGGL(fwd_megakernel, dim3(grid), dim3(NWAVES * 64), LDS_BYTES, stream, a);
#ifdef PROBE_DUP
        if (li == PROBE_DUP) hipLaunchKernelGGL(fwd_megakernel, dim3(grid), dim3(NWAVES * 64), LDS_BYTES, stream, a);
#endif
    }
    const hipError_t le = hipPeekAtLastError();
    if (le != hipSuccess) fprintf(stderr, "kernel_launch: launch failed: %s\n", hipGetErrorName(le));
}
```

```cpp
#include <hip/hip_runtime.h>
#include <hip/hip_bf16.h>
#include <cstdio>
#include <cstdint>
#include <cmath>

#ifndef MK_N_LAUNCHES
#define MK_N_LAUNCHES 1
#endif
namespace pg8 {
#define PG8_LAS __attribute__((address_space(3)))
typedef unsigned short bf16_t;
typedef short bf16x8 __attribute__((ext_vector_type(8)));
typedef float f32x4 __attribute__((ext_vector_type(4)));
typedef float f32x2 __attribute__((ext_vector_type(2)));
typedef unsigned u32x4 __attribute__((ext_vector_type(4)));
typedef unsigned u32x2 __attribute__((ext_vector_type(2)));
constexpr int BM = 256, BK = 64, HALF = 128, HTB = HALF * BK * 2  , STAGE_BYTES = 8 * HTB, NXCD = 8, WGM = 8;

__host__ __device__ __forceinline__ int lds_byte(int r, int c) { const int st = (r >> 4) * 2 + (c >> 5), rr = r & 15, cc = c & 31, ob = rr * 64 + cc * 2; return st * 1024 + (ob ^ (((ob >> 9) & 1) << 5)); }
__host__ __device__ __forceinline__ void stage_rc(int b, int& R, int& C) { const int st = b / 1024, sb = b % 1024, swz = sb ^ (((sb >> 9) & 1) << 5); R = (st >> 1) * 16 + swz / 64; C = (st & 1) * 32 + (swz % 64) / 2; }
__host__ __device__ __forceinline__ int perm32(int rho) { const int n = rho >> 4, i = rho & 15; return 8 * (i >> 2) + 4 * n + (i & 3); }

struct Unit { int pm, pn, g; };
struct GemmSet { const bf16_t* A0; const bf16_t* B0; const bf16_t* A1; const bf16_t* B1; int K; };

struct TileOrder {
    int nM, nN, nwg, G, c, passes;
    __device__ void init(int M, int N, int G_, int c_, int passes_ = 1) { nM = M / BM; nN = N / BM; nwg = nM * nN; G = G_; c = c_; passes = passes_; }
    __device__ bool next(int i, Unit& u) const {
        const int ti = (passes == 2) ? (i >> 1) : i; u.g = (passes == 2) ? (i & 1) : 0;
        const long L = (long)ti * G + c; if (L >= nwg) return false;
        int wgid = (int)L; { const int q = nwg / NXCD, r = nwg % NXCD, xcd = wgid % NXCD, off = wgid / NXCD; wgid = (xcd < r ? xcd * (q + 1) : r * (q + 1) + (xcd - r) * q) + off; }
        const int nig = WGM * nN, gid = wgid / nig, fm = gid * WGM, gsz = (nM - fm) < WGM ? (nM - fm) : WGM;
        u.pm = fm + ((wgid % nig) % gsz); u.pn = (wgid % nig) / gsz; return true;
    }
    __device__ __forceinline__ void a_ready(const Unit&) const {}
    __device__ __forceinline__ void done(const Unit&) const {}
};
struct SubOrder {
    int nN, n, idx;
    __device__ void init(int M, int N, int c0, int c_) { nN = N / BM; n = (M / BM) * nN; idx = c_ - c0; }
    __device__ bool next(int i, Unit& u) const { if (i != 0 || idx < 0 || idx >= n) return false; u.pm = idx / nN; u.pn = idx % nN; u.g = 0; return true; }
    __device__ __forceinline__ void a_ready(const Unit&) const {}
    __device__ __forceinline__ void done(const Unit&) const {}
};

typedef __bf16 bf16x2_t __attribute__((ext_vector_type(2)));
__device__ __forceinline__ unsigned cvt_pk_bf16(float lo, float hi) { f32x2 v = {lo, hi}; bf16x2_t b = __builtin_convertvector(v, bf16x2_t); return __builtin_bit_cast(unsigned, b); }
__device__ __forceinline__ float bf_lo(unsigned w) { return __builtin_bit_cast(float, w << 16); }
__device__ __forceinline__ float bf_hi(unsigned w) { return __builtin_bit_cast(float, w & 0xffff0000u); }
__device__ __forceinline__ u32x4 pack8(const f32x4 v0, const f32x4 v1) { u32x4 w; w.x = cvt_pk_bf16(v0[0], v0[1]); w.y = cvt_pk_bf16(v0[2], v0[3]); w.z = cvt_pk_bf16(v1[0], v1[1]); w.w = cvt_pk_bf16(v1[2], v1[3]); return w; }
__device__ __forceinline__ float sigmoidf_fast(float x) { return __builtin_amdgcn_rcpf(1.0f + __builtin_amdgcn_exp2f(-1.4426950408889634f * x)); }

struct EpiStore {
    static constexpr bool PERM = true, AFTER_DRAIN = false;
    bf16_t* O; int ldc; float scale;
    __device__ __forceinline__ void operator()(const f32x4 (&acc)[2][2][4][2], const Unit& u, int wr, int wc, int fr, int fq) const {
        const int row0 = u.pm * BM + wr * 64 + fr, col0 = u.pn * BM + wc * 32 + 8 * fq;
#pragma unroll
        for (int ai = 0; ai < 2; ++ai)
#pragma unroll
            for (int m = 0; m < 4; ++m) { bf16_t* rowp = O + (size_t)(row0 + ai * HALF + m * 16) * ldc + col0;
#pragma unroll
                for (int bj = 0; bj < 2; ++bj) *(u32x4*)(rowp + bj * HALF) = pack8(acc[ai][bj][m][0] * scale, acc[ai][bj][m][1] * scale); }
    }
};

struct EpiStoreKPerm {
    static constexpr bool PERM = true, AFTER_DRAIN = false;
    bf16_t* O; int ldc;
    __device__ __forceinline__ void operator()(const f32x4 (&acc)[2][2][4][2], const Unit& u, int wr, int wc, int fr, int fq) const {
        const int row0 = u.pm * BM + wr * 64 + fr, colg = u.pn * BM + wc * 32;
#pragma unroll
        for (int ai = 0; ai < 2; ++ai)
#pragma unroll
            for (int m = 0; m < 4; ++m) { bf16_t* rowp = O + (size_t)(row0 + ai * HALF + m * 16) * ldc + colg;
#pragma unroll
                for (int bj = 0; bj < 2; ++bj)
#pragma unroll
                    for (int n = 0; n < 2; ++n) { const f32x4 v = acc[ai][bj][m][n]; u32x2 w; w.x = cvt_pk_bf16(v[0], v[1]); w.y = cvt_pk_bf16(v[2], v[3]);
                        *(u32x2*)(rowp + bj * HALF + 8 * ((2 * fq + n) & 3) + 4 * (fq >> 1)) = w; } }
    }
};

struct EpiInProj {
    static constexpr bool PERM = true, AFTER_DRAIN = false;
    bf16_t *q, *k, *v, *uu, *cb, *sga, *sgc; float qscale;
    __device__ __forceinline__ void operator()(const f32x4 (&acc)[2][2][4][2], const Unit& u, int wr, int wc, int fr, int fq) const {
        const int row0 = u.pm * BM + wr * 64 + fr; const int pn = u.pn;
        if (pn >= 12 && pn < 20) {
            const int col0 = (pn - 12) * 128 + wc * 32 + 8 * fq;
#pragma unroll
            for (int ai = 0; ai < 2; ++ai)
#pragma unroll
                for (int m = 0; m < 4; ++m) *(u32x4*)(uu + (size_t)(row0 + ai * HALF + m * 16) * 1024 + col0) = pack8(acc[ai][0][m][0] * acc[ai][1][m][0], acc[ai][0][m][1] * acc[ai][1][m][1]);
            return;
        }
        bf16_t* base; float sc = 1.f; bool sig = false;
        if (pn < 4) { base = q; sc = qscale; } else if (pn < 8) base = k; else if (pn < 12) base = v; else if (pn < 24) base = cb; else if (pn < 28) { base = sga; sig = true; } else { base = sgc; sig = true; }
        const int col0 = (pn & 3) * BM + wc * 32 + 8 * fq;
#pragma unroll
        for (int ai = 0; ai < 2; ++ai)
#pragma unroll
            for (int m = 0; m < 4; ++m) { bf16_t* rowp = base + (size_t)(row0 + ai * HALF + m * 16) * 1024 + col0;
#pragma unroll
                for (int bj = 0; bj < 2; ++bj) { f32x4 v0 = acc[ai][bj][m][0], v1 = acc[ai][bj][m][1];
                    if (sig) {
#pragma unroll
                        for (int e = 0; e < 4; ++e) { v0[e] = sigmoidf_fast(v0[e]); v1[e] = sigmoidf_fast(v1[e]); } }
                    else { v0 = v0 * sc; v1 = v1 * sc; }
                    *(u32x4*)(rowp + bj * HALF) = pack8(v0, v1); } }
    }
};

struct EpiGate {
    static constexpr bool PERM = true, AFTER_DRAIN = false;
    bf16_t* merged; const bf16_t* sga; const bf16_t* sgc;
    __device__ __forceinline__ void operator()(const f32x4 (&acc)[2][2][4][2], const Unit& u, int wr, int wc, int fr, int fq) const {
        const int row0 = u.pm * BM + wr * 64 + fr, col0 = u.pn * BM + wc * 32 + 8 * fq; const bf16_t* gate = u.g ? sgc : sga;
#pragma unroll
        for (int ai = 0; ai < 2; ++ai)
#pragma unroll
            for (int m = 0; m < 4; ++m) { const size_t off = (size_t)(row0 + ai * HALF + m * 16) * 1024 + col0;
#pragma unroll
                for (int bj = 0; bj < 2; ++bj) { const u32x4 gw = *(const u32x4*)(gate + off + bj * HALF);
                    f32x4 v0 = acc[ai][bj][m][0], v1 = acc[ai][bj][m][1];
                    v0[0] *= bf_lo(gw.x); v0[1] *= bf_hi(gw.x); v0[2] *= bf_lo(gw.y); v0[3] *= bf_hi(gw.y); v1[0] *= bf_lo(gw.z); v1[1] *= bf_hi(gw.z); v1[2] *= bf_lo(gw.w); v1[3] *= bf_hi(gw.w);
                    if (u.g) { const u32x4 pw = *(const u32x4*)(merged + off + bj * HALF);
                        v0[0] += bf_lo(pw.x); v0[1] += bf_hi(pw.x); v0[2] += bf_lo(pw.y); v0[3] += bf_hi(pw.y); v1[0] += bf_lo(pw.z); v1[1] += bf_hi(pw.z); v1[2] += bf_lo(pw.w); v1[3] += bf_hi(pw.w); }
                    *(u32x4*)(merged + off + bj * HALF) = pack8(v0, v1); } }
    }
};

template <bool BASE_BF16> struct EpiResid {
    static constexpr bool PERM = false, AFTER_DRAIN = false;
    const float* basef; const bf16_t* baseb; bf16_t* hb; float* ssq;
    __device__ __forceinline__ void operator()(const f32x4 (&acc)[2][2][4][2], const Unit& u, int wr, int wc, int fr, int fq) const {
        const int row0 = u.pm * BM + wr * 64 + fr, col0 = u.pn * BM + wc * 32 + 4 * fq;
#pragma unroll
        for (int ai = 0; ai < 2; ++ai)
#pragma unroll
            for (int m = 0; m < 4; ++m) { const int row = row0 + ai * HALF + m * 16; const size_t off = (size_t)row * 1024 + col0; float s = 0.f;
#pragma unroll
                for (int bj = 0; bj < 2; ++bj)
#pragma unroll
                    for (int n = 0; n < 2; ++n) { f32x4 b;
                        if (BASE_BF16) { const u32x2 w = *(const u32x2*)(baseb + off + bj * HALF + n * 16); b = (f32x4){bf_lo(w.x), bf_hi(w.x), bf_lo(w.y), bf_hi(w.y)}; }
                        else b = *(const f32x4*)(basef + off + bj * HALF + n * 16);
                        const f32x4 h = b + acc[ai][bj][m][n];
                        s += (h[0] * h[0] + h[1] * h[1]) + (h[2] * h[2] + h[3] * h[3]);
                        u32x2 w; w.x = cvt_pk_bf16(h[0], h[1]); w.y = cvt_pk_bf16(h[2], h[3]); *(u32x2*)(hb + off + bj * HALF + n * 16) = w; }
                s += __shfl_xor(s, 16); s += __shfl_xor(s, 32);
                if (fq == 0) ssq[(size_t)row * 16 + u.pn * 4 + wc] = s; }
    }
};

struct EpiRowScale {
    static constexpr bool PERM = true, AFTER_DRAIN = false;
    bf16_t* O; int ldc; const float* ssq; float scale; float eps;
    __device__ __forceinline__ void operator()(const f32x4 (&acc)[2][2][4][2], const Unit& u, int wr, int wc, int fr, int fq) const {
        const int row0 = u.pm * BM + wr * 64 + fr, col0 = u.pn * BM + wc * 32 + 8 * fq;
#pragma unroll
        for (int ai = 0; ai < 2; ++ai)
#pragma unroll
            for (int m = 0; m < 4; ++m) { const int row = row0 + ai * HALF + m * 16; const f32x4* sp = (const f32x4*)(ssq + (size_t)row * 16);
                const f32x4 a = sp[0], b = sp[1], c = sp[2], d = sp[3]; const f32x4 t = (a + b) + (c + d);
                const float rs = __builtin_amdgcn_rsqf(((t[0] + t[1]) + (t[2] + t[3])) * (1.0f / 1024.0f) + eps) * scale;
                bf16_t* rowp = O + (size_t)row * ldc + col0;
#pragma unroll
                for (int bj = 0; bj < 2; ++bj) *(u32x4*)(rowp + bj * HALF) = pack8(acc[ai][bj][m][0] * rs, acc[ai][bj][m][1] * rs); }
    }
};

template <class Epi, class Sched, bool ALIGN_EPI = false, bool SP2 = false>
__device__ __forceinline__ void gemm_phase(PG8_LAS unsigned char* lds, const GemmSet g, const Sched& S, const Epi& E) {
    const int tid = threadIdx.x, wid = __builtin_amdgcn_readfirstlane(tid >> 6), lane = tid & 63, wr = wid >> 2, wc = wid & 3, fr = lane & 15, fq = lane >> 4;
    const int K = g.K, nt = K / BK;
    unsigned voffA[2], voffB[2];
#pragma unroll
    for (int i = 0; i < 2; ++i) { int R, C; stage_rc(tid * 16 + i * 8192, R, C); const int Rb = Epi::PERM ? ((R & ~31) + perm32(R & 31)) : R;
        voffA[i] = (unsigned)(R * K + C) * 2u; voffB[i] = (unsigned)(Rb * K + C) * 2u; }
    const size_t kstep = (size_t)(BK * 2);
    const size_t hstep = (size_t)HALF * K * 2;
    const size_t tstep = 2 * hstep;
    const unsigned ldsw = (unsigned)wid * 1024u;
    const int aoff = lds_byte(wr * 64 + fr, fq * 8), boff = lds_byte(wc * 32 + fr, fq * 8);
#define PG8_SA(b, h) (((b) * 2 + (h)) * HTB)
#define PG8_SB(b, h) ((4 + (b) * 2 + (h)) * HTB)
#define PG8_STAGE(bufoff, gbase, voff) do { _Pragma("unroll") for (int _i = 0; _i < 2; ++_i) \
        __builtin_amdgcn_global_load_lds((const unsigned*)((const char*)(gbase) + (voff)[_i]), (PG8_LAS unsigned*)(lds + (bufoff) + ldsw + _i * 8192), 16, 0, 0); } while (0)
#define PG8_LDA(dst, b, h) do { _Pragma("unroll") for (int m = 0; m < 4; ++m) _Pragma("unroll") for (int k = 0; k < 2; ++k) dst[m][k] = *(const PG8_LAS bf16x8*)(lds + PG8_SA(b, h) + aoff + m * 2048 + k * 1024); } while (0)
#define PG8_LDB(dst, b, h) do { _Pragma("unroll") for (int n = 0; n < 2; ++n) _Pragma("unroll") for (int k = 0; k < 2; ++k) dst[n][k] = *(const PG8_LAS bf16x8*)(lds + PG8_SB(b, h) + boff + n * 2048 + k * 1024); } while (0)
#define PG8_MMA(ai, bj, At, Bt) do { __builtin_amdgcn_s_setprio(1); _Pragma("unroll") for (int m = 0; m < 4; ++m) _Pragma("unroll") for (int n = 0; n < 2; ++n) _Pragma("unroll") for (int k = 0; k < 2; ++k) \
        acc[ai][bj][m][n] = __builtin_amdgcn_mfma_f32_16x16x32_bf16(Bt[n][k], At[m][k], acc[ai][bj][m][n], 0, 0, 0); __builtin_amdgcn_s_setprio(0); } while (0)
#define PG8_WAIT_V(n) asm volatile("s_waitcnt vmcnt(" #n ")" ::: "memory")
#define PG8_WAIT_L(n) asm volatile("s_waitcnt lgkmcnt(" #n ")" ::: "memory")
#define PG8_BAR __builtin_amdgcn_s_barrier()
#define PG8_SCHED __builtin_amdgcn_sched_barrier(0)
    Unit cur, nxt; int ui = 0;
    if (!S.next(0, cur)) return;
    f32x4 acc[2][2][4][2];
#pragma unroll
    for (int a = 0; a < 2; ++a)
#pragma unroll
        for (int b = 0; b < 2; ++b)
#pragma unroll
            for (int m = 0; m < 4; ++m)
#pragma unroll
                for (int n = 0; n < 2; ++n) acc[a][b][m][n] = (f32x4){0.f, 0.f, 0.f, 0.f};
    bf16x8 At[4][2], B0[2][2], B1[2][2];
    const char* cA = (const char*)(cur.g ? g.A1 : g.A0) + (size_t)cur.pm * tstep; const char* cB = (const char*)(cur.g ? g.B1 : g.B0) + (size_t)cur.pn * tstep;
    S.a_ready(cur);
    if constexpr (SP2) {
        PG8_STAGE(PG8_SB(0, 0), cB, voffB); PG8_STAGE(PG8_SB(0, 1), cB + hstep, voffB); PG8_STAGE(PG8_SA(0, 0), cA, voffA); PG8_STAGE(PG8_SA(0, 1), cA + hstep, voffA);
        if (wr == 1) PG8_BAR;
        PG8_WAIT_V(2); PG8_BAR;
        PG8_STAGE(PG8_SB(1, 0), cB + kstep, voffB); PG8_STAGE(PG8_SA(1, 0), cA + kstep, voffA); PG8_STAGE(PG8_SB(1, 1), cB + hstep + kstep, voffB);
        PG8_WAIT_V(6); PG8_BAR;
    } else {
        PG8_STAGE(PG8_SB(0, 0), cB, voffB); PG8_STAGE(PG8_SA(0, 0), cA, voffA); PG8_STAGE(PG8_SB(0, 1), cB + hstep, voffB); PG8_STAGE(PG8_SA(0, 1), cA + hstep, voffA);
        if (wr == 1) PG8_BAR;
        PG8_WAIT_V(4); PG8_BAR;
        PG8_STAGE(PG8_SB(1, 0), cB + kstep, voffB); PG8_STAGE(PG8_SA(1, 0), cA + kstep, voffA); PG8_STAGE(PG8_SB(1, 1), cB + hstep + kstep, voffB);
        PG8_WAIT_V(6); PG8_BAR;
    }
    for (;;) {
        const bool has_next = S.next(ui + 1, nxt);
        const char* nA = has_next ? (const char*)(nxt.g ? g.A1 : g.A0) + (size_t)nxt.pm * tstep : cA; const char* nB = has_next ? (const char*)(nxt.g ? g.B1 : g.B0) + (size_t)nxt.pn * tstep : cB;
        for (int t = 0; t < nt; t += 2) {
            const bool last = (t == nt - 2);
            const char* a1 = cA + (size_t)(t + 1) * kstep;
            const char* a2 = last ? nA : cA + (size_t)(t + 2) * kstep; const char* b2 = last ? nB : cB + (size_t)(t + 2) * kstep;
            const char* a3 = a2 + kstep; const char* b3 = b2 + kstep;
            if (last && has_next) S.a_ready(nxt);
            if constexpr (SP2) {
            PG8_LDB(B0, 0, 0); PG8_LDB(B1, 0, 1); PG8_SCHED; PG8_LDA(At, 0, 0); PG8_STAGE(PG8_SA(1, 1), a1 + hstep, voffA);
            PG8_WAIT_V(8); PG8_WAIT_L(0); PG8_BAR; PG8_MMA(0, 0, At, B0); PG8_MMA(0, 1, At, B1); PG8_BAR; PG8_SCHED;
            PG8_LDA(At, 0, 1); PG8_STAGE(PG8_SB(0, 0), b2, voffB); PG8_STAGE(PG8_SB(0, 1), b2 + hstep, voffB); PG8_STAGE(PG8_SA(0, 0), a2, voffA);
            PG8_WAIT_V(8); PG8_WAIT_L(0); PG8_BAR; PG8_MMA(1, 0, At, B0); PG8_MMA(1, 1, At, B1); PG8_BAR; PG8_SCHED;
            PG8_LDB(B0, 1, 0); PG8_LDB(B1, 1, 1); PG8_SCHED; PG8_LDA(At, 1, 0); PG8_STAGE(PG8_SA(0, 1), a2 + hstep, voffA);
            PG8_WAIT_V(8); PG8_WAIT_L(0); PG8_BAR; PG8_MMA(0, 0, At, B0); PG8_MMA(0, 1, At, B1); PG8_BAR; PG8_SCHED;
            PG8_LDA(At, 1, 1); PG8_STAGE(PG8_SB(1, 0), b3, voffB); PG8_STAGE(PG8_SB(1, 1), b3 + hstep, voffB); PG8_STAGE(PG8_SA(1, 0), a3, voffA);
            PG8_WAIT_V(8); PG8_WAIT_L(0); PG8_BAR; PG8_MMA(1, 0, At, B0); PG8_MMA(1, 1, At, B1); PG8_BAR; PG8_SCHED;
            } else {
            PG8_LDB(B0, 0, 0); PG8_SCHED; PG8_LDA(At, 0, 0); PG8_STAGE(PG8_SA(1, 1), a1 + hstep, voffA);
            PG8_WAIT_L(8); PG8_BAR; PG8_WAIT_L(0); PG8_MMA(0, 0, At, B0); PG8_BAR; PG8_SCHED;
            PG8_LDB(B1, 0, 1); PG8_STAGE(PG8_SB(0, 0), b2, voffB);
            PG8_BAR; PG8_WAIT_L(0); PG8_MMA(0, 1, At, B1); PG8_BAR;
            PG8_LDA(At, 0, 1); PG8_STAGE(PG8_SA(0, 0), a2, voffA);
            PG8_BAR; PG8_WAIT_L(0); PG8_MMA(1, 0, At, B0); PG8_BAR; PG8_SCHED;
            PG8_STAGE(PG8_SB(0, 1), b2 + hstep, voffB);
            PG8_WAIT_V(6); PG8_BAR; PG8_MMA(1, 1, At, B1); PG8_BAR;
            PG8_LDB(B0, 1, 0); PG8_SCHED; PG8_LDA(At, 1, 0); PG8_STAGE(PG8_SA(0, 1), a2 + hstep, voffA);
            PG8_WAIT_L(8); PG8_BAR; PG8_WAIT_L(0); PG8_MMA(0, 0, At, B0); PG8_BAR; PG8_SCHED;
            PG8_LDB(B1, 1, 1); PG8_STAGE(PG8_SB(1, 0), b3, voffB);
            PG8_BAR; PG8_WAIT_L(0); PG8_MMA(0, 1, At, B1); PG8_BAR;
            PG8_LDA(At, 1, 1); PG8_STAGE(PG8_SA(1, 0), a3, voffA);
            PG8_BAR; PG8_WAIT_L(0); PG8_MMA(1, 0, At, B0); PG8_BAR; PG8_SCHED;
            PG8_STAGE(PG8_SB(1, 1), b3 + hstep, voffB);
            PG8_WAIT_V(6); PG8_BAR; PG8_MMA(1, 1, At, B1); PG8_BAR;
            }
        }
        if constexpr (ALIGN_EPI) { if (wr == 0) PG8_BAR; }
        if constexpr (!Epi::AFTER_DRAIN) { E(acc, cur, wr, wc, fr, fq); S.done(cur); }
        if (!has_next) break;
#pragma unroll
        for (int a = 0; a < 2; ++a)
#pragma unroll
            for (int b = 0; b < 2; ++b)
#pragma unroll
                for (int m = 0; m < 4; ++m)
#pragma unroll
                    for (int n = 0; n < 2; ++n) acc[a][b][m][n] = (f32x4){0.f, 0.f, 0.f, 0.f};
        cur = nxt; cA = nA; cB = nB; ++ui;
        if constexpr (ALIGN_EPI) { if (wr == 1) PG8_BAR; }
    }
    PG8_WAIT_V(0);
    if constexpr (!ALIGN_EPI) { if (wr == 0) PG8_BAR; }
    PG8_BAR;
    if constexpr (Epi::AFTER_DRAIN) { E.fused(acc, cur, wr, wc, fr, fq, lds, wid, lane); S.done(cur); }
#undef PG8_SA
#undef PG8_SB
#undef PG8_STAGE
#undef PG8_LDA
#undef PG8_LDB
#undef PG8_MMA
#undef PG8_WAIT_V
#undef PG8_WAIT_L
#undef PG8_BAR
#undef PG8_SCHED
}
}

namespace sb {
using bf16 = __hip_bfloat16;
using bf16x8 = __attribute__((ext_vector_type(8))) short;
using s16x4 = __attribute__((ext_vector_type(4))) short;
using f32x16 = __attribute__((ext_vector_type(16))) float;
using u32x4 = __attribute__((ext_vector_type(4))) unsigned;
constexpr int SEQ = 2048, NHEAD = 16, HD = 64, DM = 1024;
constexpr int SLOTB = 8192, LDS_K = 0, LDS_V = 2 * SLOTB, LDS_FLAG = 4 * SLOTB, LDS_OST = 4 * SLOTB + 4096, LDS_BYTES = LDS_OST + 8 * 4096;
constexpr float EXIT_THR = -150.0f;
__device__ __forceinline__ int crow(int r, int hi) { return (r & 3) + 8 * (r >> 2) + 4 * hi; }
__device__ __forceinline__ void glds16(const void* gsrc, unsigned lds_dst) { unsigned keep;
    asm volatile("s_mov_b32 %0, m0\n\ts_mov_b32 m0, %2\n\ts_nop 0\n\tglobal_load_lds_dwordx4 %1, off\n\ts_mov_b32 m0, %0" : "=&s"(keep) : "v"(gsrc), "s"(lds_dst) : "memory"); }
typedef __attribute__((address_space(3))) const char* lds_cptr;
typedef short v4i16_t __attribute__((ext_vector_type(4)));
typedef float f32x2_t __attribute__((ext_vector_type(2))); typedef __bf16 bf16x2_t __attribute__((ext_vector_type(2)));
__device__ __forceinline__ unsigned cvtpk(float lo, float hi) { f32x2_t v = {lo, hi}; bf16x2_t b = __builtin_convertvector(v, bf16x2_t); return __builtin_bit_cast(unsigned, b); }
__device__ __forceinline__ s16x4 vtr(lds_cptr p) { return __builtin_bit_cast(s16x4, __builtin_amdgcn_ds_read_tr16_b64_v4i16((__attribute__((address_space(3))) v4i16_t*)p)); }
__device__ __forceinline__ bf16x8 pack8(const f32x16& p, int b) { u32x4 w; w.x = cvtpk(p[b], p[b + 1]); w.y = cvtpk(p[b + 2], p[b + 3]); w.z = cvtpk(p[b + 4], p[b + 5]); w.w = cvtpk(p[b + 6], p[b + 7]); return __builtin_bit_cast(bf16x8, w); }
__device__ __forceinline__ float lo_lane(float x) { auto rr = __builtin_amdgcn_permlane32_swap(__float_as_uint(x), __float_as_uint(x), false, false); return __uint_as_float(rr[0]); }
#define SB_WAIT_BAR() asm volatile("s_waitcnt vmcnt(0) lgkmcnt(0)\n\ts_barrier" ::: "memory")

template <bool EARLY> __device__ __forceinline__ void sb_unit(int b, int h, int qb, const bf16* Q, const bf16* __restrict__ K, const bf16* __restrict__ V, bf16* O, char* shm) {
    const int tid = threadIdx.x, lane = tid & 63, r32 = lane & 31, hi = lane >> 5; const int wid = __builtin_amdgcn_readfirstlane(tid >> 6);
    const long rowbase = (long)b * SEQ; const int q0 = qb * 256;
    const bf16* Qw = Q + (rowbase + q0 + wid * 32) * DM + h * HD;
    const bf16* Kh = K + rowbase * DM + h * HD; const bf16* Vh = V + rowbase * DM + h * HD;
    const unsigned lds0 = (unsigned)(uintptr_t)shm;
    const bf16* ksrc = Kh + (long)lane * DM + wid * 8;
    const bf16* vsrc = Vh + (long)(16 * (wid & 3) + (lane >> 2)) * DM + (wid >> 2) * 32 + (lane & 3) * 8;
    const unsigned kdst = lds0 + LDS_K + wid * 1024, vdst = lds0 + LDS_V + wid * 1024;
#define SB_DMA_K(t, slot) glds16(ksrc + (long)(t) * 64 * DM, (unsigned)__builtin_amdgcn_readfirstlane(kdst + (slot)))
#define SB_DMA_V(t, slot) glds16(vsrc + (long)(t) * 64 * DM, (unsigned)__builtin_amdgcn_readfirstlane(vdst + (slot)))
    const lds_cptr shm3 = (lds_cptr)shm; const lds_cptr kp0 = shm3 + LDS_K + hi * 1024 + r32 * 16;
    const lds_cptr vp0 = shm3 + LDS_V + ((lane >> 4) & 1) * 32 + (lane & 3) * 8 + (4 * hi + ((lane & 15) >> 2)) * 64;
    const int NT = (q0 + 256) / 64;
    volatile __attribute__((address_space(3))) unsigned* flags = (volatile __attribute__((address_space(3))) unsigned*)(shm3 + LDS_FLAG);
    if (EARLY && lane == 0) flags[wid] = 0u;
    bool wdone = false;
    SB_DMA_K(NT - 1, 0); SB_DMA_V(NT - 1, 0);
    bf16x8 qr[4];
#pragma unroll
    for (int d0 = 0; d0 < 4; ++d0) qr[d0] = *reinterpret_cast<const bf16x8*>(&Qw[(long)r32 * DM + d0 * 16 + hi * 8]);
    bf16x8 tri[2], ones;
#pragma unroll
    for (int ks = 0; ks < 2; ++ks)
#pragma unroll
        for (int j = 0; j < 8; ++j) { const int kk = 16 * ks + 8 * (j >> 2) + 4 * hi + (j & 3); tri[ks][j] = (kk >= r32) ? (short)0x3F80 : (short)0; }
#pragma unroll
    for (int j = 0; j < 8; ++j) ones[j] = (short)0x3F80;
    f32x16 o0 = f32x16{}, o1 = f32x16{}; float R = 0.f;
    const int trow = q0 + wid * 32 + r32;
    const int wmin = q0 + wid * 32, wmax = wmin + 31;
    for (int it = 0; it < NT; ++it) {
        const int t = NT - 1 - it; const int sl = (it & 1) * SLOTB;
        SB_WAIT_BAR();
        if (EARLY) { const unsigned f = flags[lane & 7]; if (__all(f != 0u)) break; }
        if (t > 0) { SB_DMA_K(t - 1, sl ^ SLOTB); SB_DMA_V(t - 1, sl ^ SLOTB); }
        if (64 * t < wmax && !wdone) {
            f32x16 p0 = f32x16{}, p1 = f32x16{};
#pragma unroll
            for (int d0 = 0; d0 < 4; ++d0) {
                const bf16x8 b0 = *(const __attribute__((address_space(3))) bf16x8*)(kp0 + sl + d0 * 2048);
                const bf16x8 b1 = *(const __attribute__((address_space(3))) bf16x8*)(kp0 + sl + d0 * 2048 + 512);
                p0 = __builtin_amdgcn_mfma_f32_32x32x16_bf16(b0, qr[d0], p0, 0, 0, 0);
                p1 = __builtin_amdgcn_mfma_f32_32x32x16_bf16(b1, qr[d0], p1, 0, 0, 0); }
            const bool diag = (64 * t + 63 >= wmin);
            f32x16 l0, l1;
#pragma unroll
            for (int r = 0; r < 16; ++r) {
                const float y0 = p0[r], y1 = p1[r];
                l0[r] = -(__builtin_fmaxf(y0, 0.f) + __builtin_amdgcn_logf(1.0f + __builtin_amdgcn_exp2f(-__builtin_fabsf(y0))));
                l1[r] = -(__builtin_fmaxf(y1, 0.f) + __builtin_amdgcn_logf(1.0f + __builtin_amdgcn_exp2f(-__builtin_fabsf(y1)))); }
            if (diag) {
#pragma unroll
                for (int r = 0; r < 16; ++r) { const int s = 64 * t + crow(r, hi); if (s >= trow) l0[r] = 0.f; if (s + 32 >= trow) l1[r] = 0.f; } }
            const bf16x8 l0a = pack8(l0, 0), l0b = pack8(l0, 8), l1a = pack8(l1, 0), l1b = pack8(l1, 8);
            f32x16 Rv;
#pragma unroll
            for (int r = 0; r < 16; ++r) Rv[r] = R;
            f32x16 c1 = __builtin_amdgcn_mfma_f32_32x32x16_bf16(tri[0], l1a, Rv, 0, 0, 0); c1 = __builtin_amdgcn_mfma_f32_32x32x16_bf16(tri[1], l1b, c1, 0, 0, 0);
            f32x16 c0 = __builtin_amdgcn_mfma_f32_32x32x16_bf16(ones, l1a, Rv, 0, 0, 0); c0 = __builtin_amdgcn_mfma_f32_32x32x16_bf16(ones, l1b, c0, 0, 0, 0);
            c0 = __builtin_amdgcn_mfma_f32_32x32x16_bf16(tri[0], l0a, c0, 0, 0, 0); c0 = __builtin_amdgcn_mfma_f32_32x32x16_bf16(tri[1], l0b, c0, 0, 0, 0);
#pragma unroll
            for (int r = 0; r < 16; ++r) { p0[r] = __builtin_amdgcn_exp2f(p0[r] + c0[r]); p1[r] = __builtin_amdgcn_exp2f(p1[r] + c1[r]); }
            if (diag) {
#pragma unroll
                for (int r = 0; r < 16; ++r) { const int s = 64 * t + crow(r, hi); if (s >= trow) p0[r] = 0.f; if (s + 32 >= trow) p1[r] = 0.f; } }
            R = lo_lane(c0[0]);
            if (EARLY && !__any(R >= EXIT_THR)) { wdone = true; if (lane == 0) flags[wid] = 1u; }
            const bf16x8 pa0 = pack8(p0, 0), pa1 = pack8(p0, 8), pa2 = pack8(p1, 0), pa3 = pack8(p1, 8);
            const lds_cptr vp = vp0 + sl;
#define SB_VF(dh, ks) ({ const s16x4 lo_ = vtr(vp + (dh) * 4096 + (ks) * 1024), hi_ = vtr(vp + (dh) * 4096 + (ks) * 1024 + 512); (bf16x8){lo_[0], lo_[1], lo_[2], lo_[3], hi_[0], hi_[1], hi_[2], hi_[3]}; })
            o0 = __builtin_amdgcn_mfma_f32_32x32x16_bf16(pa0, SB_VF(0, 0), o0, 0, 0, 0); o1 = __builtin_amdgcn_mfma_f32_32x32x16_bf16(pa0, SB_VF(1, 0), o1, 0, 0, 0);
            o0 = __builtin_amdgcn_mfma_f32_32x32x16_bf16(pa1, SB_VF(0, 1), o0, 0, 0, 0); o1 = __builtin_amdgcn_mfma_f32_32x32x16_bf16(pa1, SB_VF(1, 1), o1, 0, 0, 0);
            o0 = __builtin_amdgcn_mfma_f32_32x32x16_bf16(pa2, SB_VF(0, 2), o0, 0, 0, 0); o1 = __builtin_amdgcn_mfma_f32_32x32x16_bf16(pa2, SB_VF(1, 2), o1, 0, 0, 0);
            o0 = __builtin_amdgcn_mfma_f32_32x32x16_bf16(pa3, SB_VF(0, 3), o0, 0, 0, 0); o1 = __builtin_amdgcn_mfma_f32_32x32x16_bf16(pa3, SB_VF(1, 3), o1, 0, 0, 0);
#undef SB_VF
        }
    }
    if (EARLY) SB_WAIT_BAR();
    bf16* Ow = O + (rowbase + q0 + wid * 32) * DM + h * HD;
    {
        bf16* stg = (bf16*)(shm + LDS_OST) + wid * 2048;
#pragma unroll
        for (int r = 0; r < 16; ++r) { const int orow = crow(r, hi); stg[orow * 64 + r32] = __float2bfloat16(o0[r]); stg[orow * 64 + 32 + r32] = __float2bfloat16(o1[r]); }
        asm volatile("s_waitcnt lgkmcnt(0)" ::: "memory");
#pragma unroll
        for (int i = 0; i < 4; ++i) { const int row = i * 8 + (lane >> 3), ch = lane & 7; const u32x4 v = *(const u32x4*)(stg + row * 64 + ch * 8); *(u32x4*)(Ow + (long)row * DM + ch * 8) = v; }
        asm volatile("s_waitcnt lgkmcnt(0)" ::: "memory");
    }
#undef SB_DMA_K
#undef SB_DMA_V
}
}

constexpr int NWAVES = 8;
constexpr int N_LAUNCHES = MK_N_LAUNCHES;
constexpr int N_PHASES = 10;
constexpr int BATCH = 8, SEQ = 2048, D = 1024, M = BATCH * SEQ, MEMLEN = 256, MROWS = BATCH * MEMLEN, NIN = 8192, NPQ = 2048;
constexpr float RMS_EPS = 1e-6f;
constexpr float LOG2E = 1.4426950408889634f;
constexpr size_t MiB = 1u << 20;
constexpr size_t WS_CTL = 0, CTL_ZERO_BYTES = 32768;
constexpr size_t WS_WIN = 1 * MiB, WS_WA = 17 * MiB, WS_WC = 19 * MiB, WS_WO = 21 * MiB, WS_WQ2 = 23 * MiB, WS_WKV2 = 25 * MiB, WS_WO2 = 29 * MiB, WS_WPQ = 31 * MiB, WS_SK = 35 * MiB;
constexpr size_t WS_SSQ1 = 36 * MiB, WS_SSQ2 = 37 * MiB, WS_MEMN = 38 * MiB, WS_K2 = 42 * MiB, WS_V2T = 46 * MiB;
constexpr size_t WS_B0 = 52 * MiB, WS_B1 = 84 * MiB, WS_B2 = 116 * MiB, WS_B3 = 148 * MiB, WS_B4 = 180 * MiB, WS_B5 = 212 * MiB, WS_END = 244 * MiB;
constexpr int CW_TMO = 0, CW_CODE = 1, CW_BAR = 4096;

constexpr int RING_OFF = 0, RING_BYTES = 131072;
constexpr int LDSCTL_OFF = RING_BYTES, MISC_OFF = LDSCTL_OFF + 320;
constexpr int LDS_BYTES = 147456;
#define GAS __attribute__((address_space(1)))
#define LAS __attribute__((address_space(3)))
typedef unsigned short bf16;
typedef unsigned v4u __attribute__((ext_vector_type(4)));
typedef float f32x4 __attribute__((ext_vector_type(4)));
typedef short bf16x8 __attribute__((ext_vector_type(8)));
typedef GAS unsigned gu32;
typedef GAS unsigned long long gu64;
#define RLX_AGENT __ATOMIC_RELAXED, __HIP_MEMORY_SCOPE_AGENT
#define LDS_WAIT() asm volatile("s_waitcnt lgkmcnt(0)" ::: "memory")
#define VM_WAIT() asm volatile("s_waitcnt vmcnt(0)" ::: "memory")
__device__ __forceinline__ unsigned long long rt() { return __builtin_amdgcn_s_memrealtime(); }
__device__ __forceinline__ unsigned f2bf(float f) { unsigned u = __builtin_bit_cast(unsigned, f); return (u + 0x7fffu + ((u >> 16) & 1u)) >> 16; }
__device__ __forceinline__ unsigned pk2(float lo, float hi) { return f2bf(lo) | (f2bf(hi) << 16); }

#define XB_TMO      128
#define XB_XCNT(j)  (256  + 64 * (j))
#define XB_XSUB(j)  (1280 + 64 * (j))
#define XB_XGEN(j)  (2304 + 64 * (j))
#define XB_TOP      3328
#define XB_TOPGEN   3392
#define XCD_BAR_WORDS 3456
#define XB_SPIN_CAP (1u << 18)

__device__ __forceinline__ unsigned xb_ld(unsigned* p)              { return __hip_atomic_load(p, __ATOMIC_RELAXED, __HIP_MEMORY_SCOPE_AGENT); }
__device__ __forceinline__ unsigned xb_add(unsigned* p, unsigned v) { return __hip_atomic_fetch_add(p, v, __ATOMIC_RELAXED, __HIP_MEMORY_SCOPE_AGENT); }
__device__ __forceinline__ unsigned xb_xcc_id() { return (unsigned)__builtin_amdgcn_s_getreg((3 << 11) | 20) & 0xFu; }
#define XB_SPIN(cond, bar) do { unsigned _sp = 0; while (cond) { __builtin_amdgcn_s_sleep(1); \
    if ((++_sp & 255u) == 0u) { if (xb_ld(&(bar)[XB_TMO])) break; if (_sp > XB_SPIN_CAP) { atomicAdd(&(bar)[XB_TMO], 1u); break; } } } } while (0)

struct XcdBarrier {
    unsigned* bar; unsigned x;
    volatile LAS unsigned* st;
};

__device__ __forceinline__ XcdBarrier xcd_barrier_post(unsigned* bar, volatile LAS unsigned* st) {
    XcdBarrier b; b.bar = bar; b.x = xb_xcc_id(); b.st = st;
    if (threadIdx.x == 0) (void)xb_add(&bar[XB_XCNT(b.x)], 1u);
    return b;
}
__device__ __forceinline__ void xcd_barrier_complete(unsigned* bar, unsigned x, unsigned& nloc, unsigned& nx) {
    const unsigned G = gridDim.x * gridDim.y * gridDim.z;
    unsigned sum, cnt, mine, sp = 0u;
    for (;;) {
        sum = 0u; cnt = 0u; mine = 0u;
#pragma unroll
        for (unsigned j = 0; j < 16; ++j) { const unsigned c = xb_ld(&bar[XB_XCNT(j)]); sum += c; cnt += (c > 0u) ? 1u : 0u; mine = (j == x) ? c : mine; }
        if (sum == G) break;
        __builtin_amdgcn_s_sleep(1);
        if ((++sp & 255u) == 0u) { if (xb_ld(&bar[XB_TMO])) break; if (sp > XB_SPIN_CAP) { atomicAdd(&bar[XB_TMO], 1u); break; } }
    }
    nloc = mine > 0u ? mine : 1u; nx = cnt > 0u ? cnt : 1u;
}

__device__ __forceinline__ void xcd_barrier(const XcdBarrier& b) {
    asm volatile("s_waitcnt vmcnt(0)" ::: "memory");
    __syncthreads();
    if (threadIdx.x == 0) {
        unsigned* bar = b.bar;
        __builtin_amdgcn_s_waitcnt(0);
        unsigned nloc = b.st[0], nx = b.st[1];
        if (nloc == 0u) { xcd_barrier_complete(bar, b.x, nloc, nx); b.st[0] = nloc; b.st[1] = nx; }
        const unsigned old = xb_add(&bar[XB_XSUB(b.x)], 1u);
        const unsigned gen = old / nloc;
        if (old + 1u == (gen + 1u) * nloc) {
            __builtin_amdgcn_fence(__ATOMIC_RELEASE, "agent");
            asm volatile("s_waitcnt vmcnt(0)" ::: "memory");
            const unsigned og = xb_add(&bar[XB_TOP], 1u);
            const unsigned tg = og / nx;
            if (og + 1u == (tg + 1u) * nx) xb_add(&bar[XB_TOPGEN], 1u);
            else XB_SPIN(xb_ld(&bar[XB_TOPGEN]) == tg, bar);
            __builtin_amdgcn_fence(__ATOMIC_ACQUIRE, "agent");
            xb_add(&bar[XB_XGEN(b.x)], 1u);
            asm volatile("s_waitcnt vmcnt(0)" ::: "memory");
        } else {
            XB_SPIN(xb_ld(&bar[XB_XGEN(b.x)]) == gen, bar);
            __builtin_amdgcn_fence(__ATOMIC_ACQUIRE, "agent");
            asm volatile("s_waitcnt vmcnt(0)" ::: "memory");
        }
    }
    __syncthreads();
}


__device__ __forceinline__ float wave_sum(float v) {
#pragma unroll
    for (int o = 1; o < 64; o <<= 1) v += __shfl_xor(v, o);
    return v;
}
__device__ __forceinline__ int inproj_row(int n) {
    const int g = n >> 10, c = n & 1023;
    if (g < 3) return n;
    if (g == 3) return 3072 + (c >> 7) * 256 + (c & 127);
    if (g == 5) return 3072 + (c >> 7) * 256 + 128 + (c & 127);
    if (g == 4) return 5120 + c;
    return n;
}
template <bool INMAP> __device__ __forceinline__ void transpose_item(const float* W, int K, int N, const float* gain, bf16* WT, int row_off, LAS float* scr, int item, int lane) {
    const int nblk = N / 32, kb = item / nblk, nb = item % nblk, k0 = 64 * kb, n0 = 32 * nb;
#pragma unroll 8
    for (int i = 0; i < 32; ++i) { const int kk = 2 * i + (lane >> 5); float w = W[(size_t)(k0 + kk) * N + n0 + (lane & 31)]; if (gain) w *= gain[k0 + kk]; scr[kk * 33 + (lane & 31)] = w; }
    LDS_WAIT(); asm volatile("" ::: "memory");
    const int c = lane & 7; const int r0 = INMAP ? inproj_row(n0) : (row_off + n0);
#pragma unroll
    for (int j = 0; j < 4; ++j) { const int n = (lane >> 3) + 8 * j; const LAS float* s = scr + (8 * c) * 33 + n;
        v4u o; o.x = pk2(s[0 * 33], s[1 * 33]); o.y = pk2(s[2 * 33], s[3 * 33]); o.z = pk2(s[4 * 33], s[5 * 33]); o.w = pk2(s[6 * 33], s[7 * 33]);
        *(GAS v4u*)(WT + (size_t)(r0 + n) * K + k0 + 8 * c) = o; }
    LDS_WAIT(); asm volatile("" ::: "memory");
}
__device__ __forceinline__ void rms_row_to_bf16(const float* xrow, const float* gain, bf16* orow, int lane) {
    const GAS f32x4* xr = (const GAS f32x4*)xrow + lane; const GAS f32x4* gr = (const GAS f32x4*)gain + lane;
    f32x4 v[4]; float s = 0.f;
#pragma unroll
    for (int j = 0; j < 4; ++j) { v[j] = xr[64 * j]; s += (v[j].x * v[j].x + v[j].y * v[j].y) + (v[j].z * v[j].z + v[j].w * v[j].w); }
    const float rstd = 1.0f / sqrtf(wave_sum(s) * (1.f / 1024.f) + RMS_EPS);
    GAS unsigned long long* o8 = (GAS unsigned long long*)orow + lane;
#pragma unroll
    for (int j = 0; j < 4; ++j) { const f32x4 g = gr[64 * j]; o8[64 * j] = (unsigned long long)pk2(v[j].x * rstd * g.x, v[j].y * rstd * g.y) | ((unsigned long long)pk2(v[j].z * rstd * g.z, v[j].w * rstd * g.w) << 32); }
}
__device__ __forceinline__ void row_to_bf16(const float* xrow, const float* gain, bf16* orow, int lane) {
    const GAS f32x4* xr = (const GAS f32x4*)xrow + lane; GAS unsigned long long* o8 = (GAS unsigned long long*)orow + lane;
#pragma unroll
    for (int j = 0; j < 4; ++j) { f32x4 v = xr[64 * j]; if (gain) { const f32x4 g = ((const GAS f32x4*)gain + lane)[64 * j]; v = v * g; }
        o8[64 * j] = (unsigned long long)pk2(v.x, v.y) | ((unsigned long long)pk2(v.z, v.w) << 32); }
}
__device__ __forceinline__ void row_to_fp8(const float* xrow, const float* gain, float scale, unsigned char* orow, int lane) {
    const GAS f32x4* xr = (const GAS f32x4*)xrow + lane; GAS unsigned* o4 = (GAS unsigned*)orow + lane;
#pragma unroll
    for (int j = 0; j < 4; ++j) { f32x4 v = xr[64 * j] * scale; if (gain) { const f32x4 g = ((const GAS f32x4*)gain + lane)[64 * j]; v = v * g; }
        int w = 0; w = __builtin_amdgcn_cvt_pk_fp8_f32(v.x, v.y, w, false); w = __builtin_amdgcn_cvt_pk_fp8_f32(v.z, v.w, w, true); o4[64 * j] = (unsigned)w; }
}
__device__ __forceinline__ void rows4_to_fp8(const float* x0, size_t rstride, const float* gain, float scale, unsigned char* o0, int lane) {
    f32x4 v[4][4];
#pragma unroll
    for (int r = 0; r < 4; ++r)
#pragma unroll
        for (int j = 0; j < 4; ++j) v[r][j] = ((const GAS f32x4*)(x0 + r * rstride * 1024) + lane)[64 * j];
#pragma unroll
    for (int j = 0; j < 4; ++j) { f32x4 g = (f32x4){scale, scale, scale, scale}; if (gain) g = g * ((const GAS f32x4*)gain + lane)[64 * j];
#pragma unroll
        for (int r = 0; r < 4; ++r) { const f32x4 t = v[r][j] * g; int w = 0; w = __builtin_amdgcn_cvt_pk_fp8_f32(t.x, t.y, w, false); w = __builtin_amdgcn_cvt_pk_fp8_f32(t.z, t.w, w, true);
            ((GAS unsigned*)(o0 + r * rstride * 1024) + lane)[64 * j] = (unsigned)w; } }
}
__device__ __forceinline__ void rms_rows2_to_bf16(const float* x0, size_t rstride, const float* gain, bf16* o0, int lane) {
    f32x4 v[2][4]; float s[2] = {0.f, 0.f};
#pragma unroll
    for (int r = 0; r < 2; ++r)
#pragma unroll
        for (int j = 0; j < 4; ++j) v[r][j] = ((const GAS f32x4*)(x0 + r * rstride * 1024) + lane)[64 * j];
#pragma unroll
    for (int r = 0; r < 2; ++r)
#pragma unroll
        for (int j = 0; j < 4; ++j) s[r] += (v[r][j].x * v[r][j].x + v[r][j].y * v[r][j].y) + (v[r][j].z * v[r][j].z + v[r][j].w * v[r][j].w);
#pragma unroll
    for (int r = 0; r < 2; ++r) { const float rstd = 1.0f / sqrtf(wave_sum(s[r]) * (1.f / 1024.f) + RMS_EPS);
        GAS unsigned long long* o8 = (GAS unsigned long long*)(o0 + r * rstride * 1024) + lane;
#pragma unroll
        for (int j = 0; j < 4; ++j) { const f32x4 g = ((const GAS f32x4*)gain + lane)[64 * j];
            o8[64 * j] = (unsigned long long)pk2(v[r][j].x * rstd * g.x, v[r][j].y * rstd * g.y) | ((unsigned long long)pk2(v[r][j].z * rstd * g.z, v[r][j].w * rstd * g.w) << 32); } }
}
__device__ __forceinline__ void final_norm_row(const float* hrow, const float* gain, float* orow, int lane) {
    const GAS f32x4* xr = (const GAS f32x4*)hrow + lane; const GAS f32x4* gr = (const GAS f32x4*)gain + lane;
    f32x4 v[4]; float s = 0.f;
#pragma unroll
    for (int j = 0; j < 4; ++j) { v[j] = xr[64 * j]; s += (v[j].x * v[j].x + v[j].y * v[j].y) + (v[j].z * v[j].z + v[j].w * v[j].w); }
    const float rstd = 1.0f / sqrtf(wave_sum(s) * (1.f / 1024.f) + RMS_EPS);
    GAS f32x4* o = (GAS f32x4*)orow + lane;
#pragma unroll
    for (int j = 0; j < 4; ++j) o[64 * j] = v[j] * rstd * gr[64 * j];
}
__device__ __forceinline__ float bflo(unsigned w) { return __builtin_bit_cast(float, w << 16); }
__device__ __forceinline__ float bfhi(unsigned w) { return __builtin_bit_cast(float, w & 0xffff0000u); }
__device__ __forceinline__ void yconv_item(const bf16* U, const bf16* CB, const float* cw, bf16* YC, int item, int lane) {
    const int t0 = item * 8; const bool first = (t0 % SEQ) == 0;
#pragma unroll 1
    for (int ps = 0; ps < 2; ++ps) {
        const int c0 = ps * 512 + lane * 8;
        float w0[8], w1[8], w2[8];
#pragma unroll
        for (int e = 0; e < 8; ++e) { w0[e] = cw[c0 + e]; w1[e] = cw[1024 + c0 + e]; w2[e] = cw[2048 + c0 + e]; }
        v4u um2 = (v4u){0u, 0u, 0u, 0u}, um1 = (v4u){0u, 0u, 0u, 0u};
        if (!first) { um2 = *(const GAS v4u*)(U + (size_t)(t0 - 2) * 1024 + c0); um1 = *(const GAS v4u*)(U + (size_t)(t0 - 1) * 1024 + c0); }
#pragma unroll
        for (int i = 0; i < 8; ++i) {
            const v4u uc = *(const GAS v4u*)(U + (size_t)(t0 + i) * 1024 + c0); const v4u cbv = *(const GAS v4u*)(CB + (size_t)(t0 + i) * 1024 + c0);
            v4u o;
#pragma unroll
            for (int q = 0; q < 4; ++q) {
                const float a = bflo(cbv[q]) * (w0[2 * q] * bflo(um2[q]) + w1[2 * q] * bflo(um1[q]) + w2[2 * q] * bflo(uc[q]));
                const float b = bfhi(cbv[q]) * (w0[2 * q + 1] * bfhi(um2[q]) + w1[2 * q + 1] * bfhi(um1[q]) + w2[2 * q + 1] * bfhi(uc[q]));
                o[q] = pk2(a, b); }
            *(GAS v4u*)(YC + (size_t)(t0 + i) * 1024 + c0) = o;
            um2 = um1; um1 = uc; }
    }
}


namespace xa {
using bf16x8 = __attribute__((ext_vector_type(8))) short;
using f32x4 = __attribute__((ext_vector_type(4))) float;
using u32x4 = __attribute__((ext_vector_type(4))) unsigned;
using u32x2 = __attribute__((ext_vector_type(2))) unsigned;
typedef __attribute__((address_space(3))) const char* lds_cptr;
constexpr int BUFB = 65536, VOFF = 32768;
#define XA_WAIT_BAR() asm volatile("s_waitcnt vmcnt(0) lgkmcnt(0)\n\ts_barrier" ::: "memory")
__device__ __forceinline__ void xattn_unit(int b, int head, int qh, const bf16* Q, const bf16* K2, const bf16* V2P, bf16* O, char* shm) {
    const int lane = threadIdx.x & 63, kr = lane & 15, g = lane >> 4; const int wid = __builtin_amdgcn_readfirstlane((int)threadIdx.x >> 6);
    const unsigned lds0 = (unsigned)(uintptr_t)shm; const lds_cptr shm3 = (lds_cptr)shm;
    const size_t qrow = (size_t)b * SEQ + qh * 128 + wid * 16 + kr;
    const bf16* ksrc = K2 + ((size_t)b * MEMLEN + lane) * 1024 + head * 256 + 8 * wid;
    const bf16* vsrc = V2P + ((size_t)head * 256 + lane) * 2048 + (size_t)b * MEMLEN + 8 * wid;
#define XA_DMA(c, bufo) do { _Pragma("unroll") for (int i = 0; i < 4; ++i) { \
        sb::glds16(ksrc + (size_t)(64 * (c)) * 1024 + 64 * i, (unsigned)__builtin_amdgcn_readfirstlane(lds0 + (bufo) + (wid + 8 * i) * 1024)); \
        sb::glds16(vsrc + (size_t)(64 * i) * 2048 + 64 * (c), (unsigned)__builtin_amdgcn_readfirstlane(lds0 + (bufo) + VOFF + wid * 4096 + i * 1024)); } } while (0)
    XA_DMA(0, 0);
    bf16x8 qf[8];
#pragma unroll
    for (int ks = 0; ks < 8; ++ks) qf[ks] = *(const GAS bf16x8*)(Q + qrow * 1024 + head * 256 + 32 * ks + 8 * g);
    f32x4 o[16];
#pragma unroll
    for (int dt = 0; dt < 16; ++dt) o[dt] = (f32x4){0.f, 0.f, 0.f, 0.f};
    float mrun = -1e30f, lrun = 0.f;
    const lds_cptr kfr = shm3 + g * 1024 + kr * 16, vfr = shm3 + VOFF + g * 4096 + kr * 16;
#pragma unroll 1
    for (int c = 0; c < 4; ++c) {
        const int bo = (c & 1) * BUFB;
        XA_WAIT_BAR();
        if (c < 3) XA_DMA(c + 1, bo ^ BUFB);
        f32x4 s[4];
#pragma unroll
        for (int kt = 0; kt < 4; ++kt) { s[kt] = (f32x4){0.f, 0.f, 0.f, 0.f};
#pragma unroll
            for (int ks = 0; ks < 8; ++ks) { const bf16x8 a = *(const __attribute__((address_space(3))) bf16x8*)(kfr + bo + ks * 4096 + kt * 256);
                s[kt] = __builtin_amdgcn_mfma_f32_16x16x32_bf16(a, qf[ks], s[kt], 0, 0, 0); } }
        float mx = __builtin_fmaxf(__builtin_fmaxf(s[0].x, s[0].y), __builtin_fmaxf(s[0].z, s[0].w));
#pragma unroll
        for (int kt = 1; kt < 4; ++kt) mx = __builtin_fmaxf(mx, __builtin_fmaxf(__builtin_fmaxf(s[kt].x, s[kt].y), __builtin_fmaxf(s[kt].z, s[kt].w)));
        mx = __builtin_fmaxf(mx, __shfl_xor(mx, 16)); mx = __builtin_fmaxf(mx, __shfl_xor(mx, 32));
        const float mnew = __builtin_fmaxf(mrun, mx), alpha = __builtin_amdgcn_exp2f(mrun - mnew);
        mrun = mnew; float ps = 0.f;
#pragma unroll
        for (int kt = 0; kt < 4; ++kt) { s[kt].x = __builtin_amdgcn_exp2f(s[kt].x - mnew); s[kt].y = __builtin_amdgcn_exp2f(s[kt].y - mnew); s[kt].z = __builtin_amdgcn_exp2f(s[kt].z - mnew); s[kt].w = __builtin_amdgcn_exp2f(s[kt].w - mnew);
            ps += (s[kt].x + s[kt].y) + (s[kt].z + s[kt].w); }
        lrun = lrun * alpha + ps;
#pragma unroll
        for (int dt = 0; dt < 16; ++dt) o[dt] = o[dt] * alpha;
        bf16x8 pb[2];
#pragma unroll
        for (int k2 = 0; k2 < 2; ++k2) { u32x4 w; w.x = pg8::cvt_pk_bf16(s[2 * k2].x, s[2 * k2].y); w.y = pg8::cvt_pk_bf16(s[2 * k2].z, s[2 * k2].w);
            w.z = pg8::cvt_pk_bf16(s[2 * k2 + 1].x, s[2 * k2 + 1].y); w.w = pg8::cvt_pk_bf16(s[2 * k2 + 1].z, s[2 * k2 + 1].w); pb[k2] = __builtin_bit_cast(bf16x8, w); }
#pragma unroll
        for (int dt = 0; dt < 16; ++dt)
#pragma unroll
            for (int k2 = 0; k2 < 2; ++k2) { const bf16x8 a = *(const __attribute__((address_space(3))) bf16x8*)(vfr + bo + k2 * 16384 + dt * 256);
                o[dt] = __builtin_amdgcn_mfma_f32_16x16x32_bf16(a, pb[k2], o[dt], 0, 0, 0); }
    }
    lrun += __shfl_xor(lrun, 16); lrun += __shfl_xor(lrun, 32);
    const float rl = 1.0f / lrun;
    bf16* op = O + qrow * 1024 + head * 256 + 4 * g;
#pragma unroll
    for (int dt = 0; dt < 16; ++dt) { u32x2 w; w.x = pg8::cvt_pk_bf16(o[dt].x * rl, o[dt].y * rl); w.y = pg8::cvt_pk_bf16(o[dt].z * rl, o[dt].w * rl); *(GAS u32x2*)(op + 16 * dt) = w; }
#undef XA_DMA
}
}

namespace peer {
using bf16x8 = __attribute__((ext_vector_type(8))) short;
using f32x16 = __attribute__((ext_vector_type(16))) float;
using u32x4 = __attribute__((ext_vector_type(4))) unsigned;
using u32x2 = __attribute__((ext_vector_type(2))) unsigned;
typedef __bf16 bf16x2_t __attribute__((ext_vector_type(2)));
#define PEER_CE(a, b) do { const int _h = ((a) > (b)) ? (a) : (b); const int _l = ((a) > (b)) ? (b) : (a); (a) = _h; (b) = _l; } while (0)
#define PEER_SORT16(x, o) do { PEER_CE(x[(o)+0], x[(o)+1]); PEER_CE(x[(o)+2], x[(o)+3]); PEER_CE(x[(o)+4], x[(o)+5]); PEER_CE(x[(o)+6], x[(o)+7]); PEER_CE(x[(o)+8], x[(o)+9]); PEER_CE(x[(o)+10], x[(o)+11]); PEER_CE(x[(o)+12], x[(o)+13]); PEER_CE(x[(o)+14], x[(o)+15]); PEER_CE(x[(o)+0], x[(o)+2]); PEER_CE(x[(o)+1], x[(o)+3]); PEER_CE(x[(o)+4], x[(o)+6]); PEER_CE(x[(o)+5], x[(o)+7]); PEER_CE(x[(o)+8], x[(o)+10]); PEER_CE(x[(o)+9], x[(o)+11]); PEER_CE(x[(o)+12], x[(o)+14]); PEER_CE(x[(o)+13], x[(o)+15]); PEER_CE(x[(o)+1], x[(o)+2]); PEER_CE(x[(o)+5], x[(o)+6]); PEER_CE(x[(o)+9], x[(o)+10]); PEER_CE(x[(o)+13], x[(o)+14]); PEER_CE(x[(o)+0], x[(o)+4]); PEER_CE(x[(o)+1], x[(o)+5]); PEER_CE(x[(o)+2], x[(o)+6]); PEER_CE(x[(o)+3], x[(o)+7]); PEER_CE(x[(o)+8], x[(o)+12]); PEER_CE(x[(o)+9], x[(o)+13]); PEER_CE(x[(o)+10], x[(o)+14]); PEER_CE(x[(o)+11], x[(o)+15]); PEER_CE(x[(o)+2], x[(o)+4]); PEER_CE(x[(o)+3], x[(o)+5]); PEER_CE(x[(o)+10], x[(o)+12]); PEER_CE(x[(o)+11], x[(o)+13]); PEER_CE(x[(o)+1], x[(o)+2]); PEER_CE(x[(o)+3], x[(o)+4]); PEER_CE(x[(o)+5], x[(o)+6]); PEER_CE(x[(o)+9], x[(o)+10]); PEER_CE(x[(o)+11], x[(o)+12]); PEER_CE(x[(o)+13], x[(o)+14]); PEER_CE(x[(o)+0], x[(o)+8]); PEER_CE(x[(o)+1], x[(o)+9]); PEER_CE(x[(o)+2], x[(o)+10]); PEER_CE(x[(o)+3], x[(o)+11]); PEER_CE(x[(o)+4], x[(o)+12]); PEER_CE(x[(o)+5], x[(o)+13]); PEER_CE(x[(o)+6], x[(o)+14]); PEER_CE(x[(o)+7], x[(o)+15]); PEER_CE(x[(o)+4], x[(o)+8]); PEER_CE(x[(o)+5], x[(o)+9]); PEER_CE(x[(o)+6], x[(o)+10]); PEER_CE(x[(o)+7], x[(o)+11]); PEER_CE(x[(o)+2], x[(o)+4]); PEER_CE(x[(o)+3], x[(o)+5]); PEER_CE(x[(o)+6], x[(o)+8]); PEER_CE(x[(o)+7], x[(o)+9]); PEER_CE(x[(o)+10], x[(o)+12]); PEER_CE(x[(o)+11], x[(o)+13]); PEER_CE(x[(o)+1], x[(o)+2]); PEER_CE(x[(o)+3], x[(o)+4]); PEER_CE(x[(o)+5], x[(o)+6]); PEER_CE(x[(o)+7], x[(o)+8]); PEER_CE(x[(o)+9], x[(o)+10]); PEER_CE(x[(o)+11], x[(o)+12]); PEER_CE(x[(o)+13], x[(o)+14]); } while (0)
#define PEER_MERGE16(x, a, b) do { x[(a)+0] = (x[(a)+0] > x[(b)+15]) ? x[(a)+0] : x[(b)+15]; x[(a)+1] = (x[(a)+1] > x[(b)+14]) ? x[(a)+1] : x[(b)+14]; x[(a)+2] = (x[(a)+2] > x[(b)+13]) ? x[(a)+2] : x[(b)+13]; x[(a)+3] = (x[(a)+3] > x[(b)+12]) ? x[(a)+3] : x[(b)+12]; x[(a)+4] = (x[(a)+4] > x[(b)+11]) ? x[(a)+4] : x[(b)+11]; x[(a)+5] = (x[(a)+5] > x[(b)+10]) ? x[(a)+5] : x[(b)+10]; x[(a)+6] = (x[(a)+6] > x[(b)+9]) ? x[(a)+6] : x[(b)+9]; x[(a)+7] = (x[(a)+7] > x[(b)+8]) ? x[(a)+7] : x[(b)+8]; x[(a)+8] = (x[(a)+8] > x[(b)+7]) ? x[(a)+8] : x[(b)+7]; x[(a)+9] = (x[(a)+9] > x[(b)+6]) ? x[(a)+9] : x[(b)+6]; x[(a)+10] = (x[(a)+10] > x[(b)+5]) ? x[(a)+10] : x[(b)+5]; x[(a)+11] = (x[(a)+11] > x[(b)+4]) ? x[(a)+11] : x[(b)+4]; x[(a)+12] = (x[(a)+12] > x[(b)+3]) ? x[(a)+12] : x[(b)+3]; x[(a)+13] = (x[(a)+13] > x[(b)+2]) ? x[(a)+13] : x[(b)+2]; x[(a)+14] = (x[(a)+14] > x[(b)+1]) ? x[(a)+14] : x[(b)+1]; x[(a)+15] = (x[(a)+15] > x[(b)+0]) ? x[(a)+15] : x[(b)+0]; PEER_CE(x[(a)+0], x[(a)+8]); PEER_CE(x[(a)+1], x[(a)+9]); PEER_CE(x[(a)+2], x[(a)+10]); PEER_CE(x[(a)+3], x[(a)+11]); PEER_CE(x[(a)+4], x[(a)+12]); PEER_CE(x[(a)+5], x[(a)+13]); PEER_CE(x[(a)+6], x[(a)+14]); PEER_CE(x[(a)+7], x[(a)+15]); PEER_CE(x[(a)+0], x[(a)+4]); PEER_CE(x[(a)+1], x[(a)+5]); PEER_CE(x[(a)+2], x[(a)+6]); PEER_CE(x[(a)+3], x[(a)+7]); PEER_CE(x[(a)+8], x[(a)+12]); PEER_CE(x[(a)+9], x[(a)+13]); PEER_CE(x[(a)+10], x[(a)+14]); PEER_CE(x[(a)+11], x[(a)+15]); PEER_CE(x[(a)+0], x[(a)+2]); PEER_CE(x[(a)+1], x[(a)+3]); PEER_CE(x[(a)+4], x[(a)+6]); PEER_CE(x[(a)+5], x[(a)+7]); PEER_CE(x[(a)+8], x[(a)+10]); PEER_CE(x[(a)+9], x[(a)+11]); PEER_CE(x[(a)+12], x[(a)+14]); PEER_CE(x[(a)+13], x[(a)+15]); PEER_CE(x[(a)+0], x[(a)+1]); PEER_CE(x[(a)+2], x[(a)+3]); PEER_CE(x[(a)+4], x[(a)+5]); PEER_CE(x[(a)+6], x[(a)+7]); PEER_CE(x[(a)+8], x[(a)+9]); PEER_CE(x[(a)+10], x[(a)+11]); PEER_CE(x[(a)+12], x[(a)+13]); PEER_CE(x[(a)+14], x[(a)+15]); } while (0)
#define PEER_MERGE16_SET(x, a, b) do { x[(a)+0] = (x[(a)+0] > x[(b)+15]) ? x[(a)+0] : x[(b)+15]; x[(a)+1] = (x[(a)+1] > x[(b)+14]) ? x[(a)+1] : x[(b)+14]; x[(a)+2] = (x[(a)+2] > x[(b)+13]) ? x[(a)+2] : x[(b)+13]; x[(a)+3] = (x[(a)+3] > x[(b)+12]) ? x[(a)+3] : x[(b)+12]; x[(a)+4] = (x[(a)+4] > x[(b)+11]) ? x[(a)+4] : x[(b)+11]; x[(a)+5] = (x[(a)+5] > x[(b)+10]) ? x[(a)+5] : x[(b)+10]; x[(a)+6] = (x[(a)+6] > x[(b)+9]) ? x[(a)+6] : x[(b)+9]; x[(a)+7] = (x[(a)+7] > x[(b)+8]) ? x[(a)+7] : x[(b)+8]; x[(a)+8] = (x[(a)+8] > x[(b)+7]) ? x[(a)+8] : x[(b)+7]; x[(a)+9] = (x[(a)+9] > x[(b)+6]) ? x[(a)+9] : x[(b)+6]; x[(a)+10] = (x[(a)+10] > x[(b)+5]) ? x[(a)+10] : x[(b)+5]; x[(a)+11] = (x[(a)+11] > x[(b)+4]) ? x[(a)+11] : x[(b)+4]; x[(a)+12] = (x[(a)+12] > x[(b)+3]) ? x[(a)+12] : x[(b)+3]; x[(a)+13] = (x[(a)+13] > x[(b)+2]) ? x[(a)+13] : x[(b)+2]; x[(a)+14] = (x[(a)+14] > x[(b)+1]) ? x[(a)+14] : x[(b)+1]; x[(a)+15] = (x[(a)+15] > x[(b)+0]) ? x[(a)+15] : x[(b)+0]; } while (0)
constexpr int PEER_NCAND = 50;
__device__ const unsigned char PEER_CAND[64] = {0, 16, 32, 48, 64, 80, 96, 112, 128, 144, 160, 176, 192, 208, 224, 240, 1, 17, 33, 49, 65, 81, 97, 113, 2, 18, 34, 50, 66, 3, 19, 35, 51, 4, 20, 36, 5, 21, 6, 22, 7, 23, 8, 9, 10, 11, 12, 13, 14, 15, 0, 0, 0, 0, 0, 0, 0, 0, 0, 0, 0, 0, 0, 0};
#define PEER_CAND_SUMS(x, v0, v1, KEYF) do { x[0] = KEYF((v0)[0] + (v1)[0], 0); x[1] = KEYF((v0)[0] + (v1)[1], 1); x[2] = KEYF((v0)[0] + (v1)[2], 2); x[3] = KEYF((v0)[0] + (v1)[3], 3); x[4] = KEYF((v0)[0] + (v1)[4], 4); x[5] = KEYF((v0)[0] + (v1)[5], 5); x[6] = KEYF((v0)[0] + (v1)[6], 6); x[7] = KEYF((v0)[0] + (v1)[7], 7); x[8] = KEYF((v0)[0] + (v1)[8], 8); x[9] = KEYF((v0)[0] + (v1)[9], 9); x[10] = KEYF((v0)[0] + (v1)[10], 10); x[11] = KEYF((v0)[0] + (v1)[11], 11); x[12] = KEYF((v0)[0] + (v1)[12], 12); x[13] = KEYF((v0)[0] + (v1)[13], 13); x[14] = KEYF((v0)[0] + (v1)[14], 14); x[15] = KEYF((v0)[0] + (v1)[15], 15); x[16] = KEYF((v0)[1] + (v1)[0], 16); x[17] = KEYF((v0)[1] + (v1)[1], 17); x[18] = KEYF((v0)[1] + (v1)[2], 18); x[19] = KEYF((v0)[1] + (v1)[3], 19); x[20] = KEYF((v0)[1] + (v1)[4], 20); x[21] = KEYF((v0)[1] + (v1)[5], 21); x[22] = KEYF((v0)[1] + (v1)[6], 22); x[23] = KEYF((v0)[1] + (v1)[7], 23); x[24] = KEYF((v0)[2] + (v1)[0], 24); x[25] = KEYF((v0)[2] + (v1)[1], 25); x[26] = KEYF((v0)[2] + (v1)[2], 26); x[27] = KEYF((v0)[2] + (v1)[3], 27); x[28] = KEYF((v0)[2] + (v1)[4], 28); x[29] = KEYF((v0)[3] + (v1)[0], 29); x[30] = KEYF((v0)[3] + (v1)[1], 30); x[31] = KEYF((v0)[3] + (v1)[2], 31); x[32] = KEYF((v0)[3] + (v1)[3], 32); x[33] = KEYF((v0)[4] + (v1)[0], 33); x[34] = KEYF((v0)[4] + (v1)[1], 34); x[35] = KEYF((v0)[4] + (v1)[2], 35); x[36] = KEYF((v0)[5] + (v1)[0], 36); x[37] = KEYF((v0)[5] + (v1)[1], 37); x[38] = KEYF((v0)[6] + (v1)[0], 38); x[39] = KEYF((v0)[6] + (v1)[1], 39); x[40] = KEYF((v0)[7] + (v1)[0], 40); x[41] = KEYF((v0)[7] + (v1)[1], 41); x[42] = KEYF((v0)[8] + (v1)[0], 42); x[43] = KEYF((v0)[9] + (v1)[0], 43); x[44] = KEYF((v0)[10] + (v1)[0], 44); x[45] = KEYF((v0)[11] + (v1)[0], 45); x[46] = KEYF((v0)[12] + (v1)[0], 46); x[47] = KEYF((v0)[13] + (v1)[0], 47); x[48] = KEYF((v0)[14] + (v1)[0], 48); x[49] = KEYF((v0)[15] + (v1)[0], 49); x[50] = (int)0x80000000; x[51] = (int)0x80000000; x[52] = (int)0x80000000; x[53] = (int)0x80000000; x[54] = (int)0x80000000; x[55] = (int)0x80000000; x[56] = (int)0x80000000; x[57] = (int)0x80000000; x[58] = (int)0x80000000; x[59] = (int)0x80000000; x[60] = (int)0x80000000; x[61] = (int)0x80000000; x[62] = (int)0x80000000; x[63] = (int)0x80000000; } while (0)

__device__ __forceinline__ int crow(int r, int hi) { return (r & 3) + 8 * (r >> 2) + 4 * hi; }
__device__ __forceinline__ int f2key(float f) { const int t = __builtin_bit_cast(int, f); return t ^ ((t >> 31) & 0x7fffffff); }
__device__ __forceinline__ float key2f(int t) { return __builtin_bit_cast(float, t ^ ((t >> 31) & 0x7fffffff)); }
__device__ __forceinline__ int sel_hi(int a, int b, int hm) { int r; asm("v_bfi_b32 %0, %1, %2, %3" : "=v"(r) : "v"(hm), "v"(b), "v"(a)); return r; }
__device__ __forceinline__ float fsel(float a, float b, int m) { return __int_as_float(sel_hi(__float_as_int(a), __float_as_int(b), m)); }
typedef float f32x2 __attribute__((ext_vector_type(2)));
__device__ __forceinline__ int key7(float f, int low) { return (f2key(f) & ~127) | low; }
__device__ __forceinline__ int key6(float f, int ord) { return (f2key(f) & ~63) | (63 - ord); }
__device__ __forceinline__ void top16_of_64(int (&x)[64]) {
    PEER_SORT16(x, 0); PEER_SORT16(x, 16); PEER_SORT16(x, 32); PEER_SORT16(x, 48);
    PEER_MERGE16(x, 0, 16); PEER_MERGE16(x, 32, 48); PEER_MERGE16(x, 0, 32);
}
__device__ __forceinline__ float dot2_bf16(unsigned w, unsigned x, float acc) { return __builtin_amdgcn_fdot2_f32_bf16(__builtin_bit_cast(bf16x2_t, w), __builtin_bit_cast(bf16x2_t, x), acc, false); }
__device__ __forceinline__ float dot8(const u32x4 a, const u32x4 b, float acc) {
    acc = dot2_bf16(a.x, b.x, acc); acc = dot2_bf16(a.y, b.y, acc); acc = dot2_bf16(a.z, b.z, acc); acc = dot2_bf16(a.w, b.w, acc); return acc;
}
__device__ __forceinline__ float gelu_tanh(float x) {
    const float u = 0.7978845608028654f * (x + 0.044715f * x * x * x);
    const float e = __builtin_amdgcn_exp2f(2.0f * LOG2E * u);
    const float th = 1.0f - 2.0f * __builtin_amdgcn_rcpf(e + 1.0f);
    return 0.5f * x * (1.0f + th);
}
__device__ __forceinline__ void topk_half(const bf16* qp, const bf16* sp, int hi, int (&T)[16]) {
    bf16x8 qf[8];
#pragma unroll
    for (int ks = 0; ks < 8; ++ks) qf[ks] = *(const GAS bf16x8*)(qp + ks * 16);
    const int hi4 = hi << 2;
    int x[64];
#pragma unroll
    for (int kt = 0; kt < 4; ++kt) { f32x16 sc = f32x16{};
#pragma unroll
        for (int ks = 0; ks < 8; ++ks) { const bf16x8 a = *(const GAS bf16x8*)(sp + (size_t)(32 * kt) * 128 + ks * 16); sc = __builtin_amdgcn_mfma_f32_32x32x16_bf16(a, qf[ks], sc, 0, 0, 0); }
#pragma unroll
        for (int r = 0; r < 16; ++r) x[16 * kt + r] = ((f2key(sc[r]) & ~127) | (127 - (32 * kt + crow(r, 0)))) ^ hi4; }
    top16_of_64(x);
#pragma unroll
    for (int i = 0; i < 16; ++i) { auto rr = __builtin_amdgcn_permlane32_swap((unsigned)x[i], (unsigned)x[i], false, false); x[i] = (int)rr[0]; x[16 + i] = (int)rr[1]; }
    PEER_MERGE16(x, 0, 16);
#pragma unroll
    for (int i = 0; i < 16; ++i) T[i] = x[i];
}
__device__ __forceinline__ float fp8dot4(unsigned w, float h0, float h1, float h2, float h3) {
    const f32x2 lo = __builtin_amdgcn_cvt_pk_f32_fp8((int)w, false), hi = __builtin_amdgcn_cvt_pk_f32_fp8((int)w, true);
    return (lo.x * h0 + lo.y * h1) + (hi.x * h2 + hi.y * h3);
}
__device__ __forceinline__ float fp8dot16(const u32x4 u, const float (&h)[16]) {
    return (fp8dot4(u.x, h[0], h[1], h[2], h[3]) + fp8dot4(u.y, h[4], h[5], h[6], h[7])) + (fp8dot4(u.z, h[8], h[9], h[10], h[11]) + fp8dot4(u.w, h[12], h[13], h[14], h[15]));
}
__device__ __forceinline__ void fp8axpy4(unsigned w, float c, float& a0, float& a1, float& a2, float& a3) {
    const f32x2 lo = __builtin_amdgcn_cvt_pk_f32_fp8((int)w, false), hi = __builtin_amdgcn_cvt_pk_f32_fp8((int)w, true);
    a0 += c * lo.x; a1 += c * lo.y; a2 += c * hi.x; a3 += c * hi.y;
}
__device__ __forceinline__ void fp8axpy16(const u32x4 v, float c, float (&a)[16]) {
    fp8axpy4(v.x, c, a[0], a[1], a[2], a[3]); fp8axpy4(v.y, c, a[4], a[5], a[6], a[7]); fp8axpy4(v.z, c, a[8], a[9], a[10], a[11]); fp8axpy4(v.w, c, a[12], a[13], a[14], a[15]);
}
constexpr int L_ROUTE = 0, L_NLIST = 32768, L_CAND = 40960, L_OFF = 41472, L_SORT = 43008, L_END = 43008 + 32768;
constexpr int NSL = 4, SL_SHIFT = 12;
__device__ __forceinline__ void peer_tile(int tile, const bf16* PQ, const bf16* SK, const float* SSQ, const unsigned char* U8, const unsigned char* V8, const float* gfin, const bf16* HB, float* out, LAS unsigned char* lds, int mode = 3, float* outw = nullptr) {
    const int lane = threadIdx.x & 63, r32 = lane & 31, hi = lane >> 5; const int wid = __builtin_amdgcn_readfirstlane((int)threadIdx.x >> 6);
    const int tok0 = tile * 32; if (!outw) outw = out;
    LAS unsigned* route = (LAS unsigned*)(lds + L_ROUTE);
    LAS unsigned char* nl = lds + L_NLIST + (wid * 32 + r32) * 32;
    const LAS unsigned char* cand = lds + L_CAND;
    if (mode & 1) {
        const int h = wid; int T0[16], T1[16];
        topk_half(PQ + (size_t)(tok0 + r32) * NPQ + (h * 2 + 0) * 128 + hi * 8, SK + ((size_t)(h * 2 + 0) * 128 + r32) * 128 + hi * 8, hi, T0);
        topk_half(PQ + (size_t)(tok0 + r32) * NPQ + (h * 2 + 1) * 128 + hi * 8, SK + ((size_t)(h * 2 + 1) * 128 + r32) * 128 + hi * 8, hi, T1);
        const int hm = -hi;
        {
            u32x4 w;
#pragma unroll
            for (int q4 = 0; q4 < 4; ++q4) { unsigned a = 0;
#pragma unroll
                for (int e = 0; e < 4; ++e) { const int t = sel_hi(T0[4 * q4 + e], T1[4 * q4 + e], hm); a |= (unsigned)(127 - (t & 127)) << (8 * e); }
                w[q4] = a; }
            *(LAS u32x4*)(nl + 16 * hi) = w;
        }
        float v0[16], v1[16];
#pragma unroll
        for (int i = 0; i < 16; ++i) { v0[i] = key2f(T0[i] & ~127); v1[i] = key2f(T1[i] & ~127); }
        int x[64];
        PEER_CAND_SUMS(x, v0, v1, key6);
        top16_of_64(x);
        const float smax = key2f(x[0] & ~63);
        float p[16], ps = 0.f;
#pragma unroll
        for (int i = 0; i < 16; ++i) { p[i] = __builtin_amdgcn_exp2f((key2f(x[i] & ~63) - smax) * LOG2E); ps += p[i]; }
        const float rps = 1.0f / ps;
        LDS_WAIT();
#pragma unroll
        for (int i = 0; i < 8; ++i) {
            const int xi = sel_hi(x[i], x[8 + i], hm); const float g = __int_as_float(sel_hi(__float_as_int(p[i]), __float_as_int(p[8 + i]), hm)) * rps;
            const int ij = cand[63 - (xi & 63)]; const int n0 = nl[ij & 15], n1 = nl[16 + (ij >> 4)];
            u32x2 w; w.x = (unsigned)(n0 * 128 + n1); w.y = __float_as_uint(g);
            *(LAS u32x2*)(route + ((size_t)r32 * 128 + h * 16 + 8 * hi + i) * 2) = w; }
    }
    LDS_WAIT(); __syncthreads();
    if (mode & 2) {
    const int m0 = -(lane & 1), m1 = -((lane >> 1) & 1);
    const int jj = ((lane & 1) << 1) | ((lane >> 1) & 1);
    LAS unsigned* srtw = (LAS unsigned*)(lds + L_SORT) + wid * 1024;
    LAS unsigned char* offw = lds + L_OFF + wid * 128;
    const unsigned long long lt = (1ull << lane) - 1ull;
#pragma unroll 1
    for (int tt = 0; tt < 4; ++tt) {
        const LAS unsigned* rt0 = route + (wid * 4 + tt) * 256; LAS unsigned* srt = srtw + tt * 256; LAS unsigned char* offb = offw + tt * 32;
        const u32x2 ea = *(const LAS u32x2*)(rt0 + lane * 2), eb = *(const LAS u32x2*)(rt0 + (lane + 64) * 2);
        const int sa = (int)ea.x >> SL_SHIFT, sb_ = (int)eb.x >> SL_SHIFT; int base = 0, pa = 0, pb = 0;
#pragma unroll 1
        for (int v = 0; v < NSL; ++v) { const unsigned long long ma = __ballot(sa == v), mb = __ballot(sb_ == v); const int ca = __popcll(ma), cb2 = __popcll(mb);
            if (lane == 0) offb[v] = (unsigned char)base;
            if (sa == v) pa = base + __popcll(ma & lt); if (sb_ == v) pb = base + ca + __popcll(mb & lt); base += ca + cb2; }
        if (lane == 0) offb[NSL] = (unsigned char)128;
        *(LAS u32x2*)(srt + pa * 2) = ea; *(LAS u32x2*)(srt + pb * 2) = eb;
    }
    LDS_WAIT();
    float hr[4][16], acc[4][16];
#pragma unroll
    for (int tt = 0; tt < 4; ++tt) {
        const size_t tok = (size_t)tok0 + wid * 4 + tt; const bf16* hrow = HB + tok * 1024 + lane * 16;
        const f32x4* sp = (const f32x4*)(SSQ + tok * 16); const f32x4 a = sp[0], b = sp[1], c = sp[2], d = sp[3]; const f32x4 t4 = (a + b) + (c + d);
        const float sc = __builtin_amdgcn_rsqf(((t4[0] + t4[1]) + (t4[2] + t4[3])) * (1.0f / 1024.0f) + RMS_EPS) * (1.0f / 256.0f);
        { const u32x4 ha = *(const GAS u32x4*)hrow, hb2 = *(const GAS u32x4*)(hrow + 8);
          hr[tt][0] = bflo(ha.x) * sc; hr[tt][1] = bfhi(ha.x) * sc; hr[tt][2] = bflo(ha.y) * sc; hr[tt][3] = bfhi(ha.y) * sc; hr[tt][4] = bflo(ha.z) * sc; hr[tt][5] = bfhi(ha.z) * sc; hr[tt][6] = bflo(ha.w) * sc; hr[tt][7] = bfhi(ha.w) * sc;
          hr[tt][8] = bflo(hb2.x) * sc; hr[tt][9] = bfhi(hb2.x) * sc; hr[tt][10] = bflo(hb2.y) * sc; hr[tt][11] = bfhi(hb2.y) * sc; hr[tt][12] = bflo(hb2.z) * sc; hr[tt][13] = bfhi(hb2.z) * sc; hr[tt][14] = bflo(hb2.w) * sc; hr[tt][15] = bfhi(hb2.w) * sc; }
#pragma unroll
        for (int i = 0; i < 16; ++i) acc[tt][i] = 0.f;
    }
#define PEER_BATCH(tt_, k_, hi_) do { const LAS unsigned* srt = srtw + (tt_) * 256; u32x4 uu[4], vv[4]; float d_[4]; \
        _Pragma("unroll") for (int j = 0; j < 4; ++j) { const int ix = ((k_) + j < (hi_)) ? (k_) + j : (hi_) - 1; const int e = __builtin_amdgcn_readfirstlane((int)srt[ix * 2]); \
            uu[j] = *(const GAS u32x4*)(U8 + (size_t)e * 1024 + lane * 16); vv[j] = *(const GAS u32x4*)(V8 + (size_t)e * 1024 + lane * 16); } \
        _Pragma("unroll") for (int j = 0; j < 4; ++j) d_[j] = fp8dot16(uu[j], hr[tt_]); \
        float e_[2]; \
        _Pragma("unroll") for (int i = 0; i < 2; ++i) { const float keep = fsel(d_[i], d_[i + 2], m0), send = fsel(d_[i + 2], d_[i], m0); e_[i] = keep + __shfl_xor(send, 1); } \
        float g_ = fsel(e_[0], e_[1], m1) + __shfl_xor(fsel(e_[1], e_[0], m1), 2); \
        g_ += __shfl_xor(g_, 4); g_ += __shfl_xor(g_, 8); g_ += __shfl_xor(g_, 16); g_ += __shfl_xor(g_, 32); \
        const int mi = (k_) + jj; const float gate = (mi < (hi_)) ? __uint_as_float(srt[(mi < (hi_) ? mi : (hi_) - 1) * 2 + 1]) : 0.f; \
        const float cfl = gate * gelu_tanh(g_) * (1.0f / 16.0f); \
        _Pragma("unroll") for (int j = 0; j < 4; ++j) { const int src = ((j & 1) << 1) | ((j >> 1) & 1); \
            const float cj = __int_as_float(__builtin_amdgcn_readlane(__float_as_int(cfl), src)); \
            fp8axpy16(vv[j], cj, acc[tt_]); } } while (0)
#pragma unroll 1
    for (int r = 0; r < NSL; ++r) {
#pragma unroll
        for (int tt = 0; tt < 4; ++tt) {
            const int lo = __builtin_amdgcn_readfirstlane((int)offw[tt * 32 + r]), hi2 = __builtin_amdgcn_readfirstlane((int)offw[tt * 32 + r + 1]);
#pragma unroll 1
            for (int k = lo; k < hi2; k += 4) PEER_BATCH(tt, k, hi2);
        }
    }
#undef PEER_BATCH
#pragma unroll
    for (int tt = 0; tt < 4; ++tt) {
        const size_t tok = (size_t)tok0 + wid * 4 + tt; const bf16* hrow = HB + tok * 1024 + lane * 16; float* wrow = outw + tok * 1024;
        float hv[16]; float s = 0.f;
        { const u32x4 ha = *(const GAS u32x4*)hrow, hb2 = *(const GAS u32x4*)(hrow + 8);
          hv[0] = bflo(ha.x); hv[1] = bfhi(ha.x); hv[2] = bflo(ha.y); hv[3] = bfhi(ha.y); hv[4] = bflo(ha.z); hv[5] = bfhi(ha.z); hv[6] = bflo(ha.w); hv[7] = bfhi(ha.w);
          hv[8] = bflo(hb2.x); hv[9] = bfhi(hb2.x); hv[10] = bflo(hb2.y); hv[11] = bfhi(hb2.y); hv[12] = bflo(hb2.z); hv[13] = bfhi(hb2.z); hv[14] = bflo(hb2.w); hv[15] = bfhi(hb2.w); }
#pragma unroll
        for (int i = 0; i < 16; ++i) { hv[i] += acc[tt][i]; s += hv[i] * hv[i]; }
        const float rs = 1.0f / sqrtf(wave_sum(s) * (1.f / 1024.f) + RMS_EPS);
#pragma unroll
        for (int q = 0; q < 4; ++q) { const f32x4 g = *(const GAS f32x4*)(gfin + lane * 16 + q * 4); f32x4 t;
            t.x = hv[4 * q] * rs * g.x; t.y = hv[4 * q + 1] * rs * g.y; t.z = hv[4 * q + 2] * rs * g.z; t.w = hv[4 * q + 3] * rs * g.w;
            *(GAS f32x4*)(wrow + lane * 16 + q * 4) = t; }
    }
    }
    LDS_WAIT(); __syncthreads();
}
}
struct Args { const float* in[20]; float* out; unsigned char* ws; int ph_lo, ph_hi, li, pad; };
__global__ void __launch_bounds__(NWAVES * 64, 2) fwd_megakernel(Args args) {
    extern __shared__ __attribute__((aligned(16))) unsigned char lds[];
    LAS unsigned char* ldsp = (LAS unsigned char*)lds;
    volatile LAS unsigned* MISC = (volatile LAS unsigned*)(ldsp + MISC_OFF);
    const int tid = threadIdx.x, lane = tid & 63, wave = __builtin_amdgcn_readfirstlane(tid >> 6);
    const int G = gridDim.x; const int bx = blockIdx.x; const int vcu = (G % 8 == 0) ? (bx % 8) * (G / 8) + bx / 8 : bx;
    unsigned char* ws = args.ws;
    gu32* ctl = (gu32*)(ws + WS_CTL);
    const float* x = args.in[0]; const float* mem = args.in[1]; const float* norm_mix = args.in[2]; const float* w_in = args.in[3]; const float* conv_w = args.in[4];
    const float* w_ba = args.in[5]; const float* w_bc = args.in[6]; const float* w_out = args.in[7]; const float* norm_xattn = args.in[8]; const float* norm_mem = args.in[9];
    const float* xwq = args.in[10]; const float* xwk = args.in[11]; const float* xwv = args.in[12]; const float* xwo = args.in[13]; const float* norm_ffn = args.in[14];
    const float* pwq = args.in[15]; const float* psk = args.in[16]; const float* pu = args.in[17]; const float* pv = args.in[18]; const float* norm_final = args.in[19];
    float* out = args.out;
    bf16* Win_t = (bf16*)(ws + WS_WIN); bf16* Wa_t = (bf16*)(ws + WS_WA); bf16* Wc_t = (bf16*)(ws + WS_WC); bf16* Wo_t = (bf16*)(ws + WS_WO); bf16* Wq2_t = (bf16*)(ws + WS_WQ2);
    bf16* Wkv2_t = (bf16*)(ws + WS_WKV2); bf16* Wo2_t = (bf16*)(ws + WS_WO2); bf16* Wpq_t = (bf16*)(ws + WS_WPQ); bf16* SKb = (bf16*)(ws + WS_SK);
    float* SSQ1 = (float*)(ws + WS_SSQ1); float* SSQ2 = (float*)(ws + WS_SSQ2); bf16* MEMN = (bf16*)(ws + WS_MEMN); bf16* K2 = (bf16*)(ws + WS_K2); bf16* V2T = (bf16*)(ws + WS_V2T);
    bf16* B0 = (bf16*)(ws + WS_B0); bf16* B1 = (bf16*)(ws + WS_B1); bf16* B2 = (bf16*)(ws + WS_B2); bf16* B3 = (bf16*)(ws + WS_B3); bf16* B4 = (bf16*)(ws + WS_B4); bf16* B5 = (bf16*)(ws + WS_B5);
    bf16* XN1 = (bf16*)out; bf16* YC = (bf16*)out; bf16* CBb = (bf16*)((unsigned char*)out + 32 * MiB);

    for (int u = tid; u < (LDS_BYTES - LDSCTL_OFF) / 4; u += NWAVES * 64) ((LAS unsigned*)(ldsp + LDSCTL_OFF))[u] = 0u;
    __syncthreads();
    XcdBarrier bar; bar.bar = (unsigned*)(ctl + CW_BAR); bar.x = 0; bar.st = nullptr;
    if (N_LAUNCHES == 1) bar = xcd_barrier_post((unsigned*)(ctl + CW_BAR), MISC + 8);
#define GRID_BAR() do { if (N_LAUNCHES == 1) xcd_barrier(bar); } while (0)
    const int lo = args.ph_lo, hi = args.ph_hi;
#define IN(k) (lo <= (k) && (k) < hi)
#define BOTH(k) (IN(k) && IN((k) + 1))
    const int gw = vcu * NWAVES + wave, NGW = G * NWAVES;

    if (IN(0)) {
        LAS float* scr = (LAS float*)(ldsp + RING_OFF + wave * 16384);
        constexpr int I_IN = 16 * 256, I_SQ = 16 * 32, I_PQ = 16 * 64;
        constexpr int NT_ITEMS = I_IN + 7 * I_SQ + I_PQ;
        for (int it = gw; it < NT_ITEMS; it += NGW) {
            int r = it;
            if (r < I_IN) { transpose_item<true>(w_in, D, NIN, nullptr, Win_t, 0, scr, r, lane); continue; } r -= I_IN;
            if (r < I_SQ) { transpose_item<false>(w_ba, D, D, nullptr, Wa_t, 0, scr, r, lane); continue; } r -= I_SQ;
            if (r < I_SQ) { transpose_item<false>(w_bc, D, D, nullptr, Wc_t, 0, scr, r, lane); continue; } r -= I_SQ;
            if (r < I_SQ) { transpose_item<false>(w_out, D, D, nullptr, Wo_t, 0, scr, r, lane); continue; } r -= I_SQ;
            if (r < I_SQ) { transpose_item<false>(xwq, D, D, norm_xattn, Wq2_t, 0, scr, r, lane); continue; } r -= I_SQ;
            if (r < I_SQ) { transpose_item<false>(xwk, D, D, nullptr, Wkv2_t, 0, scr, r, lane); continue; } r -= I_SQ;
            if (r < I_SQ) { transpose_item<false>(xwv, D, D, nullptr, Wkv2_t, D, scr, r, lane); continue; } r -= I_SQ;
            if (r < I_SQ) { transpose_item<false>(xwo, D, D, nullptr, Wo2_t, 0, scr, r, lane); continue; } r -= I_SQ;
            transpose_item<false>(pwq, D, NPQ, norm_ffn, Wpq_t, 0, scr, r, lane);
        }
        for (int it = gw; it < 512; it += NGW) {
            const GAS f32x4* s = (const GAS f32x4*)psk + (size_t)it * 128 + lane * 2; const f32x4 a = s[0], b = s[1];
            v4u o; o.x = pk2(a.x, a.y); o.y = pk2(a.z, a.w); o.z = pk2(b.x, b.y); o.w = pk2(b.z, b.w);
            *((GAS v4u*)SKb + (size_t)it * 64 + lane) = o; }
        for (int m = gw; m < M; m += 2 * NGW) rms_rows2_to_bf16(x + (size_t)m * D, (size_t)NGW, norm_mix, XN1 + (size_t)m * D, lane);
        for (int m = gw; m < MROWS; m += NGW) rms_row_to_bf16(mem + (size_t)m * D, norm_mem, MEMN + (size_t)m * D, lane);
        if (BOTH(0)) GRID_BAR();
    }

    if (IN(1)) {
        pg8::GemmSet g{XN1, Win_t, XN1, Win_t, D}; pg8::TileOrder S; S.init(M, NIN, G, bx);
        pg8::EpiInProj E{B0, B1, B2, B3, CBb, B4, B5, 0.125f * LOG2E};
        pg8::gemm_phase<pg8::EpiInProj, pg8::TileOrder, true, true>(ldsp + RING_OFF, g, S, E);
        if (BOTH(1)) GRID_BAR();
    }

    if (IN(2)) {
        {
            const int bh = vcu >> 1, s = vcu & 1;
            if (bh < BATCH * 16) {
#pragma unroll 1
                for (int i = 0; i < 4; ++i) { const int qb = (i == 0) ? s : (i == 1) ? 7 - s : (i == 2) ? 2 + s : 5 - s;
                    sb::sb_unit<true>(bh >> 4, bh & 15, qb, (const sb::bf16*)B0, (const sb::bf16*)B1, (const sb::bf16*)B2, (sb::bf16*)B0, (char*)lds + RING_OFF); }
            }
            asm volatile("s_waitcnt vmcnt(0) lgkmcnt(0)" ::: "memory"); __syncthreads();
        }
        if (vcu < 32) {
            pg8::GemmSet g{MEMN, Wkv2_t, MEMN, Wkv2_t, D}; pg8::SubOrder S; S.init(MROWS, D, 0, vcu);
            pg8::EpiStore E{K2, D, 1.0f};
            pg8::gemm_phase<pg8::EpiStore, pg8::SubOrder, false, true>(ldsp + RING_OFF, g, S, E);
        } else if (vcu < 64) {
            pg8::GemmSet g{Wkv2_t + (size_t)D * D, MEMN, Wkv2_t + (size_t)D * D, MEMN, D}; pg8::SubOrder S; S.init(D, MROWS, 32, vcu);
            pg8::EpiStoreKPerm E{V2T, MROWS};
            pg8::gemm_phase<pg8::EpiStoreKPerm, pg8::SubOrder, false, true>(ldsp + RING_OFF, g, S, E);
        } else {
            const int cw_ = (vcu - 64) * NWAVES + wave, ncw = (G - 64) * NWAVES;
            for (int it = cw_; it < M / 8; it += ncw) yconv_item(B3, CBb, conv_w, YC, it, lane);
        }
        if (BOTH(2)) GRID_BAR();
    }

    if (IN(3)) {
        pg8::GemmSet g{B0, Wa_t, YC, Wc_t, D}; pg8::TileOrder S; S.init(M, D, G, bx, 2);
        pg8::EpiGate E{B1, B4, B5};
        pg8::gemm_phase<pg8::EpiGate, pg8::TileOrder, true, true>(ldsp + RING_OFF, g, S, E);
        if (BOTH(3)) GRID_BAR();
    }

    if (IN(4)) {
        pg8::GemmSet g{B1, Wo_t, B1, Wo_t, D}; pg8::TileOrder S; S.init(M, D, G, bx);
        pg8::EpiResid<false> E{x, nullptr, B2, SSQ1};
        pg8::gemm_phase<pg8::EpiResid<false>, pg8::TileOrder, true, true>(ldsp + RING_OFF, g, S, E);
        if (BOTH(4)) GRID_BAR();
    }

    if (IN(5)) {
        pg8::GemmSet g{B2, Wq2_t, B2, Wq2_t, D}; pg8::TileOrder S; S.init(M, D, G, bx);
        pg8::EpiRowScale E{B3, D, SSQ1, LOG2E / 16.0f, RMS_EPS};
        pg8::gemm_phase<pg8::EpiRowScale, pg8::TileOrder, true, true>(ldsp + RING_OFF, g, S, E);
        for (int r = gw; r < 16384; r += 4 * NGW) rows4_to_fp8(pu + (size_t)r * D, (size_t)NGW, norm_ffn, 256.0f, (unsigned char*)B4 + (size_t)r * D, lane);
        for (int r = gw; r < 16384; r += 4 * NGW) rows4_to_fp8(pv + (size_t)r * D, (size_t)NGW, nullptr, 16.0f, (unsigned char*)B4 + 16 * MiB + (size_t)r * D, lane);
        if (BOTH(5)) GRID_BAR();
    }

    if (IN(6)) {
#ifndef NO_XA
        for (int u = 2 * vcu; u < 512; u += 2 * G) { xa::xattn_unit(u >> 6, (u >> 4) & 3, u & 15, B3, K2, V2T, B0, (char*)lds + RING_OFF); xa::xattn_unit(u >> 6, (u >> 4) & 3, (u & 15) + 1, B3, K2, V2T, B0, (char*)lds + RING_OFF); }
        asm volatile("s_waitcnt vmcnt(0) lgkmcnt(0)" ::: "memory"); __syncthreads();
#endif
        if (BOTH(6)) GRID_BAR();
    }

    if (IN(7)) {
        pg8::GemmSet g{B0, Wo2_t, B0, Wo2_t, D}; pg8::TileOrder S; S.init(M, D, G, bx);
        pg8::EpiResid<true> E{nullptr, B2, B1, SSQ2};
        pg8::gemm_phase<pg8::EpiResid<true>, pg8::TileOrder, true, true>(ldsp + RING_OFF, g, S, E);
        if (BOTH(7)) GRID_BAR();
    }

    if (IN(8)) {
        pg8::GemmSet g{B1, Wpq_t, B1, Wpq_t, D}; pg8::TileOrder S; S.init(M, NPQ, G, bx);
        pg8::EpiRowScale E{B2, NPQ, SSQ2, 1.0f, RMS_EPS};
        pg8::gemm_phase<pg8::EpiRowScale, pg8::TileOrder, true, true>(ldsp + RING_OFF, g, S, E);
        if (BOTH(8)) GRID_BAR();
    }

    if (IN(9)) {
        if (tid < 64) { int cnt = 0, val = 0;
            for (int ii = 0; ii < 16; ++ii) { const int nj = 16 / (ii + 1); if (tid >= cnt && tid < cnt + nj) val = ii | ((tid - cnt) << 4); cnt += nj; }
            ldsp[RING_OFF + peer::L_CAND + tid] = (unsigned char)val; }
        LDS_WAIT(); __syncthreads();
#ifndef NO_PEER
        for (int tile = vcu; tile < M / 32; tile += G) {
#ifdef PROBE_P9
            peer::peer_tile(tile, B2, SKb, SSQ2, (const unsigned char*)B4, (const unsigned char*)B4 + 16 * MiB, norm_final, B1, out, ldsp + RING_OFF, PROBE_P9, (float*)B0);
#endif
            peer::peer_tile(tile, B2, SKb, SSQ2, (const unsigned char*)B4, (const unsigned char*)B4 + 16 * MiB, norm_final, B1, out, ldsp + RING_OFF); }
#else
        for (int m = gw; m < M; m += NGW) final_norm_row(out + (size_t)m * D, norm_final, out + (size_t)m * D, lane);
#endif
    }
#undef IN
#undef BOTH
#undef GRID_BAR
}

extern "C" void kernel_launch(void* const* d_in, const int* in_sizes, int n_in, void* d_out, int out_size, void* d_ws, size_t ws_size, hipStream_t stream) {
    static int grid = 0;
    if (grid == 0) {
        if (n_in != 20 || in_sizes[0] != M * D || out_size != M * D || ws_size < WS_END) { fprintf(stderr, "kernel_launch: unexpected shapes (n_in %d, in0 %d, out %d, ws %zu); nothing launched\n", n_in, n_in > 0 ? in_sizes[0] : -1, out_size, ws_size); grid = -1; return; }
        int dev = 0, cus = 0, per_cu = 0;
        if (hipGetDevice(&dev) != hipSuccess || hipDeviceGetAttribute(&cus, hipDeviceAttributeMultiprocessorCount, dev) != hipSuccess) { grid = -1; return; }
        if (hipFuncSetAttribute((const void*)fwd_megakernel, hipFuncAttributeMaxDynamicSharedMemorySize, LDS_BYTES) != hipSuccess) { fprintf(stderr, "kernel_launch: hipFuncSetAttribute failed\n"); grid = -1; return; }
        if (hipOccupancyMaxActiveBlocksPerMultiprocessor(&per_cu, (const void*)fwd_megakernel, NWAVES * 64, LDS_BYTES) != hipSuccess || per_cu < 1)
            fprintf(stderr, "kernel_launch: note: occupancy query reports %d workgroups per CU\n", per_cu);
        (void)hipGetLastError();
        grid = cus;
    }
    if (grid < 0) return;
    if (hipMemsetAsync((char*)d_ws + WS_CTL, 0, CTL_ZERO_BYTES, stream) != hipSuccess) { fprintf(stderr, "kernel_launch: hipMemsetAsync failed\n"); return; }
    Args a{};
    for (int i = 0; i < 20; ++i) a.in[i] = (const float*)d_in[i];
    a.out = (float*)d_out; a.ws = (unsigned char*)d_ws;
    if (N_LAUNCHES == 1) { a.ph_lo = 0; a.ph_hi = N_PHASES; a.li = 0; hipLaunchKernelGGL(fwd_megakernel, dim3(grid), dim3(NWAVES * 64), LDS_BYTES, stream, a); }
    else for (int li = 0; li < N_PHASES; ++li) { a.ph_lo = li; a.ph_hi = li + 1; a.li = li; hipLaunchKernelGGL(fwd_megakernel, dim3(grid), dim3(NWAVES * 64), LDS_BYTES, stream, a);
#ifdef PROBE_DUP
        if (li == PROBE_DUP) hipLaunchKernelGGL(fwd_megakernel, dim3(grid), dim3(NWAVES * 64), LDS_BYTES, stream, a);
#endif
    }
    const hipError_t le = hipPeekAtLastError();
    if (le != hipSuccess) fprintf(stderr, "kernel_launch: launch failed: %s\n", hipGetErrorName(le));
}
```

```cpp
#include <hip/hip_runtime.h>
#include <hip/hip_bf16.h>
#include <cstdio>
#include <cstdint>
#include <cmath>

#ifndef MK_N_LAUNCHES
#define MK_N_LAUNCHES 1
#endif
namespace pg8 {
#define PG8_LAS __attribute__((address_space(3)))
typedef unsigned short bf16_t;
typedef short bf16x8 __attribute__((ext_vector_type(8)));
typedef float f32x4 __attribute__((ext_vector_type(4)));
typedef float f32x2 __attribute__((ext_vector_type(2)));
typedef unsigned u32x4 __attribute__((ext_vector_type(4)));
typedef unsigned u32x2 __attribute__((ext_vector_type(2)));
constexpr int BM = 256, BK = 64, HALF = 128, HTB = HALF * BK * 2  , STAGE_BYTES = 8 * HTB, NXCD = 8, WGM = 8;

__host__ __device__ __forceinline__ int lds_byte(int r, int c) { const int st = (r >> 4) * 2 + (c >> 5), rr = r & 15, cc = c & 31, ob = rr * 64 + cc * 2; return st * 1024 + (ob ^ (((ob >> 9) & 1) << 5)); }
__host__ __device__ __forceinline__ void stage_rc(int b, int& R, int& C) { const int st = b / 1024, sb = b % 1024, swz = sb ^ (((sb >> 9) & 1) << 5); R = (st >> 1) * 16 + swz / 64; C = (st & 1) * 32 + (swz % 64) / 2; }
__host__ __device__ __forceinline__ int perm32(int rho) { const int n = rho >> 4, i = rho & 15; return 8 * (i >> 2) + 4 * n + (i & 3); }

struct Unit { int pm, pn, g; };
struct GemmSet { const bf16_t* A0; const bf16_t* B0; const bf16_t* A1; const bf16_t* B1; int K; };

struct TileOrder {
    int nM, nN, nwg, G, c, passes;
    __device__ void init(int M, int N, int G_, int c_, int passes_ = 1) { nM = M / BM; nN = N / BM; nwg = nM * nN; G = G_; c = c_; passes = passes_; }
    __device__ bool next(int i, Unit& u) const {
        const int ti = (passes == 2) ? (i >> 1) : i; u.g = (passes == 2) ? (i & 1) : 0;
        const long L = (long)ti * G + c; if (L >= nwg) return false;
        int wgid = (int)L; { const int q = nwg / NXCD, r = nwg % NXCD, xcd = wgid % NXCD, off = wgid / NXCD; wgid = (xcd < r ? xcd * (q + 1) : r * (q + 1) + (xcd - r) * q) + off; }
        const int nig = WGM * nN, gid = wgid / nig, fm = gid * WGM, gsz = (nM - fm) < WGM ? (nM - fm) : WGM;
        u.pm = fm + ((wgid % nig) % gsz); u.pn = (wgid % nig) / gsz; return true;
    }
    __device__ __forceinline__ void a_ready(const Unit&) const {}
    __device__ __forceinline__ void done(const Unit&) const {}
};
struct SubOrder {
    int nN, n, idx;
    __device__ void init(int M, int N, int c0, int c_) { nN = N / BM; n = (M / BM) * nN; idx = c_ - c0; }
    __device__ bool next(int i, Unit& u) const { if (i != 0 || idx < 0 || idx >= n) return false; u.pm = idx / nN; u.pn = idx % nN; u.g = 0; return true; }
    __device__ __forceinline__ void a_ready(const Unit&) const {}
    __device__ __forceinline__ void done(const Unit&) const {}
};

typedef __bf16 bf16x2_t __attribute__((ext_vector_type(2)));
__device__ __forceinline__ unsigned cvt_pk_bf16(float lo, float hi) { f32x2 v = {lo, hi}; bf16x2_t b = __builtin_convertvector(v, bf16x2_t); return __builtin_bit_cast(unsigned, b); }
__device__ __forceinline__ float bf_lo(unsigned w) { return __builtin_bit_cast(float, w << 16); }
__device__ __forceinline__ float bf_hi(unsigned w) { return __builtin_bit_cast(float, w & 0xffff0000u); }
__device__ __forceinline__ u32x4 pack8(const f32x4 v0, const f32x4 v1) { u32x4 w; w.x = cvt_pk_bf16(v0[0], v0[1]); w.y = cvt_pk_bf16(v0[2], v0[3]); w.z = cvt_pk_bf16(v1[0], v1[1]); w.w = cvt_pk_bf16(v1[2], v1[3]); return w; }
__device__ __forceinline__ float sigmoidf_fast(float x) { return __builtin_amdgcn_rcpf(1.0f + __builtin_amdgcn_exp2f(-1.4426950408889634f * x)); }

struct EpiStore {
    static constexpr bool PERM = true, AFTER_DRAIN = false;
    bf16_t* O; int ldc; float scale;
    __device__ __forceinline__ void operator()(const f32x4 (&acc)[2][2][4][2], const Unit& u, int wr, int wc, int fr, int fq) const {
        const int row0 = u.pm * BM + wr * 64 + fr, col0 = u.pn * BM + wc * 32 + 8 * fq;
#pragma unroll
        for (int ai = 0; ai < 2; ++ai)
#pragma unroll
            for (int m = 0; m < 4; ++m) { bf16_t* rowp = O + (size_t)(row0 + ai * HALF + m * 16) * ldc + col0;
#pragma unroll
                for (int bj = 0; bj < 2; ++bj) *(u32x4*)(rowp + bj * HALF) = pack8(acc[ai][bj][m][0] * scale, acc[ai][bj][m][1] * scale); }
    }
};

struct EpiStoreKPerm {
    static constexpr bool PERM = true, AFTER_DRAIN = false;
    bf16_t* O; int ldc;
    __device__ __forceinline__ void operator()(const f32x4 (&acc)[2][2][4][2], const Unit& u, int wr, int wc, int fr, int fq) const {
        const int row0 = u.pm * BM + wr * 64 + fr, colg = u.pn * BM + wc * 32;
#pragma unroll
        for (int ai = 0; ai < 2; ++ai)
#pragma unroll
            for (int m = 0; m < 4; ++m) { bf16_t* rowp = O + (size_t)(row0 + ai * HALF + m * 16) * ldc + colg;
#pragma unroll
                for (int bj = 0; bj < 2; ++bj)
#pragma unroll
                    for (int n = 0; n < 2; ++n) { const f32x4 v = acc[ai][bj][m][n]; u32x2 w; w.x = cvt_pk_bf16(v[0], v[1]); w.y = cvt_pk_bf16(v[2], v[3]);
                        *(u32x2*)(rowp + bj * HALF + 8 * ((2 * fq + n) & 3) + 4 * (fq >> 1)) = w; } }
    }
};

struct EpiInProj {
    static constexpr bool PERM = true, AFTER_DRAIN = false;
    bf16_t *q, *k, *v, *uu, *cb, *sga, *sgc; float qscale;
    __device__ __forceinline__ void operator()(const f32x4 (&acc)[2][2][4][2], const Unit& u, int wr, int wc, int fr, int fq) const {
        const int row0 = u.pm * BM + wr * 64 + fr; const int pn = u.pn;
        if (pn >= 12 && pn < 20) {
            const int col0 = (pn - 12) * 128 + wc * 32 + 8 * fq;
#pragma unroll
            for (int ai = 0; ai < 2; ++ai)
#pragma unroll
                for (int m = 0; m < 4; ++m) *(u32x4*)(uu + (size_t)(row0 + ai * HALF + m * 16) * 1024 + col0) = pack8(acc[ai][0][m][0] * acc[ai][1][m][0], acc[ai][0][m][1] * acc[ai][1][m][1]);
            return;
        }
        bf16_t* base; float sc = 1.f; bool sig = false;
        if (pn < 4) { base = q; sc = qscale; } else if (pn < 8) base = k; else if (pn < 12) base = v; else if (pn < 24) base = cb; else if (pn < 28) { base = sga; sig = true; } else { base = sgc; sig = true; }
        const int col0 = (pn & 3) * BM + wc * 32 + 8 * fq;
#pragma unroll
        for (int ai = 0; ai < 2; ++ai)
#pragma unroll
            for (int m = 0; m < 4; ++m) { bf16_t* rowp = base + (size_t)(row0 + ai * HALF + m * 16) * 1024 + col0;
#pragma unroll
                for (int bj = 0; bj < 2; ++bj) { f32x4 v0 = acc[ai][bj][m][0], v1 = acc[ai][bj][m][1];
                    if (sig) {
#pragma unroll
                        for (int e = 0; e < 4; ++e) { v0[e] = sigmoidf_fast(v0[e]); v1[e] = sigmoidf_fast(v1[e]); } }
                    else { v0 = v0 * sc; v1 = v1 * sc; }
                    *(u32x4*)(rowp + bj * HALF) = pack8(v0, v1); } }
    }
};

struct EpiGate {
    static constexpr bool PERM = true, AFTER_DRAIN = false;
    bf16_t* merged; const bf16_t* sga; const bf16_t* sgc;
    __device__ __forceinline__ void operator()(const f32x4 (&acc)[2][2][4][2], const Unit& u, int wr, int wc, int fr, int fq) const {
        const int row0 = u.pm * BM + wr * 64 + fr, col0 = u.pn * BM + wc * 32 + 8 * fq; const bf16_t* gate = u.g ? sgc : sga;
#pragma unroll
        for (int ai = 0; ai < 2; ++ai)
#pragma unroll
            for (int m = 0; m < 4; ++m) { const size_t off = (size_t)(row0 + ai * HALF + m * 16) * 1024 + col0;
#pragma unroll
                for (int bj = 0; bj < 2; ++bj) { const u32x4 gw = *(const u32x4*)(gate + off + bj * HALF);
                    f32x4 v0 = acc[ai][bj][m][0], v1 = acc[ai][bj][m][1];
                    v0[0] *= bf_lo(gw.x); v0[1] *= bf_hi(gw.x); v0[2] *= bf_lo(gw.y); v0[3] *= bf_hi(gw.y); v1[0] *= bf_lo(gw.z); v1[1] *= bf_hi(gw.z); v1[2] *= bf_lo(gw.w); v1[3] *= bf_hi(gw.w);
                    if (u.g) { const u32x4 pw = *(const u32x4*)(merged + off + bj * HALF);
                        v0[0] += bf_lo(pw.x); v0[1] += bf_hi(pw.x); v0[2] += bf_lo(pw.y); v0[3] += bf_hi(pw.y); v1[0] += bf_lo(pw.z); v1[1] += bf_hi(pw.z); v1[2] += bf_lo(pw.w); v1[3] += bf_hi(pw.w); }
                    *(u32x4*)(merged + off + bj * HALF) = pack8(v0, v1); } }
    }
};

template <bool BASE_BF16> struct EpiResid {
    static constexpr bool PERM = false, AFTER_DRAIN = false;
    const float* basef; const bf16_t* baseb; bf16_t* hb; float* ssq;
    __device__ __forceinline__ void operator()(const f32x4 (&acc)[2][2][4][2], const Unit& u, int wr, int wc, int fr, int fq) const {
        const int row0 = u.pm * BM + wr * 64 + fr, col0 = u.pn * BM + wc * 32 + 4 * fq;
#pragma unroll
        for (int ai = 0; ai < 2; ++ai)
#pragma unroll
            for (int m = 0; m < 4; ++m) { const int row = row0 + ai * HALF + m * 16; const size_t off = (size_t)row * 1024 + col0; float s = 0.f;
#pragma unroll
                for (int bj = 0; bj < 2; ++bj)
#pragma unroll
                    for (int n = 0; n < 2; ++n) { f32x4 b;
                        if (BASE_BF16) { const u32x2 w = *(const u32x2*)(baseb + off + bj * HALF + n * 16); b = (f32x4){bf_lo(w.x), bf_hi(w.x), bf_lo(w.y), bf_hi(w.y)}; }
                        else b = *(const f32x4*)(basef + off + bj * HALF + n * 16);
                        const f32x4 h = b + acc[ai][bj][m][n];
                        s += (h[0] * h[0] + h[1] * h[1]) + (h[2] * h[2] + h[3] * h[3]);
                        u32x2 w; w.x = cvt_pk_bf16(h[0], h[1]); w.y = cvt_pk_bf16(h[2], h[3]); *(u32x2*)(hb + off + bj * HALF + n * 16) = w; }
                s += __shfl_xor(s, 16); s += __shfl_xor(s, 32);
                if (fq == 0) ssq[(size_t)row * 16 + u.pn * 4 + wc] = s; }
    }
};

struct EpiRowScale {
    static constexpr bool PERM = true, AFTER_DRAIN = false;
    bf16_t* O; int ldc; const float* ssq; float scale; float eps;
    __device__ __forceinline__ void operator()(const f32x4 (&acc)[2][2][4][2], const Unit& u, int wr, int wc, int fr, int fq) const {
        const int row0 = u.pm * BM + wr * 64 + fr, col0 = u.pn * BM + wc * 32 + 8 * fq;
#pragma unroll
        for (int ai = 0; ai < 2; ++ai)
#pragma unroll
            for (int m = 0; m < 4; ++m) { const int row = row0 + ai * HALF + m * 16; const f32x4* sp = (const f32x4*)(ssq + (size_t)row * 16);
                const f32x4 a = sp[0], b = sp[1], c = sp[2], d = sp[3]; const f32x4 t = (a + b) + (c + d);
                const float rs = __builtin_amdgcn_rsqf(((t[0] + t[1]) + (t[2] + t[3])) * (1.0f / 1024.0f) + eps) * scale;
                bf16_t* rowp = O + (size_t)row * ldc + col0;
#pragma unroll
                for (int bj = 0; bj < 2; ++bj) *(u32x4*)(rowp + bj * HALF) = pack8(acc[ai][bj][m][0] * rs, acc[ai][bj][m][1] * rs); }
    }
};

template <class Epi, class Sched, bool ALIGN_EPI = false, bool SP2 = false>
__device__ __forceinline__ void gemm_phase(PG8_LAS unsigned char* lds, const GemmSet g, const Sched& S, const Epi& E) {
    const int tid = threadIdx.x, wid = __builtin_amdgcn_readfirstlane(tid >> 6), lane = tid & 63, wr = wid >> 2, wc = wid & 3, fr = lane & 15, fq = lane >> 4;
    const int K = g.K, nt = K / BK;
    unsigned voffA[2], voffB[2];
#pragma unroll
    for (int i = 0; i < 2; ++i) { int R, C; stage_rc(tid * 16 + i * 8192, R, C); const int Rb = Epi::PERM ? ((R & ~31) + perm32(R & 31)) : R;
        voffA[i] = (unsigned)(R * K + C) * 2u; voffB[i] = (unsigned)(Rb * K + C) * 2u; }
    const size_t kstep = (size_t)(BK * 2);
    const size_t hstep = (size_t)HALF * K * 2;
    const size_t tstep = 2 * hstep;
    const unsigned ldsw = (unsigned)wid * 1024u;
    const int aoff = lds_byte(wr * 64 + fr, fq * 8), boff = lds_byte(wc * 32 + fr, fq * 8);
#define PG8_SA(b, h) (((b) * 2 + (h)) * HTB)
#define PG8_SB(b, h) ((4 + (b) * 2 + (h)) * HTB)
#define PG8_STAGE(bufoff, gbase, voff) do { _Pragma("unroll") for (int _i = 0; _i < 2; ++_i) \
        __builtin_amdgcn_global_load_lds((const unsigned*)((const char*)(gbase) + (voff)[_i]), (PG8_LAS unsigned*)(lds + (bufoff) + ldsw + _i * 8192), 16, 0, 0); } while (0)
#define PG8_LDA(dst, b, h) do { _Pragma("unroll") for (int m = 0; m < 4; ++m) _Pragma("unroll") for (int k = 0; k < 2; ++k) dst[m][k] = *(const PG8_LAS bf16x8*)(lds + PG8_SA(b, h) + aoff + m * 2048 + k * 1024); } while (0)
#define PG8_LDB(dst, b, h) do { _Pragma("unroll") for (int n = 0; n < 2; ++n) _Pragma("unroll") for (int k = 0; k < 2; ++k) dst[n][k] = *(const PG8_LAS bf16x8*)(lds + PG8_SB(b, h) + boff + n * 2048 + k * 1024); } while (0)
#define PG8_MMA(ai, bj, At, Bt) do { __builtin_amdgcn_s_setprio(1); _Pragma("unroll") for (int m = 0; m < 4; ++m) _Pragma("unroll") for (int n = 0; n < 2; ++n) _Pragma("unroll") for (int k = 0; k < 2; ++k) \
        acc[ai][bj][m][n] = __builtin_amdgcn_mfma_f32_16x16x32_bf16(Bt[n][k], At[m][k], acc[ai][bj][m][n], 0, 0, 0); __builtin_amdgcn_s_setprio(0); } while (0)
#define PG8_WAIT_V(n) asm volatile("s_waitcnt vmcnt(" #n ")" ::: "memory")
#define PG8_WAIT_L(n) asm volatile("s_waitcnt lgkmcnt(" #n ")" ::: "memory")
#define PG8_BAR __builtin_amdgcn_s_barrier()
#define PG8_SCHED __builtin_amdgcn_sched_barrier(0)
    Unit cur, nxt; int ui = 0;
    if (!S.next(0, cur)) return;
    f32x4 acc[2][2][4][2];
#pragma unroll
    for (int a = 0; a < 2; ++a)
#pragma unroll
        for (int b = 0; b < 2; ++b)
#pragma unroll
            for (int m = 0; m < 4; ++m)
#pragma unroll
                for (int n = 0; n < 2; ++n) acc[a][b][m][n] = (f32x4){0.f, 0.f, 0.f, 0.f};
    bf16x8 At[4][2], B0[2][2], B1[2][2];
    const char* cA = (const char*)(cur.g ? g.A1 : g.A0) + (size_t)cur.pm * tstep; const char* cB = (const char*)(cur.g ? g.B1 : g.B0) + (size_t)cur.pn * tstep;
    S.a_ready(cur);
    if constexpr (SP2) {
        PG8_STAGE(PG8_SB(0, 0), cB, voffB); PG8_STAGE(PG8_SB(0, 1), cB + hstep, voffB); PG8_STAGE(PG8_SA(0, 0), cA, voffA); PG8_STAGE(PG8_SA(0, 1), cA + hstep, voffA);
        if (wr == 1) PG8_BAR;
        PG8_WAIT_V(2); PG8_BAR;
        PG8_STAGE(PG8_SB(1, 0), cB + kstep, voffB); PG8_STAGE(PG8_SA(1, 0), cA + kstep, voffA); PG8_STAGE(PG8_SB(1, 1), cB + hstep + kstep, voffB);
        PG8_WAIT_V(6); PG8_BAR;
    } else {
        PG8_STAGE(PG8_SB(0, 0), cB, voffB); PG8_STAGE(PG8_SA(0, 0), cA, voffA); PG8_STAGE(PG8_SB(0, 1), cB + hstep, voffB); PG8_STAGE(PG8_SA(0, 1), cA + hstep, voffA);
        if (wr == 1) PG8_BAR;
        PG8_WAIT_V(4); PG8_BAR;
        PG8_STAGE(PG8_SB(1, 0), cB + kstep, voffB); PG8_STAGE(PG8_SA(1, 0), cA + kstep, voffA); PG8_STAGE(PG8_SB(1, 1), cB + hstep + kstep, voffB);
        PG8_WAIT_V(6); PG8_BAR;
    }
    for (;;) {
        const bool has_next = S.next(ui + 1, nxt);
        const char* nA = has_next ? (const char*)(nxt.g ? g.A1 : g.A0) + (size_t)nxt.pm * tstep : cA; const char* nB = has_next ? (const char*)(nxt.g ? g.B1 : g.B0) + (size_t)nxt.pn * tstep : cB;
        for (int t = 0; t < nt; t += 2) {
            const bool last = (t == nt - 2);
            const char* a1 = cA + (size_t)(t + 1) * kstep;
            const char* a2 = last ? nA : cA + (size_t)(t + 2) * kstep; const char* b2 = last ? nB : cB + (size_t)(t + 2) * kstep;
            const char* a3 = a2 + kstep; const char* b3 = b2 + kstep;
            if (last && has_next) S.a_ready(nxt);
            if constexpr (SP2) {
            PG8_LDB(B0, 0, 0); PG8_LDB(B1, 0, 1); PG8_SCHED; PG8_LDA(At, 0, 0); PG8_STAGE(PG8_SA(1, 1), a1 + hstep, voffA);
            PG8_WAIT_V(8); PG8_WAIT_L(0); PG8_BAR; PG8_MMA(0, 0, At, B0); PG8_MMA(0, 1, At, B1); PG8_BAR; PG8_SCHED;
            PG8_LDA(At, 0, 1); PG8_STAGE(PG8_SB(0, 0), b2, voffB); PG8_STAGE(PG8_SB(0, 1), b2 + hstep, voffB); PG8_STAGE(PG8_SA(0, 0), a2, voffA);
            PG8_WAIT_V(8); PG8_WAIT_L(0); PG8_BAR; PG8_MMA(1, 0, At, B0); PG8_MMA(1, 1, At, B1); PG8_BAR; PG8_SCHED;
            PG8_LDB(B0, 1, 0); PG8_LDB(B1, 1, 1); PG8_SCHED; PG8_LDA(At, 1, 0); PG8_STAGE(PG8_SA(0, 1), a2 + hstep, voffA);
            PG8_WAIT_V(8); PG8_WAIT_L(0); PG8_BAR; PG8_MMA(0, 0, At, B0); PG8_MMA(0, 1, At, B1); PG8_BAR; PG8_SCHED;
            PG8_LDA(At, 1, 1); PG8_STAGE(PG8_SB(1, 0), b3, voffB); PG8_STAGE(PG8_SB(1, 1), b3 + hstep, voffB); PG8_STAGE(PG8_SA(1, 0), a3, voffA);
            PG8_WAIT_V(8); PG8_WAIT_L(0); PG8_BAR; PG8_MMA(1, 0, At, B0); PG8_MMA(1, 1, At, B1); PG8_BAR; PG8_SCHED;
            } else {
            PG8_LDB(B0, 0, 0); PG8_SCHED; PG8_LDA(At, 0, 0); PG8_STAGE(PG8_SA(1, 1), a1 + hstep, voffA);
            PG8_WAIT_L(8); PG8_BAR; PG8_WAIT_L(0); PG8_MMA(0, 0, At, B0); PG8_BAR; PG8_SCHED;
            PG8_LDB(B1, 0, 1); PG8_STAGE(PG8_SB(0, 0), b2, voffB);
            PG8_BAR; PG8_WAIT_L(0); PG8_MMA(0, 1, At, B1); PG8_BAR;
            PG8_LDA(At, 0, 1); PG8_STAGE(PG8_SA(0, 0), a2, voffA);
            PG8_BAR; PG8_WAIT_L(0); PG8_MMA(1, 0, At, B0); PG8_BAR; PG8_SCHED;
            PG8_STAGE(PG8_SB(0, 1), b2 + hstep, voffB);
            PG8_WAIT_V(6); PG8_BAR; PG8_MMA(1, 1, At, B1); PG8_BAR;
            PG8_LDB(B0, 1, 0); PG8_SCHED; PG8_LDA(At, 1, 0); PG8_STAGE(PG8_SA(0, 1), a2 + hstep, voffA);
            PG8_WAIT_L(8); PG8_BAR; PG8_WAIT_L(0); PG8_MMA(0, 0, At, B0); PG8_BAR; PG8_SCHED;
            PG8_LDB(B1, 1, 1); PG8_STAGE(PG8_SB(1, 0), b3, voffB);
            PG8_BAR; PG8_WAIT_L(0); PG8_MMA(0, 1, At, B1); PG8_BAR;
            PG8_LDA(At, 1, 1); PG8_STAGE(PG8_SA(1, 0), a3, voffA);
            PG8_BAR; PG8_WAIT_L(0); PG8_MMA(1, 0, At, B0); PG8_BAR; PG8_SCHED;
            PG8_STAGE(PG8_SB(1, 1), b3 + hstep, voffB);
            PG8_WAIT_V(6); PG8_BAR; PG8_MMA(1, 1, At, B1); PG8_BAR;
            }
        }
        if constexpr (ALIGN_EPI) { if (wr == 0) PG8_BAR; }
        if constexpr (!Epi::AFTER_DRAIN) { E(acc, cur, wr, wc, fr, fq); S.done(cur); }
        if (!has_next) break;
#pragma unroll
        for (int a = 0; a < 2; ++a)
#pragma unroll
            for (int b = 0; b < 2; ++b)
#pragma unroll
                for (int m = 0; m < 4; ++m)
#pragma unroll
                    for (int n = 0; n < 2; ++n) acc[a][b][m][n] = (f32x4){0.f, 0.f, 0.f, 0.f};
        cur = nxt; cA = nA; cB = nB; ++ui;
        if constexpr (ALIGN_EPI) { if (wr == 1) PG8_BAR; }
    }
    PG8_WAIT_V(0);
    if constexpr (!ALIGN_EPI) { if (wr == 0) PG8_BAR; }
    PG8_BAR;
    if constexpr (Epi::AFTER_DRAIN) { E.fused(acc, cur, wr, wc, fr, fq, lds, wid, lane); S.done(cur); }
#undef PG8_SA
#undef PG8_SB
#undef PG8_STAGE
#undef PG8_LDA
#undef PG8_LDB
#undef PG8_MMA
#undef PG8_WAIT_V
#undef PG8_WAIT_L
#undef PG8_BAR
#undef PG8_SCHED
}
}

namespace sb {
using bf16 = __hip_bfloat16;
using bf16x8 = __attribute__((ext_vector_type(8))) short;
using s16x4 = __attribute__((ext_vector_type(4))) short;
using f32x16 = __attribute__((ext_vector_type(16))) float;
using u32x4 = __attribute__((ext_vector_type(4))) unsigned;
constexpr int SEQ = 2048, NHEAD = 16, HD = 64, DM = 1024;
constexpr int SLOTB = 8192, LDS_K = 0, LDS_V = 2 * SLOTB, LDS_FLAG = 4 * SLOTB, LDS_OST = 4 * SLOTB + 4096, LDS_BYTES = LDS_OST + 8 * 4096;
constexpr float EXIT_THR = -40.0f;
__device__ __forceinline__ int crow(int r, int hi) { return (r & 3) + 8 * (r >> 2) + 4 * hi; }
__device__ __forceinline__ void glds16(const void* gsrc, unsigned lds_dst) { unsigned keep;
    asm volatile("s_mov_b32 %0, m0\n\ts_mov_b32 m0, %2\n\ts_nop 0\n\tglobal_load_lds_dwordx4 %1, off\n\ts_mov_b32 m0, %0" : "=&s"(keep) : "v"(gsrc), "s"(lds_dst) : "memory"); }
typedef __attribute__((address_space(3))) const char* lds_cptr;
typedef short v4i16_t __attribute__((ext_vector_type(4)));
typedef float f32x2_t __attribute__((ext_vector_type(2))); typedef __bf16 bf16x2_t __attribute__((ext_vector_type(2)));
__device__ __forceinline__ unsigned cvtpk(float lo, float hi) { f32x2_t v = {lo, hi}; bf16x2_t b = __builtin_convertvector(v, bf16x2_t); return __builtin_bit_cast(unsigned, b); }
__device__ __forceinline__ s16x4 vtr(lds_cptr p) { return __builtin_bit_cast(s16x4, __builtin_amdgcn_ds_read_tr16_b64_v4i16((__attribute__((address_space(3))) v4i16_t*)p)); }
__device__ __forceinline__ bf16x8 pack8(const f32x16& p, int b) { u32x4 w; w.x = cvtpk(p[b], p[b + 1]); w.y = cvtpk(p[b + 2], p[b + 3]); w.z = cvtpk(p[b + 4], p[b + 5]); w.w = cvtpk(p[b + 6], p[b + 7]); return __builtin_bit_cast(bf16x8, w); }
__device__ __forceinline__ float lo_lane(float x) { auto rr = __builtin_amdgcn_permlane32_swap(__float_as_uint(x), __float_as_uint(x), false, false); return __uint_as_float(rr[0]); }
#define SB_WAIT_BAR() asm volatile("s_waitcnt vmcnt(0) lgkmcnt(0)\n\ts_barrier" ::: "memory")

template <bool EARLY> __device__ __forceinline__ void sb_unit(int b, int h, int qb, const bf16* Q, const bf16* __restrict__ K, const bf16* __restrict__ V, bf16* O, char* shm) {
    const int tid = threadIdx.x, lane = tid & 63, r32 = lane & 31, hi = lane >> 5; const int wid = __builtin_amdgcn_readfirstlane(tid >> 6);
    const long rowbase = (long)b * SEQ; const int q0 = qb * 256;
    const bf16* Qw = Q + (rowbase + q0 + wid * 32) * DM + h * HD;
    const bf16* Kh = K + rowbase * DM + h * HD; const bf16* Vh = V + rowbase * DM + h * HD;
    const unsigned lds0 = (unsigned)(uintptr_t)shm;
    const bf16* ksrc = Kh + (long)lane * DM + wid * 8;
    const bf16* vsrc = Vh + (long)(16 * (wid & 3) + (lane >> 2)) * DM + (wid >> 2) * 32 + (lane & 3) * 8;
    const unsigned kdst = lds0 + LDS_K + wid * 1024, vdst = lds0 + LDS_V + wid * 1024;
#define SB_DMA_K(t, slot) glds16(ksrc + (long)(t) * 64 * DM, (unsigned)__builtin_amdgcn_readfirstlane(kdst + (slot)))
#define SB_DMA_V(t, slot) glds16(vsrc + (long)(t) * 64 * DM, (unsigned)__builtin_amdgcn_readfirstlane(vdst + (slot)))
    const lds_cptr shm3 = (lds_cptr)shm; const lds_cptr kp0 = shm3 + LDS_K + hi * 1024 + r32 * 16;
    const lds_cptr vp0 = shm3 + LDS_V + ((lane >> 4) & 1) * 32 + (lane & 3) * 8 + (4 * hi + ((lane & 15) >> 2)) * 64;
    const int NT = (q0 + 256) / 64;
    volatile __attribute__((address_space(3))) unsigned* flags = (volatile __attribute__((address_space(3))) unsigned*)(shm3 + LDS_FLAG);
    if (EARLY && lane == 0) flags[wid] = 0u;
    bool wdone = false;
    SB_DMA_K(NT - 1, 0); SB_DMA_V(NT - 1, 0);
    bf16x8 qr[4];
#pragma unroll
    for (int d0 = 0; d0 < 4; ++d0) qr[d0] = *reinterpret_cast<const bf16x8*>(&Qw[(long)r32 * DM + d0 * 16 + hi * 8]);
    bf16x8 tri[2], ones;
#pragma unroll
    for (int ks = 0; ks < 2; ++ks)
#pragma unroll
        for (int j = 0; j < 8; ++j) { const int kk = 16 * ks + 8 * (j >> 2) + 4 * hi + (j & 3); tri[ks][j] = (kk >= r32) ? (short)0x3F80 : (short)0; }
#pragma unroll
    for (int j = 0; j < 8; ++j) ones[j] = (short)0x3F80;
    f32x16 o0 = f32x16{}, o1 = f32x16{}; float R = 0.f;
    const int trow = q0 + wid * 32 + r32;
    const int wmin = q0 + wid * 32, wmax = wmin + 31;
    for (int it = 0; it < NT; ++it) {
        const int t = NT - 1 - it; const int sl = (it & 1) * SLOTB;
        SB_WAIT_BAR();
        if (EARLY) { const unsigned f = flags[lane & 7]; if (__all(f != 0u)) break; }
        if (t > 0) { SB_DMA_K(t - 1, sl ^ SLOTB); SB_DMA_V(t - 1, sl ^ SLOTB); }
        if (64 * t < wmax && !wdone) {
            f32x16 p0 = f32x16{}, p1 = f32x16{};
#pragma unroll
            for (int d0 = 0; d0 < 4; ++d0) {
                const bf16x8 b0 = *(const __attribute__((address_space(3))) bf16x8*)(kp0 + sl + d0 * 2048);
                const bf16x8 b1 = *(const __attribute__((address_space(3))) bf16x8*)(kp0 + sl + d0 * 2048 + 512);
                p0 = __builtin_amdgcn_mfma_f32_32x32x16_bf16(b0, qr[d0], p0, 0, 0, 0);
                p1 = __builtin_amdgcn_mfma_f32_32x32x16_bf16(b1, qr[d0], p1, 0, 0, 0); }
            const bool diag = (64 * t + 63 >= wmin);
            f32x16 l0, l1;
#pragma unroll
            for (int r = 0; r < 16; ++r) {
                const float y0 = p0[r], y1 = p1[r];
                l0[r] = -(__builtin_fmaxf(y0, 0.f) + __builtin_amdgcn_logf(1.0f + __builtin_amdgcn_exp2f(-__builtin_fabsf(y0))));
                l1[r] = -(__builtin_fmaxf(y1, 0.f) + __builtin_amdgcn_logf(1.0f + __builtin_amdgcn_exp2f(-__builtin_fabsf(y1)))); }
            if (diag) {
#pragma unroll
                for (int r = 0; r < 16; ++r) { const int s = 64 * t + crow(r, hi); if (s >= trow) l0[r] = 0.f; if (s + 32 >= trow) l1[r] = 0.f; } }
            const bf16x8 l0a = pack8(l0, 0), l0b = pack8(l0, 8), l1a = pack8(l1, 0), l1b = pack8(l1, 8);
            f32x16 Rv;
#pragma unroll
            for (int r = 0; r < 16; ++r) Rv[r] = R;
            f32x16 c1 = __builtin_amdgcn_mfma_f32_32x32x16_bf16(tri[0], l1a, Rv, 0, 0, 0); c1 = __builtin_amdgcn_mfma_f32_32x32x16_bf16(tri[1], l1b, c1, 0, 0, 0);
            f32x16 c0 = __builtin_amdgcn_mfma_f32_32x32x16_bf16(ones, l1a, Rv, 0, 0, 0); c0 = __builtin_amdgcn_mfma_f32_32x32x16_bf16(ones, l1b, c0, 0, 0, 0);
            c0 = __builtin_amdgcn_mfma_f32_32x32x16_bf16(tri[0], l0a, c0, 0, 0, 0); c0 = __builtin_amdgcn_mfma_f32_32x32x16_bf16(tri[1], l0b, c0, 0, 0, 0);
#pragma unroll
            for (int r = 0; r < 16; ++r) { p0[r] = __builtin_amdgcn_exp2f(p0[r] + c0[r]); p1[r] = __builtin_amdgcn_exp2f(p1[r] + c1[r]); }
            if (diag) {
#pragma unroll
                for (int r = 0; r < 16; ++r) { const int s = 64 * t + crow(r, hi); if (s >= trow) p0[r] = 0.f; if (s + 32 >= trow) p1[r] = 0.f; } }
            R = lo_lane(c0[0]);
            if (EARLY && !__any(R >= EXIT_THR)) { wdone = true; if (lane == 0) flags[wid] = 1u; }
            const bf16x8 pa0 = pack8(p0, 0), pa1 = pack8(p0, 8), pa2 = pack8(p1, 0), pa3 = pack8(p1, 8);
            const lds_cptr vp = vp0 + sl;
#define SB_VF(dh, ks) ({ const s16x4 lo_ = vtr(vp + (dh) * 4096 + (ks) * 1024), hi_ = vtr(vp + (dh) * 4096 + (ks) * 1024 + 512); (bf16x8){lo_[0], lo_[1], lo_[2], lo_[3], hi_[0], hi_[1], hi_[2], hi_[3]}; })
            o0 = __builtin_amdgcn_mfma_f32_32x32x16_bf16(pa0, SB_VF(0, 0), o0, 0, 0, 0); o1 = __builtin_amdgcn_mfma_f32_32x32x16_bf16(pa0, SB_VF(1, 0), o1, 0, 0, 0);
            o0 = __builtin_amdgcn_mfma_f32_32x32x16_bf16(pa1, SB_VF(0, 1), o0, 0, 0, 0); o1 = __builtin_amdgcn_mfma_f32_32x32x16_bf16(pa1, SB_VF(1, 1), o1, 0, 0, 0);
            o0 = __builtin_amdgcn_mfma_f32_32x32x16_bf16(pa2, SB_VF(0, 2), o0, 0, 0, 0); o1 = __builtin_amdgcn_mfma_f32_32x32x16_bf16(pa2, SB_VF(1, 2), o1, 0, 0, 0);
            o0 = __builtin_amdgcn_mfma_f32_32x32x16_bf16(pa3, SB_VF(0, 3), o0, 0, 0, 0); o1 = __builtin_amdgcn_mfma_f32_32x32x16_bf16(pa3, SB_VF(1, 3), o1, 0, 0, 0);
#undef SB_VF
        }
    }
    if (EARLY) SB_WAIT_BAR();
    bf16* Ow = O + (rowbase + q0 + wid * 32) * DM + h * HD;
    {
        bf16* stg = (bf16*)(shm + LDS_OST) + wid * 2048;
#pragma unroll
        for (int r = 0; r < 16; ++r) { const int orow = crow(r, hi); stg[orow * 64 + r32] = __float2bfloat16(o0[r]); stg[orow * 64 + 32 + r32] = __float2bfloat16(o1[r]); }
        asm volatile("s_waitcnt lgkmcnt(0)" ::: "memory");
#pragma unroll
        for (int i = 0; i < 4; ++i) { const int row = i * 8 + (lane >> 3), ch = lane & 7; const u32x4 v = *(const u32x4*)(stg + row * 64 + ch * 8); *(u32x4*)(Ow + (long)row * DM + ch * 8) = v; }
        asm volatile("s_waitcnt lgkmcnt(0)" ::: "memory");
    }
#undef SB_DMA_K
#undef SB_DMA_V
}
}

constexpr int NWAVES = 8;
constexpr int N_LAUNCHES = MK_N_LAUNCHES;
constexpr int N_PHASES = 10;
constexpr int BATCH = 8, SEQ = 2048, D = 1024, M = BATCH * SEQ, MEMLEN = 256, MROWS = BATCH * MEMLEN, NIN = 8192, NPQ = 2048;
constexpr float RMS_EPS = 1e-6f;
constexpr float LOG2E = 1.4426950408889634f;
constexpr size_t MiB = 1u << 20;
constexpr size_t WS_CTL = 0, CTL_ZERO_BYTES = 32768;
constexpr size_t WS_WIN = 1 * MiB, WS_WA = 17 * MiB, WS_WC = 19 * MiB, WS_WO = 21 * MiB, WS_WQ2 = 23 * MiB, WS_WKV2 = 25 * MiB, WS_WO2 = 29 * MiB, WS_WPQ = 31 * MiB, WS_SK = 35 * MiB;
constexpr size_t WS_SSQ1 = 36 * MiB, WS_SSQ2 = 37 * MiB, WS_MEMN = 38 * MiB, WS_K2 = 42 * MiB, WS_V2T = 46 * MiB;
constexpr size_t WS_B0 = 52 * MiB, WS_B1 = 84 * MiB, WS_B2 = 116 * MiB, WS_B3 = 148 * MiB, WS_B4 = 180 * MiB, WS_B5 = 212 * MiB, WS_END = 244 * MiB;
constexpr int CW_TMO = 0, CW_CODE = 1, CW_BAR = 4096;

constexpr int RING_OFF = 0, RING_BYTES = 131072;
constexpr int LDSCTL_OFF = RING_BYTES, MISC_OFF = LDSCTL_OFF + 320;
constexpr int LDS_BYTES = 147456;
#define GAS __attribute__((address_space(1)))
#define LAS __attribute__((address_space(3)))
typedef unsigned short bf16;
typedef unsigned v4u __attribute__((ext_vector_type(4)));
typedef float f32x4 __attribute__((ext_vector_type(4)));
typedef short bf16x8 __attribute__((ext_vector_type(8)));
typedef GAS unsigned gu32;
typedef GAS unsigned long long gu64;
#define RLX_AGENT __ATOMIC_RELAXED, __HIP_MEMORY_SCOPE_AGENT
#define LDS_WAIT() asm volatile("s_waitcnt lgkmcnt(0)" ::: "memory")
#define VM_WAIT() asm volatile("s_waitcnt vmcnt(0)" ::: "memory")
__device__ __forceinline__ unsigned long long rt() { return __builtin_amdgcn_s_memrealtime(); }
__device__ __forceinline__ unsigned f2bf(float f) { unsigned u = __builtin_bit_cast(unsigned, f); return (u + 0x7fffu + ((u >> 16) & 1u)) >> 16; }
__device__ __forceinline__ unsigned pk2(float lo, float hi) { return f2bf(lo) | (f2bf(hi) << 16); }

#define XB_TMO      128
#define XB_XCNT(j)  (256  + 64 * (j))
#define XB_XSUB(j)  (1280 + 64 * (j))
#define XB_XGEN(j)  (2304 + 64 * (j))
#define XB_TOP      3328
#define XB_TOPGEN   3392
#define XCD_BAR_WORDS 3456
#define XB_SPIN_CAP (1u << 18)

__device__ __forceinline__ unsigned xb_ld(unsigned* p)              { return __hip_atomic_load(p, __ATOMIC_RELAXED, __HIP_MEMORY_SCOPE_AGENT); }
__device__ __forceinline__ unsigned xb_add(unsigned* p, unsigned v) { return __hip_atomic_fetch_add(p, v, __ATOMIC_RELAXED, __HIP_MEMORY_SCOPE_AGENT); }
__device__ __forceinline__ unsigned xb_xcc_id() { return (unsigned)__builtin_amdgcn_s_getreg((3 << 11) | 20) & 0xFu; }
#define XB_SPIN(cond, bar) do { unsigned _sp = 0; while (cond) { __builtin_amdgcn_s_sleep(1); \
    if ((++_sp & 255u) == 0u) { if (xb_ld(&(bar)[XB_TMO])) break; if (_sp > XB_SPIN_CAP) { atomicAdd(&(bar)[XB_TMO], 1u); break; } } } } while (0)

struct XcdBarrier {
    unsigned* bar; unsigned x;
    volatile LAS unsigned* st;
};

__device__ __forceinline__ XcdBarrier xcd_barrier_post(unsigned* bar, volatile LAS unsigned* st) {
    XcdBarrier b; b.bar = bar; b.x = xb_xcc_id(); b.st = st;
    if (threadIdx.x == 0) (void)xb_add(&bar[XB_XCNT(b.x)], 1u);
    return b;
}
__device__ __forceinline__ void xcd_barrier_complete(unsigned* bar, unsigned x, unsigned& nloc, unsigned& nx) {
    const unsigned G = gridDim.x * gridDim.y * gridDim.z;
    unsigned sum, cnt, mine, sp = 0u;
    for (;;) {
        sum = 0u; cnt = 0u; mine = 0u;
#pragma unroll
        for (unsigned j = 0; j < 16; ++j) { const unsigned c = xb_ld(&bar[XB_XCNT(j)]); sum += c; cnt += (c > 0u) ? 1u : 0u; mine = (j == x) ? c : mine; }
        if (sum == G) break;
        __builtin_amdgcn_s_sleep(1);
        if ((++sp & 255u) == 0u) { if (xb_ld(&bar[XB_TMO])) break; if (sp > XB_SPIN_CAP) { atomicAdd(&bar[XB_TMO], 1u); break; } }
    }
    nloc = mine > 0u ? mine : 1u; nx = cnt > 0u ? cnt : 1u;
}

__device__ __forceinline__ void xcd_barrier(const XcdBarrier& b) {
    asm volatile("s_waitcnt vmcnt(0)" ::: "memory");
    __syncthreads();
    if (threadIdx.x == 0) {
        unsigned* bar = b.bar;
        __builtin_amdgcn_s_waitcnt(0);
        unsigned nloc = b.st[0], nx = b.st[1];
        if (nloc == 0u) { xcd_barrier_complete(bar, b.x, nloc, nx); b.st[0] = nloc; b.st[1] = nx; }
        const unsigned old = xb_add(&bar[XB_XSUB(b.x)], 1u);
        const unsigned gen = old / nloc;
        if (old + 1u == (gen + 1u) * nloc) {
            __builtin_amdgcn_fence(__ATOMIC_RELEASE, "agent");
            asm volatile("s_waitcnt vmcnt(0)" ::: "memory");
            const unsigned og = xb_add(&bar[XB_TOP], 1u);
            const unsigned tg = og / nx;
            if (og + 1u == (tg + 1u) * nx) xb_add(&bar[XB_TOPGEN], 1u);
            else XB_SPIN(xb_ld(&bar[XB_TOPGEN]) == tg, bar);
            __builtin_amdgcn_fence(__ATOMIC_ACQUIRE, "agent");
            xb_add(&bar[XB_XGEN(b.x)], 1u);
            asm volatile("s_waitcnt vmcnt(0)" ::: "memory");
        } else {
            XB_SPIN(xb_ld(&bar[XB_XGEN(b.x)]) == gen, bar);
            __builtin_amdgcn_fence(__ATOMIC_ACQUIRE, "agent");
            asm volatile("s_waitcnt vmcnt(0)" ::: "memory");
        }
    }
    __syncthreads();
}


__device__ __forceinline__ float wave_sum(float v) {
#pragma unroll
    for (int o = 1; o < 64; o <<= 1) v += __shfl_xor(v, o);
    return v;
}
__device__ __forceinline__ int inproj_row(int n) {
    const int g = n >> 10, c = n & 1023;
    if (g < 3) return n;
    if (g == 3) return 3072 + (c >> 7) * 256 + (c & 127);
    if (g == 5) return 3072 + (c >> 7) * 256 + 128 + (c & 127);
    if (g == 4) return 5120 + c;
    return n;
}
template <bool INMAP> __device__ __forceinline__ void transpose_item(const float* W, int K, int N, const float* gain, bf16* WT, int row_off, LAS float* scr, int item, int lane) {
    const int nblk = N / 32, kb = item / nblk, nb = item % nblk, k0 = 64 * kb, n0 = 32 * nb;
    {
        f32x4 w[8]; const int c4 = 4 * (lane & 7), kr = lane >> 3;
#pragma unroll
        for (int j = 0; j < 8; ++j) w[j] = *(const GAS f32x4*)(W + (size_t)(k0 + kr + 8 * j) * N + n0 + c4);
#pragma unroll
        for (int j = 0; j < 8; ++j) { const int kk = kr + 8 * j; f32x4 t = w[j]; if (gain) t = t * gain[k0 + kk];
            LAS float* d = scr + kk * 33 + c4; d[0] = t.x; d[1] = t.y; d[2] = t.z; d[3] = t.w; } }
    LDS_WAIT(); asm volatile("" ::: "memory");
    const int c = lane & 7; const int r0 = INMAP ? inproj_row(n0) : (row_off + n0);
#pragma unroll
    for (int j = 0; j < 4; ++j) { const int n = (lane >> 3) + 8 * j; const LAS float* s = scr + (8 * c) * 33 + n;
        v4u o; o.x = pk2(s[0 * 33], s[1 * 33]); o.y = pk2(s[2 * 33], s[3 * 33]); o.z = pk2(s[4 * 33], s[5 * 33]); o.w = pk2(s[6 * 33], s[7 * 33]);
        *(GAS v4u*)(WT + (size_t)(r0 + n) * K + k0 + 8 * c) = o; }
    LDS_WAIT(); asm volatile("" ::: "memory");
}
__device__ __forceinline__ void rms_row_to_bf16(const float* xrow, const float* gain, bf16* orow, int lane) {
    const GAS f32x4* xr = (const GAS f32x4*)xrow + lane; const GAS f32x4* gr = (const GAS f32x4*)gain + lane;
    f32x4 v[4]; float s = 0.f;
#pragma unroll
    for (int j = 0; j < 4; ++j) { v[j] = xr[64 * j]; s += (v[j].x * v[j].x + v[j].y * v[j].y) + (v[j].z * v[j].z + v[j].w * v[j].w); }
    const float rstd = 1.0f / sqrtf(wave_sum(s) * (1.f / 1024.f) + RMS_EPS);
    GAS unsigned long long* o8 = (GAS unsigned long long*)orow + lane;
#pragma unroll
    for (int j = 0; j < 4; ++j) { const f32x4 g = gr[64 * j]; o8[64 * j] = (unsigned long long)pk2(v[j].x * rstd * g.x, v[j].y * rstd * g.y) | ((unsigned long long)pk2(v[j].z * rstd * g.z, v[j].w * rstd * g.w) << 32); }
}
__device__ __forceinline__ void row_to_bf16(const float* xrow, const float* gain, bf16* orow, int lane) {
    const GAS f32x4* xr = (const GAS f32x4*)xrow + lane; GAS unsigned long long* o8 = (GAS unsigned long long*)orow + lane;
#pragma unroll
    for (int j = 0; j < 4; ++j) { f32x4 v = xr[64 * j]; if (gain) { const f32x4 g = ((const GAS f32x4*)gain + lane)[64 * j]; v = v * g; }
        o8[64 * j] = (unsigned long long)pk2(v.x, v.y) | ((unsigned long long)pk2(v.z, v.w) << 32); }
}
__device__ __forceinline__ void row_to_fp8(const float* xrow, const float* gain, float scale, unsigned char* orow, int lane) {
    const GAS f32x4* xr = (const GAS f32x4*)xrow + lane; GAS unsigned* o4 = (GAS unsigned*)orow + lane;
#pragma unroll
    for (int j = 0; j < 4; ++j) { f32x4 v = xr[64 * j] * scale; if (gain) { const f32x4 g = ((const GAS f32x4*)gain + lane)[64 * j]; v = v * g; }
        int w = 0; w = __builtin_amdgcn_cvt_pk_fp8_f32(v.x, v.y, w, false); w = __builtin_amdgcn_cvt_pk_fp8_f32(v.z, v.w, w, true); o4[64 * j] = (unsigned)w; }
}
__device__ __forceinline__ void rows4_to_fp8(const float* x0, size_t rstride, const float* gain, float scale, unsigned char* o0, int lane) {
    f32x4 v[4][4];
#pragma unroll
    for (int r = 0; r < 4; ++r)
#pragma unroll
        for (int j = 0; j < 4; ++j) v[r][j] = ((const GAS f32x4*)(x0 + r * rstride * 1024) + lane)[64 * j];
#pragma unroll
    for (int j = 0; j < 4; ++j) { f32x4 g = (f32x4){scale, scale, scale, scale}; if (gain) g = g * ((const GAS f32x4*)gain + lane)[64 * j];
#pragma unroll
        for (int r = 0; r < 4; ++r) { const f32x4 t = v[r][j] * g; int w = 0; w = __builtin_amdgcn_cvt_pk_fp8_f32(t.x, t.y, w, false); w = __builtin_amdgcn_cvt_pk_fp8_f32(t.z, t.w, w, true);
            ((GAS unsigned*)(o0 + r * rstride * 1024) + lane)[64 * j] = (unsigned)w; } }
}
__device__ __forceinline__ void rms_rows2_to_bf16(const float* x0, size_t rstride, const float* gain, bf16* o0, int lane) {
    f32x4 v[2][4]; float s[2] = {0.f, 0.f};
#pragma unroll
    for (int r = 0; r < 2; ++r)
#pragma unroll
        for (int j = 0; j < 4; ++j) v[r][j] = ((const GAS f32x4*)(x0 + r * rstride * 1024) + lane)[64 * j];
#pragma unroll
    for (int r = 0; r < 2; ++r)
#pragma unroll
        for (int j = 0; j < 4; ++j) s[r] += (v[r][j].x * v[r][j].x + v[r][j].y * v[r][j].y) + (v[r][j].z * v[r][j].z + v[r][j].w * v[r][j].w);
#pragma unroll
    for (int r = 0; r < 2; ++r) { const float rstd = 1.0f / sqrtf(wave_sum(s[r]) * (1.f / 1024.f) + RMS_EPS);
        GAS unsigned long long* o8 = (GAS unsigned long long*)(o0 + r * rstride * 1024) + lane;
#pragma unroll
        for (int j = 0; j < 4; ++j) { const f32x4 g = ((const GAS f32x4*)gain + lane)[64 * j];
            o8[64 * j] = (unsigned long long)pk2(v[r][j].x * rstd * g.x, v[r][j].y * rstd * g.y) | ((unsigned long long)pk2(v[r][j].z * rstd * g.z, v[r][j].w * rstd * g.w) << 32); } }
}
__device__ __forceinline__ void final_norm_row(const float* hrow, const float* gain, float* orow, int lane) {
    const GAS f32x4* xr = (const GAS f32x4*)hrow + lane; const GAS f32x4* gr = (const GAS f32x4*)gain + lane;
    f32x4 v[4]; float s = 0.f;
#pragma unroll
    for (int j = 0; j < 4; ++j) { v[j] = xr[64 * j]; s += (v[j].x * v[j].x + v[j].y * v[j].y) + (v[j].z * v[j].z + v[j].w * v[j].w); }
    const float rstd = 1.0f / sqrtf(wave_sum(s) * (1.f / 1024.f) + RMS_EPS);
    GAS f32x4* o = (GAS f32x4*)orow + lane;
#pragma unroll
    for (int j = 0; j < 4; ++j) o[64 * j] = v[j] * rstd * gr[64 * j];
}
__device__ __forceinline__ float bflo(unsigned w) { return __builtin_bit_cast(float, w << 16); }
__device__ __forceinline__ float bfhi(unsigned w) { return __builtin_bit_cast(float, w & 0xffff0000u); }
__device__ __forceinline__ void yconv_item(const bf16* U, const bf16* CB, const float* cw, bf16* YC, int item, int lane) {
    const int t0 = item * 8; const bool first = (t0 % SEQ) == 0;
#pragma unroll 1
    for (int ps = 0; ps < 2; ++ps) {
        const int c0 = ps * 512 + lane * 8;
        float w0[8], w1[8], w2[8];
#pragma unroll
        for (int e = 0; e < 8; ++e) { w0[e] = cw[c0 + e]; w1[e] = cw[1024 + c0 + e]; w2[e] = cw[2048 + c0 + e]; }
        v4u um2 = (v4u){0u, 0u, 0u, 0u}, um1 = (v4u){0u, 0u, 0u, 0u};
        if (!first) { um2 = *(const GAS v4u*)(U + (size_t)(t0 - 2) * 1024 + c0); um1 = *(const GAS v4u*)(U + (size_t)(t0 - 1) * 1024 + c0); }
#pragma unroll
        for (int i = 0; i < 8; ++i) {
            const v4u uc = *(const GAS v4u*)(U + (size_t)(t0 + i) * 1024 + c0); const v4u cbv = *(const GAS v4u*)(CB + (size_t)(t0 + i) * 1024 + c0);
            v4u o;
#pragma unroll
            for (int q = 0; q < 4; ++q) {
                const float a = bflo(cbv[q]) * (w0[2 * q] * bflo(um2[q]) + w1[2 * q] * bflo(um1[q]) + w2[2 * q] * bflo(uc[q]));
                const float b = bfhi(cbv[q]) * (w0[2 * q + 1] * bfhi(um2[q]) + w1[2 * q + 1] * bfhi(um1[q]) + w2[2 * q + 1] * bfhi(uc[q]));
                o[q] = pk2(a, b); }
            *(GAS v4u*)(YC + (size_t)(t0 + i) * 1024 + c0) = o;
            um2 = um1; um1 = uc; }
    }
}


namespace xa {
using bf16x8 = __attribute__((ext_vector_type(8))) short;
using f32x4 = __attribute__((ext_vector_type(4))) float;
using u32x4 = __attribute__((ext_vector_type(4))) unsigned;
using u32x2 = __attribute__((ext_vector_type(2))) unsigned;
typedef __attribute__((address_space(3))) const char* lds_cptr;
constexpr int BUFB = 65536, VOFF = 32768;
#define XA_WAIT_BAR() asm volatile("s_waitcnt vmcnt(0) lgkmcnt(0)\n\ts_barrier" ::: "memory")
__device__ __forceinline__ void xattn_unit(int b, int head, int qh, const bf16* Q, const bf16* K2, const bf16* V2P, bf16* O, char* shm) {
    const int lane = threadIdx.x & 63, kr = lane & 15, g = lane >> 4; const int wid = __builtin_amdgcn_readfirstlane((int)threadIdx.x >> 6);
    const unsigned lds0 = (unsigned)(uintptr_t)shm; const lds_cptr shm3 = (lds_cptr)shm;
    const size_t qrow = (size_t)b * SEQ + qh * 128 + wid * 16 + kr;
    const bf16* ksrc = K2 + ((size_t)b * MEMLEN + lane) * 1024 + head * 256 + 8 * wid;
    const bf16* vsrc = V2P + ((size_t)head * 256 + lane) * 2048 + (size_t)b * MEMLEN + 8 * wid;
#define XA_DMA(c, bufo) do { _Pragma("unroll") for (int i = 0; i < 4; ++i) { \
        sb::glds16(ksrc + (size_t)(64 * (c)) * 1024 + 64 * i, (unsigned)__builtin_amdgcn_readfirstlane(lds0 + (bufo) + (wid + 8 * i) * 1024)); \
        sb::glds16(vsrc + (size_t)(64 * i) * 2048 + 64 * (c), (unsigned)__builtin_amdgcn_readfirstlane(lds0 + (bufo) + VOFF + wid * 4096 + i * 1024)); } } while (0)
    XA_DMA(0, 0);
    bf16x8 qf[8];
#pragma unroll
    for (int ks = 0; ks < 8; ++ks) qf[ks] = *(const GAS bf16x8*)(Q + qrow * 1024 + head * 256 + 32 * ks + 8 * g);
    f32x4 o[16];
#pragma unroll
    for (int dt = 0; dt < 16; ++dt) o[dt] = (f32x4){0.f, 0.f, 0.f, 0.f};
    float mrun = -1e30f, lrun = 0.f;
    const lds_cptr kfr = shm3 + g * 1024 + kr * 16, vfr = shm3 + VOFF + g * 4096 + kr * 16;
#pragma unroll 1
    for (int c = 0; c < 4; ++c) {
        const int bo = (c & 1) * BUFB;
        XA_WAIT_BAR();
        if (c < 3) XA_DMA(c + 1, bo ^ BUFB);
        f32x4 s[4];
#pragma unroll
        for (int kt = 0; kt < 4; ++kt) { s[kt] = (f32x4){0.f, 0.f, 0.f, 0.f};
#pragma unroll
            for (int ks = 0; ks < 8; ++ks) { const bf16x8 a = *(const __attribute__((address_space(3))) bf16x8*)(kfr + bo + ks * 4096 + kt * 256);
                s[kt] = __builtin_amdgcn_mfma_f32_16x16x32_bf16(a, qf[ks], s[kt], 0, 0, 0); } }
        float mx = __builtin_fmaxf(__builtin_fmaxf(s[0].x, s[0].y), __builtin_fmaxf(s[0].z, s[0].w));
#pragma unroll
        for (int kt = 1; kt < 4; ++kt) mx = __builtin_fmaxf(mx, __builtin_fmaxf(__builtin_fmaxf(s[kt].x, s[kt].y), __builtin_fmaxf(s[kt].z, s[kt].w)));
        mx = __builtin_fmaxf(mx, __shfl_xor(mx, 16)); mx = __builtin_fmaxf(mx, __shfl_xor(mx, 32));
        const float mnew = __builtin_fmaxf(mrun, mx), alpha = __builtin_amdgcn_exp2f(mrun - mnew);
        mrun = mnew; float ps = 0.f;
#pragma unroll
        for (int kt = 0; kt < 4; ++kt) { s[kt].x = __builtin_amdgcn_exp2f(s[kt].x - mnew); s[kt].y = __builtin_amdgcn_exp2f(s[kt].y - mnew); s[kt].z = __builtin_amdgcn_exp2f(s[kt].z - mnew); s[kt].w = __builtin_amdgcn_exp2f(s[kt].w - mnew);
            ps += (s[kt].x + s[kt].y) + (s[kt].z + s[kt].w); }
        lrun = lrun * alpha + ps;
#pragma unroll
        for (int dt = 0; dt < 16; ++dt) o[dt] = o[dt] * alpha;
        bf16x8 pb[2];
#pragma unroll
        for (int k2 = 0; k2 < 2; ++k2) { u32x4 w; w.x = pg8::cvt_pk_bf16(s[2 * k2].x, s[2 * k2].y); w.y = pg8::cvt_pk_bf16(s[2 * k2].z, s[2 * k2].w);
            w.z = pg8::cvt_pk_bf16(s[2 * k2 + 1].x, s[2 * k2 + 1].y); w.w = pg8::cvt_pk_bf16(s[2 * k2 + 1].z, s[2 * k2 + 1].w); pb[k2] = __builtin_bit_cast(bf16x8, w); }
#pragma unroll
        for (int dt = 0; dt < 16; ++dt)
#pragma unroll
            for (int k2 = 0; k2 < 2; ++k2) { const bf16x8 a = *(const __attribute__((address_space(3))) bf16x8*)(vfr + bo + k2 * 16384 + dt * 256);
                o[dt] = __builtin_amdgcn_mfma_f32_16x16x32_bf16(a, pb[k2], o[dt], 0, 0, 0); }
    }
    lrun += __shfl_xor(lrun, 16); lrun += __shfl_xor(lrun, 32);
    const float rl = 1.0f / lrun;
    bf16* op = O + qrow * 1024 + head * 256 + 4 * g;
#pragma unroll
    for (int dt = 0; dt < 16; ++dt) { u32x2 w; w.x = pg8::cvt_pk_bf16(o[dt].x * rl, o[dt].y * rl); w.y = pg8::cvt_pk_bf16(o[dt].z * rl, o[dt].w * rl); *(GAS u32x2*)(op + 16 * dt) = w; }
#undef XA_DMA
}
}

namespace peer {
using bf16x8 = __attribute__((ext_vector_type(8))) short;
using f32x16 = __attribute__((ext_vector_type(16))) float;
using u32x4 = __attribute__((ext_vector_type(4))) unsigned;
using u32x2 = __attribute__((ext_vector_type(2))) unsigned;
typedef __bf16 bf16x2_t __attribute__((ext_vector_type(2)));
#define PEER_CE(a, b) do { const int _h = ((a) > (b)) ? (a) : (b); const int _l = ((a) > (b)) ? (b) : (a); (a) = _h; (b) = _l; } while (0)
#define PEER_SORT16(x, o) do { PEER_CE(x[(o)+0], x[(o)+1]); PEER_CE(x[(o)+2], x[(o)+3]); PEER_CE(x[(o)+4], x[(o)+5]); PEER_CE(x[(o)+6], x[(o)+7]); PEER_CE(x[(o)+8], x[(o)+9]); PEER_CE(x[(o)+10], x[(o)+11]); PEER_CE(x[(o)+12], x[(o)+13]); PEER_CE(x[(o)+14], x[(o)+15]); PEER_CE(x[(o)+0], x[(o)+2]); PEER_CE(x[(o)+1], x[(o)+3]); PEER_CE(x[(o)+4], x[(o)+6]); PEER_CE(x[(o)+5], x[(o)+7]); PEER_CE(x[(o)+8], x[(o)+10]); PEER_CE(x[(o)+9], x[(o)+11]); PEER_CE(x[(o)+12], x[(o)+14]); PEER_CE(x[(o)+13], x[(o)+15]); PEER_CE(x[(o)+1], x[(o)+2]); PEER_CE(x[(o)+5], x[(o)+6]); PEER_CE(x[(o)+9], x[(o)+10]); PEER_CE(x[(o)+13], x[(o)+14]); PEER_CE(x[(o)+0], x[(o)+4]); PEER_CE(x[(o)+1], x[(o)+5]); PEER_CE(x[(o)+2], x[(o)+6]); PEER_CE(x[(o)+3], x[(o)+7]); PEER_CE(x[(o)+8], x[(o)+12]); PEER_CE(x[(o)+9], x[(o)+13]); PEER_CE(x[(o)+10], x[(o)+14]); PEER_CE(x[(o)+11], x[(o)+15]); PEER_CE(x[(o)+2], x[(o)+4]); PEER_CE(x[(o)+3], x[(o)+5]); PEER_CE(x[(o)+10], x[(o)+12]); PEER_CE(x[(o)+11], x[(o)+13]); PEER_CE(x[(o)+1], x[(o)+2]); PEER_CE(x[(o)+3], x[(o)+4]); PEER_CE(x[(o)+5], x[(o)+6]); PEER_CE(x[(o)+9], x[(o)+10]); PEER_CE(x[(o)+11], x[(o)+12]); PEER_CE(x[(o)+13], x[(o)+14]); PEER_CE(x[(o)+0], x[(o)+8]); PEER_CE(x[(o)+1], x[(o)+9]); PEER_CE(x[(o)+2], x[(o)+10]); PEER_CE(x[(o)+3], x[(o)+11]); PEER_CE(x[(o)+4], x[(o)+12]); PEER_CE(x[(o)+5], x[(o)+13]); PEER_CE(x[(o)+6], x[(o)+14]); PEER_CE(x[(o)+7], x[(o)+15]); PEER_CE(x[(o)+4], x[(o)+8]); PEER_CE(x[(o)+5], x[(o)+9]); PEER_CE(x[(o)+6], x[(o)+10]); PEER_CE(x[(o)+7], x[(o)+11]); PEER_CE(x[(o)+2], x[(o)+4]); PEER_CE(x[(o)+3], x[(o)+5]); PEER_CE(x[(o)+6], x[(o)+8]); PEER_CE(x[(o)+7], x[(o)+9]); PEER_CE(x[(o)+10], x[(o)+12]); PEER_CE(x[(o)+11], x[(o)+13]); PEER_CE(x[(o)+1], x[(o)+2]); PEER_CE(x[(o)+3], x[(o)+4]); PEER_CE(x[(o)+5], x[(o)+6]); PEER_CE(x[(o)+7], x[(o)+8]); PEER_CE(x[(o)+9], x[(o)+10]); PEER_CE(x[(o)+11], x[(o)+12]); PEER_CE(x[(o)+13], x[(o)+14]); } while (0)
#define PEER_MERGE16(x, a, b) do { x[(a)+0] = (x[(a)+0] > x[(b)+15]) ? x[(a)+0] : x[(b)+15]; x[(a)+1] = (x[(a)+1] > x[(b)+14]) ? x[(a)+1] : x[(b)+14]; x[(a)+2] = (x[(a)+2] > x[(b)+13]) ? x[(a)+2] : x[(b)+13]; x[(a)+3] = (x[(a)+3] > x[(b)+12]) ? x[(a)+3] : x[(b)+12]; x[(a)+4] = (x[(a)+4] > x[(b)+11]) ? x[(a)+4] : x[(b)+11]; x[(a)+5] = (x[(a)+5] > x[(b)+10]) ? x[(a)+5] : x[(b)+10]; x[(a)+6] = (x[(a)+6] > x[(b)+9]) ? x[(a)+6] : x[(b)+9]; x[(a)+7] = (x[(a)+7] > x[(b)+8]) ? x[(a)+7] : x[(b)+8]; x[(a)+8] = (x[(a)+8] > x[(b)+7]) ? x[(a)+8] : x[(b)+7]; x[(a)+9] = (x[(a)+9] > x[(b)+6]) ? x[(a)+9] : x[(b)+6]; x[(a)+10] = (x[(a)+10] > x[(b)+5]) ? x[(a)+10] : x[(b)+5]; x[(a)+11] = (x[(a)+11] > x[(b)+4]) ? x[(a)+11] : x[(b)+4]; x[(a)+12] = (x[(a)+12] > x[(b)+3]) ? x[(a)+12] : x[(b)+3]; x[(a)+13] = (x[(a)+13] > x[(b)+2]) ? x[(a)+13] : x[(b)+2]; x[(a)+14] = (x[(a)+14] > x[(b)+1]) ? x[(a)+14] : x[(b)+1]; x[(a)+15] = (x[(a)+15] > x[(b)+0]) ? x[(a)+15] : x[(b)+0]; PEER_CE(x[(a)+0], x[(a)+8]); PEER_CE(x[(a)+1], x[(a)+9]); PEER_CE(x[(a)+2], x[(a)+10]); PEER_CE(x[(a)+3], x[(a)+11]); PEER_CE(x[(a)+4], x[(a)+12]); PEER_CE(x[(a)+5], x[(a)+13]); PEER_CE(x[(a)+6], x[(a)+14]); PEER_CE(x[(a)+7], x[(a)+15]); PEER_CE(x[(a)+0], x[(a)+4]); PEER_CE(x[(a)+1], x[(a)+5]); PEER_CE(x[(a)+2], x[(a)+6]); PEER_CE(x[(a)+3], x[(a)+7]); PEER_CE(x[(a)+8], x[(a)+12]); PEER_CE(x[(a)+9], x[(a)+13]); PEER_CE(x[(a)+10], x[(a)+14]); PEER_CE(x[(a)+11], x[(a)+15]); PEER_CE(x[(a)+0], x[(a)+2]); PEER_CE(x[(a)+1], x[(a)+3]); PEER_CE(x[(a)+4], x[(a)+6]); PEER_CE(x[(a)+5], x[(a)+7]); PEER_CE(x[(a)+8], x[(a)+10]); PEER_CE(x[(a)+9], x[(a)+11]); PEER_CE(x[(a)+12], x[(a)+14]); PEER_CE(x[(a)+13], x[(a)+15]); PEER_CE(x[(a)+0], x[(a)+1]); PEER_CE(x[(a)+2], x[(a)+3]); PEER_CE(x[(a)+4], x[(a)+5]); PEER_CE(x[(a)+6], x[(a)+7]); PEER_CE(x[(a)+8], x[(a)+9]); PEER_CE(x[(a)+10], x[(a)+11]); PEER_CE(x[(a)+12], x[(a)+13]); PEER_CE(x[(a)+14], x[(a)+15]); } while (0)
#define PEER_MERGE16_SET(x, a, b) do { x[(a)+0] = (x[(a)+0] > x[(b)+15]) ? x[(a)+0] : x[(b)+15]; x[(a)+1] = (x[(a)+1] > x[(b)+14]) ? x[(a)+1] : x[(b)+14]; x[(a)+2] = (x[(a)+2] > x[(b)+13]) ? x[(a)+2] : x[(b)+13]; x[(a)+3] = (x[(a)+3] > x[(b)+12]) ? x[(a)+3] : x[(b)+12]; x[(a)+4] = (x[(a)+4] > x[(b)+11]) ? x[(a)+4] : x[(b)+11]; x[(a)+5] = (x[(a)+5] > x[(b)+10]) ? x[(a)+5] : x[(b)+10]; x[(a)+6] = (x[(a)+6] > x[(b)+9]) ? x[(a)+6] : x[(b)+9]; x[(a)+7] = (x[(a)+7] > x[(b)+8]) ? x[(a)+7] : x[(b)+8]; x[(a)+8] = (x[(a)+8] > x[(b)+7]) ? x[(a)+8] : x[(b)+7]; x[(a)+9] = (x[(a)+9] > x[(b)+6]) ? x[(a)+9] : x[(b)+6]; x[(a)+10] = (x[(a)+10] > x[(b)+5]) ? x[(a)+10] : x[(b)+5]; x[(a)+11] = (x[(a)+11] > x[(b)+4]) ? x[(a)+11] : x[(b)+4]; x[(a)+12] = (x[(a)+12] > x[(b)+3]) ? x[(a)+12] : x[(b)+3]; x[(a)+13] = (x[(a)+13] > x[(b)+2]) ? x[(a)+13] : x[(b)+2]; x[(a)+14] = (x[(a)+14] > x[(b)+1]) ? x[(a)+14] : x[(b)+1]; x[(a)+15] = (x[(a)+15] > x[(b)+0]) ? x[(a)+15] : x[(b)+0]; } while (0)
constexpr int PEER_NCAND = 50;
__device__ const unsigned char PEER_CAND[64] = {0, 16, 32, 48, 64, 80, 96, 112, 128, 144, 160, 176, 192, 208, 224, 240, 1, 17, 33, 49, 65, 81, 97, 113, 2, 18, 34, 50, 66, 3, 19, 35, 51, 4, 20, 36, 5, 21, 6, 22, 7, 23, 8, 9, 10, 11, 12, 13, 14, 15, 0, 0, 0, 0, 0, 0, 0, 0, 0, 0, 0, 0, 0, 0};
#define PEER_CAND_SUMS(x, v0, v1, KEYF) do { x[0] = KEYF((v0)[0] + (v1)[0], 0); x[1] = KEYF((v0)[0] + (v1)[1], 1); x[2] = KEYF((v0)[0] + (v1)[2], 2); x[3] = KEYF((v0)[0] + (v1)[3], 3); x[4] = KEYF((v0)[0] + (v1)[4], 4); x[5] = KEYF((v0)[0] + (v1)[5], 5); x[6] = KEYF((v0)[0] + (v1)[6], 6); x[7] = KEYF((v0)[0] + (v1)[7], 7); x[8] = KEYF((v0)[0] + (v1)[8], 8); x[9] = KEYF((v0)[0] + (v1)[9], 9); x[10] = KEYF((v0)[0] + (v1)[10], 10); x[11] = KEYF((v0)[0] + (v1)[11], 11); x[12] = KEYF((v0)[0] + (v1)[12], 12); x[13] = KEYF((v0)[0] + (v1)[13], 13); x[14] = KEYF((v0)[0] + (v1)[14], 14); x[15] = KEYF((v0)[0] + (v1)[15], 15); x[16] = KEYF((v0)[1] + (v1)[0], 16); x[17] = KEYF((v0)[1] + (v1)[1], 17); x[18] = KEYF((v0)[1] + (v1)[2], 18); x[19] = KEYF((v0)[1] + (v1)[3], 19); x[20] = KEYF((v0)[1] + (v1)[4], 20); x[21] = KEYF((v0)[1] + (v1)[5], 21); x[22] = KEYF((v0)[1] + (v1)[6], 22); x[23] = KEYF((v0)[1] + (v1)[7], 23); x[24] = KEYF((v0)[2] + (v1)[0], 24); x[25] = KEYF((v0)[2] + (v1)[1], 25); x[26] = KEYF((v0)[2] + (v1)[2], 26); x[27] = KEYF((v0)[2] + (v1)[3], 27); x[28] = KEYF((v0)[2] + (v1)[4], 28); x[29] = KEYF((v0)[3] + (v1)[0], 29); x[30] = KEYF((v0)[3] + (v1)[1], 30); x[31] = KEYF((v0)[3] + (v1)[2], 31); x[32] = KEYF((v0)[3] + (v1)[3], 32); x[33] = KEYF((v0)[4] + (v1)[0], 33); x[34] = KEYF((v0)[4] + (v1)[1], 34); x[35] = KEYF((v0)[4] + (v1)[2], 35); x[36] = KEYF((v0)[5] + (v1)[0], 36); x[37] = KEYF((v0)[5] + (v1)[1], 37); x[38] = KEYF((v0)[6] + (v1)[0], 38); x[39] = KEYF((v0)[6] + (v1)[1], 39); x[40] = KEYF((v0)[7] + (v1)[0], 40); x[41] = KEYF((v0)[7] + (v1)[1], 41); x[42] = KEYF((v0)[8] + (v1)[0], 42); x[43] = KEYF((v0)[9] + (v1)[0], 43); x[44] = KEYF((v0)[10] + (v1)[0], 44); x[45] = KEYF((v0)[11] + (v1)[0], 45); x[46] = KEYF((v0)[12] + (v1)[0], 46); x[47] = KEYF((v0)[13] + (v1)[0], 47); x[48] = KEYF((v0)[14] + (v1)[0], 48); x[49] = KEYF((v0)[15] + (v1)[0], 49); x[50] = (int)0x80000000; x[51] = (int)0x80000000; x[52] = (int)0x80000000; x[53] = (int)0x80000000; x[54] = (int)0x80000000; x[55] = (int)0x80000000; x[56] = (int)0x80000000; x[57] = (int)0x80000000; x[58] = (int)0x80000000; x[59] = (int)0x80000000; x[60] = (int)0x80000000; x[61] = (int)0x80000000; x[62] = (int)0x80000000; x[63] = (int)0x80000000; } while (0)

__device__ __forceinline__ int crow(int r, int hi) { return (r & 3) + 8 * (r >> 2) + 4 * hi; }
__device__ __forceinline__ int f2key(float f) { const int t = __builtin_bit_cast(int, f); return t ^ ((t >> 31) & 0x7fffffff); }
__device__ __forceinline__ float key2f(int t) { return __builtin_bit_cast(float, t ^ ((t >> 31) & 0x7fffffff)); }
__device__ __forceinline__ int sel_hi(int a, int b, int hm) { int r; asm("v_bfi_b32 %0, %1, %2, %3" : "=v"(r) : "v"(hm), "v"(b), "v"(a)); return r; }
template <int CTRL> __device__ __forceinline__ float dpp(float x) { return __int_as_float(__builtin_amdgcn_update_dpp(0, __float_as_int(x), CTRL, 0xF, 0xF, true)); }
__device__ __forceinline__ float swap16_sum(float x) { auto rr = __builtin_amdgcn_permlane16_swap(__float_as_uint(x), __float_as_uint(x), false, false); return __uint_as_float(rr[0]) + __uint_as_float(rr[1]); }
__device__ __forceinline__ float swap32_sum(float x) { auto rr = __builtin_amdgcn_permlane32_swap(__float_as_uint(x), __float_as_uint(x), false, false); return __uint_as_float(rr[0]) + __uint_as_float(rr[1]); }
__device__ __forceinline__ float fsel(float a, float b, int m) { return __int_as_float(sel_hi(__float_as_int(a), __float_as_int(b), m)); }
typedef float f32x2 __attribute__((ext_vector_type(2)));
__device__ __forceinline__ int key7(float f, int low) { return (f2key(f) & ~127) | low; }
__device__ __forceinline__ int key6(float f, int ord) { return (f2key(f) & ~63) | (63 - ord); }
__device__ __forceinline__ void top16_of_64(int (&x)[64]) {
    PEER_SORT16(x, 0); PEER_SORT16(x, 16); PEER_SORT16(x, 32); PEER_SORT16(x, 48);
    PEER_MERGE16(x, 0, 16); PEER_MERGE16(x, 32, 48); PEER_MERGE16(x, 0, 32);
}
__device__ __forceinline__ float dot2_bf16(unsigned w, unsigned x, float acc) { return __builtin_amdgcn_fdot2_f32_bf16(__builtin_bit_cast(bf16x2_t, w), __builtin_bit_cast(bf16x2_t, x), acc, false); }
__device__ __forceinline__ float dot8(const u32x4 a, const u32x4 b, float acc) {
    acc = dot2_bf16(a.x, b.x, acc); acc = dot2_bf16(a.y, b.y, acc); acc = dot2_bf16(a.z, b.z, acc); acc = dot2_bf16(a.w, b.w, acc); return acc;
}
__device__ __forceinline__ float gelu_tanh(float x) {
    const float u = 0.7978845608028654f * (x + 0.044715f * x * x * x);
    const float e = __builtin_amdgcn_exp2f(2.0f * LOG2E * u);
    const float th = 1.0f - 2.0f * __builtin_amdgcn_rcpf(e + 1.0f);
    return 0.5f * x * (1.0f + th);
}
__device__ __forceinline__ void topk_half(const bf16* qp, const bf16* sp, int hi, int (&T)[16]) {
    bf16x8 qf[8];
#pragma unroll
    for (int ks = 0; ks < 8; ++ks) qf[ks] = *(const GAS bf16x8*)(qp + ks * 16);
    const int hi4 = hi << 2;
    int x[64];
#pragma unroll
    for (int kt = 0; kt < 4; ++kt) { f32x16 sc = f32x16{};
#pragma unroll
        for (int ks = 0; ks < 8; ++ks) { const bf16x8 a = *(const GAS bf16x8*)(sp + (size_t)((kt * 8 + ks) * 64) * 8); sc = __builtin_amdgcn_mfma_f32_32x32x16_bf16(a, qf[ks], sc, 0, 0, 0); }
#pragma unroll
        for (int r = 0; r < 16; ++r) x[16 * kt + r] = ((f2key(sc[r]) & ~127) | (127 - (32 * kt + crow(r, 0)))) ^ hi4; }
    top16_of_64(x);
#pragma unroll
    for (int i = 0; i < 16; ++i) { auto rr = __builtin_amdgcn_permlane32_swap((unsigned)x[i], (unsigned)x[i], false, false); x[i] = (int)rr[0]; x[16 + i] = (int)rr[1]; }
    PEER_MERGE16(x, 0, 16);
#pragma unroll
    for (int i = 0; i < 16; ++i) T[i] = x[i];
}
__device__ __forceinline__ float fp8dot4(unsigned w, float h0, float h1, float h2, float h3) {
    const f32x2 lo = __builtin_amdgcn_cvt_pk_f32_fp8((int)w, false), hi = __builtin_amdgcn_cvt_pk_f32_fp8((int)w, true);
    return __builtin_fmaf(hi.y, h3, __builtin_fmaf(hi.x, h2, __builtin_fmaf(lo.y, h1, lo.x * h0)));
}
__device__ __forceinline__ float fp8dot16(const u32x4 u, const float (&h)[16]) {
    return (fp8dot4(u.x, h[0], h[1], h[2], h[3]) + fp8dot4(u.y, h[4], h[5], h[6], h[7])) + (fp8dot4(u.z, h[8], h[9], h[10], h[11]) + fp8dot4(u.w, h[12], h[13], h[14], h[15]));
}
__device__ __forceinline__ void fp8axpy4(unsigned w, float c, float& a0, float& a1, float& a2, float& a3) {
    const f32x2 lo = __builtin_amdgcn_cvt_pk_f32_fp8((int)w, false), hi = __builtin_amdgcn_cvt_pk_f32_fp8((int)w, true);
    a0 += c * lo.x; a1 += c * lo.y; a2 += c * hi.x; a3 += c * hi.y;
}
__device__ __forceinline__ void fp8axpy16(const u32x4 v, float c, float (&a)[16]) {
    fp8axpy4(v.x, c, a[0], a[1], a[2], a[3]); fp8axpy4(v.y, c, a[4], a[5], a[6], a[7]); fp8axpy4(v.z, c, a[8], a[9], a[10], a[11]); fp8axpy4(v.w, c, a[12], a[13], a[14], a[15]);
}
constexpr int L_ROUTE = 0, L_NLIST = 32768, L_CAND = 40960, L_OFF = 41472, L_SORT = 43008, L_END = 43008 + 32768;
constexpr int NSL = 4, SL_SHIFT = 12;
__device__ __forceinline__ void peer_tile(int tile, const bf16* PQ, const bf16* SK, const float* SSQ, const unsigned char* U8, const unsigned char* V8, const float* gfin, const bf16* HB, float* out, LAS unsigned char* lds, int mode = 3, float* outw = nullptr) {
    const int lane = threadIdx.x & 63, r32 = lane & 31, hi = lane >> 5; const int wid = __builtin_amdgcn_readfirstlane((int)threadIdx.x >> 6);
    const int tok0 = tile * 32; if (!outw) outw = out;
    LAS unsigned* route = (LAS unsigned*)(lds + L_ROUTE);
    LAS unsigned char* nl = lds + L_NLIST + (wid * 32 + r32) * 32;
    const LAS unsigned char* cand = lds + L_CAND;
    if (mode & 1) {
        const int h = wid; int T0[16], T1[16];
        topk_half(PQ + (size_t)(tok0 + r32) * NPQ + (h * 2 + 0) * 128 + hi * 8, SK + (size_t)(h * 2 + 0) * 16384 + (hi * 32 + r32) * 8, hi, T0);
        topk_half(PQ + (size_t)(tok0 + r32) * NPQ + (h * 2 + 1) * 128 + hi * 8, SK + (size_t)(h * 2 + 1) * 16384 + (hi * 32 + r32) * 8, hi, T1);
        const int hm = -hi;
        {
            u32x4 w;
#pragma unroll
            for (int q4 = 0; q4 < 4; ++q4) { unsigned a = 0;
#pragma unroll
                for (int e = 0; e < 4; ++e) { const int t = sel_hi(T0[4 * q4 + e], T1[4 * q4 + e], hm); a |= (unsigned)(127 - (t & 127)) << (8 * e); }
                w[q4] = a; }
            *(LAS u32x4*)(nl + 16 * hi) = w;
        }
        float v0[16], v1[16];
#pragma unroll
        for (int i = 0; i < 16; ++i) { v0[i] = key2f(T0[i] & ~127); v1[i] = key2f(T1[i] & ~127); }
        int x[64];
        PEER_CAND_SUMS(x, v0, v1, key6);
        top16_of_64(x);
        const float smax = key2f(x[0] & ~63);
        float p[16], ps = 0.f;
#pragma unroll
        for (int i = 0; i < 16; ++i) { p[i] = __builtin_amdgcn_exp2f((key2f(x[i] & ~63) - smax) * LOG2E); ps += p[i]; }
        const float rps = 1.0f / ps;
        LDS_WAIT();
#pragma unroll
        for (int i = 0; i < 8; ++i) {
            const int xi = sel_hi(x[i], x[8 + i], hm); const float g = __int_as_float(sel_hi(__float_as_int(p[i]), __float_as_int(p[8 + i]), hm)) * rps;
            const int ij = cand[63 - (xi & 63)]; const int n0 = nl[ij & 15], n1 = nl[16 + (ij >> 4)];
            u32x2 w; w.x = (unsigned)(n0 * 128 + n1); w.y = __float_as_uint(g);
            *(LAS u32x2*)(route + ((size_t)r32 * 128 + h * 16 + 8 * hi + i) * 2) = w; }
    }
    LDS_WAIT(); __syncthreads();
    if (mode & 2) {
    const int m0 = -(lane & 1), m1 = -((lane >> 1) & 1);
    const int jj = ((lane & 1) << 1) | ((lane >> 1) & 1);
    LAS unsigned* srtw = (LAS unsigned*)(lds + L_SORT) + wid * 1024;
    LAS unsigned char* offw = lds + L_OFF + wid * 128;
    const unsigned long long lt = (1ull << lane) - 1ull;
#pragma unroll 1
    for (int tt = 0; tt < 4; ++tt) {
        const LAS unsigned* rt0 = route + (wid * 4 + tt) * 256; LAS unsigned* srt = srtw + tt * 256; LAS unsigned char* offb = offw + tt * 32;
        const u32x2 ea = *(const LAS u32x2*)(rt0 + lane * 2), eb = *(const LAS u32x2*)(rt0 + (lane + 64) * 2);
        const int sa = (int)ea.x >> SL_SHIFT, sb_ = (int)eb.x >> SL_SHIFT; int base = 0, pa = 0, pb = 0;
#pragma unroll 1
        for (int v = 0; v < NSL; ++v) { const unsigned long long ma = __ballot(sa == v), mb = __ballot(sb_ == v); const int ca = __popcll(ma), cb2 = __popcll(mb);
            if (lane == 0) offb[v] = (unsigned char)base;
            if (sa == v) pa = base + __popcll(ma & lt); if (sb_ == v) pb = base + ca + __popcll(mb & lt); base += ca + cb2; }
        if (lane == 0) offb[NSL] = (unsigned char)128;
        *(LAS u32x2*)(srt + pa * 2) = ea; *(LAS u32x2*)(srt + pb * 2) = eb;
    }
    LDS_WAIT();
    float hr[4][16], acc[4][16];
#pragma unroll
    for (int tt = 0; tt < 4; ++tt) {
        const size_t tok = (size_t)tok0 + wid * 4 + tt; const bf16* hrow = HB + tok * 1024 + lane * 16;
        const f32x4* sp = (const f32x4*)(SSQ + tok * 16); const f32x4 a = sp[0], b = sp[1], c = sp[2], d = sp[3]; const f32x4 t4 = (a + b) + (c + d);
        const float sc = __builtin_amdgcn_rsqf(((t4[0] + t4[1]) + (t4[2] + t4[3])) * (1.0f / 1024.0f) + RMS_EPS) * (1.0f / 256.0f);
        { const u32x4 ha = *(const GAS u32x4*)hrow, hb2 = *(const GAS u32x4*)(hrow + 8);
          hr[tt][0] = bflo(ha.x) * sc; hr[tt][1] = bfhi(ha.x) * sc; hr[tt][2] = bflo(ha.y) * sc; hr[tt][3] = bfhi(ha.y) * sc; hr[tt][4] = bflo(ha.z) * sc; hr[tt][5] = bfhi(ha.z) * sc; hr[tt][6] = bflo(ha.w) * sc; hr[tt][7] = bfhi(ha.w) * sc;
          hr[tt][8] = bflo(hb2.x) * sc; hr[tt][9] = bfhi(hb2.x) * sc; hr[tt][10] = bflo(hb2.y) * sc; hr[tt][11] = bfhi(hb2.y) * sc; hr[tt][12] = bflo(hb2.z) * sc; hr[tt][13] = bfhi(hb2.z) * sc; hr[tt][14] = bflo(hb2.w) * sc; hr[tt][15] = bfhi(hb2.w) * sc; }
#pragma unroll
        for (int i = 0; i < 16; ++i) acc[tt][i] = 0.f;
    }
#define PEER_BATCH(tt_, k_, hi_) do { const LAS unsigned* srt = srtw + (tt_) * 256; u32x4 uu[4], vv[4]; float d_[4]; \
        _Pragma("unroll") for (int j = 0; j < 4; ++j) { const int ix = ((k_) + j < (hi_)) ? (k_) + j : (hi_) - 1; const int e = __builtin_amdgcn_readfirstlane((int)srt[ix * 2]); \
            uu[j] = *(const GAS u32x4*)(U8 + (size_t)e * 1024 + lane * 16); vv[j] = *(const GAS u32x4*)(V8 + (size_t)e * 1024 + lane * 16); } \
        _Pragma("unroll") for (int j = 0; j < 4; ++j) d_[j] = fp8dot16(uu[j], hr[tt_]); \
        float e_[2]; \
        _Pragma("unroll") for (int i = 0; i < 2; ++i) { const float keep = fsel(d_[i], d_[i + 2], m0), send = fsel(d_[i + 2], d_[i], m0); e_[i] = keep + dpp<0xB1>(send); } \
        float g_ = fsel(e_[0], e_[1], m1) + dpp<0x4E>(fsel(e_[1], e_[0], m1)); \
        g_ += dpp<0x124>(g_); g_ += dpp<0x128>(g_); g_ = swap16_sum(g_); g_ = swap32_sum(g_);     \
        const int mi = (k_) + jj; const float gate = (mi < (hi_)) ? __uint_as_float(srt[(mi < (hi_) ? mi : (hi_) - 1) * 2 + 1]) : 0.f; \
        const float cfl = gate * gelu_tanh(g_) * (1.0f / 16.0f); \
        _Pragma("unroll") for (int j = 0; j < 4; ++j) { const int src = ((j & 1) << 1) | ((j >> 1) & 1); \
            const float cj = __int_as_float(__builtin_amdgcn_readlane(__float_as_int(cfl), src)); \
            fp8axpy16(vv[j], cj, acc[tt_]); } } while (0)
#pragma unroll 1
    for (int r = 0; r < NSL; ++r) {
#pragma unroll
        for (int tt = 0; tt < 4; ++tt) {
            const int lo = __builtin_amdgcn_readfirstlane((int)offw[tt * 32 + r]), hi2 = __builtin_amdgcn_readfirstlane((int)offw[tt * 32 + r + 1]);
#pragma unroll 1
            for (int k = lo; k < hi2; k += 4) PEER_BATCH(tt, k, hi2);
        }
    }
#undef PEER_BATCH
#pragma unroll
    for (int tt = 0; tt < 4; ++tt) {
        const size_t tok = (size_t)tok0 + wid * 4 + tt; const bf16* hrow = HB + tok * 1024 + lane * 16; float* wrow = outw + tok * 1024;
        float hv[16]; float s = 0.f;
        { const u32x4 ha = *(const GAS u32x4*)hrow, hb2 = *(const GAS u32x4*)(hrow + 8);
          hv[0] = bflo(ha.x); hv[1] = bfhi(ha.x); hv[2] = bflo(ha.y); hv[3] = bfhi(ha.y); hv[4] = bflo(ha.z); hv[5] = bfhi(ha.z); hv[6] = bflo(ha.w); hv[7] = bfhi(ha.w);
          hv[8] = bflo(hb2.x); hv[9] = bfhi(hb2.x); hv[10] = bflo(hb2.y); hv[11] = bfhi(hb2.y); hv[12] = bflo(hb2.z); hv[13] = bfhi(hb2.z); hv[14] = bflo(hb2.w); hv[15] = bfhi(hb2.w); }
#pragma unroll
        for (int i = 0; i < 16; ++i) { hv[i] += acc[tt][i]; s += hv[i] * hv[i]; }
        const float rs = 1.0f / sqrtf(wave_sum(s) * (1.f / 1024.f) + RMS_EPS);
#pragma unroll
        for (int q = 0; q < 4; ++q) { const f32x4 g = *(const GAS f32x4*)(gfin + lane * 16 + q * 4); f32x4 t;
            t.x = hv[4 * q] * rs * g.x; t.y = hv[4 * q + 1] * rs * g.y; t.z = hv[4 * q + 2] * rs * g.z; t.w = hv[4 * q + 3] * rs * g.w;
            *(GAS f32x4*)(wrow + lane * 16 + q * 4) = t; }
    }
    }
    LDS_WAIT(); __syncthreads();
}
}
struct Args { const float* in[20]; float* out; unsigned char* ws; int ph_lo, ph_hi, li, pad; };
__global__ void __launch_bounds__(NWAVES * 64, 2) fwd_megakernel(Args args) {
    extern __shared__ __attribute__((aligned(16))) unsigned char lds[];
    LAS unsigned char* ldsp = (LAS unsigned char*)lds;
    volatile LAS unsigned* MISC = (volatile LAS unsigned*)(ldsp + MISC_OFF);
    const int tid = threadIdx.x, lane = tid & 63, wave = __builtin_amdgcn_readfirstlane(tid >> 6);
    const int G = gridDim.x; const int bx = blockIdx.x; const int vcu = (G % 8 == 0) ? (bx % 8) * (G / 8) + bx / 8 : bx;
    unsigned char* ws = args.ws;
    gu32* ctl = (gu32*)(ws + WS_CTL);
    const float* x = args.in[0]; const float* mem = args.in[1]; const float* norm_mix = args.in[2]; const float* w_in = args.in[3]; const float* conv_w = args.in[4];
    const float* w_ba = args.in[5]; const float* w_bc = args.in[6]; const float* w_out = args.in[7]; const float* norm_xattn = args.in[8]; const float* norm_mem = args.in[9];
    const float* xwq = args.in[10]; const float* xwk = args.in[11]; const float* xwv = args.in[12]; const float* xwo = args.in[13]; const float* norm_ffn = args.in[14];
    const float* pwq = args.in[15]; const float* psk = args.in[16]; const float* pu = args.in[17]; const float* pv = args.in[18]; const float* norm_final = args.in[19];
    float* out = args.out;
    bf16* Win_t = (bf16*)(ws + WS_WIN); bf16* Wa_t = (bf16*)(ws + WS_WA); bf16* Wc_t = (bf16*)(ws + WS_WC); bf16* Wo_t = (bf16*)(ws + WS_WO); bf16* Wq2_t = (bf16*)(ws + WS_WQ2);
    bf16* Wkv2_t = (bf16*)(ws + WS_WKV2); bf16* Wo2_t = (bf16*)(ws + WS_WO2); bf16* Wpq_t = (bf16*)(ws + WS_WPQ); bf16* SKb = (bf16*)(ws + WS_SK);
    float* SSQ1 = (float*)(ws + WS_SSQ1); float* SSQ2 = (float*)(ws + WS_SSQ2); bf16* MEMN = (bf16*)(ws + WS_MEMN); bf16* K2 = (bf16*)(ws + WS_K2); bf16* V2T = (bf16*)(ws + WS_V2T);
    bf16* B0 = (bf16*)(ws + WS_B0); bf16* B1 = (bf16*)(ws + WS_B1); bf16* B2 = (bf16*)(ws + WS_B2); bf16* B3 = (bf16*)(ws + WS_B3); bf16* B4 = (bf16*)(ws + WS_B4); bf16* B5 = (bf16*)(ws + WS_B5);
    bf16* XN1 = (bf16*)out; bf16* YC = (bf16*)out; bf16* CBb = (bf16*)((unsigned char*)out + 32 * MiB);

    for (int u = tid; u < (LDS_BYTES - LDSCTL_OFF) / 4; u += NWAVES * 64) ((LAS unsigned*)(ldsp + LDSCTL_OFF))[u] = 0u;
    __syncthreads();
    XcdBarrier bar; bar.bar = (unsigned*)(ctl + CW_BAR); bar.x = 0; bar.st = nullptr;
    if (N_LAUNCHES == 1) bar = xcd_barrier_post((unsigned*)(ctl + CW_BAR), MISC + 8);
#define GRID_BAR() do { if (N_LAUNCHES == 1) xcd_barrier(bar); } while (0)
    const int lo = args.ph_lo, hi = args.ph_hi;
#define IN(k) (lo <= (k) && (k) < hi)
#define BOTH(k) (IN(k) && IN((k) + 1))
    const int gw = vcu * NWAVES + wave, NGW = G * NWAVES;

    if (IN(0)) {
        LAS float* scr = (LAS float*)(ldsp + RING_OFF + wave * 16384);
        constexpr int I_IN = 16 * 256, I_SQ = 16 * 32, I_PQ = 16 * 64;
        constexpr int NT_ITEMS = I_IN + 7 * I_SQ + I_PQ;
        for (int it = gw; it < NT_ITEMS; it += NGW) {
            int r = it;
            if (r < I_IN) { transpose_item<true>(w_in, D, NIN, nullptr, Win_t, 0, scr, r, lane); continue; } r -= I_IN;
            if (r < I_SQ) { transpose_item<false>(w_ba, D, D, nullptr, Wa_t, 0, scr, r, lane); continue; } r -= I_SQ;
            if (r < I_SQ) { transpose_item<false>(w_bc, D, D, nullptr, Wc_t, 0, scr, r, lane); continue; } r -= I_SQ;
            if (r < I_SQ) { transpose_item<false>(w_out, D, D, nullptr, Wo_t, 0, scr, r, lane); continue; } r -= I_SQ;
            if (r < I_SQ) { transpose_item<false>(xwq, D, D, norm_xattn, Wq2_t, 0, scr, r, lane); continue; } r -= I_SQ;
            if (r < I_SQ) { transpose_item<false>(xwk, D, D, nullptr, Wkv2_t, 0, scr, r, lane); continue; } r -= I_SQ;
            if (r < I_SQ) { transpose_item<false>(xwv, D, D, nullptr, Wkv2_t, D, scr, r, lane); continue; } r -= I_SQ;
            if (r < I_SQ) { transpose_item<false>(xwo, D, D, nullptr, Wo2_t, 0, scr, r, lane); continue; } r -= I_SQ;
            transpose_item<false>(pwq, D, NPQ, norm_ffn, Wpq_t, 0, scr, r, lane);
        }
        for (int it = gw; it < 512; it += NGW) {
            const int hc = it >> 5, kt = (it >> 3) & 3, ks = it & 7, n = 32 * kt + (lane & 31), d0 = 16 * ks + 8 * (lane >> 5);
            const GAS f32x4* s = (const GAS f32x4*)(psk + ((size_t)(hc * 128 + n) * 128 + d0)); const f32x4 a = s[0], b = s[1];
            v4u o; o.x = pk2(a.x, a.y); o.y = pk2(a.z, a.w); o.z = pk2(b.x, b.y); o.w = pk2(b.z, b.w);
            *((GAS v4u*)SKb + (size_t)it * 64 + lane) = o; }
        for (int m = gw; m < M; m += 2 * NGW) rms_rows2_to_bf16(x + (size_t)m * D, (size_t)NGW, norm_mix, XN1 + (size_t)m * D, lane);
        for (int m = gw; m < MROWS; m += NGW) rms_row_to_bf16(mem + (size_t)m * D, norm_mem, MEMN + (size_t)m * D, lane);
        if (BOTH(0)) GRID_BAR();
    }

    if (IN(1)) {
        pg8::GemmSet g{XN1, Win_t, XN1, Win_t, D}; pg8::TileOrder S; S.init(M, NIN, G, bx);
        pg8::EpiInProj E{B0, B1, B2, B3, CBb, B4, B5, 0.125f * LOG2E};
        pg8::gemm_phase<pg8::EpiInProj, pg8::TileOrder, true, true>(ldsp + RING_OFF, g, S, E);
        if (BOTH(1)) GRID_BAR();
    }

    if (IN(2)) {
        {
            const int bh = vcu >> 1, s = vcu & 1;
            if (bh < BATCH * 16) {
#pragma unroll 1
                for (int i = 0; i < 4; ++i) { const int qb = (i == 0) ? s : (i == 1) ? 7 - s : (i == 2) ? 2 + s : 5 - s;
                    sb::sb_unit<true>(bh >> 4, bh & 15, qb, (const sb::bf16*)B0, (const sb::bf16*)B1, (const sb::bf16*)B2, (sb::bf16*)B0, (char*)lds + RING_OFF); }
            }
            asm volatile("s_waitcnt vmcnt(0) lgkmcnt(0)" ::: "memory"); __syncthreads();
        }
        if (vcu < 32) {
            pg8::GemmSet g{MEMN, Wkv2_t, MEMN, Wkv2_t, D}; pg8::SubOrder S; S.init(MROWS, D, 0, vcu);
            pg8::EpiStore E{K2, D, 1.0f};
            pg8::gemm_phase<pg8::EpiStore, pg8::SubOrder, false, true>(ldsp + RING_OFF, g, S, E);
        } else if (vcu < 64) {
            pg8::GemmSet g{Wkv2_t + (size_t)D * D, MEMN, Wkv2_t + (size_t)D * D, MEMN, D}; pg8::SubOrder S; S.init(D, MROWS, 32, vcu);
            pg8::EpiStoreKPerm E{V2T, MROWS};
            pg8::gemm_phase<pg8::EpiStoreKPerm, pg8::SubOrder, false, true>(ldsp + RING_OFF, g, S, E);
        } else {
            const int cw_ = (vcu - 64) * NWAVES + wave, ncw = (G - 64) * NWAVES;
            for (int it = cw_; it < M / 8; it += ncw) yconv_item(B3, CBb, conv_w, YC, it, lane);
        }
        if (BOTH(2)) GRID_BAR();
    }

    if (IN(3)) {
        pg8::GemmSet g{B0, Wa_t, YC, Wc_t, D}; pg8::TileOrder S; S.init(M, D, G, bx, 2);
        pg8::EpiGate E{B1, B4, B5};
        pg8::gemm_phase<pg8::EpiGate, pg8::TileOrder, true, true>(ldsp + RING_OFF, g, S, E);
        if (BOTH(3)) GRID_BAR();
    }

    if (IN(4)) {
        pg8::GemmSet g{B1, Wo_t, B1, Wo_t, D}; pg8::TileOrder S; S.init(M, D, G, bx);
        pg8::EpiResid<false> E{x, nullptr, B2, SSQ1};
        pg8::gemm_phase<pg8::EpiResid<false>, pg8::TileOrder, true, true>(ldsp + RING_OFF, g, S, E);
        if (BOTH(4)) GRID_BAR();
    }

    if (IN(5)) {
        pg8::GemmSet g{B2, Wq2_t, B2, Wq2_t, D}; pg8::TileOrder S; S.init(M, D, G, bx);
        pg8::EpiRowScale E{B3, D, SSQ1, LOG2E / 16.0f, RMS_EPS};
        pg8::gemm_phase<pg8::EpiRowScale, pg8::TileOrder, true, true>(ldsp + RING_OFF, g, S, E);
        for (int r = gw; r < 16384; r += 4 * NGW) rows4_to_fp8(pu + (size_t)r * D, (size_t)NGW, norm_ffn, 256.0f, (unsigned char*)B4 + (size_t)r * D, lane);
        for (int r = gw; r < 16384; r += 4 * NGW) rows4_to_fp8(pv + (size_t)r * D, (size_t)NGW, nullptr, 16.0f, (unsigned char*)B4 + 16 * MiB + (size_t)r * D, lane);
        if (BOTH(5)) GRID_BAR();
    }

    if (IN(6)) {
#ifndef NO_XA
        for (int u = 2 * vcu; u < 512; u += 2 * G) { xa::xattn_unit(u >> 6, (u >> 4) & 3, u & 15, B3, K2, V2T, B0, (char*)lds + RING_OFF); xa::xattn_unit(u >> 6, (u >> 4) & 3, (u & 15) + 1, B3, K2, V2T, B0, (char*)lds + RING_OFF); }
        asm volatile("s_waitcnt vmcnt(0) lgkmcnt(0)" ::: "memory"); __syncthreads();
#endif
        if (BOTH(6)) GRID_BAR();
    }

    if (IN(7)) {
        pg8::GemmSet g{B0, Wo2_t, B0, Wo2_t, D}; pg8::TileOrder S; S.init(M, D, G, bx);
        pg8::EpiResid<true> E{nullptr, B2, B1, SSQ2};
        pg8::gemm_phase<pg8::EpiResid<true>, pg8::TileOrder, true, true>(ldsp + RING_OFF, g, S, E);
        if (BOTH(7)) GRID_BAR();
    }

    if (IN(8)) {
        pg8::GemmSet g{B1, Wpq_t, B1, Wpq_t, D}; pg8::TileOrder S; S.init(M, NPQ, G, bx);
        pg8::EpiRowScale E{B2, NPQ, SSQ2, 1.0f, RMS_EPS};
        pg8::gemm_phase<pg8::EpiRowScale, pg8::TileOrder, true, true>(ldsp + RING_OFF, g, S, E);
        if (BOTH(8)) GRID_BAR();
    }

    if (IN(9)) {
        if (tid < 64) { int cnt = 0, val = 0;
            for (int ii = 0; ii < 16; ++ii) { const int nj = 16 / (ii + 1); if (tid >= cnt && tid < cnt + nj) val = ii | ((tid - cnt) << 4); cnt += nj; }
            ldsp[RING_OFF + peer::L_CAND + tid] = (unsigned char)val; }
        LDS_WAIT(); __syncthreads();
#ifndef NO_PEER
        for (int tile = vcu; tile < M / 32; tile += G) {
#ifdef PROBE_P9
            peer::peer_tile(tile, B2, SKb, SSQ2, (const unsigned char*)B4, (const unsigned char*)B4 + 16 * MiB, norm_final, B1, out, ldsp + RING_OFF, PROBE_P9, (float*)B0);
#endif
            peer::peer_tile(tile, B2, SKb, SSQ2, (const unsigned char*)B4, (const unsigned char*)B4 + 16 * MiB, norm_final, B1, out, ldsp + RING_OFF); }
#else
        for (int m = gw; m < M; m += NGW) final_norm_row(out + (size_t)m * D, norm_final, out + (size_t)m * D, lane);
#endif
    }
#undef IN
#undef BOTH
#undef GRID_BAR
}

extern "C" void kernel_launch(void* const* d_in, const int* in_sizes, int n_in, void* d_out, int out_size, void* d_ws, size_t ws_size, hipStream_t stream) {
    static int grid = 0;
    if (grid == 0) {
        if (n_in != 20 || in_sizes[0] != M * D || out_size != M * D || ws_size < WS_END) { fprintf(stderr, "kernel_launch: unexpected shapes (n_in %d, in0 %d, out %d, ws %zu); nothing launched\n", n_in, n_in > 0 ? in_sizes[0] : -1, out_size, ws_size); grid = -1; return; }
        int dev = 0, cus = 0, per_cu = 0;
        if (hipGetDevice(&dev) != hipSuccess || hipDeviceGetAttribute(&cus, hipDeviceAttributeMultiprocessorCount, dev) != hipSuccess) { grid = -1; return; }
        if (hipFuncSetAttribute((const void*)fwd_megakernel, hipFuncAttributeMaxDynamicSharedMemorySize, LDS_BYTES) != hipSuccess) { fprintf(stderr, "kernel_launch: hipFuncSetAttribute failed\n"); grid = -1; return; }
        if (hipOccupancyMaxActiveBlocksPerMultiprocessor(&per_cu, (const void*)fwd_megakernel, NWAVES * 64, LDS_BYTES) != hipSuccess || per_cu < 1)
            fprintf(stderr, "kernel_launch: note: occupancy query reports %d workgroups per CU\n", per_cu);
        (void)hipGetLastError();
        grid = cus;
    }
    if (grid < 0) return;
    if (hipMemsetAsync((char*)d_ws + WS_CTL, 0, CTL_ZERO_BYTES, stream) != hipSuccess) { fprintf(stderr, "kernel_launch: hipMemsetAsync failed\n"); return; }
    Args a{};
    for (int i = 0; i < 20; ++i) a.in[i] = (const float*)d_in[i];
    a.out = (float*)d_out; a.ws = (unsigned char*)d_ws;
    if (N_LAUNCHES == 1) { a.ph_lo = 0; a.ph_hi = N_PHASES; a.li = 0; hipLaunchKernelGGL(fwd_megakernel, dim3(grid), dim3(NWAVES * 64), LDS_BYTES, stream, a); }
    else for (int li = 0; li < N_PHASES; ++li) { a.ph_lo = li; a.ph_hi = li + 1; a.li = li; hipLaunchKernelGGL(fwd_megakernel, dim3(grid), dim3(NWAVES * 64), LDS_BYTES, stream, a);
#ifdef PROBE_DUP
        if (li == PROBE_DUP) hipLaunchKernelGGL(fwd_megakernel, dim3(grid), dim3(NWAVES * 64), LDS_BYTES, stream, a);
#endif
    }
    const hipError_t le = hipPeekAtLastError();
    if (le != hipSuccess) fprintf(stderr, "kernel_launch: launch failed: %s\n", hipGetErrorName(le));
}
```

```cpp
#include <hip/hip_runtime.h>
#include <hip/hip_bf16.h>
#include <cstdio>
#include <cstdint>
#include <cmath>

#ifndef MK_N_LAUNCHES
#define MK_N_LAUNCHES 1
#endif
namespace pg8 {
#define PG8_LAS __attribute__((address_space(3)))
typedef unsigned short bf16_t;
typedef short bf16x8 __attribute__((ext_vector_type(8)));
typedef float f32x4 __attribute__((ext_vector_type(4)));
typedef float f32x2 __attribute__((ext_vector_type(2)));
typedef unsigned u32x4 __attribute__((ext_vector_type(4)));
typedef unsigned u32x2 __attribute__((ext_vector_type(2)));
constexpr int BM = 256, BK = 64, HALF = 128, HTB = HALF * BK * 2  , STAGE_BYTES = 8 * HTB, NXCD = 8, WGM = 8;

__host__ __device__ __forceinline__ int lds_byte(int r, int c) { const int st = (r >> 4) * 2 + (c >> 5), rr = r & 15, cc = c & 31, ob = rr * 64 + cc * 2; return st * 1024 + (ob ^ (((ob >> 9) & 1) << 5)); }
__host__ __device__ __forceinline__ void stage_rc(int b, int& R, int& C) { const int st = b / 1024, sb = b % 1024, swz = sb ^ (((sb >> 9) & 1) << 5); R = (st >> 1) * 16 + swz / 64; C = (st & 1) * 32 + (swz % 64) / 2; }
__host__ __device__ __forceinline__ int perm32(int rho) { const int n = rho >> 4, i = rho & 15; return 8 * (i >> 2) + 4 * n + (i & 3); }

struct Unit { int pm, pn, g; };
struct GemmSet { const bf16_t* A0; const bf16_t* B0; const bf16_t* A1; const bf16_t* B1; int K; };

struct TileOrder {
    int nM, nN, nwg, G, c, passes;
    __device__ void init(int M, int N, int G_, int c_, int passes_ = 1) { nM = M / BM; nN = N / BM; nwg = nM * nN; G = G_; c = c_; passes = passes_; }
    __device__ bool next(int i, Unit& u) const {
        const int ti = (passes == 2) ? (i >> 1) : i; u.g = (passes == 2) ? (i & 1) : 0;
        const long L = (long)ti * G + c; if (L >= nwg) return false;
        int wgid = (int)L; { const int q = nwg / NXCD, r = nwg % NXCD, xcd = wgid % NXCD, off = wgid / NXCD; wgid = (xcd < r ? xcd * (q + 1) : r * (q + 1) + (xcd - r) * q) + off; }
        const int nig = WGM * nN, gid = wgid / nig, fm = gid * WGM, gsz = (nM - fm) < WGM ? (nM - fm) : WGM;
        u.pm = fm + ((wgid % nig) % gsz); u.pn = (wgid % nig) / gsz; return true;
    }
    __device__ __forceinline__ void a_ready(const Unit&) const {}
    __device__ __forceinline__ void done(const Unit&) const {}
};
struct SubOrder {
    int nN, n, idx;
    __device__ void init(int M, int N, int c0, int c_) { nN = N / BM; n = (M / BM) * nN; idx = c_ - c0; }
    __device__ bool next(int i, Unit& u) const { if (i != 0 || idx < 0 || idx >= n) return false; u.pm = idx / nN; u.pn = idx % nN; u.g = 0; return true; }
    __device__ __forceinline__ void a_ready(const Unit&) const {}
    __device__ __forceinline__ void done(const Unit&) const {}
};

typedef __bf16 bf16x2_t __attribute__((ext_vector_type(2)));
__device__ __forceinline__ unsigned cvt_pk_bf16(float lo, float hi) { f32x2 v = {lo, hi}; bf16x2_t b = __builtin_convertvector(v, bf16x2_t); return __builtin_bit_cast(unsigned, b); }
__device__ __forceinline__ float bf_lo(unsigned w) { return __builtin_bit_cast(float, w << 16); }
__device__ __forceinline__ float bf_hi(unsigned w) { return __builtin_bit_cast(float, w & 0xffff0000u); }
__device__ __forceinline__ u32x4 pack8(const f32x4 v0, const f32x4 v1) { u32x4 w; w.x = cvt_pk_bf16(v0[0], v0[1]); w.y = cvt_pk_bf16(v0[2], v0[3]); w.z = cvt_pk_bf16(v1[0], v1[1]); w.w = cvt_pk_bf16(v1[2], v1[3]); return w; }
__device__ __forceinline__ float sigmoidf_fast(float x) { return __builtin_amdgcn_rcpf(1.0f + __builtin_amdgcn_exp2f(-1.4426950408889634f * x)); }

struct EpiStore {
    static constexpr bool PERM = true, AFTER_DRAIN = false;
    bf16_t* O; int ldc; float scale;
    __device__ __forceinline__ void operator()(const f32x4 (&acc)[2][2][4][2], const Unit& u, int wr, int wc, int fr, int fq) const {
        const int row0 = u.pm * BM + wr * 64 + fr, col0 = u.pn * BM + wc * 32 + 8 * fq;
#pragma unroll
        for (int ai = 0; ai < 2; ++ai)
#pragma unroll
            for (int m = 0; m < 4; ++m) { bf16_t* rowp = O + (size_t)(row0 + ai * HALF + m * 16) * ldc + col0;
#pragma unroll
                for (int bj = 0; bj < 2; ++bj) *(u32x4*)(rowp + bj * HALF) = pack8(acc[ai][bj][m][0] * scale, acc[ai][bj][m][1] * scale); }
    }
};

struct EpiStoreKPerm {
    static constexpr bool PERM = true, AFTER_DRAIN = false;
    bf16_t* O; int ldc;
    __device__ __forceinline__ void operator()(const f32x4 (&acc)[2][2][4][2], const Unit& u, int wr, int wc, int fr, int fq) const {
        const int row0 = u.pm * BM + wr * 64 + fr, colg = u.pn * BM + wc * 32;
#pragma unroll
        for (int ai = 0; ai < 2; ++ai)
#pragma unroll
            for (int m = 0; m < 4; ++m) { bf16_t* rowp = O + (size_t)(row0 + ai * HALF + m * 16) * ldc + colg;
#pragma unroll
                for (int bj = 0; bj < 2; ++bj)
#pragma unroll
                    for (int n = 0; n < 2; ++n) { const f32x4 v = acc[ai][bj][m][n]; u32x2 w; w.x = cvt_pk_bf16(v[0], v[1]); w.y = cvt_pk_bf16(v[2], v[3]);
                        *(u32x2*)(rowp + bj * HALF + 8 * ((2 * fq + n) & 3) + 4 * (fq >> 1)) = w; } }
    }
};

struct EpiInProj {
    static constexpr bool PERM = true, AFTER_DRAIN = false;
    bf16_t *q, *k, *v, *uu, *cb, *sga, *sgc; float qscale;
    __device__ __forceinline__ void operator()(const f32x4 (&acc)[2][2][4][2], const Unit& u, int wr, int wc, int fr, int fq) const {
        const int row0 = u.pm * BM + wr * 64 + fr; const int pn = u.pn;
        if (pn >= 12 && pn < 20) {
            const int col0 = (pn - 12) * 128 + wc * 32 + 8 * fq;
#pragma unroll
            for (int ai = 0; ai < 2; ++ai)
#pragma unroll
                for (int m = 0; m < 4; ++m) *(u32x4*)(uu + (size_t)(row0 + ai * HALF + m * 16) * 1024 + col0) = pack8(acc[ai][0][m][0] * acc[ai][1][m][0], acc[ai][0][m][1] * acc[ai][1][m][1]);
            return;
        }
        bf16_t* base; float sc = 1.f; bool sig = false;
        if (pn < 4) { base = q; sc = qscale; } else if (pn < 8) base = k; else if (pn < 12) base = v; else if (pn < 24) base = cb; else if (pn < 28) { base = sga; sig = true; } else { base = sgc; sig = true; }
        const int col0 = (pn & 3) * BM + wc * 32 + 8 * fq;
#pragma unroll
        for (int ai = 0; ai < 2; ++ai)
#pragma unroll
            for (int m = 0; m < 4; ++m) { bf16_t* rowp = base + (size_t)(row0 + ai * HALF + m * 16) * 1024 + col0;
#pragma unroll
                for (int bj = 0; bj < 2; ++bj) { f32x4 v0 = acc[ai][bj][m][0], v1 = acc[ai][bj][m][1];
                    if (sig) {
#pragma unroll
                        for (int e = 0; e < 4; ++e) { v0[e] = sigmoidf_fast(v0[e]); v1[e] = sigmoidf_fast(v1[e]); } }
                    else { v0 = v0 * sc; v1 = v1 * sc; }
                    *(u32x4*)(rowp + bj * HALF) = pack8(v0, v1); } }
    }
};

struct EpiGate {
    static constexpr bool PERM = true, AFTER_DRAIN = false;
    bf16_t* merged; const bf16_t* sga; const bf16_t* sgc;
    __device__ __forceinline__ void operator()(const f32x4 (&acc)[2][2][4][2], const Unit& u, int wr, int wc, int fr, int fq) const {
        const int row0 = u.pm * BM + wr * 64 + fr, col0 = u.pn * BM + wc * 32 + 8 * fq; const bf16_t* gate = u.g ? sgc : sga;
#pragma unroll
        for (int ai = 0; ai < 2; ++ai)
#pragma unroll
            for (int m = 0; m < 4; ++m) { const size_t off = (size_t)(row0 + ai * HALF + m * 16) * 1024 + col0;
#pragma unroll
                for (int bj = 0; bj < 2; ++bj) { const u32x4 gw = *(const u32x4*)(gate + off + bj * HALF);
                    f32x4 v0 = acc[ai][bj][m][0], v1 = acc[ai][bj][m][1];
                    v0[0] *= bf_lo(gw.x); v0[1] *= bf_hi(gw.x); v0[2] *= bf_lo(gw.y); v0[3] *= bf_hi(gw.y); v1[0] *= bf_lo(gw.z); v1[1] *= bf_hi(gw.z); v1[2] *= bf_lo(gw.w); v1[3] *= bf_hi(gw.w);
                    if (u.g) { const u32x4 pw = *(const u32x4*)(merged + off + bj * HALF);
                        v0[0] += bf_lo(pw.x); v0[1] += bf_hi(pw.x); v0[2] += bf_lo(pw.y); v0[3] += bf_hi(pw.y); v1[0] += bf_lo(pw.z); v1[1] += bf_hi(pw.z); v1[2] += bf_lo(pw.w); v1[3] += bf_hi(pw.w); }
                    *(u32x4*)(merged + off + bj * HALF) = pack8(v0, v1); } }
    }
};

template <bool BASE_BF16> struct EpiResid {
    static constexpr bool PERM = false, AFTER_DRAIN = false;
    const float* basef; const bf16_t* baseb; bf16_t* hb; float* ssq;
    __device__ __forceinline__ void operator()(const f32x4 (&acc)[2][2][4][2], const Unit& u, int wr, int wc, int fr, int fq) const {
        const int row0 = u.pm * BM + wr * 64 + fr, col0 = u.pn * BM + wc * 32 + 4 * fq;
#pragma unroll
        for (int ai = 0; ai < 2; ++ai)
#pragma unroll
            for (int m = 0; m < 4; ++m) { const int row = row0 + ai * HALF + m * 16; const size_t off = (size_t)row * 1024 + col0; float s = 0.f;
#pragma unroll
                for (int bj = 0; bj < 2; ++bj)
#pragma unroll
                    for (int n = 0; n < 2; ++n) { f32x4 b;
                        if (BASE_BF16) { const u32x2 w = *(const u32x2*)(baseb + off + bj * HALF + n * 16); b = (f32x4){bf_lo(w.x), bf_hi(w.x), bf_lo(w.y), bf_hi(w.y)}; }
                        else b = *(const f32x4*)(basef + off + bj * HALF + n * 16);
                        const f32x4 h = b + acc[ai][bj][m][n];
                        s += (h[0] * h[0] + h[1] * h[1]) + (h[2] * h[2] + h[3] * h[3]);
                        u32x2 w; w.x = cvt_pk_bf16(h[0], h[1]); w.y = cvt_pk_bf16(h[2], h[3]); *(u32x2*)(hb + off + bj * HALF + n * 16) = w; }
                s += __shfl_xor(s, 16); s += __shfl_xor(s, 32);
                if (fq == 0) ssq[(size_t)row * 16 + u.pn * 4 + wc] = s; }
    }
};

struct EpiRowScale {
    static constexpr bool PERM = true, AFTER_DRAIN = false;
    bf16_t* O; int ldc; const float* ssq; float scale; float eps;
    __device__ __forceinline__ void operator()(const f32x4 (&acc)[2][2][4][2], const Unit& u, int wr, int wc, int fr, int fq) const {
        const int row0 = u.pm * BM + wr * 64 + fr, col0 = u.pn * BM + wc * 32 + 8 * fq;
#pragma unroll
        for (int ai = 0; ai < 2; ++ai)
#pragma unroll
            for (int m = 0; m < 4; ++m) { const int row = row0 + ai * HALF + m * 16; const f32x4* sp = (const f32x4*)(ssq + (size_t)row * 16);
                const f32x4 a = sp[0], b = sp[1], c = sp[2], d = sp[3]; const f32x4 t = (a + b) + (c + d);
                const float rs = __builtin_amdgcn_rsqf(((t[0] + t[1]) + (t[2] + t[3])) * (1.0f / 1024.0f) + eps) * scale;
                bf16_t* rowp = O + (size_t)row * ldc + col0;
#pragma unroll
                for (int bj = 0; bj < 2; ++bj) *(u32x4*)(rowp + bj * HALF) = pack8(acc[ai][bj][m][0] * rs, acc[ai][bj][m][1] * rs); }
    }
};

template <class Epi, class Sched, bool ALIGN_EPI = false, bool SP2 = false>
__device__ __forceinline__ void gemm_phase(PG8_LAS unsigned char* lds, const GemmSet g, const Sched& S, const Epi& E) {
    const int tid = threadIdx.x, wid = __builtin_amdgcn_readfirstlane(tid >> 6), lane = tid & 63, wr = wid >> 2, wc = wid & 3, fr = lane & 15, fq = lane >> 4;
    const int K = g.K, nt = K / BK;
    unsigned voffA[2], voffB[2];
#pragma unroll
    for (int i = 0; i < 2; ++i) { int R, C; stage_rc(tid * 16 + i * 8192, R, C); const int Rb = Epi::PERM ? ((R & ~31) + perm32(R & 31)) : R;
        voffA[i] = (unsigned)(R * K + C) * 2u; voffB[i] = (unsigned)(Rb * K + C) * 2u; }
    const size_t kstep = (size_t)(BK * 2);
    const size_t hstep = (size_t)HALF * K * 2;
    const size_t tstep = 2 * hstep;
    const unsigned ldsw = (unsigned)wid * 1024u;
    const int aoff = lds_byte(wr * 64 + fr, fq * 8), boff = lds_byte(wc * 32 + fr, fq * 8);
#define PG8_SA(b, h) (((b) * 2 + (h)) * HTB)
#define PG8_SB(b, h) ((4 + (b) * 2 + (h)) * HTB)
#define PG8_STAGE(bufoff, gbase, voff) do { _Pragma("unroll") for (int _i = 0; _i < 2; ++_i) \
        __builtin_amdgcn_global_load_lds((const unsigned*)((const char*)(gbase) + (voff)[_i]), (PG8_LAS unsigned*)(lds + (bufoff) + ldsw + _i * 8192), 16, 0, 0); } while (0)
#define PG8_LDA(dst, b, h) do { _Pragma("unroll") for (int m = 0; m < 4; ++m) _Pragma("unroll") for (int k = 0; k < 2; ++k) dst[m][k] = *(const PG8_LAS bf16x8*)(lds + PG8_SA(b, h) + aoff + m * 2048 + k * 1024); } while (0)
#define PG8_LDB(dst, b, h) do { _Pragma("unroll") for (int n = 0; n < 2; ++n) _Pragma("unroll") for (int k = 0; k < 2; ++k) dst[n][k] = *(const PG8_LAS bf16x8*)(lds + PG8_SB(b, h) + boff + n * 2048 + k * 1024); } while (0)
#define PG8_MMA(ai, bj, At, Bt) do { __builtin_amdgcn_s_setprio(1); _Pragma("unroll") for (int m = 0; m < 4; ++m) _Pragma("unroll") for (int n = 0; n < 2; ++n) _Pragma("unroll") for (int k = 0; k < 2; ++k) \
        acc[ai][bj][m][n] = __builtin_amdgcn_mfma_f32_16x16x32_bf16(Bt[n][k], At[m][k], acc[ai][bj][m][n], 0, 0, 0); __builtin_amdgcn_s_setprio(0); } while (0)
#define PG8_WAIT_V(n) asm volatile("s_waitcnt vmcnt(" #n ")" ::: "memory")
#define PG8_WAIT_L(n) asm volatile("s_waitcnt lgkmcnt(" #n ")" ::: "memory")
#define PG8_BAR __builtin_amdgcn_s_barrier()
#define PG8_SCHED __builtin_amdgcn_sched_barrier(0)
    Unit cur, nxt; int ui = 0;
    if (!S.next(0, cur)) return;
    f32x4 acc[2][2][4][2];
#pragma unroll
    for (int a = 0; a < 2; ++a)
#pragma unroll
        for (int b = 0; b < 2; ++b)
#pragma unroll
            for (int m = 0; m < 4; ++m)
#pragma unroll
                for (int n = 0; n < 2; ++n) acc[a][b][m][n] = (f32x4){0.f, 0.f, 0.f, 0.f};
    bf16x8 At[4][2], B0[2][2], B1[2][2];
    const char* cA = (const char*)(cur.g ? g.A1 : g.A0) + (size_t)cur.pm * tstep; const char* cB = (const char*)(cur.g ? g.B1 : g.B0) + (size_t)cur.pn * tstep;
    S.a_ready(cur);
    if constexpr (SP2) {
        PG8_STAGE(PG8_SB(0, 0), cB, voffB); PG8_STAGE(PG8_SB(0, 1), cB + hstep, voffB); PG8_STAGE(PG8_SA(0, 0), cA, voffA); PG8_STAGE(PG8_SA(0, 1), cA + hstep, voffA);
        if (wr == 1) PG8_BAR;
        PG8_WAIT_V(2); PG8_BAR;
        PG8_STAGE(PG8_SB(1, 0), cB + kstep, voffB); PG8_STAGE(PG8_SA(1, 0), cA + kstep, voffA); PG8_STAGE(PG8_SB(1, 1), cB + hstep + kstep, voffB);
        PG8_WAIT_V(6); PG8_BAR;
    } else {
        PG8_STAGE(PG8_SB(0, 0), cB, voffB); PG8_STAGE(PG8_SA(0, 0), cA, voffA); PG8_STAGE(PG8_SB(0, 1), cB + hstep, voffB); PG8_STAGE(PG8_SA(0, 1), cA + hstep, voffA);
        if (wr == 1) PG8_BAR;
        PG8_WAIT_V(4); PG8_BAR;
        PG8_STAGE(PG8_SB(1, 0), cB + kstep, voffB); PG8_STAGE(PG8_SA(1, 0), cA + kstep, voffA); PG8_STAGE(PG8_SB(1, 1), cB + hstep + kstep, voffB);
        PG8_WAIT_V(6); PG8_BAR;
    }
    for (;;) {
        const bool has_next = S.next(ui + 1, nxt);
        const char* nA = has_next ? (const char*)(nxt.g ? g.A1 : g.A0) + (size_t)nxt.pm * tstep : cA; const char* nB = has_next ? (const char*)(nxt.g ? g.B1 : g.B0) + (size_t)nxt.pn * tstep : cB;
        for (int t = 0; t < nt; t += 2) {
            const bool last = (t == nt - 2);
            const char* a1 = cA + (size_t)(t + 1) * kstep;
            const char* a2 = last ? nA : cA + (size_t)(t + 2) * kstep; const char* b2 = last ? nB : cB + (size_t)(t + 2) * kstep;
            const char* a3 = a2 + kstep; const char* b3 = b2 + kstep;
            if (last && has_next) S.a_ready(nxt);
            if constexpr (SP2) {
            PG8_LDB(B0, 0, 0); PG8_LDB(B1, 0, 1); PG8_SCHED; PG8_LDA(At, 0, 0); PG8_STAGE(PG8_SA(1, 1), a1 + hstep, voffA);
            PG8_WAIT_V(8); PG8_WAIT_L(0); PG8_BAR; PG8_MMA(0, 0, At, B0); PG8_MMA(0, 1, At, B1); PG8_BAR; PG8_SCHED;
            PG8_LDA(At, 0, 1); PG8_STAGE(PG8_SB(0, 0), b2, voffB); PG8_STAGE(PG8_SB(0, 1), b2 + hstep, voffB); PG8_STAGE(PG8_SA(0, 0), a2, voffA);
            PG8_WAIT_V(8); PG8_WAIT_L(0); PG8_BAR; PG8_MMA(1, 0, At, B0); PG8_MMA(1, 1, At, B1); PG8_BAR; PG8_SCHED;
            PG8_LDB(B0, 1, 0); PG8_LDB(B1, 1, 1); PG8_SCHED; PG8_LDA(At, 1, 0); PG8_STAGE(PG8_SA(0, 1), a2 + hstep, voffA);
            PG8_WAIT_V(8); PG8_WAIT_L(0); PG8_BAR; PG8_MMA(0, 0, At, B0); PG8_MMA(0, 1, At, B1); PG8_BAR; PG8_SCHED;
            PG8_LDA(At, 1, 1); PG8_STAGE(PG8_SB(1, 0), b3, voffB); PG8_STAGE(PG8_SB(1, 1), b3 + hstep, voffB); PG8_STAGE(PG8_SA(1, 0), a3, voffA);
            PG8_WAIT_V(8); PG8_WAIT_L(0); PG8_BAR; PG8_MMA(1, 0, At, B0); PG8_MMA(1, 1, At, B1); PG8_BAR; PG8_SCHED;
            } else {
            PG8_LDB(B0, 0, 0); PG8_SCHED; PG8_LDA(At, 0, 0); PG8_STAGE(PG8_SA(1, 1), a1 + hstep, voffA);
            PG8_WAIT_L(8); PG8_BAR; PG8_WAIT_L(0); PG8_MMA(0, 0, At, B0); PG8_BAR; PG8_SCHED;
            PG8_LDB(B1, 0, 1); PG8_STAGE(PG8_SB(0, 0), b2, voffB);
            PG8_BAR; PG8_WAIT_L(0); PG8_MMA(0, 1, At, B1); PG8_BAR;
            PG8_LDA(At, 0, 1); PG8_STAGE(PG8_SA(0, 0), a2, voffA);
            PG8_BAR; PG8_WAIT_L(0); PG8_MMA(1, 0, At, B0); PG8_BAR; PG8_SCHED;
            PG8_STAGE(PG8_SB(0, 1), b2 + hstep, voffB);
            PG8_WAIT_V(6); PG8_BAR; PG8_MMA(1, 1, At, B1); PG8_BAR;
            PG8_LDB(B0, 1, 0); PG8_SCHED; PG8_LDA(At, 1, 0); PG8_STAGE(PG8_SA(0, 1), a2 + hstep, voffA);
            PG8_WAIT_L(8); PG8_BAR; PG8_WAIT_L(0); PG8_MMA(0, 0, At, B0); PG8_BAR; PG8_SCHED;
            PG8_LDB(B1, 1, 1); PG8_STAGE(PG8_SB(1, 0), b3, voffB);
            PG8_BAR; PG8_WAIT_L(0); PG8_MMA(0, 1, At, B1); PG8_BAR;
            PG8_LDA(At, 1, 1); PG8_STAGE(PG8_SA(1, 0), a3, voffA);
            PG8_BAR; PG8_WAIT_L(0); PG8_MMA(1, 0, At, B0); PG8_BAR; PG8_SCHED;
            PG8_STAGE(PG8_SB(1, 1), b3 + hstep, voffB);
            PG8_WAIT_V(6); PG8_BAR; PG8_MMA(1, 1, At, B1); PG8_BAR;
            }
        }
        if constexpr (ALIGN_EPI) { if (wr == 0) PG8_BAR; }
        if constexpr (!Epi::AFTER_DRAIN) { E(acc, cur, wr, wc, fr, fq); S.done(cur); }
        if (!has_next) break;
#pragma unroll
        for (int a = 0; a < 2; ++a)
#pragma unroll
            for (int b = 0; b < 2; ++b)
#pragma unroll
                for (int m = 0; m < 4; ++m)
#pragma unroll
                    for (int n = 0; n < 2; ++n) acc[a][b][m][n] = (f32x4){0.f, 0.f, 0.f, 0.f};
        cur = nxt; cA = nA; cB = nB; ++ui;
        if constexpr (ALIGN_EPI) { if (wr == 1) PG8_BAR; }
    }
    PG8_WAIT_V(0);
    if constexpr (!ALIGN_EPI) { if (wr == 0) PG8_BAR; }
    PG8_BAR;
    if constexpr (Epi::AFTER_DRAIN) { E.fused(acc, cur, wr, wc, fr, fq, lds, wid, lane); S.done(cur); }
#undef PG8_SA
#undef PG8_SB
#undef PG8_STAGE
#undef PG8_LDA
#undef PG8_LDB
#undef PG8_MMA
#undef PG8_WAIT_V
#undef PG8_WAIT_L
#undef PG8_BAR
#undef PG8_SCHED
}
}

namespace sb {
using bf16 = __hip_bfloat16;
using bf16x8 = __attribute__((ext_vector_type(8))) short;
using s16x4 = __attribute__((ext_vector_type(4))) short;
using f32x16 = __attribute__((ext_vector_type(16))) float;
using u32x4 = __attribute__((ext_vector_type(4))) unsigned;
constexpr int SEQ = 2048, NHEAD = 16, HD = 64, DM = 1024;
constexpr int SLOTB = 8192, LDS_K = 0, LDS_V = 2 * SLOTB, LDS_FLAG = 4 * SLOTB, LDS_OST = 4 * SLOTB + 4096, LDS_BYTES = LDS_OST + 8 * 4096;
constexpr float EXIT_THR = -40.0f;
__device__ __forceinline__ int crow(int r, int hi) { return (r & 3) + 8 * (r >> 2) + 4 * hi; }
__device__ __forceinline__ void glds16(const void* gsrc, unsigned lds_dst) { unsigned keep;
    asm volatile("s_mov_b32 %0, m0\n\ts_mov_b32 m0, %2\n\ts_nop 0\n\tglobal_load_lds_dwordx4 %1, off\n\ts_mov_b32 m0, %0" : "=&s"(keep) : "v"(gsrc), "s"(lds_dst) : "memory"); }
typedef __attribute__((address_space(3))) const char* lds_cptr;
typedef short v4i16_t __attribute__((ext_vector_type(4)));
typedef float f32x2_t __attribute__((ext_vector_type(2))); typedef __bf16 bf16x2_t __attribute__((ext_vector_type(2)));
__device__ __forceinline__ unsigned cvtpk(float lo, float hi) { f32x2_t v = {lo, hi}; bf16x2_t b = __builtin_convertvector(v, bf16x2_t); return __builtin_bit_cast(unsigned, b); }
__device__ __forceinline__ s16x4 vtr(lds_cptr p) { return __builtin_bit_cast(s16x4, __builtin_amdgcn_ds_read_tr16_b64_v4i16((__attribute__((address_space(3))) v4i16_t*)p)); }
__device__ __forceinline__ bf16x8 pack8(const f32x16& p, int b) { u32x4 w; w.x = cvtpk(p[b], p[b + 1]); w.y = cvtpk(p[b + 2], p[b + 3]); w.z = cvtpk(p[b + 4], p[b + 5]); w.w = cvtpk(p[b + 6], p[b + 7]); return __builtin_bit_cast(bf16x8, w); }
__device__ __forceinline__ float lo_lane(float x) { auto rr = __builtin_amdgcn_permlane32_swap(__float_as_uint(x), __float_as_uint(x), false, false); return __uint_as_float(rr[0]); }
#define SB_WAIT_BAR() asm volatile("s_waitcnt vmcnt(0) lgkmcnt(0)\n\ts_barrier" ::: "memory")

template <bool EARLY> __device__ __forceinline__ void sb_unit(int b, int h, int qb, const bf16* Q, const bf16* __restrict__ K, const bf16* __restrict__ V, bf16* O, char* shm) {
    const int tid = threadIdx.x, lane = tid & 63, r32 = lane & 31, hi = lane >> 5; const int wid = __builtin_amdgcn_readfirstlane(tid >> 6);
    const long rowbase = (long)b * SEQ; const int q0 = qb * 256;
    const bf16* Qw = Q + (rowbase + q0 + wid * 32) * DM + h * HD;
    const bf16* Kh = K + rowbase * DM + h * HD; const bf16* Vh = V + rowbase * DM + h * HD;
    const unsigned lds0 = (unsigned)(uintptr_t)shm;
    const bf16* ksrc = Kh + (long)lane * DM + wid * 8;
    const bf16* vsrc = Vh + (long)(16 * (wid & 3) + (lane >> 2)) * DM + (wid >> 2) * 32 + (lane & 3) * 8;
    const unsigned kdst = lds0 + LDS_K + wid * 1024, vdst = lds0 + LDS_V + wid * 1024;
#define SB_DMA_K(t, slot) glds16(ksrc + (long)(t) * 64 * DM, (unsigned)__builtin_amdgcn_readfirstlane(kdst + (slot)))
#define SB_DMA_V(t, slot) glds16(vsrc + (long)(t) * 64 * DM, (unsigned)__builtin_amdgcn_readfirstlane(vdst + (slot)))
    const lds_cptr shm3 = (lds_cptr)shm; const lds_cptr kp0 = shm3 + LDS_K + hi * 1024 + r32 * 16;
    const lds_cptr vp0 = shm3 + LDS_V + ((lane >> 4) & 1) * 32 + (lane & 3) * 8 + (4 * hi + ((lane & 15) >> 2)) * 64;
    const int NT = (q0 + 256) / 64;
    volatile __attribute__((address_space(3))) unsigned* flags = (volatile __attribute__((address_space(3))) unsigned*)(shm3 + LDS_FLAG);
    if (EARLY && lane == 0) flags[wid] = 0u;
    bool wdone = false;
    SB_DMA_K(NT - 1, 0); SB_DMA_V(NT - 1, 0);
    bf16x8 qr[4];
#pragma unroll
    for (int d0 = 0; d0 < 4; ++d0) qr[d0] = *reinterpret_cast<const bf16x8*>(&Qw[(long)r32 * DM + d0 * 16 + hi * 8]);
    bf16x8 tri[2], ones;
#pragma unroll
    for (int ks = 0; ks < 2; ++ks)
#pragma unroll
        for (int j = 0; j < 8; ++j) { const int kk = 16 * ks + 8 * (j >> 2) + 4 * hi + (j & 3); tri[ks][j] = (kk >= r32) ? (short)0x3F80 : (short)0; }
#pragma unroll
    for (int j = 0; j < 8; ++j) ones[j] = (short)0x3F80;
    f32x16 o0 = f32x16{}, o1 = f32x16{}; float R = 0.f;
    const int trow = q0 + wid * 32 + r32;
    const int wmin = q0 + wid * 32, wmax = wmin + 31;
    for (int it = 0; it < NT; ++it) {
        const int t = NT - 1 - it; const int sl = (it & 1) * SLOTB;
        SB_WAIT_BAR();
        if (EARLY) { const unsigned f = flags[lane & 7]; if (__all(f != 0u)) break; }
        if (t > 0) { SB_DMA_K(t - 1, sl ^ SLOTB); SB_DMA_V(t - 1, sl ^ SLOTB); }
        if (64 * t < wmax && !wdone) {
            f32x16 p0 = f32x16{}, p1 = f32x16{};
#pragma unroll
            for (int d0 = 0; d0 < 4; ++d0) {
                const bf16x8 b0 = *(const __attribute__((address_space(3))) bf16x8*)(kp0 + sl + d0 * 2048);
                const bf16x8 b1 = *(const __attribute__((address_space(3))) bf16x8*)(kp0 + sl + d0 * 2048 + 512);
                p0 = __builtin_amdgcn_mfma_f32_32x32x16_bf16(b0, qr[d0], p0, 0, 0, 0);
                p1 = __builtin_amdgcn_mfma_f32_32x32x16_bf16(b1, qr[d0], p1, 0, 0, 0); }
            const bool diag = (64 * t + 63 >= wmin);
            f32x16 l0, l1;
#pragma unroll
            for (int r = 0; r < 16; ++r) {
                const float y0 = p0[r], y1 = p1[r];
                l0[r] = -(__builtin_fmaxf(y0, 0.f) + __builtin_amdgcn_logf(1.0f + __builtin_amdgcn_exp2f(-__builtin_fabsf(y0))));
                l1[r] = -(__builtin_fmaxf(y1, 0.f) + __builtin_amdgcn_logf(1.0f + __builtin_amdgcn_exp2f(-__builtin_fabsf(y1)))); }
            if (diag) {
#pragma unroll
                for (int r = 0; r < 16; ++r) { const int s = 64 * t + crow(r, hi); if (s >= trow) l0[r] = 0.f; if (s + 32 >= trow) l1[r] = 0.f; } }
            const bf16x8 l0a = pack8(l0, 0), l0b = pack8(l0, 8), l1a = pack8(l1, 0), l1b = pack8(l1, 8);
            f32x16 Rv;
#pragma unroll
            for (int r = 0; r < 16; ++r) Rv[r] = R;
            f32x16 c1 = __builtin_amdgcn_mfma_f32_32x32x16_bf16(tri[0], l1a, Rv, 0, 0, 0); c1 = __builtin_amdgcn_mfma_f32_32x32x16_bf16(tri[1], l1b, c1, 0, 0, 0);
            f32x16 c0 = __builtin_amdgcn_mfma_f32_32x32x16_bf16(ones, l1a, Rv, 0, 0, 0); c0 = __builtin_amdgcn_mfma_f32_32x32x16_bf16(ones, l1b, c0, 0, 0, 0);
            c0 = __builtin_amdgcn_mfma_f32_32x32x16_bf16(tri[0], l0a, c0, 0, 0, 0); c0 = __builtin_amdgcn_mfma_f32_32x32x16_bf16(tri[1], l0b, c0, 0, 0, 0);
#pragma unroll
            for (int r = 0; r < 16; ++r) { p0[r] = __builtin_amdgcn_exp2f(p0[r] + c0[r]); p1[r] = __builtin_amdgcn_exp2f(p1[r] + c1[r]); }
            if (diag) {
#pragma unroll
                for (int r = 0; r < 16; ++r) { const int s = 64 * t + crow(r, hi); if (s >= trow) p0[r] = 0.f; if (s + 32 >= trow) p1[r] = 0.f; } }
            R = lo_lane(c0[0]);
            if (EARLY && !__any(R >= EXIT_THR)) { wdone = true; if (lane == 0) flags[wid] = 1u; }
            const bf16x8 pa0 = pack8(p0, 0), pa1 = pack8(p0, 8), pa2 = pack8(p1, 0), pa3 = pack8(p1, 8);
            const lds_cptr vp = vp0 + sl;
#define SB_VF(dh, ks) ({ const s16x4 lo_ = vtr(vp + (dh) * 4096 + (ks) * 1024), hi_ = vtr(vp + (dh) * 4096 + (ks) * 1024 + 512); (bf16x8){lo_[0], lo_[1], lo_[2], lo_[3], hi_[0], hi_[1], hi_[2], hi_[3]}; })
            o0 = __builtin_amdgcn_mfma_f32_32x32x16_bf16(pa0, SB_VF(0, 0), o0, 0, 0, 0); o1 = __builtin_amdgcn_mfma_f32_32x32x16_bf16(pa0, SB_VF(1, 0), o1, 0, 0, 0);
            o0 = __builtin_amdgcn_mfma_f32_32x32x16_bf16(pa1, SB_VF(0, 1), o0, 0, 0, 0); o1 = __builtin_amdgcn_mfma_f32_32x32x16_bf16(pa1, SB_VF(1, 1), o1, 0, 0, 0);
            o0 = __builtin_amdgcn_mfma_f32_32x32x16_bf16(pa2, SB_VF(0, 2), o0, 0, 0, 0); o1 = __builtin_amdgcn_mfma_f32_32x32x16_bf16(pa2, SB_VF(1, 2), o1, 0, 0, 0);
            o0 = __builtin_amdgcn_mfma_f32_32x32x16_bf16(pa3, SB_VF(0, 3), o0, 0, 0, 0); o1 = __builtin_amdgcn_mfma_f32_32x32x16_bf16(pa3, SB_VF(1, 3), o1, 0, 0, 0);
#undef SB_VF
        }
    }
    if (EARLY) SB_WAIT_BAR();
    bf16* Ow = O + (rowbase + q0 + wid * 32) * DM + h * HD;
    {
        bf16* stg = (bf16*)(shm + LDS_OST) + wid * 2048;
#pragma unroll
        for (int r = 0; r < 16; ++r) { const int orow = crow(r, hi); stg[orow * 64 + r32] = __float2bfloat16(o0[r]); stg[orow * 64 + 32 + r32] = __float2bfloat16(o1[r]); }
        asm volatile("s_waitcnt lgkmcnt(0)" ::: "memory");
#pragma unroll
        for (int i = 0; i < 4; ++i) { const int row = i * 8 + (lane >> 3), ch = lane & 7; const u32x4 v = *(const u32x4*)(stg + row * 64 + ch * 8); *(u32x4*)(Ow + (long)row * DM + ch * 8) = v; }
        asm volatile("s_waitcnt lgkmcnt(0)" ::: "memory");
    }
#undef SB_DMA_K
#undef SB_DMA_V
}
}

constexpr int NWAVES = 8;
constexpr int N_LAUNCHES = MK_N_LAUNCHES;
constexpr int N_PHASES = 10;
constexpr int BATCH = 8, SEQ = 2048, D = 1024, M = BATCH * SEQ, MEMLEN = 256, MROWS = BATCH * MEMLEN, NIN = 8192, NPQ = 2048;
constexpr float RMS_EPS = 1e-6f;
constexpr float LOG2E = 1.4426950408889634f;
constexpr size_t MiB = 1u << 20;
constexpr size_t WS_CTL = 0, CTL_ZERO_BYTES = 32768;
constexpr size_t WS_WIN = 1 * MiB, WS_WA = 17 * MiB, WS_WC = 19 * MiB, WS_WO = 21 * MiB, WS_WQ2 = 23 * MiB, WS_WKV2 = 25 * MiB, WS_WO2 = 29 * MiB, WS_WPQ = 31 * MiB, WS_SK = 35 * MiB;
constexpr size_t WS_SSQ1 = 36 * MiB, WS_SSQ2 = 37 * MiB, WS_MEMN = 38 * MiB, WS_K2 = 42 * MiB, WS_V2T = 46 * MiB;
constexpr size_t WS_B0 = 52 * MiB, WS_B1 = 84 * MiB, WS_B2 = 116 * MiB, WS_B3 = 148 * MiB, WS_B4 = 180 * MiB, WS_B5 = 212 * MiB, WS_END = 244 * MiB;
constexpr int CW_TMO = 0, CW_CODE = 1, CW_BAR = 4096;

constexpr int RING_OFF = 0, RING_BYTES = 131072;
constexpr int LDSCTL_OFF = RING_BYTES, MISC_OFF = LDSCTL_OFF + 320;
constexpr int LDS_BYTES = 147456;
#define GAS __attribute__((address_space(1)))
#define LAS __attribute__((address_space(3)))
typedef unsigned short bf16;
typedef unsigned v4u __attribute__((ext_vector_type(4)));
typedef float f32x4 __attribute__((ext_vector_type(4)));
typedef short bf16x8 __attribute__((ext_vector_type(8)));
typedef GAS unsigned gu32;
typedef GAS unsigned long long gu64;
#define RLX_AGENT __ATOMIC_RELAXED, __HIP_MEMORY_SCOPE_AGENT
#define LDS_WAIT() asm volatile("s_waitcnt lgkmcnt(0)" ::: "memory")
#define VM_WAIT() asm volatile("s_waitcnt vmcnt(0)" ::: "memory")
__device__ __forceinline__ unsigned long long rt() { return __builtin_amdgcn_s_memrealtime(); }
__device__ __forceinline__ unsigned f2bf(float f) { unsigned u = __builtin_bit_cast(unsigned, f); return (u + 0x7fffu + ((u >> 16) & 1u)) >> 16; }
__device__ __forceinline__ unsigned pk2(float lo, float hi) { return f2bf(lo) | (f2bf(hi) << 16); }

#define XB_TMO      128
#define XB_XCNT(j)  (256  + 64 * (j))
#define XB_XSUB(j)  (1280 + 64 * (j))
#define XB_XGEN(j)  (2304 + 64 * (j))
#define XB_TOP      3328
#define XB_TOPGEN   3392
#define XCD_BAR_WORDS 3456
#define XB_SPIN_CAP (1u << 18)

__device__ __forceinline__ unsigned xb_ld(unsigned* p)              { return __hip_atomic_load(p, __ATOMIC_RELAXED, __HIP_MEMORY_SCOPE_AGENT); }
__device__ __forceinline__ unsigned xb_add(unsigned* p, unsigned v) { return __hip_atomic_fetch_add(p, v, __ATOMIC_RELAXED, __HIP_MEMORY_SCOPE_AGENT); }
__device__ __forceinline__ unsigned xb_xcc_id() { return (unsigned)__builtin_amdgcn_s_getreg((3 << 11) | 20) & 0xFu; }
#define XB_SPIN(cond, bar) do { unsigned _sp = 0; while (cond) { __builtin_amdgcn_s_sleep(1); \
    if ((++_sp & 255u) == 0u) { if (xb_ld(&(bar)[XB_TMO])) break; if (_sp > XB_SPIN_CAP) { atomicAdd(&(bar)[XB_TMO], 1u); break; } } } } while (0)

struct XcdBarrier {
    unsigned* bar; unsigned x;
    volatile LAS unsigned* st;
};

__device__ __forceinline__ XcdBarrier xcd_barrier_post(unsigned* bar, volatile LAS unsigned* st) {
    XcdBarrier b; b.bar = bar; b.x = xb_xcc_id(); b.st = st;
    if (threadIdx.x == 0) (void)xb_add(&bar[XB_XCNT(b.x)], 1u);
    return b;
}
__device__ __forceinline__ void xcd_barrier_complete(unsigned* bar, unsigned x, unsigned& nloc, unsigned& nx) {
    const unsigned G = gridDim.x * gridDim.y * gridDim.z;
    unsigned sum, cnt, mine, sp = 0u;
    for (;;) {
        sum = 0u; cnt = 0u; mine = 0u;
#pragma unroll
        for (unsigned j = 0; j < 16; ++j) { const unsigned c = xb_ld(&bar[XB_XCNT(j)]); sum += c; cnt += (c > 0u) ? 1u : 0u; mine = (j == x) ? c : mine; }
        if (sum == G) break;
        __builtin_amdgcn_s_sleep(1);
        if ((++sp & 255u) == 0u) { if (xb_ld(&bar[XB_TMO])) break; if (sp > XB_SPIN_CAP) { atomicAdd(&bar[XB_TMO], 1u); break; } }
    }
    nloc = mine > 0u ? mine : 1u; nx = cnt > 0u ? cnt : 1u;
}

__device__ __forceinline__ void xcd_barrier(const XcdBarrier& b) {
    asm volatile("s_waitcnt vmcnt(0)" ::: "memory");
    __syncthreads();
    if (threadIdx.x == 0) {
        unsigned* bar = b.bar;
        __builtin_amdgcn_s_waitcnt(0);
        unsigned nloc = b.st[0], nx = b.st[1];
        if (nloc == 0u) { xcd_barrier_complete(bar, b.x, nloc, nx); b.st[0] = nloc; b.st[1] = nx; }
        const unsigned old = xb_add(&bar[XB_XSUB(b.x)], 1u);
        const unsigned gen = old / nloc;
        if (old + 1u == (gen + 1u) * nloc) {
            __builtin_amdgcn_fence(__ATOMIC_RELEASE, "agent");
            asm volatile("s_waitcnt vmcnt(0)" ::: "memory");
            const unsigned og = xb_add(&bar[XB_TOP], 1u);
            const unsigned tg = og / nx;
            if (og + 1u == (tg + 1u) * nx) xb_add(&bar[XB_TOPGEN], 1u);
            else XB_SPIN(xb_ld(&bar[XB_TOPGEN]) == tg, bar);
            __builtin_amdgcn_fence(__ATOMIC_ACQUIRE, "agent");
            xb_add(&bar[XB_XGEN(b.x)], 1u);
            asm volatile("s_waitcnt vmcnt(0)" ::: "memory");
        } else {
            XB_SPIN(xb_ld(&bar[XB_XGEN(b.x)]) == gen, bar);
            __builtin_amdgcn_fence(__ATOMIC_ACQUIRE, "agent");
            asm volatile("s_waitcnt vmcnt(0)" ::: "memory");
        }
    }
    __syncthreads();
}


__device__ __forceinline__ float wave_sum(float v) {
#pragma unroll
    for (int o = 1; o < 64; o <<= 1) v += __shfl_xor(v, o);
    return v;
}
__device__ __forceinline__ int inproj_row(int n) {
    const int g = n >> 10, c = n & 1023;
    if (g < 3) return n;
    if (g == 3) return 3072 + (c >> 7) * 256 + (c & 127);
    if (g == 5) return 3072 + (c >> 7) * 256 + 128 + (c & 127);
    if (g == 4) return 5120 + c;
    return n;
}
template <bool INMAP> __device__ __forceinline__ void transpose_item(const float* W, int K, int N, const float* gain, bf16* WT, int row_off, LAS float* scr, int item, int lane) {
    const int nblk = N / 32, kb = item / nblk, nb = item % nblk, k0 = 64 * kb, n0 = 32 * nb;
    {
        f32x4 w[8]; const int c4 = 4 * (lane & 7), kr = lane >> 3;
#pragma unroll
        for (int j = 0; j < 8; ++j) w[j] = *(const GAS f32x4*)(W + (size_t)(k0 + kr + 8 * j) * N + n0 + c4);
#pragma unroll
        for (int j = 0; j < 8; ++j) { const int kk = kr + 8 * j; f32x4 t = w[j]; if (gain) t = t * gain[k0 + kk];
            LAS float* d = scr + kk * 33 + c4; d[0] = t.x; d[1] = t.y; d[2] = t.z; d[3] = t.w; } }
    LDS_WAIT(); asm volatile("" ::: "memory");
    const int c = lane & 7; const int r0 = INMAP ? inproj_row(n0) : (row_off + n0);
#pragma unroll
    for (int j = 0; j < 4; ++j) { const int n = (lane >> 3) + 8 * j; const LAS float* s = scr + (8 * c) * 33 + n;
        v4u o; o.x = pk2(s[0 * 33], s[1 * 33]); o.y = pk2(s[2 * 33], s[3 * 33]); o.z = pk2(s[4 * 33], s[5 * 33]); o.w = pk2(s[6 * 33], s[7 * 33]);
        *(GAS v4u*)(WT + (size_t)(r0 + n) * K + k0 + 8 * c) = o; }
    LDS_WAIT(); asm volatile("" ::: "memory");
}
__device__ __forceinline__ void rms_row_to_bf16(const float* xrow, const float* gain, bf16* orow, int lane) {
    const GAS f32x4* xr = (const GAS f32x4*)xrow + lane; const GAS f32x4* gr = (const GAS f32x4*)gain + lane;
    f32x4 v[4]; float s = 0.f;
#pragma unroll
    for (int j = 0; j < 4; ++j) { v[j] = xr[64 * j]; s += (v[j].x * v[j].x + v[j].y * v[j].y) + (v[j].z * v[j].z + v[j].w * v[j].w); }
    const float rstd = 1.0f / sqrtf(wave_sum(s) * (1.f / 1024.f) + RMS_EPS);
    GAS unsigned long long* o8 = (GAS unsigned long long*)orow + lane;
#pragma unroll
    for (int j = 0; j < 4; ++j) { const f32x4 g = gr[64 * j]; o8[64 * j] = (unsigned long long)pk2(v[j].x * rstd * g.x, v[j].y * rstd * g.y) | ((unsigned long long)pk2(v[j].z * rstd * g.z, v[j].w * rstd * g.w) << 32); }
}
__device__ __forceinline__ void row_to_bf16(const float* xrow, const float* gain, bf16* orow, int lane) {
    const GAS f32x4* xr = (const GAS f32x4*)xrow + lane; GAS unsigned long long* o8 = (GAS unsigned long long*)orow + lane;
#pragma unroll
    for (int j = 0; j < 4; ++j) { f32x4 v = xr[64 * j]; if (gain) { const f32x4 g = ((const GAS f32x4*)gain + lane)[64 * j]; v = v * g; }
        o8[64 * j] = (unsigned long long)pk2(v.x, v.y) | ((unsigned long long)pk2(v.z, v.w) << 32); }
}
__device__ __forceinline__ void row_to_fp8(const float* xrow, const float* gain, float scale, unsigned char* orow, int lane) {
    const GAS f32x4* xr = (const GAS f32x4*)xrow + lane; GAS unsigned* o4 = (GAS unsigned*)orow + lane;
#pragma unroll
    for (int j = 0; j < 4; ++j) { f32x4 v = xr[64 * j] * scale; if (gain) { const f32x4 g = ((const GAS f32x4*)gain + lane)[64 * j]; v = v * g; }
        int w = 0; w = __builtin_amdgcn_cvt_pk_fp8_f32(v.x, v.y, w, false); w = __builtin_amdgcn_cvt_pk_fp8_f32(v.z, v.w, w, true); o4[64 * j] = (unsigned)w; }
}
__device__ __forceinline__ void rows4_to_fp8(const float* x0, size_t rstride, const float* gain, float scale, unsigned char* o0, int lane) {
    f32x4 v[4][4];
#pragma unroll
    for (int r = 0; r < 4; ++r)
#pragma unroll
        for (int j = 0; j < 4; ++j) v[r][j] = ((const GAS f32x4*)(x0 + r * rstride * 1024) + lane)[64 * j];
#pragma unroll
    for (int j = 0; j < 4; ++j) { f32x4 g = (f32x4){scale, scale, scale, scale}; if (gain) g = g * ((const GAS f32x4*)gain + lane)[64 * j];
#pragma unroll
        for (int r = 0; r < 4; ++r) { const f32x4 t = v[r][j] * g; int w = 0; w = __builtin_amdgcn_cvt_pk_fp8_f32(t.x, t.y, w, false); w = __builtin_amdgcn_cvt_pk_fp8_f32(t.z, t.w, w, true);
            ((GAS unsigned*)(o0 + r * rstride * 1024) + lane)[64 * j] = (unsigned)w; } }
}
__device__ __forceinline__ void rms_rows2_to_bf16(const float* x0, size_t rstride, const float* gain, bf16* o0, int lane) {
    f32x4 v[2][4]; float s[2] = {0.f, 0.f};
#pragma unroll
    for (int r = 0; r < 2; ++r)
#pragma unroll
        for (int j = 0; j < 4; ++j) v[r][j] = ((const GAS f32x4*)(x0 + r * rstride * 1024) + lane)[64 * j];
#pragma unroll
    for (int r = 0; r < 2; ++r)
#pragma unroll
        for (int j = 0; j < 4; ++j) s[r] += (v[r][j].x * v[r][j].x + v[r][j].y * v[r][j].y) + (v[r][j].z * v[r][j].z + v[r][j].w * v[r][j].w);
#pragma unroll
    for (int r = 0; r < 2; ++r) { const float rstd = 1.0f / sqrtf(wave_sum(s[r]) * (1.f / 1024.f) + RMS_EPS);
        GAS unsigned long long* o8 = (GAS unsigned long long*)(o0 + r * rstride * 1024) + lane;
#pragma unroll
        for (int j = 0; j < 4; ++j) { const f32x4 g = ((const GAS f32x4*)gain + lane)[64 * j];
            o8[64 * j] = (unsigned long long)pk2(v[r][j].x * rstd * g.x, v[r][j].y * rstd * g.y) | ((unsigned long long)pk2(v[r][j].z * rstd * g.z, v[r][j].w * rstd * g.w) << 32); } }
}
__device__ __forceinline__ void final_norm_row(const float* hrow, const float* gain, float* orow, int lane) {
    const GAS f32x4* xr = (const GAS f32x4*)hrow + lane; const GAS f32x4* gr = (const GAS f32x4*)gain + lane;
    f32x4 v[4]; float s = 0.f;
#pragma unroll
    for (int j = 0; j < 4; ++j) { v[j] = xr[64 * j]; s += (v[j].x * v[j].x + v[j].y * v[j].y) + (v[j].z * v[j].z + v[j].w * v[j].w); }
    const float rstd = 1.0f / sqrtf(wave_sum(s) * (1.f / 1024.f) + RMS_EPS);
    GAS f32x4* o = (GAS f32x4*)orow + lane;
#pragma unroll
    for (int j = 0; j < 4; ++j) o[64 * j] = v[j] * rstd * gr[64 * j];
}
__device__ __forceinline__ float bflo(unsigned w) { return __builtin_bit_cast(float, w << 16); }
__device__ __forceinline__ float bfhi(unsigned w) { return __builtin_bit_cast(float, w & 0xffff0000u); }
__device__ __forceinline__ void yconv_item(const bf16* U, const bf16* CB, const float* cw, bf16* YC, int item, int lane) {
    const int t0 = item * 8; const bool first = (t0 % SEQ) == 0;
#pragma unroll 1
    for (int ps = 0; ps < 2; ++ps) {
        const int c0 = ps * 512 + lane * 8;
        float w0[8], w1[8], w2[8];
#pragma unroll
        for (int e = 0; e < 8; ++e) { w0[e] = cw[c0 + e]; w1[e] = cw[1024 + c0 + e]; w2[e] = cw[2048 + c0 + e]; }
        v4u um2 = (v4u){0u, 0u, 0u, 0u}, um1 = (v4u){0u, 0u, 0u, 0u};
        if (!first) { um2 = *(const GAS v4u*)(U + (size_t)(t0 - 2) * 1024 + c0); um1 = *(const GAS v4u*)(U + (size_t)(t0 - 1) * 1024 + c0); }
#pragma unroll
        for (int i = 0; i < 8; ++i) {
            const v4u uc = *(const GAS v4u*)(U + (size_t)(t0 + i) * 1024 + c0); const v4u cbv = *(const GAS v4u*)(CB + (size_t)(t0 + i) * 1024 + c0);
            v4u o;
#pragma unroll
            for (int q = 0; q < 4; ++q) {
                const float a = bflo(cbv[q]) * (w0[2 * q] * bflo(um2[q]) + w1[2 * q] * bflo(um1[q]) + w2[2 * q] * bflo(uc[q]));
                const float b = bfhi(cbv[q]) * (w0[2 * q + 1] * bfhi(um2[q]) + w1[2 * q + 1] * bfhi(um1[q]) + w2[2 * q + 1] * bfhi(uc[q]));
                o[q] = pk2(a, b); }
            *(GAS v4u*)(YC + (size_t)(t0 + i) * 1024 + c0) = o;
            um2 = um1; um1 = uc; }
    }
}


namespace xa {
using bf16x8 = __attribute__((ext_vector_type(8))) short;
using f32x4 = __attribute__((ext_vector_type(4))) float;
using u32x4 = __attribute__((ext_vector_type(4))) unsigned;
using u32x2 = __attribute__((ext_vector_type(2))) unsigned;
typedef __attribute__((address_space(3))) const char* lds_cptr;
constexpr int BUFB = 65536, VOFF = 32768;
#define XA_WAIT_BAR() asm volatile("s_waitcnt vmcnt(0) lgkmcnt(0)\n\ts_barrier" ::: "memory")
__device__ __forceinline__ void xattn_unit(int b, int head, int qh, const bf16* Q, const bf16* K2, const bf16* V2P, bf16* O, char* shm) {
    const int lane = threadIdx.x & 63, kr = lane & 15, g = lane >> 4; const int wid = __builtin_amdgcn_readfirstlane((int)threadIdx.x >> 6);
    const unsigned lds0 = (unsigned)(uintptr_t)shm; const lds_cptr shm3 = (lds_cptr)shm;
    const size_t qrow = (size_t)b * SEQ + qh * 128 + wid * 16 + kr;
    const bf16* ksrc = K2 + ((size_t)b * MEMLEN + lane) * 1024 + head * 256 + 8 * wid;
    const bf16* vsrc = V2P + ((size_t)head * 256 + lane) * 2048 + (size_t)b * MEMLEN + 8 * wid;
#define XA_DMA(c, bufo) do { _Pragma("unroll") for (int i = 0; i < 4; ++i) { \
        sb::glds16(ksrc + (size_t)(64 * (c)) * 1024 + 64 * i, (unsigned)__builtin_amdgcn_readfirstlane(lds0 + (bufo) + (wid + 8 * i) * 1024)); \
        sb::glds16(vsrc + (size_t)(64 * i) * 2048 + 64 * (c), (unsigned)__builtin_amdgcn_readfirstlane(lds0 + (bufo) + VOFF + wid * 4096 + i * 1024)); } } while (0)
    XA_DMA(0, 0);
    bf16x8 qf[8];
#pragma unroll
    for (int ks = 0; ks < 8; ++ks) qf[ks] = *(const GAS bf16x8*)(Q + qrow * 1024 + head * 256 + 32 * ks + 8 * g);
    f32x4 o[16];
#pragma unroll
    for (int dt = 0; dt < 16; ++dt) o[dt] = (f32x4){0.f, 0.f, 0.f, 0.f};
    float mrun = -1e30f, lrun = 0.f;
    const lds_cptr kfr = shm3 + g * 1024 + kr * 16, vfr = shm3 + VOFF + g * 4096 + kr * 16;
#pragma unroll 1
    for (int c = 0; c < 4; ++c) {
        const int bo = (c & 1) * BUFB;
        XA_WAIT_BAR();
        if (c < 3) XA_DMA(c + 1, bo ^ BUFB);
        f32x4 s[4];
#pragma unroll
        for (int kt = 0; kt < 4; ++kt) { s[kt] = (f32x4){0.f, 0.f, 0.f, 0.f};
#pragma unroll
            for (int ks = 0; ks < 8; ++ks) { const bf16x8 a = *(const __attribute__((address_space(3))) bf16x8*)(kfr + bo + ks * 4096 + kt * 256);
                s[kt] = __builtin_amdgcn_mfma_f32_16x16x32_bf16(a, qf[ks], s[kt], 0, 0, 0); } }
        float mx = __builtin_fmaxf(__builtin_fmaxf(s[0].x, s[0].y), __builtin_fmaxf(s[0].z, s[0].w));
#pragma unroll
        for (int kt = 1; kt < 4; ++kt) mx = __builtin_fmaxf(mx, __builtin_fmaxf(__builtin_fmaxf(s[kt].x, s[kt].y), __builtin_fmaxf(s[kt].z, s[kt].w)));
        mx = __builtin_fmaxf(mx, __shfl_xor(mx, 16)); mx = __builtin_fmaxf(mx, __shfl_xor(mx, 32));
        const float mnew = __builtin_fmaxf(mrun, mx), alpha = __builtin_amdgcn_exp2f(mrun - mnew);
        mrun = mnew; float ps = 0.f;
#pragma unroll
        for (int kt = 0; kt < 4; ++kt) { s[kt].x = __builtin_amdgcn_exp2f(s[kt].x - mnew); s[kt].y = __builtin_amdgcn_exp2f(s[kt].y - mnew); s[kt].z = __builtin_amdgcn_exp2f(s[kt].z - mnew); s[kt].w = __builtin_amdgcn_exp2f(s[kt].w - mnew);
            ps += (s[kt].x + s[kt].y) + (s[kt].z + s[kt].w); }
        lrun = lrun * alpha + ps;
#pragma unroll
        for (int dt = 0; dt < 16; ++dt) o[dt] = o[dt] * alpha;
        bf16x8 pb[2];
#pragma unroll
        for (int k2 = 0; k2 < 2; ++k2) { u32x4 w; w.x = pg8::cvt_pk_bf16(s[2 * k2].x, s[2 * k2].y); w.y = pg8::cvt_pk_bf16(s[2 * k2].z, s[2 * k2].w);
            w.z = pg8::cvt_pk_bf16(s[2 * k2 + 1].x, s[2 * k2 + 1].y); w.w = pg8::cvt_pk_bf16(s[2 * k2 + 1].z, s[2 * k2 + 1].w); pb[k2] = __builtin_bit_cast(bf16x8, w); }
#pragma unroll
        for (int dt = 0; dt < 16; ++dt)
#pragma unroll
            for (int k2 = 0; k2 < 2; ++k2) { const bf16x8 a = *(const __attribute__((address_space(3))) bf16x8*)(vfr + bo + k2 * 16384 + dt * 256);
                o[dt] = __builtin_amdgcn_mfma_f32_16x16x32_bf16(a, pb[k2], o[dt], 0, 0, 0); }
    }
    lrun += __shfl_xor(lrun, 16); lrun += __shfl_xor(lrun, 32);
    const float rl = 1.0f / lrun;
    bf16* op = O + qrow * 1024 + head * 256 + 4 * g;
#pragma unroll
    for (int dt = 0; dt < 16; ++dt) { u32x2 w; w.x = pg8::cvt_pk_bf16(o[dt].x * rl, o[dt].y * rl); w.y = pg8::cvt_pk_bf16(o[dt].z * rl, o[dt].w * rl); *(GAS u32x2*)(op + 16 * dt) = w; }
#undef XA_DMA
}
}

namespace peer {
using bf16x8 = __attribute__((ext_vector_type(8))) short;
using f32x16 = __attribute__((ext_vector_type(16))) float;
using u32x4 = __attribute__((ext_vector_type(4))) unsigned;
using u32x2 = __attribute__((ext_vector_type(2))) unsigned;
typedef __bf16 bf16x2_t __attribute__((ext_vector_type(2)));
#define PEER_CE(a, b) do { const int _h = ((a) > (b)) ? (a) : (b); const int _l = ((a) > (b)) ? (b) : (a); (a) = _h; (b) = _l; } while (0)
#define PEER_SORT16(x, o) do { PEER_CE(x[(o)+0], x[(o)+1]); PEER_CE(x[(o)+2], x[(o)+3]); PEER_CE(x[(o)+4], x[(o)+5]); PEER_CE(x[(o)+6], x[(o)+7]); PEER_CE(x[(o)+8], x[(o)+9]); PEER_CE(x[(o)+10], x[(o)+11]); PEER_CE(x[(o)+12], x[(o)+13]); PEER_CE(x[(o)+14], x[(o)+15]); PEER_CE(x[(o)+0], x[(o)+2]); PEER_CE(x[(o)+1], x[(o)+3]); PEER_CE(x[(o)+4], x[(o)+6]); PEER_CE(x[(o)+5], x[(o)+7]); PEER_CE(x[(o)+8], x[(o)+10]); PEER_CE(x[(o)+9], x[(o)+11]); PEER_CE(x[(o)+12], x[(o)+14]); PEER_CE(x[(o)+13], x[(o)+15]); PEER_CE(x[(o)+1], x[(o)+2]); PEER_CE(x[(o)+5], x[(o)+6]); PEER_CE(x[(o)+9], x[(o)+10]); PEER_CE(x[(o)+13], x[(o)+14]); PEER_CE(x[(o)+0], x[(o)+4]); PEER_CE(x[(o)+1], x[(o)+5]); PEER_CE(x[(o)+2], x[(o)+6]); PEER_CE(x[(o)+3], x[(o)+7]); PEER_CE(x[(o)+8], x[(o)+12]); PEER_CE(x[(o)+9], x[(o)+13]); PEER_CE(x[(o)+10], x[(o)+14]); PEER_CE(x[(o)+11], x[(o)+15]); PEER_CE(x[(o)+2], x[(o)+4]); PEER_CE(x[(o)+3], x[(o)+5]); PEER_CE(x[(o)+10], x[(o)+12]); PEER_CE(x[(o)+11], x[(o)+13]); PEER_CE(x[(o)+1], x[(o)+2]); PEER_CE(x[(o)+3], x[(o)+4]); PEER_CE(x[(o)+5], x[(o)+6]); PEER_CE(x[(o)+9], x[(o)+10]); PEER_CE(x[(o)+11], x[(o)+12]); PEER_CE(x[(o)+13], x[(o)+14]); PEER_CE(x[(o)+0], x[(o)+8]); PEER_CE(x[(o)+1], x[(o)+9]); PEER_CE(x[(o)+2], x[(o)+10]); PEER_CE(x[(o)+3], x[(o)+11]); PEER_CE(x[(o)+4], x[(o)+12]); PEER_CE(x[(o)+5], x[(o)+13]); PEER_CE(x[(o)+6], x[(o)+14]); PEER_CE(x[(o)+7], x[(o)+15]); PEER_CE(x[(o)+4], x[(o)+8]); PEER_CE(x[(o)+5], x[(o)+9]); PEER_CE(x[(o)+6], x[(o)+10]); PEER_CE(x[(o)+7], x[(o)+11]); PEER_CE(x[(o)+2], x[(o)+4]); PEER_CE(x[(o)+3], x[(o)+5]); PEER_CE(x[(o)+6], x[(o)+8]); PEER_CE(x[(o)+7], x[(o)+9]); PEER_CE(x[(o)+10], x[(o)+12]); PEER_CE(x[(o)+11], x[(o)+13]); PEER_CE(x[(o)+1], x[(o)+2]); PEER_CE(x[(o)+3], x[(o)+4]); PEER_CE(x[(o)+5], x[(o)+6]); PEER_CE(x[(o)+7], x[(o)+8]); PEER_CE(x[(o)+9], x[(o)+10]); PEER_CE(x[(o)+11], x[(o)+12]); PEER_CE(x[(o)+13], x[(o)+14]); } while (0)
#define PEER_MERGE16(x, a, b) do { x[(a)+0] = (x[(a)+0] > x[(b)+15]) ? x[(a)+0] : x[(b)+15]; x[(a)+1] = (x[(a)+1] > x[(b)+14]) ? x[(a)+1] : x[(b)+14]; x[(a)+2] = (x[(a)+2] > x[(b)+13]) ? x[(a)+2] : x[(b)+13]; x[(a)+3] = (x[(a)+3] > x[(b)+12]) ? x[(a)+3] : x[(b)+12]; x[(a)+4] = (x[(a)+4] > x[(b)+11]) ? x[(a)+4] : x[(b)+11]; x[(a)+5] = (x[(a)+5] > x[(b)+10]) ? x[(a)+5] : x[(b)+10]; x[(a)+6] = (x[(a)+6] > x[(b)+9]) ? x[(a)+6] : x[(b)+9]; x[(a)+7] = (x[(a)+7] > x[(b)+8]) ? x[(a)+7] : x[(b)+8]; x[(a)+8] = (x[(a)+8] > x[(b)+7]) ? x[(a)+8] : x[(b)+7]; x[(a)+9] = (x[(a)+9] > x[(b)+6]) ? x[(a)+9] : x[(b)+6]; x[(a)+10] = (x[(a)+10] > x[(b)+5]) ? x[(a)+10] : x[(b)+5]; x[(a)+11] = (x[(a)+11] > x[(b)+4]) ? x[(a)+11] : x[(b)+4]; x[(a)+12] = (x[(a)+12] > x[(b)+3]) ? x[(a)+12] : x[(b)+3]; x[(a)+13] = (x[(a)+13] > x[(b)+2]) ? x[(a)+13] : x[(b)+2]; x[(a)+14] = (x[(a)+14] > x[(b)+1]) ? x[(a)+14] : x[(b)+1]; x[(a)+15] = (x[(a)+15] > x[(b)+0]) ? x[(a)+15] : x[(b)+0]; PEER_CE(x[(a)+0], x[(a)+8]); PEER_CE(x[(a)+1], x[(a)+9]); PEER_CE(x[(a)+2], x[(a)+10]); PEER_CE(x[(a)+3], x[(a)+11]); PEER_CE(x[(a)+4], x[(a)+12]); PEER_CE(x[(a)+5], x[(a)+13]); PEER_CE(x[(a)+6], x[(a)+14]); PEER_CE(x[(a)+7], x[(a)+15]); PEER_CE(x[(a)+0], x[(a)+4]); PEER_CE(x[(a)+1], x[(a)+5]); PEER_CE(x[(a)+2], x[(a)+6]); PEER_CE(x[(a)+3], x[(a)+7]); PEER_CE(x[(a)+8], x[(a)+12]); PEER_CE(x[(a)+9], x[(a)+13]); PEER_CE(x[(a)+10], x[(a)+14]); PEER_CE(x[(a)+11], x[(a)+15]); PEER_CE(x[(a)+0], x[(a)+2]); PEER_CE(x[(a)+1], x[(a)+3]); PEER_CE(x[(a)+4], x[(a)+6]); PEER_CE(x[(a)+5], x[(a)+7]); PEER_CE(x[(a)+8], x[(a)+10]); PEER_CE(x[(a)+9], x[(a)+11]); PEER_CE(x[(a)+12], x[(a)+14]); PEER_CE(x[(a)+13], x[(a)+15]); PEER_CE(x[(a)+0], x[(a)+1]); PEER_CE(x[(a)+2], x[(a)+3]); PEER_CE(x[(a)+4], x[(a)+5]); PEER_CE(x[(a)+6], x[(a)+7]); PEER_CE(x[(a)+8], x[(a)+9]); PEER_CE(x[(a)+10], x[(a)+11]); PEER_CE(x[(a)+12], x[(a)+13]); PEER_CE(x[(a)+14], x[(a)+15]); } while (0)
#define PEER_MERGE16_SET(x, a, b) do { x[(a)+0] = (x[(a)+0] > x[(b)+15]) ? x[(a)+0] : x[(b)+15]; x[(a)+1] = (x[(a)+1] > x[(b)+14]) ? x[(a)+1] : x[(b)+14]; x[(a)+2] = (x[(a)+2] > x[(b)+13]) ? x[(a)+2] : x[(b)+13]; x[(a)+3] = (x[(a)+3] > x[(b)+12]) ? x[(a)+3] : x[(b)+12]; x[(a)+4] = (x[(a)+4] > x[(b)+11]) ? x[(a)+4] : x[(b)+11]; x[(a)+5] = (x[(a)+5] > x[(b)+10]) ? x[(a)+5] : x[(b)+10]; x[(a)+6] = (x[(a)+6] > x[(b)+9]) ? x[(a)+6] : x[(b)+9]; x[(a)+7] = (x[(a)+7] > x[(b)+8]) ? x[(a)+7] : x[(b)+8]; x[(a)+8] = (x[(a)+8] > x[(b)+7]) ? x[(a)+8] : x[(b)+7]; x[(a)+9] = (x[(a)+9] > x[(b)+6]) ? x[(a)+9] : x[(b)+6]; x[(a)+10] = (x[(a)+10] > x[(b)+5]) ? x[(a)+10] : x[(b)+5]; x[(a)+11] = (x[(a)+11] > x[(b)+4]) ? x[(a)+11] : x[(b)+4]; x[(a)+12] = (x[(a)+12] > x[(b)+3]) ? x[(a)+12] : x[(b)+3]; x[(a)+13] = (x[(a)+13] > x[(b)+2]) ? x[(a)+13] : x[(b)+2]; x[(a)+14] = (x[(a)+14] > x[(b)+1]) ? x[(a)+14] : x[(b)+1]; x[(a)+15] = (x[(a)+15] > x[(b)+0]) ? x[(a)+15] : x[(b)+0]; } while (0)
constexpr int PEER_NCAND = 50;
__device__ const unsigned char PEER_CAND[64] = {0, 16, 32, 48, 64, 80, 96, 112, 128, 144, 160, 176, 192, 208, 224, 240, 1, 17, 33, 49, 65, 81, 97, 113, 2, 18, 34, 50, 66, 3, 19, 35, 51, 4, 20, 36, 5, 21, 6, 22, 7, 23, 8, 9, 10, 11, 12, 13, 14, 15, 0, 0, 0, 0, 0, 0, 0, 0, 0, 0, 0, 0, 0, 0};
#define PEER_CAND_SUMS(x, v0, v1, KEYF) do { x[0] = KEYF((v0)[0] + (v1)[0], 0); x[1] = KEYF((v0)[0] + (v1)[1], 1); x[2] = KEYF((v0)[0] + (v1)[2], 2); x[3] = KEYF((v0)[0] + (v1)[3], 3); x[4] = KEYF((v0)[0] + (v1)[4], 4); x[5] = KEYF((v0)[0] + (v1)[5], 5); x[6] = KEYF((v0)[0] + (v1)[6], 6); x[7] = KEYF((v0)[0] + (v1)[7], 7); x[8] = KEYF((v0)[0] + (v1)[8], 8); x[9] = KEYF((v0)[0] + (v1)[9], 9); x[10] = KEYF((v0)[0] + (v1)[10], 10); x[11] = KEYF((v0)[0] + (v1)[11], 11); x[12] = KEYF((v0)[0] + (v1)[12], 12); x[13] = KEYF((v0)[0] + (v1)[13], 13); x[14] = KEYF((v0)[0] + (v1)[14], 14); x[15] = KEYF((v0)[0] + (v1)[15], 15); x[16] = KEYF((v0)[1] + (v1)[0], 16); x[17] = KEYF((v0)[1] + (v1)[1], 17); x[18] = KEYF((v0)[1] + (v1)[2], 18); x[19] = KEYF((v0)[1] + (v1)[3], 19); x[20] = KEYF((v0)[1] + (v1)[4], 20); x[21] = KEYF((v0)[1] + (v1)[5], 21); x[22] = KEYF((v0)[1] + (v1)[6], 22); x[23] = KEYF((v0)[1] + (v1)[7], 23); x[24] = KEYF((v0)[2] + (v1)[0], 24); x[25] = KEYF((v0)[2] + (v1)[1], 25); x[26] = KEYF((v0)[2] + (v1)[2], 26); x[27] = KEYF((v0)[2] + (v1)[3], 27); x[28] = KEYF((v0)[2] + (v1)[4], 28); x[29] = KEYF((v0)[3] + (v1)[0], 29); x[30] = KEYF((v0)[3] + (v1)[1], 30); x[31] = KEYF((v0)[3] + (v1)[2], 31); x[32] = KEYF((v0)[3] + (v1)[3], 32); x[33] = KEYF((v0)[4] + (v1)[0], 33); x[34] = KEYF((v0)[4] + (v1)[1], 34); x[35] = KEYF((v0)[4] + (v1)[2], 35); x[36] = KEYF((v0)[5] + (v1)[0], 36); x[37] = KEYF((v0)[5] + (v1)[1], 37); x[38] = KEYF((v0)[6] + (v1)[0], 38); x[39] = KEYF((v0)[6] + (v1)[1], 39); x[40] = KEYF((v0)[7] + (v1)[0], 40); x[41] = KEYF((v0)[7] + (v1)[1], 41); x[42] = KEYF((v0)[8] + (v1)[0], 42); x[43] = KEYF((v0)[9] + (v1)[0], 43); x[44] = KEYF((v0)[10] + (v1)[0], 44); x[45] = KEYF((v0)[11] + (v1)[0], 45); x[46] = KEYF((v0)[12] + (v1)[0], 46); x[47] = KEYF((v0)[13] + (v1)[0], 47); x[48] = KEYF((v0)[14] + (v1)[0], 48); x[49] = KEYF((v0)[15] + (v1)[0], 49); x[50] = (int)0x80000000; x[51] = (int)0x80000000; x[52] = (int)0x80000000; x[53] = (int)0x80000000; x[54] = (int)0x80000000; x[55] = (int)0x80000000; x[56] = (int)0x80000000; x[57] = (int)0x80000000; x[58] = (int)0x80000000; x[59] = (int)0x80000000; x[60] = (int)0x80000000; x[61] = (int)0x80000000; x[62] = (int)0x80000000; x[63] = (int)0x80000000; } while (0)

__device__ __forceinline__ int crow(int r, int hi) { return (r & 3) + 8 * (r >> 2) + 4 * hi; }
__device__ __forceinline__ int f2key(float f) { const int t = __builtin_bit_cast(int, f); return t ^ ((t >> 31) & 0x7fffffff); }
__device__ __forceinline__ float key2f(int t) { return __builtin_bit_cast(float, t ^ ((t >> 31) & 0x7fffffff)); }
__device__ __forceinline__ int sel_hi(int a, int b, int hm) { int r; asm("v_bfi_b32 %0, %1, %2, %3" : "=v"(r) : "v"(hm), "v"(b), "v"(a)); return r; }
template <int CTRL> __device__ __forceinline__ float dpp(float x) { return __int_as_float(__builtin_amdgcn_update_dpp(0, __float_as_int(x), CTRL, 0xF, 0xF, true)); }
__device__ __forceinline__ float swap16_sum(float x) { auto rr = __builtin_amdgcn_permlane16_swap(__float_as_uint(x), __float_as_uint(x), false, false); return __uint_as_float(rr[0]) + __uint_as_float(rr[1]); }
__device__ __forceinline__ float swap32_sum(float x) { auto rr = __builtin_amdgcn_permlane32_swap(__float_as_uint(x), __float_as_uint(x), false, false); return __uint_as_float(rr[0]) + __uint_as_float(rr[1]); }
__device__ __forceinline__ float fsel(float a, float b, int m) { return __int_as_float(sel_hi(__float_as_int(a), __float_as_int(b), m)); }
typedef float f32x2 __attribute__((ext_vector_type(2)));
__device__ __forceinline__ int key7(float f, int low) { return (f2key(f) & ~127) | low; }
__device__ __forceinline__ int key6(float f, int ord) { return (f2key(f) & ~63) | (63 - ord); }
__device__ __forceinline__ void top16_of_64(int (&x)[64]) {
    PEER_SORT16(x, 0); PEER_SORT16(x, 16); PEER_SORT16(x, 32); PEER_SORT16(x, 48);
    PEER_MERGE16(x, 0, 16); PEER_MERGE16(x, 32, 48); PEER_MERGE16(x, 0, 32);
}
__device__ __forceinline__ float dot2_bf16(unsigned w, unsigned x, float acc) { return __builtin_amdgcn_fdot2_f32_bf16(__builtin_bit_cast(bf16x2_t, w), __builtin_bit_cast(bf16x2_t, x), acc, false); }
__device__ __forceinline__ float dot8(const u32x4 a, const u32x4 b, float acc) {
    acc = dot2_bf16(a.x, b.x, acc); acc = dot2_bf16(a.y, b.y, acc); acc = dot2_bf16(a.z, b.z, acc); acc = dot2_bf16(a.w, b.w, acc); return acc;
}
__device__ __forceinline__ float gelu_tanh(float x) {
    const float u = 0.7978845608028654f * (x + 0.044715f * x * x * x);
    const float e = __builtin_amdgcn_exp2f(2.0f * LOG2E * u);
    const float th = 1.0f - 2.0f * __builtin_amdgcn_rcpf(e + 1.0f);
    return 0.5f * x * (1.0f + th);
}
__device__ __forceinline__ void topk_half(const bf16* qp, const bf16* sp, int hi, int (&T)[16]) {
    bf16x8 qf[8];
#pragma unroll
    for (int ks = 0; ks < 8; ++ks) qf[ks] = *(const GAS bf16x8*)(qp + ks * 16);
    const int hi4 = hi << 2;
    int x[64];
#pragma unroll
    for (int kt = 0; kt < 4; ++kt) { f32x16 sc = f32x16{};
#pragma unroll
        for (int ks = 0; ks < 8; ++ks) { const bf16x8 a = *(const GAS bf16x8*)(sp + (size_t)((kt * 8 + ks) * 64) * 8); sc = __builtin_amdgcn_mfma_f32_32x32x16_bf16(a, qf[ks], sc, 0, 0, 0); }
#pragma unroll
        for (int r = 0; r < 16; ++r) x[16 * kt + r] = ((f2key(sc[r]) & ~127) | (127 - (32 * kt + crow(r, 0)))) ^ hi4; }
    top16_of_64(x);
#pragma unroll
    for (int i = 0; i < 16; ++i) { auto rr = __builtin_amdgcn_permlane32_swap((unsigned)x[i], (unsigned)x[i], false, false); x[i] = (int)rr[0]; x[16 + i] = (int)rr[1]; }
    PEER_MERGE16(x, 0, 16);
#pragma unroll
    for (int i = 0; i < 16; ++i) T[i] = x[i];
}
__device__ __forceinline__ float fp8dot4(unsigned w, float h0, float h1, float h2, float h3) {
    const f32x2 lo = __builtin_amdgcn_cvt_pk_f32_fp8((int)w, false), hi = __builtin_amdgcn_cvt_pk_f32_fp8((int)w, true);
    return __builtin_fmaf(hi.y, h3, __builtin_fmaf(hi.x, h2, __builtin_fmaf(lo.y, h1, lo.x * h0)));
}
__device__ __forceinline__ float fp8dot16(const u32x4 u, const float (&h)[16]) {
    return (fp8dot4(u.x, h[0], h[1], h[2], h[3]) + fp8dot4(u.y, h[4], h[5], h[6], h[7])) + (fp8dot4(u.z, h[8], h[9], h[10], h[11]) + fp8dot4(u.w, h[12], h[13], h[14], h[15]));
}
__device__ __forceinline__ float fp8dot4b(unsigned w, unsigned x0, unsigned x1) {
    const bf16x2_t lo = __builtin_amdgcn_cvt_scalef32_pk_bf16_fp8(w, 1.0f, false), hi = __builtin_amdgcn_cvt_scalef32_pk_bf16_fp8(w, 1.0f, true);
    return __builtin_amdgcn_fdot2_f32_bf16(hi, __builtin_bit_cast(bf16x2_t, x1), __builtin_amdgcn_fdot2_f32_bf16(lo, __builtin_bit_cast(bf16x2_t, x0), 0.f, false), false);
}
__device__ __forceinline__ float fp8dot16b(const u32x4 u, const unsigned (&x)[8]) {
    return (fp8dot4b(u.x, x[0], x[1]) + fp8dot4b(u.y, x[2], x[3])) + (fp8dot4b(u.z, x[4], x[5]) + fp8dot4b(u.w, x[6], x[7]));
}
__device__ __forceinline__ void fp8axpy4(unsigned w, float c, float& a0, float& a1, float& a2, float& a3) {
    const f32x2 lo = __builtin_amdgcn_cvt_pk_f32_fp8((int)w, false), hi = __builtin_amdgcn_cvt_pk_f32_fp8((int)w, true);
    a0 += c * lo.x; a1 += c * lo.y; a2 += c * hi.x; a3 += c * hi.y;
}
__device__ __forceinline__ void fp8axpy16(const u32x4 v, float c, float (&a)[16]) {
    fp8axpy4(v.x, c, a[0], a[1], a[2], a[3]); fp8axpy4(v.y, c, a[4], a[5], a[6], a[7]); fp8axpy4(v.z, c, a[8], a[9], a[10], a[11]); fp8axpy4(v.w, c, a[12], a[13], a[14], a[15]);
}
constexpr int L_ROUTE = 0, L_NLIST = 32768, L_CAND = 40960, L_OFF = 41472, L_SORT = 43008, L_END = 43008 + 32768;
constexpr int NSL = 8, SL_SHIFT = 11;
__device__ __forceinline__ void peer_tile(int tile, const bf16* PQ, const bf16* SK, const float* SSQ, const unsigned char* U8, const unsigned char* V8, const float* gfin, const bf16* HB, float* out, LAS unsigned char* lds, int mode = 3, float* outw = nullptr) {
    const int lane = threadIdx.x & 63, r32 = lane & 31, hi = lane >> 5; const int wid = __builtin_amdgcn_readfirstlane((int)threadIdx.x >> 6);
    const int tok0 = tile * 32; if (!outw) outw = out;
    LAS unsigned* route = (LAS unsigned*)(lds + L_ROUTE);
    LAS unsigned char* nl = lds + L_NLIST + (wid * 32 + r32) * 32;
    const LAS unsigned char* cand = lds + L_CAND;
    if (mode & 1) {
        const int h = wid; int T0[16], T1[16];
        topk_half(PQ + (size_t)(tok0 + r32) * NPQ + (h * 2 + 0) * 128 + hi * 8, SK + (size_t)(h * 2 + 0) * 16384 + (hi * 32 + r32) * 8, hi, T0);
        topk_half(PQ + (size_t)(tok0 + r32) * NPQ + (h * 2 + 1) * 128 + hi * 8, SK + (size_t)(h * 2 + 1) * 16384 + (hi * 32 + r32) * 8, hi, T1);
        const int hm = -hi;
        {
            u32x4 w;
#pragma unroll
            for (int q4 = 0; q4 < 4; ++q4) { unsigned a = 0;
#pragma unroll
                for (int e = 0; e < 4; ++e) { const int t = sel_hi(T0[4 * q4 + e], T1[4 * q4 + e], hm); a |= (unsigned)(127 - (t & 127)) << (8 * e); }
                w[q4] = a; }
            *(LAS u32x4*)(nl + 16 * hi) = w;
        }
        float v0[16], v1[16];
#pragma unroll
        for (int i = 0; i < 16; ++i) { v0[i] = key2f(T0[i] & ~127); v1[i] = key2f(T1[i] & ~127); }
        int x[64];
        PEER_CAND_SUMS(x, v0, v1, key6);
        top16_of_64(x);
        const float smax = key2f(x[0] & ~63);
        float p[16], ps = 0.f;
#pragma unroll
        for (int i = 0; i < 16; ++i) { p[i] = __builtin_amdgcn_exp2f((key2f(x[i] & ~63) - smax) * LOG2E); ps += p[i]; }
        const float rps = 1.0f / ps;
        LDS_WAIT();
#pragma unroll
        for (int i = 0; i < 8; ++i) {
            const int xi = sel_hi(x[i], x[8 + i], hm); const float g = __int_as_float(sel_hi(__float_as_int(p[i]), __float_as_int(p[8 + i]), hm)) * rps;
            const int ij = cand[63 - (xi & 63)]; const int n0 = nl[ij & 15], n1 = nl[16 + (ij >> 4)];
            u32x2 w; w.x = (unsigned)(n0 * 128 + n1); w.y = __float_as_uint(g);
            *(LAS u32x2*)(route + ((size_t)r32 * 128 + h * 16 + 8 * hi + i) * 2) = w; }
    }
    LDS_WAIT(); __syncthreads();
    if (mode & 2) {
    const int m0 = -(lane & 1), m1 = -((lane >> 1) & 1);
    const int jj = ((lane & 1) << 1) | ((lane >> 1) & 1);
    LAS unsigned* srtw = (LAS unsigned*)(lds + L_SORT) + wid * 1024;
    LAS unsigned char* offw = lds + L_OFF + wid * 128;
    const unsigned long long lt = (1ull << lane) - 1ull;
#pragma unroll 1
    for (int tt = 0; tt < 4; ++tt) {
        const LAS unsigned* rt0 = route + (wid * 4 + tt) * 256; LAS unsigned* srt = srtw + tt * 256; LAS unsigned char* offb = offw + tt * 32;
        const u32x2 ea = *(const LAS u32x2*)(rt0 + lane * 2), eb = *(const LAS u32x2*)(rt0 + (lane + 64) * 2);
        const int sa = (int)ea.x >> SL_SHIFT, sb_ = (int)eb.x >> SL_SHIFT; int base = 0, pa = 0, pb = 0;
#pragma unroll 1
        for (int v = 0; v < NSL; ++v) { const unsigned long long ma = __ballot(sa == v), mb = __ballot(sb_ == v); const int ca = __popcll(ma), cb2 = __popcll(mb);
            if (lane == 0) offb[v] = (unsigned char)base;
            if (sa == v) pa = base + __popcll(ma & lt); if (sb_ == v) pb = base + ca + __popcll(mb & lt); base += ca + cb2; }
        if (lane == 0) offb[NSL] = (unsigned char)128;
        *(LAS u32x2*)(srt + pa * 2) = ea; *(LAS u32x2*)(srt + pb * 2) = eb;
    }
    LDS_WAIT();
    unsigned hx[4][8]; float scl[4], acc[4][16];
#pragma unroll
    for (int tt = 0; tt < 4; ++tt) {
        const size_t tok = (size_t)tok0 + wid * 4 + tt; const bf16* hrow = HB + tok * 1024 + lane * 16;
        const f32x4* sp = (const f32x4*)(SSQ + tok * 16); const f32x4 a = sp[0], b = sp[1], c = sp[2], d = sp[3]; const f32x4 t4 = (a + b) + (c + d);
        scl[tt] = __builtin_amdgcn_rsqf(((t4[0] + t4[1]) + (t4[2] + t4[3])) * (1.0f / 1024.0f) + RMS_EPS) * (1.0f / 256.0f);
        { const u32x4 ha = *(const GAS u32x4*)hrow, hb2 = *(const GAS u32x4*)(hrow + 8);
          hx[tt][0] = ha.x; hx[tt][1] = ha.y; hx[tt][2] = ha.z; hx[tt][3] = ha.w; hx[tt][4] = hb2.x; hx[tt][5] = hb2.y; hx[tt][6] = hb2.z; hx[tt][7] = hb2.w; }
#pragma unroll
        for (int i = 0; i < 16; ++i) acc[tt][i] = 0.f;
    }
#define PEER_BATCH(tt_, k_, hi_) do { const LAS unsigned* srt = srtw + (tt_) * 256; u32x4 uu[4], vv[4]; float d_[4]; \
        _Pragma("unroll") for (int j = 0; j < 4; ++j) { const int ix = ((k_) + j < (hi_)) ? (k_) + j : (hi_) - 1; const int e = __builtin_amdgcn_readfirstlane((int)srt[ix * 2]); \
            uu[j] = *(const GAS u32x4*)(U8 + (size_t)e * 1024 + lane * 16); vv[j] = *(const GAS u32x4*)(V8 + (size_t)e * 1024 + lane * 16); } \
        _Pragma("unroll") for (int j = 0; j < 4; ++j) d_[j] = fp8dot16b(uu[j], hx[tt_]); \
        float e_[2]; \
        _Pragma("unroll") for (int i = 0; i < 2; ++i) { const float keep = fsel(d_[i], d_[i + 2], m0), send = fsel(d_[i + 2], d_[i], m0); e_[i] = keep + dpp<0xB1>(send); } \
        float g_ = fsel(e_[0], e_[1], m1) + dpp<0x4E>(fsel(e_[1], e_[0], m1)); \
        g_ += dpp<0x124>(g_); g_ += dpp<0x128>(g_); g_ = swap16_sum(g_); g_ = swap32_sum(g_);     \
        const int mi = (k_) + jj; const float gate = (mi < (hi_)) ? __uint_as_float(srt[(mi < (hi_) ? mi : (hi_) - 1) * 2 + 1]) : 0.f; \
        const float cfl = gate * gelu_tanh(g_ * scl[tt_]) * (1.0f / 16.0f); \
        _Pragma("unroll") for (int j = 0; j < 4; ++j) { const int src = ((j & 1) << 1) | ((j >> 1) & 1); \
            const float cj = __int_as_float(__builtin_amdgcn_readlane(__float_as_int(cfl), src)); \
            fp8axpy16(vv[j], cj, acc[tt_]); } } while (0)
#pragma unroll 1
    for (int r = 0; r < NSL; ++r) {
#pragma unroll
        for (int tt = 0; tt < 4; ++tt) {
            const int lo = __builtin_amdgcn_readfirstlane((int)offw[tt * 32 + r]), hi2 = __builtin_amdgcn_readfirstlane((int)offw[tt * 32 + r + 1]);
#pragma unroll 1
            for (int k = lo; k < hi2; k += 4) PEER_BATCH(tt, k, hi2);
        }
    }
#undef PEER_BATCH
#pragma unroll
    for (int tt = 0; tt < 4; ++tt) {
        const size_t tok = (size_t)tok0 + wid * 4 + tt; const bf16* hrow = HB + tok * 1024 + lane * 16; float* wrow = outw + tok * 1024;
        float hv[16]; float s = 0.f;
        { const u32x4 ha = *(const GAS u32x4*)hrow, hb2 = *(const GAS u32x4*)(hrow + 8);
          hv[0] = bflo(ha.x); hv[1] = bfhi(ha.x); hv[2] = bflo(ha.y); hv[3] = bfhi(ha.y); hv[4] = bflo(ha.z); hv[5] = bfhi(ha.z); hv[6] = bflo(ha.w); hv[7] = bfhi(ha.w);
          hv[8] = bflo(hb2.x); hv[9] = bfhi(hb2.x); hv[10] = bflo(hb2.y); hv[11] = bfhi(hb2.y); hv[12] = bflo(hb2.z); hv[13] = bfhi(hb2.z); hv[14] = bflo(hb2.w); hv[15] = bfhi(hb2.w); }
#pragma unroll
        for (int i = 0; i < 16; ++i) { hv[i] += acc[tt][i]; s += hv[i] * hv[i]; }
        const float rs = 1.0f / sqrtf(wave_sum(s) * (1.f / 1024.f) + RMS_EPS);
#pragma unroll
        for (int q = 0; q < 4; ++q) { const f32x4 g = *(const GAS f32x4*)(gfin + lane * 16 + q * 4); f32x4 t;
            t.x = hv[4 * q] * rs * g.x; t.y = hv[4 * q + 1] * rs * g.y; t.z = hv[4 * q + 2] * rs * g.z; t.w = hv[4 * q + 3] * rs * g.w;
            *(GAS f32x4*)(wrow + lane * 16 + q * 4) = t; }
    }
    }
    LDS_WAIT(); __syncthreads();
}
}
struct Args { const float* in[20]; float* out; unsigned char* ws; int ph_lo, ph_hi, li, pad; };
__global__ void __launch_bounds__(NWAVES * 64, 2) fwd_megakernel(Args args) {
    extern __shared__ __attribute__((aligned(16))) unsigned char lds[];
    LAS unsigned char* ldsp = (LAS unsigned char*)lds;
    volatile LAS unsigned* MISC = (volatile LAS unsigned*)(ldsp + MISC_OFF);
    const int tid = threadIdx.x, lane = tid & 63, wave = __builtin_amdgcn_readfirstlane(tid >> 6);
    const int G = gridDim.x; const int bx = blockIdx.x; const int vcu = (G % 8 == 0) ? (bx % 8) * (G / 8) + bx / 8 : bx;
    unsigned char* ws = args.ws;
    gu32* ctl = (gu32*)(ws + WS_CTL);
    const float* x = args.in[0]; const float* mem = args.in[1]; const float* norm_mix = args.in[2]; const float* w_in = args.in[3]; const float* conv_w = args.in[4];
    const float* w_ba = args.in[5]; const float* w_bc = args.in[6]; const float* w_out = args.in[7]; const float* norm_xattn = args.in[8]; const float* norm_mem = args.in[9];
    const float* xwq = args.in[10]; const float* xwk = args.in[11]; const float* xwv = args.in[12]; const float* xwo = args.in[13]; const float* norm_ffn = args.in[14];
    const float* pwq = args.in[15]; const float* psk = args.in[16]; const float* pu = args.in[17]; const float* pv = args.in[18]; const float* norm_final = args.in[19];
    float* out = args.out;
    bf16* Win_t = (bf16*)(ws + WS_WIN); bf16* Wa_t = (bf16*)(ws + WS_WA); bf16* Wc_t = (bf16*)(ws + WS_WC); bf16* Wo_t = (bf16*)(ws + WS_WO); bf16* Wq2_t = (bf16*)(ws + WS_WQ2);
    bf16* Wkv2_t = (bf16*)(ws + WS_WKV2); bf16* Wo2_t = (bf16*)(ws + WS_WO2); bf16* Wpq_t = (bf16*)(ws + WS_WPQ); bf16* SKb = (bf16*)(ws + WS_SK);
    float* SSQ1 = (float*)(ws + WS_SSQ1); float* SSQ2 = (float*)(ws + WS_SSQ2); bf16* MEMN = (bf16*)(ws + WS_MEMN); bf16* K2 = (bf16*)(ws + WS_K2); bf16* V2T = (bf16*)(ws + WS_V2T);
    bf16* B0 = (bf16*)(ws + WS_B0); bf16* B1 = (bf16*)(ws + WS_B1); bf16* B2 = (bf16*)(ws + WS_B2); bf16* B3 = (bf16*)(ws + WS_B3); bf16* B4 = (bf16*)(ws + WS_B4); bf16* B5 = (bf16*)(ws + WS_B5);
    bf16* XN1 = (bf16*)out; bf16* YC = (bf16*)out; bf16* CBb = (bf16*)((unsigned char*)out + 32 * MiB);

    for (int u = tid; u < (LDS_BYTES - LDSCTL_OFF) / 4; u += NWAVES * 64) ((LAS unsigned*)(ldsp + LDSCTL_OFF))[u] = 0u;
    __syncthreads();
    XcdBarrier bar; bar.bar = (unsigned*)(ctl + CW_BAR); bar.x = 0; bar.st = nullptr;
    if (N_LAUNCHES == 1) bar = xcd_barrier_post((unsigned*)(ctl + CW_BAR), MISC + 8);
#define GRID_BAR() do { if (N_LAUNCHES == 1) xcd_barrier(bar); } while (0)
    const int lo = args.ph_lo, hi = args.ph_hi;
#define IN(k) (lo <= (k) && (k) < hi)
#define BOTH(k) (IN(k) && IN((k) + 1))
    const int gw = vcu * NWAVES + wave, NGW = G * NWAVES;

    if (IN(0)) {
        LAS float* scr = (LAS float*)(ldsp + RING_OFF + wave * 16384);
        constexpr int I_IN = 16 * 256, I_SQ = 16 * 32;
        constexpr int NT_ITEMS = I_IN + 2 * I_SQ;
        for (int it = gw; it < NT_ITEMS; it += NGW) {
            int r = it;
            if (r < I_IN) { transpose_item<true>(w_in, D, NIN, nullptr, Win_t, 0, scr, r, lane); continue; } r -= I_IN;
            if (r < I_SQ) { transpose_item<false>(xwk, D, D, nullptr, Wkv2_t, 0, scr, r, lane); continue; } r -= I_SQ;
            transpose_item<false>(xwv, D, D, nullptr, Wkv2_t, D, scr, r, lane);
        }
        for (int it = gw; it < 512; it += NGW) {
            const int hc = it >> 5, kt = (it >> 3) & 3, ks = it & 7, n = 32 * kt + (lane & 31), d0 = 16 * ks + 8 * (lane >> 5);
            const GAS f32x4* s = (const GAS f32x4*)(psk + ((size_t)(hc * 128 + n) * 128 + d0)); const f32x4 a = s[0], b = s[1];
            v4u o; o.x = pk2(a.x, a.y); o.y = pk2(a.z, a.w); o.z = pk2(b.x, b.y); o.w = pk2(b.z, b.w);
            *((GAS v4u*)SKb + (size_t)it * 64 + lane) = o; }
        for (int m = gw; m < M; m += 2 * NGW) rms_rows2_to_bf16(x + (size_t)m * D, (size_t)NGW, norm_mix, XN1 + (size_t)m * D, lane);
        for (int m = gw; m < MROWS; m += NGW) rms_row_to_bf16(mem + (size_t)m * D, norm_mem, MEMN + (size_t)m * D, lane);
        if (BOTH(0)) GRID_BAR();
    }

    if (IN(1)) {
        pg8::GemmSet g{XN1, Win_t, XN1, Win_t, D}; pg8::TileOrder S; S.init(M, NIN, G, bx);
        pg8::EpiInProj E{B0, B1, B2, B3, CBb, B4, B5, 0.125f * LOG2E};
        pg8::gemm_phase<pg8::EpiInProj, pg8::TileOrder, true, true>(ldsp + RING_OFF, g, S, E);
        if (BOTH(1)) GRID_BAR();
    }

    if (IN(2)) {
        {
            const int bh = vcu >> 1, s = vcu & 1;
            if (bh < BATCH * 16) {
#pragma unroll 1
                for (int i = 0; i < 4; ++i) { const int qb = (i == 0) ? s : (i == 1) ? 7 - s : (i == 2) ? 2 + s : 5 - s;
                    sb::sb_unit<true>(bh >> 4, bh & 15, qb, (const sb::bf16*)B0, (const sb::bf16*)B1, (const sb::bf16*)B2, (sb::bf16*)B0, (char*)lds + RING_OFF); }
            }
            asm volatile("s_waitcnt vmcnt(0) lgkmcnt(0)" ::: "memory"); __syncthreads();
        }
        if (vcu < 32) {
            pg8::GemmSet g{MEMN, Wkv2_t, MEMN, Wkv2_t, D}; pg8::SubOrder S; S.init(MROWS, D, 0, vcu);
            pg8::EpiStore E{K2, D, 1.0f};
            pg8::gemm_phase<pg8::EpiStore, pg8::SubOrder, false, true>(ldsp + RING_OFF, g, S, E);
        } else if (vcu < 64) {
            pg8::GemmSet g{Wkv2_t + (size_t)D * D, MEMN, Wkv2_t + (size_t)D * D, MEMN, D}; pg8::SubOrder S; S.init(D, MROWS, 32, vcu);
            pg8::EpiStoreKPerm E{V2T, MROWS};
            pg8::gemm_phase<pg8::EpiStoreKPerm, pg8::SubOrder, false, true>(ldsp + RING_OFF, g, S, E);
        } else {
            const int cw_ = (vcu - 64) * NWAVES + wave, ncw = (G - 64) * NWAVES;
            for (int it = cw_; it < M / 8; it += ncw) yconv_item(B3, CBb, conv_w, YC, it, lane);
            {
                LAS float* scr = (LAS float*)(ldsp + RING_OFF + wave * 16384);
                constexpr int I_SQ = 16 * 32, I_PQ = 16 * 64;
                for (int it = cw_; it < 5 * I_SQ + I_PQ; it += ncw) {
                    int r = it;
                    if (r < I_SQ) { transpose_item<false>(w_ba, D, D, nullptr, Wa_t, 0, scr, r, lane); continue; } r -= I_SQ;
                    if (r < I_SQ) { transpose_item<false>(w_bc, D, D, nullptr, Wc_t, 0, scr, r, lane); continue; } r -= I_SQ;
                    if (r < I_SQ) { transpose_item<false>(w_out, D, D, nullptr, Wo_t, 0, scr, r, lane); continue; } r -= I_SQ;
                    if (r < I_SQ) { transpose_item<false>(xwq, D, D, norm_xattn, Wq2_t, 0, scr, r, lane); continue; } r -= I_SQ;
                    if (r < I_SQ) { transpose_item<false>(xwo, D, D, nullptr, Wo2_t, 0, scr, r, lane); continue; } r -= I_SQ;
                    transpose_item<false>(pwq, D, NPQ, norm_ffn, Wpq_t, 0, scr, r, lane);
                }
            }
        }
        if (BOTH(2)) GRID_BAR();
    }

    if (IN(3)) {
        pg8::GemmSet g{B0, Wa_t, YC, Wc_t, D}; pg8::TileOrder S; S.init(M, D, G, bx, 2);
        pg8::EpiGate E{B1, B4, B5};
        pg8::gemm_phase<pg8::EpiGate, pg8::TileOrder, true, true>(ldsp + RING_OFF, g, S, E);
        if (BOTH(3)) GRID_BAR();
    }

    if (IN(4)) {
        pg8::GemmSet g{B1, Wo_t, B1, Wo_t, D}; pg8::TileOrder S; S.init(M, D, G, bx);
        pg8::EpiResid<false> E{x, nullptr, B2, SSQ1};
        pg8::gemm_phase<pg8::EpiResid<false>, pg8::TileOrder, true, true>(ldsp + RING_OFF, g, S, E);
        if (BOTH(4)) GRID_BAR();
    }

    if (IN(5)) {
        pg8::GemmSet g{B2, Wq2_t, B2, Wq2_t, D}; pg8::TileOrder S; S.init(M, D, G, bx);
        pg8::EpiRowScale E{B3, D, SSQ1, LOG2E / 16.0f, RMS_EPS};
        pg8::gemm_phase<pg8::EpiRowScale, pg8::TileOrder, true, true>(ldsp + RING_OFF, g, S, E);
        for (int r = gw; r < 16384; r += 4 * NGW) rows4_to_fp8(pu + (size_t)r * D, (size_t)NGW, norm_ffn, 256.0f, (unsigned char*)B4 + (size_t)r * D, lane);
        for (int r = gw; r < 16384; r += 4 * NGW) rows4_to_fp8(pv + (size_t)r * D, (size_t)NGW, nullptr, 16.0f, (unsigned char*)B4 + 16 * MiB + (size_t)r * D, lane);
        if (BOTH(5)) GRID_BAR();
    }

    if (IN(6)) {
#ifndef NO_XA
        for (int u = 2 * vcu; u < 512; u += 2 * G) { xa::xattn_unit(u >> 6, (u >> 4) & 3, u & 15, B3, K2, V2T, B0, (char*)lds + RING_OFF); xa::xattn_unit(u >> 6, (u >> 4) & 3, (u & 15) + 1, B3, K2, V2T, B0, (char*)lds + RING_OFF); }
        asm volatile("s_waitcnt vmcnt(0) lgkmcnt(0)" ::: "memory"); __syncthreads();
#endif
        if (BOTH(6)) GRID_BAR();
    }

    if (IN(7)) {
        pg8::GemmSet g{B0, Wo2_t, B0, Wo2_t, D}; pg8::TileOrder S; S.init(M, D, G, bx);
        pg8::EpiResid<true> E{nullptr, B2, B1, SSQ2};
        pg8::gemm_phase<pg8::EpiResid<true>, pg8::TileOrder, true, true>(ldsp + RING_OFF, g, S, E);
        if (BOTH(7)) GRID_BAR();
    }

    if (IN(8)) {
        pg8::GemmSet g{B1, Wpq_t, B1, Wpq_t, D}; pg8::TileOrder S; S.init(M, NPQ, G, bx);
        pg8::EpiRowScale E{B2, NPQ, SSQ2, 1.0f, RMS_EPS};
        pg8::gemm_phase<pg8::EpiRowScale, pg8::TileOrder, true, true>(ldsp + RING_OFF, g, S, E);
        if (BOTH(8)) GRID_BAR();
    }

    if (IN(9)) {
        if (tid < 64) { int cnt = 0, val = 0;
            for (int ii = 0; ii < 16; ++ii) { const int nj = 16 / (ii + 1); if (tid >= cnt && tid < cnt + nj) val = ii | ((tid - cnt) << 4); cnt += nj; }
            ldsp[RING_OFF + peer::L_CAND + tid] = (unsigned char)val; }
        LDS_WAIT(); __syncthreads();
#ifndef NO_PEER
        for (int tile = vcu; tile < M / 32; tile += G) {
#ifdef PROBE_P9
            peer::peer_tile(tile, B2, SKb, SSQ2, (const unsigned char*)B4, (const unsigned char*)B4 + 16 * MiB, norm_final, B1, out, ldsp + RING_OFF, PROBE_P9, (float*)B0);
#endif
            peer::peer_tile(tile, B2, SKb, SSQ2, (const unsigned char*)B4, (const unsigned char*)B4 + 16 * MiB, norm_final, B1, out, ldsp + RING_OFF); }
#else
        for (int m = gw; m < M; m += NGW) final_norm_row(out + (size_t)m * D, norm_final, out + (size_t)m * D, lane);
#endif
    }
#undef IN
#undef BOTH
#undef GRID_BAR
}

extern "C" void kernel_launch(void* const* d_in, const int* in_sizes, int n_in, void* d_out, int out_size, void* d_ws, size_t ws_size, hipStream_t stream) {
    static int grid = 0;
    if (grid == 0) {
        if (n_in != 20 || in_sizes[0] != M * D || out_size != M * D || ws_size < WS_END) { fprintf(stderr, "kernel_launch: unexpected shapes (n_in %d, in0 %d, out %d, ws %zu); nothing launched\n", n_in, n_in > 0 ? in_sizes[0] : -1, out_size, ws_size); grid = -1; return; }
        int dev = 0, cus = 0, per_cu = 0;
        if (hipGetDevice(&dev) != hipSuccess || hipDeviceGetAttribute(&cus, hipDeviceAttributeMultiprocessorCount, dev) != hipSuccess) { grid = -1; return; }
        if (hipFuncSetAttribute((const void*)fwd_megakernel, hipFuncAttributeMaxDynamicSharedMemorySize, LDS_BYTES) != hipSuccess) { fprintf(stderr, "kernel_launch: hipFuncSetAttribute failed\n"); grid = -1; return; }
        if (hipOccupancyMaxActiveBlocksPerMultiprocessor(&per_cu, (const void*)fwd_megakernel, NWAVES * 64, LDS_BYTES) != hipSuccess || per_cu < 1)
            fprintf(stderr, "kernel_launch: note: occupancy query reports %d workgroups per CU\n", per_cu);
        (void)hipGetLastError();
        grid = cus;
    }
    if (grid < 0) return;
    if (hipMemsetAsync((char*)d_ws + WS_CTL, 0, CTL_ZERO_BYTES, stream) != hipSuccess) { fprintf(stderr, "kernel_launch: hipMemsetAsync failed\n"); return; }
    Args a{};
    for (int i = 0; i < 20; ++i) a.in[i] = (const float*)d_in[i];
    a.out = (float*)d_out; a.ws = (unsigned char*)d_ws;
    if (N_LAUNCHES == 1) { a.ph_lo = 0; a.ph_hi = N_PHASES; a.li = 0; hipLaunchKernelGGL(fwd_megakernel, dim3(grid), dim3(NWAVES * 64), LDS_BYTES, stream, a); }
    else for (int li = 0; li < N_PHASES; ++li) { a.ph_lo = li; a.ph_hi = li + 1; a.li = li; hipLaunchKernelGGL(fwd_megakernel, dim3(grid), dim3(NWAVES * 64), LDS_BYTES, stream, a);
#ifdef PROBE_DUP
        if (li == PROBE_DUP) hipLaunchKernelGGL(fwd_megakernel, dim3(grid), dim3(NWAVES * 64), LDS_BYTES, stream, a);
#endif
    }
    const hipError_t le = hipPeekAtLastError();
    if (le != hipSuccess) fprintf(stderr, "kernel_launch: launch failed: %s\n", hipGetErrorName(le));
}
```

```cpp
#include <hip/hip_runtime.h>
#include <hip/hip_bf16.h>
#include <cstdio>
#include <cstdint>
#include <cmath>
#include <type_traits>

#ifndef MK_N_LAUNCHES
#define MK_N_LAUNCHES 1
#endif
namespace pg8 {
#define PG8_LAS __attribute__((address_space(3)))
typedef unsigned short bf16_t;
typedef short bf16x8 __attribute__((ext_vector_type(8)));
typedef float f32x4 __attribute__((ext_vector_type(4)));
typedef float f32x2 __attribute__((ext_vector_type(2)));
typedef unsigned u32x4 __attribute__((ext_vector_type(4)));
typedef unsigned u32x2 __attribute__((ext_vector_type(2)));
constexpr int BM = 256, BK = 64, HALF = 128, HTB = HALF * BK * 2  , STAGE_BYTES = 8 * HTB, NXCD = 8, WGM = 8;

__host__ __device__ __forceinline__ int lds_byte(int r, int c) { const int st = (r >> 4) * 2 + (c >> 5), rr = r & 15, cc = c & 31, ob = rr * 64 + cc * 2; return st * 1024 + (ob ^ (((ob >> 9) & 1) << 5)); }
__host__ __device__ __forceinline__ void stage_rc(int b, int& R, int& C) { const int st = b / 1024, sb = b % 1024, swz = sb ^ (((sb >> 9) & 1) << 5); R = (st >> 1) * 16 + swz / 64; C = (st & 1) * 32 + (swz % 64) / 2; }
__host__ __device__ __forceinline__ int perm32(int rho) { const int n = rho >> 4, i = rho & 15; return 8 * (i >> 2) + 4 * n + (i & 3); }

template <class E, class = void> struct epi_has_init : std::false_type {};
template <class E> struct epi_has_init<E, std::void_t<decltype(E::HAS_INIT)>> : std::true_type {};
struct Unit { int pm, pn, g; };
struct GemmSet { const bf16_t* A0; const bf16_t* B0; const bf16_t* A1; const bf16_t* B1; int K; };

struct TileOrder {
    int nM, nN, nwg, G, c, passes;
    __device__ void init(int M, int N, int G_, int c_, int passes_ = 1) { nM = M / BM; nN = N / BM; nwg = nM * nN; G = G_; c = c_; passes = passes_; }
    __device__ bool next(int i, Unit& u) const {
        const int ti = (passes == 2) ? (i >> 1) : i; u.g = (passes == 2) ? (i & 1) : 0;
        const long L = (long)ti * G + c; if (L >= nwg) return false;
        int wgid = (int)L; { const int q = nwg / NXCD, r = nwg % NXCD, xcd = wgid % NXCD, off = wgid / NXCD; wgid = (xcd < r ? xcd * (q + 1) : r * (q + 1) + (xcd - r) * q) + off; }
        const int nig = WGM * nN, gid = wgid / nig, fm = gid * WGM, gsz = (nM - fm) < WGM ? (nM - fm) : WGM;
        u.pm = fm + ((wgid % nig) % gsz); u.pn = (wgid % nig) / gsz; return true;
    }
    __device__ __forceinline__ void a_ready(const Unit&) const {}
    __device__ __forceinline__ void done(const Unit&) const {}
};
struct SubOrder {
    int nN, n, idx;
    __device__ void init(int M, int N, int c0, int c_) { nN = N / BM; n = (M / BM) * nN; idx = c_ - c0; }
    __device__ bool next(int i, Unit& u) const { if (i != 0 || idx < 0 || idx >= n) return false; u.pm = idx / nN; u.pn = idx % nN; u.g = 0; return true; }
    __device__ __forceinline__ void a_ready(const Unit&) const {}
    __device__ __forceinline__ void done(const Unit&) const {}
};

typedef __bf16 bf16x2_t __attribute__((ext_vector_type(2)));
__device__ __forceinline__ unsigned cvt_pk_bf16(float lo, float hi) { f32x2 v = {lo, hi}; bf16x2_t b = __builtin_convertvector(v, bf16x2_t); return __builtin_bit_cast(unsigned, b); }
__device__ __forceinline__ float bf_lo(unsigned w) { return __builtin_bit_cast(float, w << 16); }
__device__ __forceinline__ float bf_hi(unsigned w) { return __builtin_bit_cast(float, w & 0xffff0000u); }
__device__ __forceinline__ u32x4 pack8(const f32x4 v0, const f32x4 v1) { u32x4 w; w.x = cvt_pk_bf16(v0[0], v0[1]); w.y = cvt_pk_bf16(v0[2], v0[3]); w.z = cvt_pk_bf16(v1[0], v1[1]); w.w = cvt_pk_bf16(v1[2], v1[3]); return w; }
__device__ __forceinline__ float sigmoidf_fast(float x) { return __builtin_amdgcn_rcpf(1.0f + __builtin_amdgcn_exp2f(-1.4426950408889634f * x)); }

struct EpiStore {
    static constexpr bool PERM = true, AFTER_DRAIN = false;
    bf16_t* O; int ldc; float scale;
    __device__ __forceinline__ void operator()(const f32x4 (&acc)[2][2][4][2], const Unit& u, int wr, int wc, int fr, int fq) const {
        const int row0 = u.pm * BM + wr * 64 + fr, col0 = u.pn * BM + wc * 32 + 8 * fq;
#pragma unroll
        for (int ai = 0; ai < 2; ++ai)
#pragma unroll
            for (int m = 0; m < 4; ++m) { bf16_t* rowp = O + (size_t)(row0 + ai * HALF + m * 16) * ldc + col0;
#pragma unroll
                for (int bj = 0; bj < 2; ++bj) *(u32x4*)(rowp + bj * HALF) = pack8(acc[ai][bj][m][0] * scale, acc[ai][bj][m][1] * scale); }
    }
};

struct EpiStoreKPerm {
    static constexpr bool PERM = true, AFTER_DRAIN = false;
    bf16_t* O; int ldc;
    __device__ __forceinline__ void operator()(const f32x4 (&acc)[2][2][4][2], const Unit& u, int wr, int wc, int fr, int fq) const {
        const int row0 = u.pm * BM + wr * 64 + fr, colg = u.pn * BM + wc * 32;
#pragma unroll
        for (int ai = 0; ai < 2; ++ai)
#pragma unroll
            for (int m = 0; m < 4; ++m) { bf16_t* rowp = O + (size_t)(row0 + ai * HALF + m * 16) * ldc + colg;
#pragma unroll
                for (int bj = 0; bj < 2; ++bj)
#pragma unroll
                    for (int n = 0; n < 2; ++n) { const f32x4 v = acc[ai][bj][m][n]; u32x2 w; w.x = cvt_pk_bf16(v[0], v[1]); w.y = cvt_pk_bf16(v[2], v[3]);
                        *(u32x2*)(rowp + bj * HALF + 8 * ((2 * fq + n) & 3) + 4 * (fq >> 1)) = w; } }
    }
};

struct EpiInProj {
    static constexpr bool PERM = true, AFTER_DRAIN = false;
    bf16_t *q, *k, *v, *uu, *cb, *sga, *sgc; float qscale;
    __device__ __forceinline__ void operator()(const f32x4 (&acc)[2][2][4][2], const Unit& u, int wr, int wc, int fr, int fq) const {
        const int row0 = u.pm * BM + wr * 64 + fr; const int pn = u.pn;
        if (pn >= 12 && pn < 20) {
            const int col0 = (pn - 12) * 128 + wc * 32 + 8 * fq;
#pragma unroll
            for (int ai = 0; ai < 2; ++ai)
#pragma unroll
                for (int m = 0; m < 4; ++m) *(u32x4*)(uu + (size_t)(row0 + ai * HALF + m * 16) * 1024 + col0) = pack8(acc[ai][0][m][0] * acc[ai][1][m][0], acc[ai][0][m][1] * acc[ai][1][m][1]);
            return;
        }
        if (pn >= 24) {
            const int col0 = (pn - 24) * 128 + wc * 32 + 8 * fq;
#pragma unroll
            for (int ai = 0; ai < 2; ++ai)
#pragma unroll
                for (int m = 0; m < 4; ++m) { const size_t off = (size_t)(row0 + ai * HALF + m * 16) * 1024 + col0; unsigned q[8];
#pragma unroll
                    for (int e = 0; e < 8; ++e) { const int n = e >> 2, c = e & 3;
                        const float sa = __builtin_amdgcn_rcpf(1.0f + __builtin_amdgcn_exp2f(-1.4426950408889634f * acc[ai][0][m][n][c])), sc = __builtin_amdgcn_rcpf(1.0f + __builtin_amdgcn_exp2f(-1.4426950408889634f * acc[ai][1][m][n][c]));
                        const unsigned qa = (unsigned)(255.0f * sa + 0.5f); unsigned qc = (unsigned)(255.0f * sc + 0.5f); qc = qc < 1u ? 1u : qc;
                        q[e] = qa | (qc << 8); }
                    u32x4 w; w.x = q[0] | (q[1] << 16); w.y = q[2] | (q[3] << 16); w.z = q[4] | (q[5] << 16); w.w = q[6] | (q[7] << 16);
                    *(u32x4*)(sga + off) = w; }
            return;
        }
        bf16_t* base; float sc = 1.f;
        if (pn < 4) { base = q; sc = qscale; } else if (pn < 8) base = k; else if (pn < 12) base = v; else base = cb;
        const int col0 = (pn & 3) * BM + wc * 32 + 8 * fq;
#pragma unroll
        for (int ai = 0; ai < 2; ++ai)
#pragma unroll
            for (int m = 0; m < 4; ++m) { bf16_t* rowp = base + (size_t)(row0 + ai * HALF + m * 16) * 1024 + col0;
#pragma unroll
                for (int bj = 0; bj < 2; ++bj) *(u32x4*)(rowp + bj * HALF) = pack8(acc[ai][bj][m][0] * sc, acc[ai][bj][m][1] * sc); }
    }
};

struct EpiMidK {
    static constexpr bool PERM = true, AFTER_DRAIN = false;
    bf16_t* merged; const bf16_t* gates; const bf16_t* unused_;
    template <bool FINAL> static __device__ __forceinline__ float gmul(unsigned w, int hi) { const float qa = (float)((w >> (16 * hi)) & 0xffu), qc = (float)((w >> (16 * hi + 8)) & 0xffu);
        return FINAL ? qc * (1.0f / 255.0f) : qa * __builtin_amdgcn_rcpf(qc); }
    __device__ __forceinline__ void midk(f32x4 (&acc)[2][2][4][2], const Unit& u, int wr, int wc, int fr, int fq) const {
        const int row0 = u.pm * BM + wr * 64 + fr, col0 = u.pn * BM + wc * 32 + 8 * fq;
#pragma unroll
        for (int ai = 0; ai < 2; ++ai)
#pragma unroll
            for (int m = 0; m < 4; ++m) { const size_t off = (size_t)(row0 + ai * HALF + m * 16) * 1024 + col0;
#pragma unroll
                for (int bj = 0; bj < 2; ++bj) { const u32x4 gw = *(const u32x4*)(gates + off + bj * HALF);
                    f32x4& v0 = acc[ai][bj][m][0]; f32x4& v1 = acc[ai][bj][m][1];
                    v0[0] *= gmul<false>(gw.x, 0); v0[1] *= gmul<false>(gw.x, 1); v0[2] *= gmul<false>(gw.y, 0); v0[3] *= gmul<false>(gw.y, 1);
                    v1[0] *= gmul<false>(gw.z, 0); v1[1] *= gmul<false>(gw.z, 1); v1[2] *= gmul<false>(gw.w, 0); v1[3] *= gmul<false>(gw.w, 1); } }
    }
    __device__ __forceinline__ void operator()(const f32x4 (&acc_)[2][2][4][2], const Unit& u, int wr, int wc, int fr, int fq) const {
        const int row0 = u.pm * BM + wr * 64 + fr, col0 = u.pn * BM + wc * 32 + 8 * fq;
#pragma unroll
        for (int ai = 0; ai < 2; ++ai)
#pragma unroll
            for (int m = 0; m < 4; ++m) { const size_t off = (size_t)(row0 + ai * HALF + m * 16) * 1024 + col0;
#pragma unroll
                for (int bj = 0; bj < 2; ++bj) { const u32x4 gw = *(const u32x4*)(gates + off + bj * HALF);
                    f32x4 v0 = acc_[ai][bj][m][0], v1 = acc_[ai][bj][m][1];
                    v0[0] *= gmul<true>(gw.x, 0); v0[1] *= gmul<true>(gw.x, 1); v0[2] *= gmul<true>(gw.y, 0); v0[3] *= gmul<true>(gw.y, 1);
                    v1[0] *= gmul<true>(gw.z, 0); v1[1] *= gmul<true>(gw.z, 1); v1[2] *= gmul<true>(gw.w, 0); v1[3] *= gmul<true>(gw.w, 1);
                    *(u32x4*)(merged + off + bj * HALF) = pack8(v0, v1); } }
    }
};

struct EpiGate {
    static constexpr bool PERM = true, AFTER_DRAIN = false;
    bf16_t* merged; const bf16_t* sga; const bf16_t* sgc;
    __device__ __forceinline__ void operator()(const f32x4 (&acc)[2][2][4][2], const Unit& u, int wr, int wc, int fr, int fq) const {
        const int row0 = u.pm * BM + wr * 64 + fr, col0 = u.pn * BM + wc * 32 + 8 * fq; const bf16_t* gate = u.g ? sgc : sga;
#pragma unroll
        for (int ai = 0; ai < 2; ++ai)
#pragma unroll
            for (int m = 0; m < 4; ++m) { const size_t off = (size_t)(row0 + ai * HALF + m * 16) * 1024 + col0;
#pragma unroll
                for (int bj = 0; bj < 2; ++bj) { const u32x4 gw = *(const u32x4*)(gate + off + bj * HALF);
                    f32x4 v0 = acc[ai][bj][m][0], v1 = acc[ai][bj][m][1];
                    v0[0] *= bf_lo(gw.x); v0[1] *= bf_hi(gw.x); v0[2] *= bf_lo(gw.y); v0[3] *= bf_hi(gw.y); v1[0] *= bf_lo(gw.z); v1[1] *= bf_hi(gw.z); v1[2] *= bf_lo(gw.w); v1[3] *= bf_hi(gw.w);
                    if (u.g) { const u32x4 pw = *(const u32x4*)(merged + off + bj * HALF);
                        v0[0] += bf_lo(pw.x); v0[1] += bf_hi(pw.x); v0[2] += bf_lo(pw.y); v0[3] += bf_hi(pw.y); v1[0] += bf_lo(pw.z); v1[1] += bf_hi(pw.z); v1[2] += bf_lo(pw.w); v1[3] += bf_hi(pw.w); }
                    *(u32x4*)(merged + off + bj * HALF) = pack8(v0, v1); } }
    }
};

template <bool BASE_BF16> struct EpiResid {
    static constexpr bool PERM = true, AFTER_DRAIN = false, HAS_INIT = true;
    const float* basef; const bf16_t* baseb; bf16_t* hb; float* ssq; bool pre;
    __device__ __forceinline__ void init(f32x4 (&acc)[2][2][4][2], const Unit& u, int wr, int wc, int fr, int fq) const {
        const int row0 = u.pm * BM + wr * 64 + fr, col0 = u.pn * BM + wc * 32 + 8 * fq;
#pragma unroll
        for (int ai = 0; ai < 2; ++ai)
#pragma unroll
            for (int m = 0; m < 4; ++m) { const size_t off = (size_t)(row0 + ai * HALF + m * 16) * 1024 + col0;
#pragma unroll
                for (int bj = 0; bj < 2; ++bj) { f32x4 b0 = (f32x4){0.f, 0.f, 0.f, 0.f}, b1 = b0;
                    if (pre) {
                        if (BASE_BF16) { const u32x4 w = *(const u32x4*)(baseb + off + bj * HALF); b0 = (f32x4){bf_lo(w.x), bf_hi(w.x), bf_lo(w.y), bf_hi(w.y)}; b1 = (f32x4){bf_lo(w.z), bf_hi(w.z), bf_lo(w.w), bf_hi(w.w)}; }
                        else { b0 = *(const f32x4*)(basef + off + bj * HALF); b1 = *(const f32x4*)(basef + off + bj * HALF + 4); } }
                    acc[ai][bj][m][0] = b0; acc[ai][bj][m][1] = b1; } }
    }
    __device__ __forceinline__ void operator()(const f32x4 (&acc)[2][2][4][2], const Unit& u, int wr, int wc, int fr, int fq) const {
        const int row0 = u.pm * BM + wr * 64 + fr, col0 = u.pn * BM + wc * 32 + 8 * fq;
#pragma unroll
        for (int ai = 0; ai < 2; ++ai)
#pragma unroll
            for (int m = 0; m < 4; ++m) { const int row = row0 + ai * HALF + m * 16; const size_t off = (size_t)row * 1024 + col0; float s = 0.f;
#pragma unroll
                for (int bj = 0; bj < 2; ++bj) { f32x4 b0 = (f32x4){0.f, 0.f, 0.f, 0.f}, b1 = b0;
                    if (!pre) {
                        if (BASE_BF16) { const u32x4 w = *(const u32x4*)(baseb + off + bj * HALF); b0 = (f32x4){bf_lo(w.x), bf_hi(w.x), bf_lo(w.y), bf_hi(w.y)}; b1 = (f32x4){bf_lo(w.z), bf_hi(w.z), bf_lo(w.w), bf_hi(w.w)}; }
                        else { b0 = *(const f32x4*)(basef + off + bj * HALF); b1 = *(const f32x4*)(basef + off + bj * HALF + 4); } }
                    const f32x4 h0 = b0 + acc[ai][bj][m][0], h1 = b1 + acc[ai][bj][m][1];
                    s += ((h0[0] * h0[0] + h0[1] * h0[1]) + (h0[2] * h0[2] + h0[3] * h0[3])) + ((h1[0] * h1[0] + h1[1] * h1[1]) + (h1[2] * h1[2] + h1[3] * h1[3]));
                    *(u32x4*)(hb + off + bj * HALF) = pack8(h0, h1); }
                s += __shfl_xor(s, 16); s += __shfl_xor(s, 32);
                if (fq == 0) ssq[(size_t)row * 16 + u.pn * 4 + wc] = s; }
    }
};

struct EpiRowScale {
    static constexpr bool PERM = true, AFTER_DRAIN = false;
    bf16_t* O; int ldc; const float* ssq; float scale; float eps;
    __device__ __forceinline__ void operator()(const f32x4 (&acc)[2][2][4][2], const Unit& u, int wr, int wc, int fr, int fq) const {
        const int row0 = u.pm * BM + wr * 64 + fr, col0 = u.pn * BM + wc * 32 + 8 * fq;
#pragma unroll
        for (int ai = 0; ai < 2; ++ai)
#pragma unroll
            for (int m = 0; m < 4; ++m) { const int row = row0 + ai * HALF + m * 16; const f32x4* sp = (const f32x4*)(ssq + (size_t)row * 16);
                const f32x4 a = sp[0], b = sp[1], c = sp[2], d = sp[3]; const f32x4 t = (a + b) + (c + d);
                const float rs = __builtin_amdgcn_rsqf(((t[0] + t[1]) + (t[2] + t[3])) * (1.0f / 1024.0f) + eps) * scale;
                bf16_t* rowp = O + (size_t)row * ldc + col0;
#pragma unroll
                for (int bj = 0; bj < 2; ++bj) *(u32x4*)(rowp + bj * HALF) = pack8(acc[ai][bj][m][0] * rs, acc[ai][bj][m][1] * rs); }
    }
};

template <class Epi, class Sched, bool ALIGN_EPI = false, bool SP2 = false, bool MIDK = false>
__device__ __forceinline__ void gemm_phase(PG8_LAS unsigned char* lds, const GemmSet g, const Sched& S, const Epi& E) {
    const int tid = threadIdx.x, wid = __builtin_amdgcn_readfirstlane(tid >> 6), lane = tid & 63, wr = wid >> 2, wc = wid & 3, fr = lane & 15, fq = lane >> 4;
    const int KA = g.K, KB = MIDK ? 2 * g.K : g.K, nt = KB / BK;
    unsigned voffA[2], voffB[2];
#pragma unroll
    for (int i = 0; i < 2; ++i) { int R, C; stage_rc(tid * 16 + i * 8192, R, C); const int Rb = Epi::PERM ? ((R & ~31) + perm32(R & 31)) : R;
        voffA[i] = (unsigned)(R * KA + C) * 2u; voffB[i] = (unsigned)(Rb * KB + C) * 2u; }
    const size_t kstep = (size_t)(BK * 2);
    const size_t hstepA = (size_t)HALF * KA * 2, hstepB = (size_t)HALF * KB * 2;
    const size_t tstepA = 2 * hstepA, tstepB = 2 * hstepB;
    const unsigned ldsw = (unsigned)wid * 1024u;
    const int aoff = lds_byte(wr * 64 + fr, fq * 8), boff = lds_byte(wc * 32 + fr, fq * 8);
#define PG8_SA(b, h) (((b) * 2 + (h)) * HTB)
#define PG8_SB(b, h) ((4 + (b) * 2 + (h)) * HTB)
#define PG8_STAGE(bufoff, gbase, voff) do { _Pragma("unroll") for (int _i = 0; _i < 2; ++_i) \
        __builtin_amdgcn_global_load_lds((const unsigned*)((const char*)(gbase) + (voff)[_i]), (PG8_LAS unsigned*)(lds + (bufoff) + ldsw + _i * 8192), 16, 0, 0); } while (0)
#define PG8_LDA(dst, b, h) do { _Pragma("unroll") for (int m = 0; m < 4; ++m) _Pragma("unroll") for (int k = 0; k < 2; ++k) dst[m][k] = *(const PG8_LAS bf16x8*)(lds + PG8_SA(b, h) + aoff + m * 2048 + k * 1024); } while (0)
#define PG8_LDB(dst, b, h) do { _Pragma("unroll") for (int n = 0; n < 2; ++n) _Pragma("unroll") for (int k = 0; k < 2; ++k) dst[n][k] = *(const PG8_LAS bf16x8*)(lds + PG8_SB(b, h) + boff + n * 2048 + k * 1024); } while (0)
#define PG8_MMA(ai, bj, At, Bt) do { __builtin_amdgcn_s_setprio(1); _Pragma("unroll") for (int m = 0; m < 4; ++m) _Pragma("unroll") for (int n = 0; n < 2; ++n) _Pragma("unroll") for (int k = 0; k < 2; ++k) \
        acc[ai][bj][m][n] = __builtin_amdgcn_mfma_f32_16x16x32_bf16(Bt[n][k], At[m][k], acc[ai][bj][m][n], 0, 0, 0); __builtin_amdgcn_s_setprio(0); } while (0)
#define PG8_WAIT_V(n) asm volatile("s_waitcnt vmcnt(" #n ")" ::: "memory")
#define PG8_WAIT_L(n) asm volatile("s_waitcnt lgkmcnt(" #n ")" ::: "memory")
#define PG8_BAR __builtin_amdgcn_s_barrier()
#define PG8_SCHED __builtin_amdgcn_sched_barrier(0)
    Unit cur, nxt; int ui = 0;
    if (!S.next(0, cur)) return;
    f32x4 acc[2][2][4][2];
    if constexpr (epi_has_init<Epi>::value) E.init(acc, cur, wr, wc, fr, fq);
    else {
#pragma unroll
    for (int a = 0; a < 2; ++a)
#pragma unroll
        for (int b = 0; b < 2; ++b)
#pragma unroll
            for (int m = 0; m < 4; ++m)
#pragma unroll
                for (int n = 0; n < 2; ++n) acc[a][b][m][n] = (f32x4){0.f, 0.f, 0.f, 0.f};
    }
    bf16x8 At[4][2], B0[2][2], B1[2][2];
    const char* cA = (const char*)((!MIDK && cur.g) ? g.A1 : g.A0) + (size_t)cur.pm * tstepA; const char* cB = (const char*)((!MIDK && cur.g) ? g.B1 : g.B0) + (size_t)cur.pn * tstepB;
    const char* cA1 = (const char*)g.A1 + (size_t)cur.pm * tstepA;
#define PG8_AP(tt) ((MIDK && (tt) >= nt / 2) ? cA1 + (size_t)((tt) - nt / 2) * kstep : cA + (size_t)(tt) * kstep)
    S.a_ready(cur);
    if constexpr (SP2) {
        PG8_STAGE(PG8_SB(0, 0), cB, voffB); PG8_STAGE(PG8_SB(0, 1), cB + hstepB, voffB); PG8_STAGE(PG8_SA(0, 0), cA, voffA); PG8_STAGE(PG8_SA(0, 1), cA + hstepA, voffA);
        if (wr == 1) PG8_BAR;
        PG8_WAIT_V(2); PG8_BAR;
        PG8_STAGE(PG8_SB(1, 0), cB + kstep, voffB); PG8_STAGE(PG8_SA(1, 0), cA + kstep, voffA); PG8_STAGE(PG8_SB(1, 1), cB + hstepB + kstep, voffB);
        PG8_WAIT_V(6); PG8_BAR;
    } else {
        PG8_STAGE(PG8_SB(0, 0), cB, voffB); PG8_STAGE(PG8_SA(0, 0), cA, voffA); PG8_STAGE(PG8_SB(0, 1), cB + hstepB, voffB); PG8_STAGE(PG8_SA(0, 1), cA + hstepA, voffA);
        if (wr == 1) PG8_BAR;
        PG8_WAIT_V(4); PG8_BAR;
        PG8_STAGE(PG8_SB(1, 0), cB + kstep, voffB); PG8_STAGE(PG8_SA(1, 0), cA + kstep, voffA); PG8_STAGE(PG8_SB(1, 1), cB + hstepB + kstep, voffB);
        PG8_WAIT_V(6); PG8_BAR;
    }
    for (;;) {
        const bool has_next = S.next(ui + 1, nxt);
        const char* nA = has_next ? (const char*)((!MIDK && nxt.g) ? g.A1 : g.A0) + (size_t)nxt.pm * tstepA : cA; const char* nB = has_next ? (const char*)((!MIDK && nxt.g) ? g.B1 : g.B0) + (size_t)nxt.pn * tstepB : cB;
        for (int t = 0; t < nt; t += 2) {
            const bool last = (t == nt - 2);
            if constexpr (MIDK) { if (t == nt / 2) E.midk(acc, cur, wr, wc, fr, fq); }
            const char* a1 = PG8_AP(t + 1);
            const char* a2 = last ? nA : PG8_AP(t + 2); const char* b2 = last ? nB : cB + (size_t)(t + 2) * kstep;
            const char* a3 = last ? nA + kstep : PG8_AP(t + 3); const char* b3 = b2 + kstep;
            if (last && has_next) S.a_ready(nxt);
            if constexpr (SP2) {
            PG8_LDB(B0, 0, 0); PG8_LDB(B1, 0, 1); PG8_SCHED; PG8_LDA(At, 0, 0); PG8_STAGE(PG8_SA(1, 1), a1 + hstepA, voffA);
            PG8_WAIT_V(8); PG8_WAIT_L(0); PG8_BAR; PG8_MMA(0, 0, At, B0); PG8_MMA(0, 1, At, B1); PG8_BAR; PG8_SCHED;
            PG8_LDA(At, 0, 1); PG8_STAGE(PG8_SB(0, 0), b2, voffB); PG8_STAGE(PG8_SB(0, 1), b2 + hstepB, voffB); PG8_STAGE(PG8_SA(0, 0), a2, voffA);
            PG8_WAIT_V(8); PG8_WAIT_L(0); PG8_BAR; PG8_MMA(1, 0, At, B0); PG8_MMA(1, 1, At, B1); PG8_BAR; PG8_SCHED;
            PG8_LDB(B0, 1, 0); PG8_LDB(B1, 1, 1); PG8_SCHED; PG8_LDA(At, 1, 0); PG8_STAGE(PG8_SA(0, 1), a2 + hstepA, voffA);
            PG8_WAIT_V(8); PG8_WAIT_L(0); PG8_BAR; PG8_MMA(0, 0, At, B0); PG8_MMA(0, 1, At, B1); PG8_BAR; PG8_SCHED;
            PG8_LDA(At, 1, 1); PG8_STAGE(PG8_SB(1, 0), b3, voffB); PG8_STAGE(PG8_SB(1, 1), b3 + hstepB, voffB); PG8_STAGE(PG8_SA(1, 0), a3, voffA);
            PG8_WAIT_V(8); PG8_WAIT_L(0); PG8_BAR; PG8_MMA(1, 0, At, B0); PG8_MMA(1, 1, At, B1); PG8_BAR; PG8_SCHED;
            } else {
            PG8_LDB(B0, 0, 0); PG8_SCHED; PG8_LDA(At, 0, 0); PG8_STAGE(PG8_SA(1, 1), a1 + hstepA, voffA);
            PG8_WAIT_L(8); PG8_BAR; PG8_WAIT_L(0); PG8_MMA(0, 0, At, B0); PG8_BAR; PG8_SCHED;
            PG8_LDB(B1, 0, 1); PG8_STAGE(PG8_SB(0, 0), b2, voffB);
            PG8_BAR; PG8_WAIT_L(0); PG8_MMA(0, 1, At, B1); PG8_BAR;
            PG8_LDA(At, 0, 1); PG8_STAGE(PG8_SA(0, 0), a2, voffA);
            PG8_BAR; PG8_WAIT_L(0); PG8_MMA(1, 0, At, B0); PG8_BAR; PG8_SCHED;
            PG8_STAGE(PG8_SB(0, 1), b2 + hstepB, voffB);
            PG8_WAIT_V(6); PG8_BAR; PG8_MMA(1, 1, At, B1); PG8_BAR;
            PG8_LDB(B0, 1, 0); PG8_SCHED; PG8_LDA(At, 1, 0); PG8_STAGE(PG8_SA(0, 1), a2 + hstepA, voffA);
            PG8_WAIT_L(8); PG8_BAR; PG8_WAIT_L(0); PG8_MMA(0, 0, At, B0); PG8_BAR; PG8_SCHED;
            PG8_LDB(B1, 1, 1); PG8_STAGE(PG8_SB(1, 0), b3, voffB);
            PG8_BAR; PG8_WAIT_L(0); PG8_MMA(0, 1, At, B1); PG8_BAR;
            PG8_LDA(At, 1, 1); PG8_STAGE(PG8_SA(1, 0), a3, voffA);
            PG8_BAR; PG8_WAIT_L(0); PG8_MMA(1, 0, At, B0); PG8_BAR; PG8_SCHED;
            PG8_STAGE(PG8_SB(1, 1), b3 + hstepB, voffB);
            PG8_WAIT_V(6); PG8_BAR; PG8_MMA(1, 1, At, B1); PG8_BAR;
            }
        }
        if constexpr (ALIGN_EPI) { if (wr == 0) PG8_BAR; }
        if constexpr (!Epi::AFTER_DRAIN) { E(acc, cur, wr, wc, fr, fq); S.done(cur); }
        if (!has_next) break;
        if constexpr (epi_has_init<Epi>::value) E.init(acc, nxt, wr, wc, fr, fq);
        else {
#pragma unroll
        for (int a = 0; a < 2; ++a)
#pragma unroll
            for (int b = 0; b < 2; ++b)
#pragma unroll
                for (int m = 0; m < 4; ++m)
#pragma unroll
                    for (int n = 0; n < 2; ++n) acc[a][b][m][n] = (f32x4){0.f, 0.f, 0.f, 0.f};
        }
        cur = nxt; cA = nA; cB = nB; ++ui;
        if constexpr (ALIGN_EPI) { if (wr == 1) PG8_BAR; }
    }
    PG8_WAIT_V(0);
    if constexpr (!ALIGN_EPI) { if (wr == 0) PG8_BAR; }
    PG8_BAR;
    if constexpr (Epi::AFTER_DRAIN) { E.fused(acc, cur, wr, wc, fr, fq, lds, wid, lane); S.done(cur); }
#undef PG8_AP
#undef PG8_SA
#undef PG8_SB
#undef PG8_STAGE
#undef PG8_LDA
#undef PG8_LDB
#undef PG8_MMA
#undef PG8_WAIT_V
#undef PG8_WAIT_L
#undef PG8_BAR
#undef PG8_SCHED
}
}

namespace sb {
using bf16 = __hip_bfloat16;
using bf16x8 = __attribute__((ext_vector_type(8))) short;
using s16x4 = __attribute__((ext_vector_type(4))) short;
using f32x16 = __attribute__((ext_vector_type(16))) float;
using u32x4 = __attribute__((ext_vector_type(4))) unsigned;
constexpr int SEQ = 2048, NHEAD = 16, HD = 64, DM = 1024;
constexpr int SLOTB = 8192, LDS_K = 0, LDS_V = 2 * SLOTB, PAIRB = 4 * SLOTB, LDS_FLAG = 131584, LDS_BYTES = 4 * PAIRB;
constexpr float EXIT_THR = -40.0f;
__device__ __forceinline__ int crow(int r, int hi) { return (r & 3) + 8 * (r >> 2) + 4 * hi; }
__device__ __forceinline__ void glds16(const void* gsrc, unsigned lds_dst) { unsigned keep;
    asm volatile("s_mov_b32 %0, m0\n\ts_mov_b32 m0, %2\n\ts_nop 0\n\tglobal_load_lds_dwordx4 %1, off\n\ts_mov_b32 m0, %0" : "=&s"(keep) : "v"(gsrc), "s"(lds_dst) : "memory"); }
typedef __attribute__((address_space(3))) const char* lds_cptr;
typedef short v4i16_t __attribute__((ext_vector_type(4)));
typedef float f32x2_t __attribute__((ext_vector_type(2))); typedef __bf16 bf16x2_t __attribute__((ext_vector_type(2)));
__device__ __forceinline__ unsigned cvtpk(float lo, float hi) { f32x2_t v = {lo, hi}; bf16x2_t b = __builtin_convertvector(v, bf16x2_t); return __builtin_bit_cast(unsigned, b); }
__device__ __forceinline__ s16x4 vtr(lds_cptr p) { return __builtin_bit_cast(s16x4, __builtin_amdgcn_ds_read_tr16_b64_v4i16((__attribute__((address_space(3))) v4i16_t*)p)); }
__device__ __forceinline__ bf16x8 pack8(const f32x16& p, int b) { u32x4 w; w.x = cvtpk(p[b], p[b + 1]); w.y = cvtpk(p[b + 2], p[b + 3]); w.z = cvtpk(p[b + 4], p[b + 5]); w.w = cvtpk(p[b + 6], p[b + 7]); return __builtin_bit_cast(bf16x8, w); }
__device__ __forceinline__ float lo_lane(float x) { auto rr = __builtin_amdgcn_permlane32_swap(__float_as_uint(x), __float_as_uint(x), false, false); return __uint_as_float(rr[0]); }
#define SB_WAIT_BAR() asm volatile("s_waitcnt vmcnt(0) lgkmcnt(0)\n\ts_barrier" ::: "memory")

template <bool EARLY> __device__ __forceinline__ void sb_unit(int b, int h, int qb, const bf16* Q, const bf16* __restrict__ K, const bf16* __restrict__ V, bf16* O, char* shm) {
    const int tid = threadIdx.x, lane = tid & 63, r32 = lane & 31, hi = lane >> 5; const int wid = __builtin_amdgcn_readfirstlane(tid >> 6); const int pr = wid >> 1, sub = wid & 1;
    const long rowbase = (long)b * SEQ; const int q0 = qb * 256;
    const int wmin = q0 + 64 * pr + 32 * sub, wmax = wmin + 31, trow = wmin + r32;
    const bf16* Qw = Q + (rowbase + wmin) * DM + h * HD;
    const bf16* Kh = K + rowbase * DM + h * HD; const bf16* Vh = V + rowbase * DM + h * HD;
    const unsigned lds0 = (unsigned)(uintptr_t)shm + pr * PAIRB;
    const bf16* ksrc = Kh + (long)(lane >> 2) * DM + (4 * sub + ((lane & 3) ^ ((lane >> 4) & 3))) * 8;
    const bf16* vsrc = Vh + (long)(lane >> 2) * DM + sub * 32 + (lane & 3) * 8;
    const unsigned kdst = lds0 + LDS_K + (4 * sub) * 1024, vdst = lds0 + LDS_V + (4 * sub) * 1024;
#define SB_DMA_KV(t, slot) do { _Pragma("unroll") for (int j = 0; j < 4; ++j) { \
        glds16(ksrc + ((long)(t) * 64 + 16 * j) * DM, (unsigned)__builtin_amdgcn_readfirstlane(kdst + (slot) + j * 1024)); \
        glds16(vsrc + ((long)(t) * 64 + 16 * j) * DM, (unsigned)__builtin_amdgcn_readfirstlane(vdst + (slot) + j * 1024)); } } while (0)
    const lds_cptr shm3 = (lds_cptr)shm; const lds_cptr kpb = shm3 + pr * PAIRB + LDS_K + (r32 >> 4) * 1024 + (r32 & 15) * 64; const lds_cptr kp0 = kpb + ((hi ^ ((r32 >> 2) & 3)) * 16), kp1 = kpb + (((2 + hi) ^ ((r32 >> 2) & 3)) * 16);
    const lds_cptr vp0 = shm3 + pr * PAIRB + LDS_V + ((lane >> 4) & 1) * 32 + (lane & 3) * 8 + (4 * hi + ((lane & 15) >> 2)) * 64;
    const int tp = q0 / 64 + pr;
    const int NIT = q0 / 64 + 4;
    volatile __attribute__((address_space(3))) unsigned* flags = (volatile __attribute__((address_space(3))) unsigned*)(shm3 + LDS_FLAG);
    if (EARLY && lane == 0) flags[wid] = 0u;
    bool wdone = false;
    SB_DMA_KV(tp, 0);
    bf16x8 qr[4];
#pragma unroll
    for (int d0 = 0; d0 < 4; ++d0) qr[d0] = *reinterpret_cast<const bf16x8*>(&Qw[(long)r32 * DM + d0 * 16 + hi * 8]);
    bf16x8 tri[2], ones;
#pragma unroll
    for (int ks = 0; ks < 2; ++ks)
#pragma unroll
        for (int j = 0; j < 8; ++j) { const int kk = 16 * ks + 8 * (j >> 2) + 4 * hi + (j & 3); tri[ks][j] = (kk >= r32) ? (short)0x3F80 : (short)0; }
#pragma unroll
    for (int j = 0; j < 8; ++j) ones[j] = (short)0x3F80;
    f32x16 o0 = f32x16{}, o1 = f32x16{}; float R = 0.f;
    for (int it = 0; it < NIT; ++it) {
        const int t = tp - it; const int sl = (it & 1) * SLOTB;
        SB_WAIT_BAR();
        if (EARLY) { const unsigned f = flags[lane & 7]; if (__all(f != 0u)) break; }
        if (t > 0) SB_DMA_KV(t - 1, sl ^ SLOTB);
        if (t < 0 && !wdone) { wdone = true; if (EARLY && lane == 0) flags[wid] = 1u; }
        if (!wdone) {
            f32x16 p0 = f32x16{}, p1 = f32x16{};
#pragma unroll
            for (int d0 = 0; d0 < 4; ++d0) {
                const lds_cptr kq = ((d0 & 1) ? kp1 : kp0) + sl + (d0 >> 1) * 4096;
                const bf16x8 b0 = *(const __attribute__((address_space(3))) bf16x8*)(kq);
                const bf16x8 b1 = *(const __attribute__((address_space(3))) bf16x8*)(kq + 2048);
                p0 = __builtin_amdgcn_mfma_f32_32x32x16_bf16(b0, qr[d0], p0, 0, 0, 0);
                p1 = __builtin_amdgcn_mfma_f32_32x32x16_bf16(b1, qr[d0], p1, 0, 0, 0); }
            const bool diag = (64 * t + 63 >= wmin);
            if (diag) {
#pragma unroll
                for (int r = 0; r < 16; ++r) { const int s = 64 * t + crow(r, hi); if (s >= trow) p0[r] = -1e30f; if (s + 32 >= trow) p1[r] = -1e30f; } }
            f32x16 l0, l1;
#pragma unroll
            for (int r = 0; r < 16; ++r) {
                const float y0 = p0[r], y1 = p1[r];
                l0[r] = __builtin_amdgcn_fmed3f(-y0, 0.f, -3.0e38f) - __builtin_amdgcn_logf(1.0f + __builtin_amdgcn_exp2f(-__builtin_fabsf(y0)));
                l1[r] = __builtin_amdgcn_fmed3f(-y1, 0.f, -3.0e38f) - __builtin_amdgcn_logf(1.0f + __builtin_amdgcn_exp2f(-__builtin_fabsf(y1))); }
            const bf16x8 l0a = pack8(l0, 0), l0b = pack8(l0, 8), l1a = pack8(l1, 0), l1b = pack8(l1, 8);
            f32x16 Rv;
#pragma unroll
            for (int r = 0; r < 16; ++r) Rv[r] = R;
            f32x16 c1 = __builtin_amdgcn_mfma_f32_32x32x16_bf16(tri[0], l1a, Rv, 0, 0, 0); c1 = __builtin_amdgcn_mfma_f32_32x32x16_bf16(tri[1], l1b, c1, 0, 0, 0);
            f32x16 c0 = __builtin_amdgcn_mfma_f32_32x32x16_bf16(ones, l1a, Rv, 0, 0, 0); c0 = __builtin_amdgcn_mfma_f32_32x32x16_bf16(ones, l1b, c0, 0, 0, 0);
            c0 = __builtin_amdgcn_mfma_f32_32x32x16_bf16(tri[0], l0a, c0, 0, 0, 0); c0 = __builtin_amdgcn_mfma_f32_32x32x16_bf16(tri[1], l0b, c0, 0, 0, 0);
#pragma unroll
            for (int r = 0; r < 16; ++r) { p0[r] = __builtin_amdgcn_exp2f(p0[r] + c0[r]); p1[r] = __builtin_amdgcn_exp2f(p1[r] + c1[r]); }
            R = lo_lane(c0[0]);
            const bf16x8 pa0 = pack8(p0, 0), pa1 = pack8(p0, 8), pa2 = pack8(p1, 0), pa3 = pack8(p1, 8);
            const lds_cptr vp = vp0 + sl;
#define SB_VF(dh, ks) ({ const s16x4 lo_ = vtr(vp + (dh) * 4096 + (ks) * 1024), hi_ = vtr(vp + (dh) * 4096 + (ks) * 1024 + 512); (bf16x8){lo_[0], lo_[1], lo_[2], lo_[3], hi_[0], hi_[1], hi_[2], hi_[3]}; })
            o0 = __builtin_amdgcn_mfma_f32_32x32x16_bf16(pa0, SB_VF(0, 0), o0, 0, 0, 0); o1 = __builtin_amdgcn_mfma_f32_32x32x16_bf16(pa0, SB_VF(1, 0), o1, 0, 0, 0);
            o0 = __builtin_amdgcn_mfma_f32_32x32x16_bf16(pa1, SB_VF(0, 1), o0, 0, 0, 0); o1 = __builtin_amdgcn_mfma_f32_32x32x16_bf16(pa1, SB_VF(1, 1), o1, 0, 0, 0);
            o0 = __builtin_amdgcn_mfma_f32_32x32x16_bf16(pa2, SB_VF(0, 2), o0, 0, 0, 0); o1 = __builtin_amdgcn_mfma_f32_32x32x16_bf16(pa2, SB_VF(1, 2), o1, 0, 0, 0);
            o0 = __builtin_amdgcn_mfma_f32_32x32x16_bf16(pa3, SB_VF(0, 3), o0, 0, 0, 0); o1 = __builtin_amdgcn_mfma_f32_32x32x16_bf16(pa3, SB_VF(1, 3), o1, 0, 0, 0);
#undef SB_VF
            if (EARLY && !__any(R >= EXIT_THR)) { wdone = true; if (lane == 0) flags[wid] = 1u; }
        }
    }
    SB_WAIT_BAR();
    bf16* Ow = O + (rowbase + wmin) * DM + h * HD;
    {
        bf16* stg = (bf16*)(shm + pr * PAIRB + LDS_K) + sub * 2048;
#pragma unroll
        for (int r = 0; r < 16; ++r) { const int orow = crow(r, hi); stg[orow * 64 + r32] = __float2bfloat16(o0[r]); stg[orow * 64 + 32 + r32] = __float2bfloat16(o1[r]); }
        asm volatile("s_waitcnt lgkmcnt(0)" ::: "memory");
#pragma unroll
        for (int i = 0; i < 4; ++i) { const int row = i * 8 + (lane >> 3), ch = lane & 7; const u32x4 v = *(const u32x4*)(stg + row * 64 + ch * 8); *(u32x4*)(Ow + (long)row * DM + ch * 8) = v; }
        asm volatile("s_waitcnt lgkmcnt(0)" ::: "memory");
    }
    SB_WAIT_BAR();
#undef SB_DMA_KV
}
}

constexpr int NWAVES = 8;
constexpr int N_LAUNCHES = MK_N_LAUNCHES;
constexpr int N_PHASES = 10;
constexpr int BATCH = 8, SEQ = 2048, D = 1024, M = BATCH * SEQ, MEMLEN = 256, MROWS = BATCH * MEMLEN, NIN = 8192, NPQ = 2048;
constexpr float RMS_EPS = 1e-6f;
constexpr float LOG2E = 1.4426950408889634f;
constexpr size_t MiB = 1u << 20;
constexpr size_t WS_CTL = 0, CTL_ZERO_BYTES = 32768;
constexpr size_t WS_WIN = 1 * MiB, WS_WA = 17 * MiB, WS_WC = 19 * MiB, WS_WO = 21 * MiB, WS_WQ2 = 23 * MiB, WS_WKV2 = 25 * MiB, WS_WO2 = 29 * MiB, WS_WPQ = 31 * MiB, WS_SK = 35 * MiB;
constexpr size_t WS_SSQ1 = 36 * MiB, WS_SSQ2 = 37 * MiB, WS_MEMN = 38 * MiB, WS_K2 = 42 * MiB, WS_V2T = 46 * MiB;
constexpr size_t WS_B0 = 52 * MiB, WS_B1 = 84 * MiB, WS_B2 = 116 * MiB, WS_B3 = 148 * MiB, WS_B4 = 180 * MiB, WS_B5 = 212 * MiB, WS_V6 = 244 * MiB, WS_END = 256 * MiB;
constexpr size_t WS_U6 = WS_WIN;
constexpr int CW_TMO = 0, CW_CODE = 1, CW_BAR = 4096;

constexpr int RING_OFF = 0, RING_BYTES = 131072;
constexpr int LDSCTL_OFF = RING_BYTES, MISC_OFF = LDSCTL_OFF + 320;
constexpr int LDS_BYTES = 147456;
#define GAS __attribute__((address_space(1)))
#define LAS __attribute__((address_space(3)))
typedef unsigned short bf16;
typedef unsigned v4u __attribute__((ext_vector_type(4)));
typedef float f32x4 __attribute__((ext_vector_type(4)));
typedef short bf16x8 __attribute__((ext_vector_type(8)));
typedef GAS unsigned gu32;
typedef GAS unsigned long long gu64;
#define RLX_AGENT __ATOMIC_RELAXED, __HIP_MEMORY_SCOPE_AGENT
#define LDS_WAIT() asm volatile("s_waitcnt lgkmcnt(0)" ::: "memory")
#define VM_WAIT() asm volatile("s_waitcnt vmcnt(0)" ::: "memory")
__device__ __forceinline__ unsigned long long rt() { return __builtin_amdgcn_s_memrealtime(); }
__device__ __forceinline__ unsigned f2bf(float f) { unsigned u = __builtin_bit_cast(unsigned, f); return (u + 0x7fffu + ((u >> 16) & 1u)) >> 16; }
__device__ __forceinline__ unsigned pk2(float lo, float hi) { return f2bf(lo) | (f2bf(hi) << 16); }

#define XB_TMO      128
#define XB_XCNT(j)  (256  + 64 * (j))
#define XB_XSUB(j)  (1280 + 64 * (j))
#define XB_XGEN(j)  (2304 + 64 * (j))
#define XB_TOP      3328
#define XB_TOPGEN   3392
#define XCD_BAR_WORDS 3456
#define XB_SPIN_CAP (1u << 18)

__device__ __forceinline__ unsigned xb_ld(unsigned* p)              { return __hip_atomic_load(p, __ATOMIC_RELAXED, __HIP_MEMORY_SCOPE_AGENT); }
__device__ __forceinline__ unsigned xb_add(unsigned* p, unsigned v) { return __hip_atomic_fetch_add(p, v, __ATOMIC_RELAXED, __HIP_MEMORY_SCOPE_AGENT); }
__device__ __forceinline__ unsigned xb_xcc_id() { return (unsigned)__builtin_amdgcn_s_getreg((3 << 11) | 20) & 0xFu; }
#define XB_SPIN(cond, bar) do { unsigned _sp = 0; while (cond) { __builtin_amdgcn_s_sleep(1); \
    if ((++_sp & 255u) == 0u) { if (xb_ld(&(bar)[XB_TMO])) break; if (_sp > XB_SPIN_CAP) { atomicAdd(&(bar)[XB_TMO], 1u); break; } } } } while (0)

struct XcdBarrier {
    unsigned* bar; unsigned x;
    volatile LAS unsigned* st;
};

__device__ __forceinline__ XcdBarrier xcd_barrier_post(unsigned* bar, volatile LAS unsigned* st) {
    XcdBarrier b; b.bar = bar; b.x = xb_xcc_id(); b.st = st;
    if (threadIdx.x == 0) (void)xb_add(&bar[XB_XCNT(b.x)], 1u);
    return b;
}
__device__ __forceinline__ void xcd_barrier_complete(unsigned* bar, unsigned x, unsigned& nloc, unsigned& nx) {
    const unsigned G = gridDim.x * gridDim.y * gridDim.z;
    unsigned sum, cnt, mine, sp = 0u;
    for (;;) {
        sum = 0u; cnt = 0u; mine = 0u;
#pragma unroll
        for (unsigned j = 0; j < 16; ++j) { const unsigned c = xb_ld(&bar[XB_XCNT(j)]); sum += c; cnt += (c > 0u) ? 1u : 0u; mine = (j == x) ? c : mine; }
        if (sum == G) break;
        __builtin_amdgcn_s_sleep(1);
        if ((++sp & 255u) == 0u) { if (xb_ld(&bar[XB_TMO])) break; if (sp > XB_SPIN_CAP) { atomicAdd(&bar[XB_TMO], 1u); break; } }
    }
    nloc = mine > 0u ? mine : 1u; nx = cnt > 0u ? cnt : 1u;
}

__device__ __forceinline__ void xcd_barrier(const XcdBarrier& b) {
    asm volatile("s_waitcnt vmcnt(0)" ::: "memory");
    __syncthreads();
    if (threadIdx.x == 0) {
        unsigned* bar = b.bar;
        __builtin_amdgcn_s_waitcnt(0);
        unsigned nloc = b.st[0], nx = b.st[1];
        if (nloc == 0u) { xcd_barrier_complete(bar, b.x, nloc, nx); b.st[0] = nloc; b.st[1] = nx; }
        const unsigned old = xb_add(&bar[XB_XSUB(b.x)], 1u);
        const unsigned gen = old / nloc;
        if (old + 1u == (gen + 1u) * nloc) {
            __builtin_amdgcn_fence(__ATOMIC_RELEASE, "agent");
            asm volatile("s_waitcnt vmcnt(0)" ::: "memory");
            const unsigned og = xb_add(&bar[XB_TOP], 1u);
            const unsigned tg = og / nx;
            if (og + 1u == (tg + 1u) * nx) xb_add(&bar[XB_TOPGEN], 1u);
            else XB_SPIN(xb_ld(&bar[XB_TOPGEN]) == tg, bar);
            __builtin_amdgcn_fence(__ATOMIC_ACQUIRE, "agent");
            xb_add(&bar[XB_XGEN(b.x)], 1u);
            asm volatile("s_waitcnt vmcnt(0)" ::: "memory");
        } else {
            XB_SPIN(xb_ld(&bar[XB_XGEN(b.x)]) == gen, bar);
            __builtin_amdgcn_fence(__ATOMIC_ACQUIRE, "agent");
            asm volatile("s_waitcnt vmcnt(0)" ::: "memory");
        }
    }
    __syncthreads();
}


__device__ __forceinline__ float wave_sum(float v) {
#pragma unroll
    for (int o = 1; o < 64; o <<= 1) v += __shfl_xor(v, o);
    return v;
}
__device__ __forceinline__ int inproj_row(int n) {
    const int g = n >> 10, c = n & 1023;
    if (g < 3) return n;
    if (g == 3) return 3072 + (c >> 7) * 256 + (c & 127);
    if (g == 5) return 3072 + (c >> 7) * 256 + 128 + (c & 127);
    if (g == 4) return 5120 + c;
    if (g == 6) return 6144 + (c >> 7) * 256 + (c & 127);
    return 6144 + (c >> 7) * 256 + 128 + (c & 127);
}
template <bool INMAP> __device__ __forceinline__ void transpose_item(const float* W, int K, int N, const float* gain, bf16* WT, int row_off, LAS float* scr, int item, int lane, int ldk = 0, int koff = 0) {
    if (ldk == 0) ldk = K;
    const int nblk = N / 32, kb = item / nblk, nb = item % nblk, k0 = 64 * kb, n0 = 32 * nb;
    {
        f32x4 w[8]; const int c4 = 4 * (lane & 7), kr = lane >> 3;
#pragma unroll
        for (int j = 0; j < 8; ++j) w[j] = *(const GAS f32x4*)(W + (size_t)(k0 + kr + 8 * j) * N + n0 + c4);
#pragma unroll
        for (int j = 0; j < 8; ++j) { const int kk = kr + 8 * j; f32x4 t = w[j]; if (gain) t = t * gain[k0 + kk];
            LAS float* d = scr + kk * 33 + c4; d[0] = t.x; d[1] = t.y; d[2] = t.z; d[3] = t.w; } }
    LDS_WAIT(); asm volatile("" ::: "memory");
    const int c = lane & 7; const int r0 = INMAP ? inproj_row(n0) : (row_off + n0);
#pragma unroll
    for (int j = 0; j < 4; ++j) { const int n = (lane >> 3) + 8 * j; const LAS float* s = scr + (8 * c) * 33 + n;
        v4u o; o.x = pk2(s[0 * 33], s[1 * 33]); o.y = pk2(s[2 * 33], s[3 * 33]); o.z = pk2(s[4 * 33], s[5 * 33]); o.w = pk2(s[6 * 33], s[7 * 33]);
        *(GAS v4u*)(WT + (size_t)(r0 + n) * ldk + koff + k0 + 8 * c) = o; }
    LDS_WAIT(); asm volatile("" ::: "memory");
}
__device__ __forceinline__ void rms_row_to_bf16(const float* xrow, const float* gain, bf16* orow, int lane) {
    const GAS f32x4* xr = (const GAS f32x4*)xrow + lane; const GAS f32x4* gr = (const GAS f32x4*)gain + lane;
    f32x4 v[4]; float s = 0.f;
#pragma unroll
    for (int j = 0; j < 4; ++j) { v[j] = xr[64 * j]; s += (v[j].x * v[j].x + v[j].y * v[j].y) + (v[j].z * v[j].z + v[j].w * v[j].w); }
    const float rstd = 1.0f / sqrtf(wave_sum(s) * (1.f / 1024.f) + RMS_EPS);
    GAS unsigned long long* o8 = (GAS unsigned long long*)orow + lane;
#pragma unroll
    for (int j = 0; j < 4; ++j) { const f32x4 g = gr[64 * j]; o8[64 * j] = (unsigned long long)pk2(v[j].x * rstd * g.x, v[j].y * rstd * g.y) | ((unsigned long long)pk2(v[j].z * rstd * g.z, v[j].w * rstd * g.w) << 32); }
}
__device__ __forceinline__ void row_to_bf16(const float* xrow, const float* gain, bf16* orow, int lane) {
    const GAS f32x4* xr = (const GAS f32x4*)xrow + lane; GAS unsigned long long* o8 = (GAS unsigned long long*)orow + lane;
#pragma unroll
    for (int j = 0; j < 4; ++j) { f32x4 v = xr[64 * j]; if (gain) { const f32x4 g = ((const GAS f32x4*)gain + lane)[64 * j]; v = v * g; }
        o8[64 * j] = (unsigned long long)pk2(v.x, v.y) | ((unsigned long long)pk2(v.z, v.w) << 32); }
}
__device__ __forceinline__ void row_to_fp8(const float* xrow, const float* gain, float scale, unsigned char* orow, int lane) {
    const GAS f32x4* xr = (const GAS f32x4*)xrow + lane; GAS unsigned* o4 = (GAS unsigned*)orow + lane;
#pragma unroll
    for (int j = 0; j < 4; ++j) { f32x4 v = xr[64 * j] * scale; if (gain) { const f32x4 g = ((const GAS f32x4*)gain + lane)[64 * j]; v = v * g; }
        int w = 0; w = __builtin_amdgcn_cvt_pk_fp8_f32(v.x, v.y, w, false); w = __builtin_amdgcn_cvt_pk_fp8_f32(v.z, v.w, w, true); o4[64 * j] = (unsigned)w; }
}
__device__ __forceinline__ unsigned fp6_code(float v) {
    const float a = __builtin_fminf(__builtin_fabsf(v), 7.5f);
    const float k = (a < 2.0f) ? __builtin_rintf(a * 8.0f) : (a < 4.0f) ? 8.0f + __builtin_rintf(a * 4.0f) : 16.0f + __builtin_rintf(a * 2.0f);
    return (unsigned)(int)k | ((__builtin_bit_cast(unsigned, v) >> 26) & 32u);
}
template <int NR> __device__ __forceinline__ void rows_to_fp6(const float* x0, size_t rstride, const float* gain, float scale, unsigned char* o0, int lane) {
    typedef __bf16 v32bf __attribute__((ext_vector_type(32))); typedef float v32f_ __attribute__((ext_vector_type(32))); typedef unsigned v6u_ __attribute__((ext_vector_type(6)));
    f32x4 v[NR][4];
#pragma unroll
    for (int r = 0; r < NR; ++r)
#pragma unroll
        for (int j = 0; j < 4; ++j) v[r][j] = *(const GAS f32x4*)(x0 + r * rstride * 1024 + j * 256 + lane * 4);
    f32x4 g[4];
#pragma unroll
    for (int j = 0; j < 4; ++j) { g[j] = (f32x4){scale, scale, scale, scale}; if (gain) g[j] = g[j] * *(const GAS f32x4*)(gain + j * 256 + lane * 4); }
#pragma unroll
    for (int q = 0; q < NR / 2; ++q) { v32f_ t;
#pragma unroll
        for (int r = 0; r < 2; ++r)
#pragma unroll
            for (int j = 0; j < 4; ++j) { const f32x4 p = v[2 * q + r][j] * g[j];
#pragma unroll
                for (int e = 0; e < 4; ++e) t[16 * r + 4 * j + e] = __builtin_fminf(__builtin_fmaxf(p[e], -7.5f), 7.5f); }
        const v6u_ w = __builtin_amdgcn_cvt_scalef32_pk32_fp6_bf16(__builtin_convertvector(t, v32bf), 1.0f);
        GAS unsigned* op0 = (GAS unsigned*)(o0 + (size_t)(2 * q) * rstride * 768) + lane * 3; GAS unsigned* op1 = (GAS unsigned*)(o0 + (size_t)(2 * q + 1) * rstride * 768) + lane * 3;
        op0[0] = w[0]; op0[1] = w[1]; op0[2] = w[2]; op1[0] = w[3]; op1[1] = w[4]; op1[2] = w[5]; }
}
__device__ __forceinline__ void rows4_to_fp8(const float* x0, size_t rstride, const float* gain, float scale, unsigned char* o0, int lane) {
    f32x4 v[4][4];
#pragma unroll
    for (int r = 0; r < 4; ++r)
#pragma unroll
        for (int j = 0; j < 4; ++j) v[r][j] = ((const GAS f32x4*)(x0 + r * rstride * 1024) + lane)[64 * j];
#pragma unroll
    for (int j = 0; j < 4; ++j) { f32x4 g = (f32x4){scale, scale, scale, scale}; if (gain) g = g * ((const GAS f32x4*)gain + lane)[64 * j];
#pragma unroll
        for (int r = 0; r < 4; ++r) { const f32x4 t = v[r][j] * g; int w = 0; w = __builtin_amdgcn_cvt_pk_fp8_f32(t.x, t.y, w, false); w = __builtin_amdgcn_cvt_pk_fp8_f32(t.z, t.w, w, true);
            ((GAS unsigned*)(o0 + r * rstride * 1024) + lane)[64 * j] = (unsigned)w; } }
}
__device__ __forceinline__ void rms_rows2_to_bf16(const float* x0, size_t rstride, const float* gain, bf16* o0, int lane) {
    f32x4 v[2][4]; float s[2] = {0.f, 0.f};
#pragma unroll
    for (int r = 0; r < 2; ++r)
#pragma unroll
        for (int j = 0; j < 4; ++j) v[r][j] = ((const GAS f32x4*)(x0 + r * rstride * 1024) + lane)[64 * j];
#pragma unroll
    for (int r = 0; r < 2; ++r)
#pragma unroll
        for (int j = 0; j < 4; ++j) s[r] += (v[r][j].x * v[r][j].x + v[r][j].y * v[r][j].y) + (v[r][j].z * v[r][j].z + v[r][j].w * v[r][j].w);
#pragma unroll
    for (int r = 0; r < 2; ++r) { const float rstd = 1.0f / sqrtf(wave_sum(s[r]) * (1.f / 1024.f) + RMS_EPS);
        GAS unsigned long long* o8 = (GAS unsigned long long*)(o0 + r * rstride * 1024) + lane;
#pragma unroll
        for (int j = 0; j < 4; ++j) { const f32x4 g = ((const GAS f32x4*)gain + lane)[64 * j];
            o8[64 * j] = (unsigned long long)pk2(v[r][j].x * rstd * g.x, v[r][j].y * rstd * g.y) | ((unsigned long long)pk2(v[r][j].z * rstd * g.z, v[r][j].w * rstd * g.w) << 32); } }
}
__device__ __forceinline__ void final_norm_row(const float* hrow, const float* gain, float* orow, int lane) {
    const GAS f32x4* xr = (const GAS f32x4*)hrow + lane; const GAS f32x4* gr = (const GAS f32x4*)gain + lane;
    f32x4 v[4]; float s = 0.f;
#pragma unroll
    for (int j = 0; j < 4; ++j) { v[j] = xr[64 * j]; s += (v[j].x * v[j].x + v[j].y * v[j].y) + (v[j].z * v[j].z + v[j].w * v[j].w); }
    const float rstd = 1.0f / sqrtf(wave_sum(s) * (1.f / 1024.f) + RMS_EPS);
    GAS f32x4* o = (GAS f32x4*)orow + lane;
#pragma unroll
    for (int j = 0; j < 4; ++j) o[64 * j] = v[j] * rstd * gr[64 * j];
}
__device__ __forceinline__ float bflo(unsigned w) { return __builtin_bit_cast(float, w << 16); }
__device__ __forceinline__ float bfhi(unsigned w) { return __builtin_bit_cast(float, w & 0xffff0000u); }
__device__ __forceinline__ void yconv_item(const bf16* U, const bf16* CB, const float* cw, bf16* YC, int item, int lane) {
    const int t0 = item * 8; const bool first = (t0 % SEQ) == 0;
#pragma unroll 1
    for (int ps = 0; ps < 2; ++ps) {
        const int c0 = ps * 512 + lane * 8;
        float w0[8], w1[8], w2[8];
#pragma unroll
        for (int e = 0; e < 8; ++e) { w0[e] = cw[c0 + e]; w1[e] = cw[1024 + c0 + e]; w2[e] = cw[2048 + c0 + e]; }
        v4u um2 = (v4u){0u, 0u, 0u, 0u}, um1 = (v4u){0u, 0u, 0u, 0u};
        if (!first) { um2 = *(const GAS v4u*)(U + (size_t)(t0 - 2) * 1024 + c0); um1 = *(const GAS v4u*)(U + (size_t)(t0 - 1) * 1024 + c0); }
#pragma unroll
        for (int i = 0; i < 8; ++i) {
            const v4u uc = *(const GAS v4u*)(U + (size_t)(t0 + i) * 1024 + c0); const v4u cbv = *(const GAS v4u*)(CB + (size_t)(t0 + i) * 1024 + c0);
            v4u o;
#pragma unroll
            for (int q = 0; q < 4; ++q) {
                const float a = bflo(cbv[q]) * (w0[2 * q] * bflo(um2[q]) + w1[2 * q] * bflo(um1[q]) + w2[2 * q] * bflo(uc[q]));
                const float b = bfhi(cbv[q]) * (w0[2 * q + 1] * bfhi(um2[q]) + w1[2 * q + 1] * bfhi(um1[q]) + w2[2 * q + 1] * bfhi(uc[q]));
                o[q] = pk2(a, b); }
            *(GAS v4u*)(YC + (size_t)(t0 + i) * 1024 + c0) = o;
            um2 = um1; um1 = uc; }
    }
}


namespace xa {
using bf16x8 = __attribute__((ext_vector_type(8))) short;
using f32x4 = __attribute__((ext_vector_type(4))) float;
using u32x4 = __attribute__((ext_vector_type(4))) unsigned;
using u32x2 = __attribute__((ext_vector_type(2))) unsigned;
typedef __attribute__((address_space(3))) const char* lds_cptr;
constexpr int BUFB = 65536, VOFF = 32768;
#define XA_WAIT_BAR() asm volatile("s_waitcnt vmcnt(0) lgkmcnt(0)\n\ts_barrier" ::: "memory")
template <bool REV> __device__ __forceinline__ void xattn_unit(int b, int head, int qh, const bf16* Q, const bf16* K2, const bf16* V2P, bf16* O, char* shm, bf16x8 (&qn)[8]) {
    const int lane = threadIdx.x & 63, kr = lane & 15, g = lane >> 4; const int wid = __builtin_amdgcn_readfirstlane((int)threadIdx.x >> 6);
    const unsigned lds0 = (unsigned)(uintptr_t)shm; const lds_cptr shm3 = (lds_cptr)shm;
    const size_t qrow = (size_t)b * SEQ + qh * 128 + wid * 16 + kr;
    const int swz = (lane & 7) ^ (lane >> 3);
    const bf16* ksrc = K2 + ((size_t)b * MEMLEN + 8 * wid + (lane >> 3)) * 1024 + head * 256 + swz * 8;
    const bf16* vsrc = V2P + ((size_t)head * 256 + 32 * wid + (lane >> 3)) * 2048 + (size_t)b * MEMLEN + swz * 8;
#define XA_DMA(c, bufo) do { _Pragma("unroll") for (int i = 0; i < 4; ++i) { \
        sb::glds16(ksrc + (size_t)(64 * (c)) * 1024 + 64 * i, (unsigned)__builtin_amdgcn_readfirstlane(lds0 + (bufo) + (wid + 8 * i) * 1024)); \
        sb::glds16(vsrc + (size_t)(8 * i) * 2048 + 64 * (c), (unsigned)__builtin_amdgcn_readfirstlane(lds0 + (bufo) + VOFF + wid * 4096 + i * 1024)); } } while (0)
    if (!REV) XA_DMA(0, 0);
    bf16x8 qf[8];
#pragma unroll
    for (int ks = 0; ks < 8; ++ks) { if (REV) qf[ks] = qn[ks]; else qf[ks] = *(const GAS bf16x8*)(Q + qrow * 1024 + head * 256 + 32 * ks + 8 * g); }
    f32x4 o[16];
#pragma unroll
    for (int dt = 0; dt < 16; ++dt) o[dt] = (f32x4){0.f, 0.f, 0.f, 0.f};
    float mrun = -1e30f, lrun = 0.f;
    const int lo0 = (kr >> 3) * 1024 + (kr & 7) * 128 + ((g ^ (kr & 7)) * 16);
    const lds_cptr kfr0 = shm3 + lo0, kfr1 = shm3 + (lo0 ^ 64);
#pragma unroll 1
    for (int ci = 0; ci < 4; ++ci) {
        const int c = REV ? 3 - ci : ci; const int bo = (c & 1) * BUFB;
        if (!(REV && ci == 0)) XA_WAIT_BAR();
        if (!REV) { if (c < 3) XA_DMA(c + 1, bo ^ BUFB); }
        else { if (ci == 1 || ci == 2) XA_DMA(c - 1, bo ^ BUFB); }
        f32x4 s[4];
#pragma unroll
        for (int kt = 0; kt < 4; ++kt) { s[kt] = (f32x4){0.f, 0.f, 0.f, 0.f};
#pragma unroll
            for (int ks = 0; ks < 8; ++ks) { const bf16x8 a = *(const __attribute__((address_space(3))) bf16x8*)(((ks & 1) ? kfr1 : kfr0) + bo + (ks >> 1) * 8192 + kt * 2048);
                s[kt] = __builtin_amdgcn_mfma_f32_16x16x32_bf16(a, qf[ks], s[kt], 0, 0, 0); } }
        float mx = __builtin_fmaxf(__builtin_fmaxf(s[0].x, s[0].y), __builtin_fmaxf(s[0].z, s[0].w));
#pragma unroll
        for (int kt = 1; kt < 4; ++kt) mx = __builtin_fmaxf(mx, __builtin_fmaxf(__builtin_fmaxf(s[kt].x, s[kt].y), __builtin_fmaxf(s[kt].z, s[kt].w)));
        mx = __builtin_fmaxf(mx, __shfl_xor(mx, 16)); mx = __builtin_fmaxf(mx, __shfl_xor(mx, 32));
        const float mnew = __builtin_fmaxf(mrun, mx), alpha = __builtin_amdgcn_exp2f(mrun - mnew);
        mrun = mnew; float ps = 0.f;
#pragma unroll
        for (int kt = 0; kt < 4; ++kt) { s[kt].x = __builtin_amdgcn_exp2f(s[kt].x - mnew); s[kt].y = __builtin_amdgcn_exp2f(s[kt].y - mnew); s[kt].z = __builtin_amdgcn_exp2f(s[kt].z - mnew); s[kt].w = __builtin_amdgcn_exp2f(s[kt].w - mnew);
            ps += (s[kt].x + s[kt].y) + (s[kt].z + s[kt].w); }
        lrun = lrun * alpha + ps;
#pragma unroll
        for (int dt = 0; dt < 16; ++dt) o[dt] = o[dt] * alpha;
        bf16x8 pb[2];
#pragma unroll
        for (int k2 = 0; k2 < 2; ++k2) { u32x4 w; w.x = pg8::cvt_pk_bf16(s[2 * k2].x, s[2 * k2].y); w.y = pg8::cvt_pk_bf16(s[2 * k2].z, s[2 * k2].w);
            w.z = pg8::cvt_pk_bf16(s[2 * k2 + 1].x, s[2 * k2 + 1].y); w.w = pg8::cvt_pk_bf16(s[2 * k2 + 1].z, s[2 * k2 + 1].w); pb[k2] = __builtin_bit_cast(bf16x8, w); }
#pragma unroll
        for (int dt = 0; dt < 16; ++dt)
#pragma unroll
            for (int k2 = 0; k2 < 2; ++k2) { const bf16x8 a = *(const __attribute__((address_space(3))) bf16x8*)((k2 ? kfr1 : kfr0) + bo + VOFF + dt * 2048);
                o[dt] = __builtin_amdgcn_mfma_f32_16x16x32_bf16(a, pb[k2], o[dt], 0, 0, 0); }
    }
    lrun += __shfl_xor(lrun, 16); lrun += __shfl_xor(lrun, 32);
    const float rl = 1.0f / lrun;
    if (!REV) {
#pragma unroll
        for (int ks = 0; ks < 8; ++ks) qn[ks] = *(const GAS bf16x8*)(Q + (qrow + 128) * 1024 + head * 256 + 32 * ks + 8 * g); }
    bf16* op = O + qrow * 1024 + head * 256 + 4 * g;
#pragma unroll
    for (int dt = 0; dt < 16; ++dt) { u32x2 w; w.x = pg8::cvt_pk_bf16(o[dt].x * rl, o[dt].y * rl); w.y = pg8::cvt_pk_bf16(o[dt].z * rl, o[dt].w * rl); *(GAS u32x2*)(op + 16 * dt) = w; }
    if (REV) __builtin_amdgcn_s_barrier();
#undef XA_DMA
}
}

namespace peer {
using bf16x8 = __attribute__((ext_vector_type(8))) short;
using f32x16 = __attribute__((ext_vector_type(16))) float;
using u32x4 = __attribute__((ext_vector_type(4))) unsigned;
using u32x2 = __attribute__((ext_vector_type(2))) unsigned;
typedef __bf16 bf16x2_t __attribute__((ext_vector_type(2)));
#define PEER_CE(a, b) do { const int _h = ((a) > (b)) ? (a) : (b); const int _l = ((a) > (b)) ? (b) : (a); (a) = _h; (b) = _l; } while (0)
#define PEER_SORT16(x, o) do { PEER_CE(x[(o)+0], x[(o)+1]); PEER_CE(x[(o)+2], x[(o)+3]); PEER_CE(x[(o)+4], x[(o)+5]); PEER_CE(x[(o)+6], x[(o)+7]); PEER_CE(x[(o)+8], x[(o)+9]); PEER_CE(x[(o)+10], x[(o)+11]); PEER_CE(x[(o)+12], x[(o)+13]); PEER_CE(x[(o)+14], x[(o)+15]); PEER_CE(x[(o)+0], x[(o)+2]); PEER_CE(x[(o)+1], x[(o)+3]); PEER_CE(x[(o)+4], x[(o)+6]); PEER_CE(x[(o)+5], x[(o)+7]); PEER_CE(x[(o)+8], x[(o)+10]); PEER_CE(x[(o)+9], x[(o)+11]); PEER_CE(x[(o)+12], x[(o)+14]); PEER_CE(x[(o)+13], x[(o)+15]); PEER_CE(x[(o)+1], x[(o)+2]); PEER_CE(x[(o)+5], x[(o)+6]); PEER_CE(x[(o)+9], x[(o)+10]); PEER_CE(x[(o)+13], x[(o)+14]); PEER_CE(x[(o)+0], x[(o)+4]); PEER_CE(x[(o)+1], x[(o)+5]); PEER_CE(x[(o)+2], x[(o)+6]); PEER_CE(x[(o)+3], x[(o)+7]); PEER_CE(x[(o)+8], x[(o)+12]); PEER_CE(x[(o)+9], x[(o)+13]); PEER_CE(x[(o)+10], x[(o)+14]); PEER_CE(x[(o)+11], x[(o)+15]); PEER_CE(x[(o)+2], x[(o)+4]); PEER_CE(x[(o)+3], x[(o)+5]); PEER_CE(x[(o)+10], x[(o)+12]); PEER_CE(x[(o)+11], x[(o)+13]); PEER_CE(x[(o)+1], x[(o)+2]); PEER_CE(x[(o)+3], x[(o)+4]); PEER_CE(x[(o)+5], x[(o)+6]); PEER_CE(x[(o)+9], x[(o)+10]); PEER_CE(x[(o)+11], x[(o)+12]); PEER_CE(x[(o)+13], x[(o)+14]); PEER_CE(x[(o)+0], x[(o)+8]); PEER_CE(x[(o)+1], x[(o)+9]); PEER_CE(x[(o)+2], x[(o)+10]); PEER_CE(x[(o)+3], x[(o)+11]); PEER_CE(x[(o)+4], x[(o)+12]); PEER_CE(x[(o)+5], x[(o)+13]); PEER_CE(x[(o)+6], x[(o)+14]); PEER_CE(x[(o)+7], x[(o)+15]); PEER_CE(x[(o)+4], x[(o)+8]); PEER_CE(x[(o)+5], x[(o)+9]); PEER_CE(x[(o)+6], x[(o)+10]); PEER_CE(x[(o)+7], x[(o)+11]); PEER_CE(x[(o)+2], x[(o)+4]); PEER_CE(x[(o)+3], x[(o)+5]); PEER_CE(x[(o)+6], x[(o)+8]); PEER_CE(x[(o)+7], x[(o)+9]); PEER_CE(x[(o)+10], x[(o)+12]); PEER_CE(x[(o)+11], x[(o)+13]); PEER_CE(x[(o)+1], x[(o)+2]); PEER_CE(x[(o)+3], x[(o)+4]); PEER_CE(x[(o)+5], x[(o)+6]); PEER_CE(x[(o)+7], x[(o)+8]); PEER_CE(x[(o)+9], x[(o)+10]); PEER_CE(x[(o)+11], x[(o)+12]); PEER_CE(x[(o)+13], x[(o)+14]); } while (0)
#define PEER_MERGE16(x, a, b) do { x[(a)+0] = (x[(a)+0] > x[(b)+15]) ? x[(a)+0] : x[(b)+15]; x[(a)+1] = (x[(a)+1] > x[(b)+14]) ? x[(a)+1] : x[(b)+14]; x[(a)+2] = (x[(a)+2] > x[(b)+13]) ? x[(a)+2] : x[(b)+13]; x[(a)+3] = (x[(a)+3] > x[(b)+12]) ? x[(a)+3] : x[(b)+12]; x[(a)+4] = (x[(a)+4] > x[(b)+11]) ? x[(a)+4] : x[(b)+11]; x[(a)+5] = (x[(a)+5] > x[(b)+10]) ? x[(a)+5] : x[(b)+10]; x[(a)+6] = (x[(a)+6] > x[(b)+9]) ? x[(a)+6] : x[(b)+9]; x[(a)+7] = (x[(a)+7] > x[(b)+8]) ? x[(a)+7] : x[(b)+8]; x[(a)+8] = (x[(a)+8] > x[(b)+7]) ? x[(a)+8] : x[(b)+7]; x[(a)+9] = (x[(a)+9] > x[(b)+6]) ? x[(a)+9] : x[(b)+6]; x[(a)+10] = (x[(a)+10] > x[(b)+5]) ? x[(a)+10] : x[(b)+5]; x[(a)+11] = (x[(a)+11] > x[(b)+4]) ? x[(a)+11] : x[(b)+4]; x[(a)+12] = (x[(a)+12] > x[(b)+3]) ? x[(a)+12] : x[(b)+3]; x[(a)+13] = (x[(a)+13] > x[(b)+2]) ? x[(a)+13] : x[(b)+2]; x[(a)+14] = (x[(a)+14] > x[(b)+1]) ? x[(a)+14] : x[(b)+1]; x[(a)+15] = (x[(a)+15] > x[(b)+0]) ? x[(a)+15] : x[(b)+0]; PEER_CE(x[(a)+0], x[(a)+8]); PEER_CE(x[(a)+1], x[(a)+9]); PEER_CE(x[(a)+2], x[(a)+10]); PEER_CE(x[(a)+3], x[(a)+11]); PEER_CE(x[(a)+4], x[(a)+12]); PEER_CE(x[(a)+5], x[(a)+13]); PEER_CE(x[(a)+6], x[(a)+14]); PEER_CE(x[(a)+7], x[(a)+15]); PEER_CE(x[(a)+0], x[(a)+4]); PEER_CE(x[(a)+1], x[(a)+5]); PEER_CE(x[(a)+2], x[(a)+6]); PEER_CE(x[(a)+3], x[(a)+7]); PEER_CE(x[(a)+8], x[(a)+12]); PEER_CE(x[(a)+9], x[(a)+13]); PEER_CE(x[(a)+10], x[(a)+14]); PEER_CE(x[(a)+11], x[(a)+15]); PEER_CE(x[(a)+0], x[(a)+2]); PEER_CE(x[(a)+1], x[(a)+3]); PEER_CE(x[(a)+4], x[(a)+6]); PEER_CE(x[(a)+5], x[(a)+7]); PEER_CE(x[(a)+8], x[(a)+10]); PEER_CE(x[(a)+9], x[(a)+11]); PEER_CE(x[(a)+12], x[(a)+14]); PEER_CE(x[(a)+13], x[(a)+15]); PEER_CE(x[(a)+0], x[(a)+1]); PEER_CE(x[(a)+2], x[(a)+3]); PEER_CE(x[(a)+4], x[(a)+5]); PEER_CE(x[(a)+6], x[(a)+7]); PEER_CE(x[(a)+8], x[(a)+9]); PEER_CE(x[(a)+10], x[(a)+11]); PEER_CE(x[(a)+12], x[(a)+13]); PEER_CE(x[(a)+14], x[(a)+15]); } while (0)
#define PEER_MERGE16_SET(x, a, b) do { x[(a)+0] = (x[(a)+0] > x[(b)+15]) ? x[(a)+0] : x[(b)+15]; x[(a)+1] = (x[(a)+1] > x[(b)+14]) ? x[(a)+1] : x[(b)+14]; x[(a)+2] = (x[(a)+2] > x[(b)+13]) ? x[(a)+2] : x[(b)+13]; x[(a)+3] = (x[(a)+3] > x[(b)+12]) ? x[(a)+3] : x[(b)+12]; x[(a)+4] = (x[(a)+4] > x[(b)+11]) ? x[(a)+4] : x[(b)+11]; x[(a)+5] = (x[(a)+5] > x[(b)+10]) ? x[(a)+5] : x[(b)+10]; x[(a)+6] = (x[(a)+6] > x[(b)+9]) ? x[(a)+6] : x[(b)+9]; x[(a)+7] = (x[(a)+7] > x[(b)+8]) ? x[(a)+7] : x[(b)+8]; x[(a)+8] = (x[(a)+8] > x[(b)+7]) ? x[(a)+8] : x[(b)+7]; x[(a)+9] = (x[(a)+9] > x[(b)+6]) ? x[(a)+9] : x[(b)+6]; x[(a)+10] = (x[(a)+10] > x[(b)+5]) ? x[(a)+10] : x[(b)+5]; x[(a)+11] = (x[(a)+11] > x[(b)+4]) ? x[(a)+11] : x[(b)+4]; x[(a)+12] = (x[(a)+12] > x[(b)+3]) ? x[(a)+12] : x[(b)+3]; x[(a)+13] = (x[(a)+13] > x[(b)+2]) ? x[(a)+13] : x[(b)+2]; x[(a)+14] = (x[(a)+14] > x[(b)+1]) ? x[(a)+14] : x[(b)+1]; x[(a)+15] = (x[(a)+15] > x[(b)+0]) ? x[(a)+15] : x[(b)+0]; } while (0)
constexpr int PEER_NCAND = 50;
__device__ const unsigned char PEER_CAND[64] = {0, 16, 32, 48, 64, 80, 96, 112, 128, 144, 160, 176, 192, 208, 224, 240, 1, 17, 33, 49, 65, 81, 97, 113, 2, 18, 34, 50, 66, 3, 19, 35, 51, 4, 20, 36, 5, 21, 6, 22, 7, 23, 8, 9, 10, 11, 12, 13, 14, 15, 0, 0, 0, 0, 0, 0, 0, 0, 0, 0, 0, 0, 0, 0};
#define PEER_CAND_SUMS(x, v0, v1, KEYF) do { x[0] = KEYF((v0)[0] + (v1)[0], 0); x[1] = KEYF((v0)[0] + (v1)[1], 1); x[2] = KEYF((v0)[0] + (v1)[2], 2); x[3] = KEYF((v0)[0] + (v1)[3], 3); x[4] = KEYF((v0)[0] + (v1)[4], 4); x[5] = KEYF((v0)[0] + (v1)[5], 5); x[6] = KEYF((v0)[0] + (v1)[6], 6); x[7] = KEYF((v0)[0] + (v1)[7], 7); x[8] = KEYF((v0)[0] + (v1)[8], 8); x[9] = KEYF((v0)[0] + (v1)[9], 9); x[10] = KEYF((v0)[0] + (v1)[10], 10); x[11] = KEYF((v0)[0] + (v1)[11], 11); x[12] = KEYF((v0)[0] + (v1)[12], 12); x[13] = KEYF((v0)[0] + (v1)[13], 13); x[14] = KEYF((v0)[0] + (v1)[14], 14); x[15] = KEYF((v0)[0] + (v1)[15], 15); x[16] = KEYF((v0)[1] + (v1)[0], 16); x[17] = KEYF((v0)[1] + (v1)[1], 17); x[18] = KEYF((v0)[1] + (v1)[2], 18); x[19] = KEYF((v0)[1] + (v1)[3], 19); x[20] = KEYF((v0)[1] + (v1)[4], 20); x[21] = KEYF((v0)[1] + (v1)[5], 21); x[22] = KEYF((v0)[1] + (v1)[6], 22); x[23] = KEYF((v0)[1] + (v1)[7], 23); x[24] = KEYF((v0)[2] + (v1)[0], 24); x[25] = KEYF((v0)[2] + (v1)[1], 25); x[26] = KEYF((v0)[2] + (v1)[2], 26); x[27] = KEYF((v0)[2] + (v1)[3], 27); x[28] = KEYF((v0)[2] + (v1)[4], 28); x[29] = KEYF((v0)[3] + (v1)[0], 29); x[30] = KEYF((v0)[3] + (v1)[1], 30); x[31] = KEYF((v0)[3] + (v1)[2], 31); x[32] = KEYF((v0)[3] + (v1)[3], 32); x[33] = KEYF((v0)[4] + (v1)[0], 33); x[34] = KEYF((v0)[4] + (v1)[1], 34); x[35] = KEYF((v0)[4] + (v1)[2], 35); x[36] = KEYF((v0)[5] + (v1)[0], 36); x[37] = KEYF((v0)[5] + (v1)[1], 37); x[38] = KEYF((v0)[6] + (v1)[0], 38); x[39] = KEYF((v0)[6] + (v1)[1], 39); x[40] = KEYF((v0)[7] + (v1)[0], 40); x[41] = KEYF((v0)[7] + (v1)[1], 41); x[42] = KEYF((v0)[8] + (v1)[0], 42); x[43] = KEYF((v0)[9] + (v1)[0], 43); x[44] = KEYF((v0)[10] + (v1)[0], 44); x[45] = KEYF((v0)[11] + (v1)[0], 45); x[46] = KEYF((v0)[12] + (v1)[0], 46); x[47] = KEYF((v0)[13] + (v1)[0], 47); x[48] = KEYF((v0)[14] + (v1)[0], 48); x[49] = KEYF((v0)[15] + (v1)[0], 49); x[50] = (int)0x80000000; x[51] = (int)0x80000000; x[52] = (int)0x80000000; x[53] = (int)0x80000000; x[54] = (int)0x80000000; x[55] = (int)0x80000000; x[56] = (int)0x80000000; x[57] = (int)0x80000000; x[58] = (int)0x80000000; x[59] = (int)0x80000000; x[60] = (int)0x80000000; x[61] = (int)0x80000000; x[62] = (int)0x80000000; x[63] = (int)0x80000000; } while (0)

__device__ __forceinline__ int crow(int r, int hi) { return (r & 3) + 8 * (r >> 2) + 4 * hi; }
__device__ __forceinline__ int f2key(float f) { const int t = __builtin_bit_cast(int, f); return t ^ ((t >> 31) & 0x7fffffff); }
__device__ __forceinline__ float key2f(int t) { return __builtin_bit_cast(float, t ^ ((t >> 31) & 0x7fffffff)); }
__device__ __forceinline__ int sel_hi(int a, int b, int hm) { int r; asm("v_bfi_b32 %0, %1, %2, %3" : "=v"(r) : "v"(hm), "v"(b), "v"(a)); return r; }
template <int CTRL> __device__ __forceinline__ float dpp(float x) { return __int_as_float(__builtin_amdgcn_update_dpp(0, __float_as_int(x), CTRL, 0xF, 0xF, true)); }
__device__ __forceinline__ float swap16_sum(float x) { auto rr = __builtin_amdgcn_permlane16_swap(__float_as_uint(x), __float_as_uint(x), false, false); return __uint_as_float(rr[0]) + __uint_as_float(rr[1]); }
__device__ __forceinline__ float swap32_sum(float x) { auto rr = __builtin_amdgcn_permlane32_swap(__float_as_uint(x), __float_as_uint(x), false, false); return __uint_as_float(rr[0]) + __uint_as_float(rr[1]); }
__device__ __forceinline__ unsigned fselu(unsigned a, unsigned b, int m) { return (a & ~(unsigned)m) | (b & (unsigned)m); }
__device__ __forceinline__ float fselc(float a, float b, int m) { return __uint_as_float(fselu(__float_as_uint(a), __float_as_uint(b), m)); }
__device__ __forceinline__ float fsel(float a, float b, int m) { return __int_as_float(sel_hi(__float_as_int(a), __float_as_int(b), m)); }
typedef float f32x2 __attribute__((ext_vector_type(2)));
__device__ __forceinline__ int key7(float f, int low) { return (f2key(f) & ~127) | low; }
__device__ __forceinline__ int key6(float f, int ord) { return (f2key(f) & ~63) | (63 - ord); }
__device__ __forceinline__ void top16_of_cands(int (&x)[64]) {
    PEER_SORT16(x, 16); PEER_SORT16(x, 32);
    PEER_MERGE16(x, 0, 16); PEER_MERGE16(x, 32, 48); PEER_MERGE16(x, 0, 32);
}
__device__ __forceinline__ void top16_of_64(int (&x)[64]) {
    PEER_SORT16(x, 0); PEER_SORT16(x, 16); PEER_SORT16(x, 32); PEER_SORT16(x, 48);
    PEER_MERGE16(x, 0, 16); PEER_MERGE16(x, 32, 48); PEER_MERGE16(x, 0, 32);
}
__device__ __forceinline__ float dot2_bf16(unsigned w, unsigned x, float acc) { return __builtin_amdgcn_fdot2_f32_bf16(__builtin_bit_cast(bf16x2_t, w), __builtin_bit_cast(bf16x2_t, x), acc, false); }
__device__ __forceinline__ float dot8(const u32x4 a, const u32x4 b, float acc) {
    acc = dot2_bf16(a.x, b.x, acc); acc = dot2_bf16(a.y, b.y, acc); acc = dot2_bf16(a.z, b.z, acc); acc = dot2_bf16(a.w, b.w, acc); return acc;
}
__device__ __forceinline__ float gelu_tanh(float x) {
    const float u = 0.7978845608028654f * (x + 0.044715f * x * x * x);
    const float e = __builtin_amdgcn_exp2f(2.0f * LOG2E * u);
    const float th = 1.0f - 2.0f * __builtin_amdgcn_rcpf(e + 1.0f);
    return 0.5f * x * (1.0f + th);
}
__device__ __forceinline__ float gelu_sig(float x) {
    const float t = x * x;
    const float z = x * __builtin_fmaf(t, -2.0f * LOG2E * 0.7978845608028654f * 0.044715f, -2.0f * LOG2E * 0.7978845608028654f);
    return x * __builtin_amdgcn_rcpf(1.0f + __builtin_amdgcn_exp2f(z));
}
__device__ __forceinline__ void topk_half(const bf16* qp, const bf16* sp, int hi, int (&T)[16]) {
    bf16x8 qf[8];
#pragma unroll
    for (int ks = 0; ks < 8; ++ks) qf[ks] = *(const GAS bf16x8*)(qp + ks * 16);
    const int hi4 = hi << 2;
    int x[64];
#pragma unroll
    for (int kt = 0; kt < 4; ++kt) { f32x16 sc = f32x16{};
#pragma unroll
        for (int ks = 0; ks < 8; ++ks) { const bf16x8 a = *(const GAS bf16x8*)(sp + (size_t)((kt * 8 + ks) * 64) * 8); sc = __builtin_amdgcn_mfma_f32_32x32x16_bf16(a, qf[ks], sc, 0, 0, 0); }
#pragma unroll
        for (int r = 0; r < 16; ++r) x[16 * kt + r] = ((f2key(sc[r]) & ~127) | (127 - (32 * kt + crow(r, 0)))) ^ hi4; }
    top16_of_64(x);
#pragma unroll
    for (int i = 0; i < 16; ++i) { auto rr = __builtin_amdgcn_permlane32_swap((unsigned)x[i], (unsigned)x[i], false, false); x[i] = (int)rr[0]; x[16 + i] = (int)rr[1]; }
    PEER_MERGE16(x, 0, 16);
#pragma unroll
    for (int i = 0; i < 16; ++i) T[i] = x[i];
}
__device__ __forceinline__ float fp8dot4(unsigned w, float h0, float h1, float h2, float h3) {
    const f32x2 lo = __builtin_amdgcn_cvt_pk_f32_fp8((int)w, false), hi = __builtin_amdgcn_cvt_pk_f32_fp8((int)w, true);
    return __builtin_fmaf(hi.y, h3, __builtin_fmaf(hi.x, h2, __builtin_fmaf(lo.y, h1, lo.x * h0)));
}
__device__ __forceinline__ float fp8dot16(const u32x4 u, const float (&h)[16]) {
    return (fp8dot4(u.x, h[0], h[1], h[2], h[3]) + fp8dot4(u.y, h[4], h[5], h[6], h[7])) + (fp8dot4(u.z, h[8], h[9], h[10], h[11]) + fp8dot4(u.w, h[12], h[13], h[14], h[15]));
}
__device__ __forceinline__ float fp8dot4b(unsigned w, unsigned x0, unsigned x1) {
    const bf16x2_t lo = __builtin_amdgcn_cvt_scalef32_pk_bf16_fp8(w, 1.0f, false), hi = __builtin_amdgcn_cvt_scalef32_pk_bf16_fp8(w, 1.0f, true);
    return __builtin_amdgcn_fdot2_f32_bf16(hi, __builtin_bit_cast(bf16x2_t, x1), __builtin_amdgcn_fdot2_f32_bf16(lo, __builtin_bit_cast(bf16x2_t, x0), 0.f, false), false);
}
__device__ __forceinline__ float fp8dot16b(const u32x4 u, const unsigned (&x)[8]) {
    return (fp8dot4b(u.x, x[0], x[1]) + fp8dot4b(u.y, x[2], x[3])) + (fp8dot4b(u.z, x[4], x[5]) + fp8dot4b(u.w, x[6], x[7]));
}
typedef unsigned u32x3 __attribute__((ext_vector_type(3)));
typedef unsigned v6u __attribute__((ext_vector_type(6)));
typedef unsigned v16u __attribute__((ext_vector_type(16)));
typedef float v32f __attribute__((ext_vector_type(32)));
__device__ __forceinline__ float dot2_bf16_z(unsigned w, unsigned x) { float r; asm("v_dot2_f32_bf16 %0, %1, %2, 0" : "=v"(r) : "v"(w), "v"(x)); return r; }
__device__ __forceinline__ float bfdot16(const v16u ub, int o, const unsigned (&x)[8]) {
    float a = dot2_bf16(ub[o], x[0], 0.f);
    a = dot2_bf16(ub[o + 1], x[1], a); a = dot2_bf16(ub[o + 2], x[2], a); a = dot2_bf16(ub[o + 3], x[3], a);
    a = dot2_bf16(ub[o + 4], x[4], a); a = dot2_bf16(ub[o + 5], x[5], a); a = dot2_bf16(ub[o + 6], x[6], a); a = dot2_bf16(ub[o + 7], x[7], a);
    return a;
}
__device__ __forceinline__ void fp8axpy4(unsigned w, float c, float& a0, float& a1, float& a2, float& a3) {
    const f32x2 lo = __builtin_amdgcn_cvt_pk_f32_fp8((int)w, false), hi = __builtin_amdgcn_cvt_pk_f32_fp8((int)w, true);
    a0 += c * lo.x; a1 += c * lo.y; a2 += c * hi.x; a3 += c * hi.y;
}
__device__ __forceinline__ void fp8axpy16(const u32x4 v, float c, float (&a)[16]) {
    fp8axpy4(v.x, c, a[0], a[1], a[2], a[3]); fp8axpy4(v.y, c, a[4], a[5], a[6], a[7]); fp8axpy4(v.z, c, a[8], a[9], a[10], a[11]); fp8axpy4(v.w, c, a[12], a[13], a[14], a[15]);
}
constexpr int LSTRIDE = 256;
constexpr int IMG_ROW = 784, IMG_WAVE = 8 * IMG_ROW;
constexpr int L_ROUTE = 0, L_NLIST = 32768, L_CAND = 40960, L_OFF = 41472, L_SORT = 43008, L_IMG = 43008 + 8 * 4 * LSTRIDE * 4, L_END = L_IMG + 8 * IMG_WAVE;
constexpr int NSL = 8, SL_SHIFT = 11;
__device__ __forceinline__ void peer_tile(int tile, const bf16* PQ, const bf16* SK, const float* SSQ, const unsigned char* U8, const unsigned char* V8, const float* gfin, const bf16* HB, float* out, LAS unsigned char* lds, int mode = 3, float* outw = nullptr) {
    const int lane = threadIdx.x & 63, r32 = lane & 31, hi = lane >> 5; const int wid = __builtin_amdgcn_readfirstlane((int)threadIdx.x >> 6);
    const int tok0 = tile * 32; if (!outw) outw = out;
    LAS unsigned* route = (LAS unsigned*)(lds + L_ROUTE);
    LAS unsigned char* nl = lds + L_NLIST + (wid * 32 + r32) * 32;
    const LAS unsigned char* cand = lds + L_CAND;
    if (mode & 1) {
        const int h = wid; int T0[16], T1[16];
        topk_half(PQ + (size_t)(tok0 + r32) * NPQ + (h * 2 + 0) * 128 + hi * 8, SK + (size_t)(h * 2 + 0) * 16384 + (hi * 32 + r32) * 8, hi, T0);
        topk_half(PQ + (size_t)(tok0 + r32) * NPQ + (h * 2 + 1) * 128 + hi * 8, SK + (size_t)(h * 2 + 1) * 16384 + (hi * 32 + r32) * 8, hi, T1);
        const int hm = -hi;
        {
            u32x4 w;
#pragma unroll
            for (int q4 = 0; q4 < 4; ++q4) { unsigned a = 0;
#pragma unroll
                for (int e = 0; e < 4; ++e) { const int t = sel_hi(T0[4 * q4 + e], T1[4 * q4 + e], hm); a |= (unsigned)(127 - (t & 127)) << (8 * e); }
                w[q4] = a; }
            *(LAS u32x4*)(nl + 16 * hi) = w;
        }
        float v0[16], v1[16];
#pragma unroll
        for (int i = 0; i < 16; ++i) { v0[i] = key2f(T0[i] & ~127); v1[i] = key2f(T1[i] & ~127); }
        int x[64];
        PEER_CAND_SUMS(x, v0, v1, key6);
        top16_of_cands(x);
        const float smax = key2f(x[0] & ~63);
        float p[16], ps = 0.f;
#pragma unroll
        for (int i = 0; i < 16; ++i) { p[i] = __builtin_amdgcn_exp2f((key2f(x[i] & ~63) - smax) * LOG2E); ps += p[i]; }
        const float rps = 1.0f / ps;
        LDS_WAIT();
#pragma unroll
        for (int i = 0; i < 8; ++i) {
            const int xi = sel_hi(x[i], x[8 + i], hm); const float g = __int_as_float(sel_hi(__float_as_int(p[i]), __float_as_int(p[8 + i]), hm)) * rps;
            const int ij = cand[63 - (xi & 63)]; const int n0 = nl[ij & 15], n1 = nl[16 + (ij >> 4)];
            u32x2 w; w.x = (unsigned)(n0 * 128 + n1); w.y = __float_as_uint(g * 0.25f);
            *(LAS u32x2*)(route + ((size_t)r32 * 128 + h * 16 + 8 * hi + i) * 2) = w; }
    }
    LDS_WAIT(); __syncthreads();
    if (mode & 2) {
    int m0 = -(lane & 1), m1 = -((lane >> 1) & 1);
    const int jj = ((lane & 1) << 1) | ((lane >> 1) & 1);
    LAS unsigned* srtw = (LAS unsigned*)(lds + L_SORT) + wid * (4 * LSTRIDE);
    const __amdgpu_buffer_rsrc_t ru = __builtin_amdgcn_make_buffer_rsrc((void*)U8, 0, 0x7fffffff, 0x00020000), rv = __builtin_amdgcn_make_buffer_rsrc((void*)V8, 0, 0x7fffffff, 0x00020000);
    const int voff = lane * 12;
    LAS unsigned char* offw = lds + L_OFF + wid * 128;
    const unsigned long long lt = (1ull << lane) - 1ull;
#pragma unroll 1
    for (int tt = 0; tt < 4; ++tt) {
        const LAS unsigned* rt0 = route + (wid * 4 + tt) * 256; LAS unsigned* srt = srtw + tt * LSTRIDE; LAS unsigned char* offb = offw + tt * 32;
        const u32x2 ea = *(const LAS u32x2*)(rt0 + lane * 2), eb = *(const LAS u32x2*)(rt0 + (lane + 64) * 2);
        const int sa = (int)ea.x >> SL_SHIFT, sb_ = (int)eb.x >> SL_SHIFT; int base = 0, pa = 0, pb = 0;
#pragma unroll 1
        for (int v = 0; v < NSL; ++v) { const unsigned long long ma = __ballot(sa == v), mb = __ballot(sb_ == v); const int ca = __popcll(ma), cb2 = __popcll(mb);
            if (lane == 0) offb[v] = (unsigned char)((base + 7) & ~7);
            if (sa == v) pa = base + __popcll(ma & lt); if (sb_ == v) pb = base + ca + __popcll(mb & lt); base += ca + cb2; }
        if (lane == 0) offb[NSL] = (unsigned char)128;
        srt[pa] = ea.x; srt[128 + pa] = ea.y; srt[pb] = eb.x; srt[128 + pb] = eb.y;
    }
    LDS_WAIT();
    typedef int v8i __attribute__((ext_vector_type(8))); typedef float v4f_ __attribute__((ext_vector_type(4))); typedef __bf16 v32bf __attribute__((ext_vector_type(32)));
    float scl[4], acc[4][16];
    LAS unsigned char* hxl = lds + L_ROUTE + wid * 4096;
    LAS unsigned char* img = lds + L_IMG + wid * IMG_WAVE;
#pragma unroll
    for (int tt = 0; tt < 4; ++tt) {
        const size_t tok = (size_t)tok0 + wid * 4 + tt; const bf16* hrow = HB + tok * 1024 + lane * 4;
        const f32x4* sp = (const f32x4*)(SSQ + tok * 16); const f32x4 a = sp[0], b = sp[1], c = sp[2], d = sp[3]; const f32x4 t4 = (a + b) + (c + d);
        const float rstd = __builtin_amdgcn_rsqf(((t4[0] + t4[1]) + (t4[2] + t4[3])) * (1.0f / 1024.0f) + RMS_EPS);
        { const u32x2 h0_ = *(const GAS u32x2*)hrow, h1_ = *(const GAS u32x2*)(hrow + 256), h2_ = *(const GAS u32x2*)(hrow + 512), h3_ = *(const GAS u32x2*)(hrow + 768);
          const unsigned hw[8] = {h0_.x, h0_.y, h1_.x, h1_.y, h2_.x, h2_.y, h3_.x, h3_.y}; float hf[16]; float am = 0.f;
#pragma unroll
          for (int i = 0; i < 8; ++i) { hf[2 * i] = bflo(hw[i]); hf[2 * i + 1] = bfhi(hw[i]); am = __builtin_fmaxf(am, __builtin_fmaxf(__builtin_fabsf(hf[2 * i]), __builtin_fabsf(hf[2 * i + 1]))); }
#pragma unroll
          for (int o = 32; o >= 1; o >>= 1) am = __builtin_fmaxf(am, __shfl_xor(am, o));
          am = __builtin_fmaxf(am, 1e-30f); const float inv = 7.5f / am;
          scl[tt] = rstd * am * (1.0f / (64.0f * 7.5f));
          v32f t;
#pragma unroll
          for (int i = 0; i < 16; ++i) { t[i] = __builtin_fminf(__builtin_fmaxf(hf[i] * inv, -7.5f), 7.5f); t[16 + i] = 0.f; }
          const v6u w = __builtin_amdgcn_cvt_scalef32_pk32_fp6_bf16(__builtin_convertvector(t, v32bf), 1.0f);
          LAS unsigned* hp = (LAS unsigned*)(hxl + tt * 768) + lane * 3; hp[0] = w[0]; hp[1] = w[1]; hp[2] = w[2]; }
#pragma unroll
        for (int i = 0; i < 16; ++i) acc[tt][i] = 0.f;
    }
    LDS_WAIT();
    const LAS unsigned char* afr = img + (lane & 7) * IMG_ROW + ((lane >> 3) & 1) * 384 + (lane >> 4) * 24;
    const LAS unsigned char* bfr = hxl + (lane & 1) * 384 + (lane >> 4) * 24;
    LAS unsigned* iml = (LAS unsigned*)img + lane * 3;
    const LAS unsigned* gatel = srtw + 128 + ((lane >> 4) & 1) * 4;
    v6u vw0, vw1, vw2, vw3;
#define PEER_LD2(w_, rs_, ea_, eb_) do { const u32x3 a_ = __builtin_amdgcn_raw_buffer_load_b96(rs_, voff, ea_, 0); const unsigned b0_ = __builtin_amdgcn_raw_buffer_load_b32(rs_, voff, eb_, 0); const u32x2 b1_ = __builtin_amdgcn_raw_buffer_load_b64(rs_, voff + 4, eb_, 0); \
        w_ = v6u{a_.x, a_.y, a_.z, b0_, b1_.x, b1_.y}; } while (0)
#define PEER_IDS(i_) const u32x4 qi_ = *(const LAS u32x4*)(srtw + (i_)); \
        const int e0_ = __builtin_amdgcn_readfirstlane((int)qi_.x) * 768, e1_ = __builtin_amdgcn_readfirstlane((int)qi_.y) * 768, e2_ = __builtin_amdgcn_readfirstlane((int)qi_.z) * 768, e3_ = __builtin_amdgcn_readfirstlane((int)qi_.w) * 768
    u32x3 ur0, ur1, ur2, ur3, ur4, ur5, ur6, ur7;
#define PEER_ULOAD(i_, ra_, rb_, rc_, rd_) do { PEER_IDS(i_); ra_ = __builtin_amdgcn_raw_buffer_load_b96(ru, voff, e0_, 0); rb_ = __builtin_amdgcn_raw_buffer_load_b96(ru, voff, e1_, 0); rc_ = __builtin_amdgcn_raw_buffer_load_b96(ru, voff, e2_, 0); rd_ = __builtin_amdgcn_raw_buffer_load_b96(ru, voff, e3_, 0); } while (0)
#define PEER_UWRITE(b_, ra_, rb_, rc_, rd_) do { LAS unsigned* p_ = iml + (4 * (b_)) * (IMG_ROW / 4); p_[0] = ra_.x; p_[1] = ra_.y; p_[2] = ra_.z; p_ += IMG_ROW / 4; p_[0] = rb_.x; p_[1] = rb_.y; p_[2] = rb_.z; p_ += IMG_ROW / 4; p_[0] = rc_.x; p_[1] = rc_.y; p_[2] = rc_.z; p_ += IMG_ROW / 4; p_[0] = rd_.x; p_[1] = rd_.y; p_[2] = rd_.z; } while (0)
#define PEER_VROWS(i_, wa_, wb_) do { PEER_IDS(i_); PEER_LD2(wa_, rv, e0_, e1_); PEER_LD2(wb_, rv, e2_, e3_); } while (0)
#define PEER_VCOMP(tt_, b_, wa_, wb_) _Pragma("unroll") for (int p = 0; p < 2; ++p) { \
            const v32f vf = __builtin_amdgcn_cvt_scalef32_pk32_f32_fp6(p ? wb_ : wa_, 1.0f); \
            const float c0 = __int_as_float(__builtin_amdgcn_readlane(__float_as_int(cf_[2 * p]), 16 * (b_))); \
            const float c1 = __int_as_float(__builtin_amdgcn_readlane(__float_as_int(cf_[2 * p + 1]), 16 * (b_))); \
            _Pragma("unroll") for (int i = 0; i < 16; ++i) acc[tt_][i] += c0 * vf[i]; \
            _Pragma("unroll") for (int i = 0; i < 16; ++i) acc[tt_][i] += c1 * vf[16 + i]; }
#define PEER_GROUP(tt_, i_, two_, n_, ntwo_) do { \
        PEER_UWRITE(0, ur0, ur1, ur2, ur3); if (two_) PEER_UWRITE(1, ur4, ur5, ur6, ur7); \
        PEER_ULOAD(n_, ur0, ur1, ur2, ur3); if (ntwo_) PEER_ULOAD((n_) + 4, ur4, ur5, ur6, ur7); \
        LDS_WAIT(); \
        v4f_ dd = {0.f, 0.f, 0.f, 0.f};                                              \
        _Pragma("unroll") for (int kk = 0; kk < 4; ++kk) { \
            const u32x2 a0_ = *(const LAS u32x2*)(afr + 96 * kk), a1_ = *(const LAS u32x2*)(afr + 96 * kk + 8), a2_ = *(const LAS u32x2*)(afr + 96 * kk + 16); \
            const u32x2 b0_ = *(const LAS u32x2*)(bfr + 768 * (tt_) + 96 * kk), b1_ = *(const LAS u32x2*)(bfr + 768 * (tt_) + 96 * kk + 8), b2_ = *(const LAS u32x2*)(bfr + 768 * (tt_) + 96 * kk + 16); \
            const v8i am_ = {(int)a0_.x, (int)a0_.y, (int)a1_.x, (int)a1_.y, (int)a2_.x, (int)a2_.y, 0, 0}, bm_ = {(int)b0_.x, (int)b0_.y, (int)b1_.x, (int)b1_.y, (int)b2_.x, (int)b2_.y, 0, 0}; \
            dd = __builtin_amdgcn_mfma_scale_f32_16x16x128_f8f6f4(am_, bm_, dd, 2, 2, 0, 0x7f7f7f7f, 0, 0x7f7f7f7f); } \
        _Pragma("unroll") for (int r_ = 0; r_ < 4; ++r_) { auto sw_ = __builtin_amdgcn_permlane32_swap(__float_as_uint(dd[r_]), __float_as_uint(dd[r_]), false, false);     \
            dd[r_] = dd[r_] + dpp<0xB1>(__uint_as_float(sw_[1])); }                   \
        const u32x4 gq_ = *(const LAS u32x4*)(gatel + (i_)); \
        float cf_[4]; \
        cf_[0] = __uint_as_float(gq_.x) * gelu_sig(dd[0] * scl[tt_]); cf_[1] = __uint_as_float(gq_.y) * gelu_sig(dd[1] * scl[tt_]); cf_[2] = __uint_as_float(gq_.z) * gelu_sig(dd[2] * scl[tt_]); cf_[3] = __uint_as_float(gq_.w) * gelu_sig(dd[3] * scl[tt_]);     \
        PEER_VCOMP(tt_, 0, vw0, vw1); PEER_VROWS(n_, vw0, vw1); \
        if (two_) { PEER_VCOMP(tt_, 1, vw2, vw3); } \
        if (ntwo_) PEER_VROWS((n_) + 4, vw2, vw3); } while (0)
    bool pft = false; int pf = -1;
#pragma unroll 1
    for (int rr = 0; rr < NSL; ++rr) { const int r = (rr + (int)(blockIdx.x & 7)) & (NSL - 1);
        const int rn = (rr + 1 + (int)(blockIdx.x & 7)) & (NSL - 1);
#pragma unroll
        for (int tt = 0; tt < 4; ++tt) {
            const int lo = __builtin_amdgcn_readfirstlane((int)offw[tt * 32 + r]), hi2 = __builtin_amdgcn_readfirstlane((int)offw[tt * 32 + r + 1]);
            int nlo = (tt < 3) ? __builtin_amdgcn_readfirstlane((int)offw[(tt + 1) * 32 + r]) : __builtin_amdgcn_readfirstlane((int)offw[rn]);
            const int nhi = (tt < 3) ? __builtin_amdgcn_readfirstlane((int)offw[(tt + 1) * 32 + r + 1]) : __builtin_amdgcn_readfirstlane((int)offw[rn + 1]);
            const bool sntwo = (nlo + 4 < nhi);
            nlo = (nlo < 120) ? nlo : 120;
            const int nseg = ((tt < 3) ? (tt + 1) * LSTRIDE : 0) + nlo;
            if (lo < hi2) { int ix = tt * LSTRIDE + lo;
                { const bool two0 = (lo + 4 < hi2); if (pf != ix || (two0 && !pft)) { PEER_ULOAD(ix, ur0, ur1, ur2, ur3); PEER_VROWS(ix, vw0, vw1); if (two0) { PEER_ULOAD(ix + 4, ur4, ur5, ur6, ur7); PEER_VROWS(ix + 4, vw2, vw3); } } }
#pragma unroll 1
                for (int k = lo; k < hi2; k += 8) { const bool two = (k + 4 < hi2), last = !(k + 8 < hi2);
                    const int nx = last ? nseg : ix + 8; const bool ntwo = last ? sntwo : (k + 12 < hi2);
                    PEER_GROUP(tt, ix, two, nx, ntwo); ix = nx; pft = ntwo; }
                pf = ix; }
        }
    }
#undef PEER_LD2
#undef PEER_IDS
#undef PEER_ULOAD
#undef PEER_UWRITE
#undef PEER_VROWS
#undef PEER_VCOMP
#undef PEER_GROUP
#pragma unroll
    for (int tt = 0; tt < 4; ++tt) {
        const size_t tok = (size_t)tok0 + wid * 4 + tt; const bf16* hrow = HB + tok * 1024 + lane * 4; float* wrow = outw + tok * 1024;
        float hv[16]; float s = 0.f;
#pragma unroll
        for (int q = 0; q < 4; ++q) { const u32x2 hq = *(const GAS u32x2*)(hrow + 256 * q); hv[4 * q] = bflo(hq.x); hv[4 * q + 1] = bfhi(hq.x); hv[4 * q + 2] = bflo(hq.y); hv[4 * q + 3] = bfhi(hq.y); }
#pragma unroll
        for (int i = 0; i < 16; ++i) { hv[i] += acc[tt][i]; s += hv[i] * hv[i]; }
        const float rs = 1.0f / sqrtf(wave_sum(s) * (1.f / 1024.f) + RMS_EPS);
#pragma unroll
        for (int q = 0; q < 4; ++q) { const f32x4 g = *(const GAS f32x4*)(gfin + q * 256 + lane * 4); f32x4 t;
            t.x = hv[4 * q] * rs * g.x; t.y = hv[4 * q + 1] * rs * g.y; t.z = hv[4 * q + 2] * rs * g.z; t.w = hv[4 * q + 3] * rs * g.w;
            *(GAS f32x4*)(wrow + q * 256 + lane * 4) = t; }
    }
    }
    LDS_WAIT(); __syncthreads();
}
}
struct Args { const float* in[20]; float* out; unsigned char* ws; int ph_lo, ph_hi, li, pad; };
__global__ void __launch_bounds__(NWAVES * 64, 2) fwd_megakernel(Args args) {
    extern __shared__ __attribute__((aligned(16))) unsigned char lds[];
    LAS unsigned char* ldsp = (LAS unsigned char*)lds;
    volatile LAS unsigned* MISC = (volatile LAS unsigned*)(ldsp + MISC_OFF);
    const int tid = threadIdx.x, lane = tid & 63, wave = __builtin_amdgcn_readfirstlane(tid >> 6);
    const int G = gridDim.x; const int bx = blockIdx.x; const int vcu = (G % 8 == 0) ? (bx % 8) * (G / 8) + bx / 8 : bx;
    unsigned char* ws = args.ws;
    gu32* ctl = (gu32*)(ws + WS_CTL);
    const float* x = args.in[0]; const float* mem = args.in[1]; const float* norm_mix = args.in[2]; const float* w_in = args.in[3]; const float* conv_w = args.in[4];
    const float* w_ba = args.in[5]; const float* w_bc = args.in[6]; const float* w_out = args.in[7]; const float* norm_xattn = args.in[8]; const float* norm_mem = args.in[9];
    const float* xwq = args.in[10]; const float* xwk = args.in[11]; const float* xwv = args.in[12]; const float* xwo = args.in[13]; const float* norm_ffn = args.in[14];
    const float* pwq = args.in[15]; const float* psk = args.in[16]; const float* pu = args.in[17]; const float* pv = args.in[18]; const float* norm_final = args.in[19];
    float* out = args.out;
    bf16* Win_t = (bf16*)(ws + WS_WIN); bf16* Wa_t = (bf16*)(ws + WS_WA); bf16* Wc_t = (bf16*)(ws + WS_WC); bf16* Wo_t = (bf16*)(ws + WS_WO); bf16* Wq2_t = (bf16*)(ws + WS_WQ2);
    bf16* Wkv2_t = (bf16*)(ws + WS_WKV2); bf16* Wo2_t = (bf16*)(ws + WS_WO2); bf16* Wpq_t = (bf16*)(ws + WS_WPQ); bf16* SKb = (bf16*)(ws + WS_SK);
    float* SSQ1 = (float*)(ws + WS_SSQ1); float* SSQ2 = (float*)(ws + WS_SSQ2); bf16* MEMN = (bf16*)(ws + WS_MEMN); bf16* K2 = (bf16*)(ws + WS_K2); bf16* V2T = (bf16*)(ws + WS_V2T);
    bf16* B0 = (bf16*)(ws + WS_B0); bf16* B1 = (bf16*)(ws + WS_B1); bf16* B2 = (bf16*)(ws + WS_B2); bf16* B3 = (bf16*)(ws + WS_B3); bf16* B4 = (bf16*)(ws + WS_B4); bf16* B5 = (bf16*)(ws + WS_B5);
    bf16* XN1 = (bf16*)out; bf16* YC = (bf16*)out; bf16* CBb = (bf16*)((unsigned char*)out + 32 * MiB);

    for (int u = tid; u < (LDS_BYTES - LDSCTL_OFF) / 4; u += NWAVES * 64) ((LAS unsigned*)(ldsp + LDSCTL_OFF))[u] = 0u;
    __syncthreads();
    XcdBarrier bar; bar.bar = (unsigned*)(ctl + CW_BAR); bar.x = 0; bar.st = nullptr;
    if (N_LAUNCHES == 1) bar = xcd_barrier_post((unsigned*)(ctl + CW_BAR), MISC + 8);
#define GRID_BAR() do { if (N_LAUNCHES == 1) xcd_barrier(bar); } while (0)
    int gs_pm = 0; bool gs_same = false;
    { pg8::TileOrder S_; S_.init(M, D, G, bx); pg8::Unit u_; if (S_.next(0, u_)) gs_pm = u_.pm; }
#define GS_CNT(p) (64 + 32 * (p))
#define GS_XCC(p) (64 + 32 * (p) + 16)
    if (N_LAUNCHES == 1 && tid == 0) (void)__hip_atomic_fetch_or((unsigned*)(ctl + GS_XCC(gs_pm)), 1u << (xb_xcc_id() & 15u), __ATOMIC_RELAXED, __HIP_MEMORY_SCOPE_AGENT);
#define GROUP_SYNC(ep) do { if (N_LAUNCHES == 1) { asm volatile("s_waitcnt vmcnt(0)" ::: "memory"); __syncthreads(); \
        if (tid == 0) { unsigned* cnt_ = (unsigned*)(ctl + GS_CNT(gs_pm)); \
            if (!gs_same) { __builtin_amdgcn_fence(__ATOMIC_RELEASE, "agent"); asm volatile("s_waitcnt vmcnt(0)" ::: "memory"); } \
            (void)xb_add(cnt_, 1u); XB_SPIN(xb_ld(cnt_) < 4u * (unsigned)(ep), (unsigned*)(ctl + CW_BAR)); \
            __builtin_amdgcn_fence(__ATOMIC_ACQUIRE, "agent"); asm volatile("s_waitcnt vmcnt(0)" ::: "memory"); } \
        __syncthreads(); } } while (0)
    const int lo = args.ph_lo, hi = args.ph_hi;
#define IN(k) (lo <= (k) && (k) < hi)
#define BOTH(k) (IN(k) && IN((k) + 1))
    const int gw = vcu * NWAVES + wave, NGW = G * NWAVES;
#define TS_MARK() do {} while (0)

    if (IN(0)) {
        LAS float* scr = (LAS float*)(ldsp + RING_OFF + wave * 16384);
        constexpr int I_IN = 16 * 256, I_SQ = 16 * 32;
        constexpr int NT_ITEMS = I_IN + 2 * I_SQ;
        for (int it = gw; it < NT_ITEMS; it += NGW) {
            int r = it;
            if (r < I_IN) { transpose_item<true>(w_in, D, NIN, nullptr, Win_t, 0, scr, r, lane); continue; } r -= I_IN;
            if (r < I_SQ) { transpose_item<false>(xwk, D, D, nullptr, Wkv2_t, 0, scr, r, lane); continue; } r -= I_SQ;
            transpose_item<false>(xwv, D, D, nullptr, Wkv2_t, D, scr, r, lane);
        }
        for (int it = gw; it < 512; it += NGW) {
            const int hc = it >> 5, kt = (it >> 3) & 3, ks = it & 7, n = 32 * kt + (lane & 31), d0 = 16 * ks + 8 * (lane >> 5);
            const GAS f32x4* s = (const GAS f32x4*)(psk + ((size_t)(hc * 128 + n) * 128 + d0)); const f32x4 a = s[0], b = s[1];
            v4u o; o.x = pk2(a.x, a.y); o.y = pk2(a.z, a.w); o.z = pk2(b.x, b.y); o.w = pk2(b.z, b.w);
            *((GAS v4u*)SKb + (size_t)it * 64 + lane) = o; }
        for (int m = gw; m < M; m += 2 * NGW) rms_rows2_to_bf16(x + (size_t)m * D, (size_t)NGW, norm_mix, XN1 + (size_t)m * D, lane);
        for (int m = gw; m < MROWS; m += NGW) rms_row_to_bf16(mem + (size_t)m * D, norm_mem, MEMN + (size_t)m * D, lane);
        if (BOTH(0)) GRID_BAR();
        if (N_LAUNCHES == 1) gs_same = __builtin_popcount((unsigned)__builtin_amdgcn_readfirstlane((int)xb_ld((unsigned*)(ctl + GS_XCC(gs_pm))))) == 1;
        TS_MARK();
    }

    if (IN(1)) {
        pg8::GemmSet g{XN1, Win_t, XN1, Win_t, D}; pg8::TileOrder S; S.init(M, NIN, G, bx);
        pg8::EpiInProj E{B0, B1, B2, B3, CBb, B4, B5, 0.125f * LOG2E};
        pg8::gemm_phase<pg8::EpiInProj, pg8::TileOrder, true, true>(ldsp + RING_OFF, g, S, E);
        if (BOTH(1)) GRID_BAR();
        TS_MARK();
    }

    if (IN(2)) {
        TS_MARK();
        if (bx < 32) {
            pg8::GemmSet g{MEMN, Wkv2_t, MEMN, Wkv2_t, D}; pg8::SubOrder S; S.init(MROWS, D, 0, bx);
            pg8::EpiStore E{K2, D, 1.0f};
            pg8::gemm_phase<pg8::EpiStore, pg8::SubOrder, false, true>(ldsp + RING_OFF, g, S, E);
        } else if (bx < 64) {
            pg8::GemmSet g{Wkv2_t + (size_t)D * D, MEMN, Wkv2_t + (size_t)D * D, MEMN, D}; pg8::SubOrder S; S.init(D, MROWS, 32, bx);
            pg8::EpiStoreKPerm E{V2T, MROWS};
            pg8::gemm_phase<pg8::EpiStoreKPerm, pg8::SubOrder, false, true>(ldsp + RING_OFF, g, S, E);
        } else {
            const int cw_ = (bx - 64) * NWAVES + wave, ncw = (G - 64) * NWAVES;
            for (int it = cw_; it < M / 8; it += ncw) yconv_item(B3, CBb, conv_w, YC, it, lane);
            {
                LAS float* scr = (LAS float*)(ldsp + RING_OFF + wave * 16384);
                constexpr int I_SQ = 16 * 32, I_PQ = 16 * 64;
                for (int it = cw_; it < 5 * I_SQ + I_PQ; it += ncw) {
                    int r = it;
                    if (r < I_SQ) { transpose_item<false>(w_ba, D, D, nullptr, Wa_t, 0, scr, r, lane, 2 * D, 0); continue; } r -= I_SQ;
                    if (r < I_SQ) { transpose_item<false>(w_bc, D, D, nullptr, Wa_t, 0, scr, r, lane, 2 * D, D); continue; } r -= I_SQ;
                    if (r < I_SQ) { transpose_item<false>(w_out, D, D, nullptr, Wo_t, 0, scr, r, lane); continue; } r -= I_SQ;
                    if (r < I_SQ) { transpose_item<false>(xwq, D, D, norm_xattn, Wq2_t, 0, scr, r, lane); continue; } r -= I_SQ;
                    if (r < I_SQ) { transpose_item<false>(xwo, D, D, nullptr, Wo2_t, 0, scr, r, lane); continue; } r -= I_SQ;
                    transpose_item<false>(pwq, D, NPQ, norm_ffn, Wpq_t, 0, scr, r, lane);
                }
            }
        }
        {
            for (;;) {
                __syncthreads();
                if (tid == 0) { unsigned* qp_ = (unsigned*)(ctl + 48); asm volatile("" : "+s"(qp_)); MISC[12] = __hip_atomic_fetch_add(qp_, 1u, __ATOMIC_RELAXED, __HIP_MEMORY_SCOPE_AGENT); }
                __syncthreads();
                const int u = __builtin_amdgcn_readfirstlane((int)MISC[12]);
                if (u >= BATCH * 16 * 8) break;
                const int bh = u >> 3, qb = u & 7;
                sb::sb_unit<true>(bh >> 4, bh & 15, qb, (const sb::bf16*)B0, (const sb::bf16*)B1, (const sb::bf16*)B2, (sb::bf16*)B0, (char*)lds + RING_OFF); }
            asm volatile("s_waitcnt vmcnt(0) lgkmcnt(0)" ::: "memory"); __syncthreads();
        }
        if (BOTH(2)) GRID_BAR();
        TS_MARK();
    }

    if (IN(3)) {
        pg8::GemmSet g{B0, Wa_t, YC, Wa_t, D}; pg8::TileOrder S; S.init(M, D, G, bx);
        pg8::EpiMidK E{B1, B4, B5};
        pg8::gemm_phase<pg8::EpiMidK, pg8::TileOrder, true, true, true>(ldsp + RING_OFF, g, S, E);
        if (BOTH(3)) GROUP_SYNC(1);
        TS_MARK();
    }

    if (IN(4)) {
        pg8::GemmSet g{B1, Wo_t, B1, Wo_t, D}; pg8::TileOrder S; S.init(M, D, G, bx);
        pg8::EpiResid<false> E{x, nullptr, B2, SSQ1, (bool)(((bx >> 3) & 3) != 0)};
        pg8::gemm_phase<pg8::EpiResid<false>, pg8::TileOrder, true, true>(ldsp + RING_OFF, g, S, E);
        if (BOTH(4)) GROUP_SYNC(2);
        TS_MARK();
    }

    if (IN(5)) {
#define PEER_TABLES() do { _Pragma("unroll 1") for (int tb = 0; tb < 2; ++tb) { const float* src_ = tb ? pv : pu; const float* gn_ = tb ? nullptr : norm_ffn; const float sc_ = tb ? 4.0f : 64.0f; unsigned char* dst_ = tb ? (ws + WS_V6) : (ws + WS_U6); \
        _Pragma("unroll 1") for (int r = gw; r < 16384; r += 4 * NGW) rows_to_fp6<4>(src_ + (size_t)r * D, (size_t)NGW, gn_, sc_, dst_ + (size_t)r * 768, lane); } } while (0)
        if ((bx >> 3) & 1) { PEER_TABLES(); asm volatile("s_waitcnt vmcnt(0)" ::: "memory"); __syncthreads(); }
        pg8::GemmSet g{B2, Wq2_t, B2, Wq2_t, D}; pg8::TileOrder S; S.init(M, D, G, bx);
        pg8::EpiRowScale E{B3, D, SSQ1, LOG2E / 16.0f, RMS_EPS};
        pg8::gemm_phase<pg8::EpiRowScale, pg8::TileOrder, true, true>(ldsp + RING_OFF, g, S, E);
        asm volatile("s_waitcnt vmcnt(0)" ::: "memory"); __syncthreads();
        if (tid == 0) { __builtin_amdgcn_fence(__ATOMIC_ACQUIRE, "agent"); asm volatile("s_waitcnt vmcnt(0)" ::: "memory"); }
        __syncthreads();
        { pg8::Unit u;
          for (int i = 0; S.next(i, u); ++i) { const int b_ = u.pm >> 3, qh = 2 * (u.pm & 7);
              xa::bf16x8 qn_[8]; xa::xattn_unit<false>(b_, u.pn, qh, B3, K2, V2T, B0, (char*)lds + RING_OFF, qn_); xa::xattn_unit<true>(b_, u.pn, qh + 1, B3, K2, V2T, B0, (char*)lds + RING_OFF, qn_); }
          asm volatile("s_waitcnt vmcnt(0) lgkmcnt(0)" ::: "memory"); __syncthreads(); }
        if (!((bx >> 3) & 1)) { PEER_TABLES(); }
        if (BOTH(5) || BOTH(6)) GROUP_SYNC(3);
        TS_MARK();
    }

    if (IN(7)) {
        pg8::GemmSet g{B0, Wo2_t, B0, Wo2_t, D}; pg8::TileOrder S; S.init(M, D, G, bx);
        pg8::EpiResid<true> E{nullptr, B2, B1, SSQ2, false};
        pg8::gemm_phase<pg8::EpiResid<true>, pg8::TileOrder, true, true>(ldsp + RING_OFF, g, S, E);
        if (BOTH(7)) GROUP_SYNC(4);
        TS_MARK();
    }

    if (IN(8)) {
        pg8::GemmSet g{B1, Wpq_t, B1, Wpq_t, D}; pg8::TileOrder S; S.init(M, NPQ, G, bx);
        pg8::EpiRowScale E{B2, NPQ, SSQ2, 1.0f, RMS_EPS};
        pg8::gemm_phase<pg8::EpiRowScale, pg8::TileOrder, true, true>(ldsp + RING_OFF, g, S, E);
        if (BOTH(8)) GRID_BAR();
        TS_MARK();
    }

    if (IN(9)) {
        if (tid < 64) { int cnt = 0, val = 0;
            for (int ii = 0; ii < 16; ++ii) { const int nj = 16 / (ii + 1); if (tid >= cnt && tid < cnt + nj) val = ii | ((tid - cnt) << 4); cnt += nj; }
            ldsp[RING_OFF + peer::L_CAND + tid] = (unsigned char)val; }
        LDS_WAIT(); __syncthreads();
#ifndef NO_PEER
        for (int tile = vcu; tile < M / 32; tile += G) {
            peer::peer_tile(tile, B2, SKb, SSQ2, (const unsigned char*)(ws + WS_U6), (const unsigned char*)(ws + WS_V6), norm_final, B1, out, ldsp + RING_OFF); }
#else
        for (int m = gw; m < M; m += NGW) final_norm_row(out + (size_t)m * D, norm_final, out + (size_t)m * D, lane);
#endif
    }
#undef IN
#undef BOTH
#undef GRID_BAR
}

extern "C" void kernel_launch(void* const* d_in, const int* in_sizes, int n_in, void* d_out, int out_size, void* d_ws, size_t ws_size, hipStream_t stream) {
    static int grid = 0;
    if (grid == 0) {
        if (n_in != 20 || in_sizes[0] != M * D || out_size != M * D || ws_size < WS_END) { fprintf(stderr, "kernel_launch: unexpected shapes (n_in %d, in0 %d, out %d, ws %zu); nothing launched\n", n_in, n_in > 0 ? in_sizes[0] : -1, out_size, ws_size); grid = -1; return; }
        int dev = 0, cus = 0, per_cu = 0;
        if (hipGetDevice(&dev) != hipSuccess || hipDeviceGetAttribute(&cus, hipDeviceAttributeMultiprocessorCount, dev) != hipSuccess) { grid = -1; return; }
        if (hipFuncSetAttribute((const void*)fwd_megakernel, hipFuncAttributeMaxDynamicSharedMemorySize, LDS_BYTES) != hipSuccess) { fprintf(stderr, "kernel_launch: hipFuncSetAttribute failed\n"); grid = -1; return; }
        if (hipOccupancyMaxActiveBlocksPerMultiprocessor(&per_cu, (const void*)fwd_megakernel, NWAVES * 64, LDS_BYTES) != hipSuccess || per_cu < 1)
            fprintf(stderr, "kernel_launch: note: occupancy query reports %d workgroups per CU\n", per_cu);
        (void)hipGetLastError();
        if (cus < 256) { fprintf(stderr, "kernel_launch: this kernel's static work split needs 256 CUs (device reports %d); nothing launched\n", cus); grid = -1; return; }
        grid = 256;
    }
    if (grid < 0) return;
    if (hipMemsetAsync((char*)d_ws + WS_CTL, 0, CTL_ZERO_BYTES, stream) != hipSuccess) { fprintf(stderr, "kernel_launch: hipMemsetAsync failed\n"); return; }
    Args a{};
    for (int i = 0; i < 20; ++i) a.in[i] = (const float*)d_in[i];
    a.out = (float*)d_out; a.ws = (unsigned char*)d_ws;
    if (N_LAUNCHES == 1) { a.ph_lo = 0; a.ph_hi = N_PHASES; a.li = 0; hipLaunchKernelGGL(fwd_megakernel, dim3(grid), dim3(NWAVES * 64), LDS_BYTES, stream, a); }
    else for (int li = 0; li < N_PHASES; ++li) { a.ph_lo = li; a.ph_hi = li + 1; a.li = li; hipLaunchKernelGGL(fwd_megakernel, dim3(grid), dim3(NWAVES * 64), LDS_BYTES, stream, a);
    }
    const hipError_t le = hipPeekAtLastError();
    if (le != hipSuccess) fprintf(stderr, "kernel_launch: launch failed: %s\n", hipGetErrorName(le));
}
```
